# Optimizing an MI355X kernel written in HIP

```python
import math
import jax, jax.numpy as jnp
from jax import lax
import numpy as np

D_MODEL = 1024
BATCH = 16
SEQ = 2048
DEPTH = 2

N_MIXERS = 2
N_ATTN_LAYERS = (DEPTH + 1) // 2
N_MLSTM_LAYERS = DEPTH // 2

DA_HEADS = 8
DA_HEAD_DIM = 64
DA_V_DIM = 2 * DA_HEAD_DIM
DA_PROJ = 3 * DA_HEADS * 2 * DA_HEAD_DIM
Q_BLOCK = 128

REL_BUCKETS = 32
REL_MAX_DIST = 128

ML_HEADS = 4
ML_V_DIM = D_MODEL // ML_HEADS
ML_QK_DIM = ML_V_DIM // 2
ML_CHUNK = 64
CONV_WIDTH = 4
ML_QK_WIDTH = 2 * ML_HEADS * ML_QK_DIM
ML_V_WIDTH = ML_HEADS * ML_V_DIM
ML_PROJ = ML_QK_WIDTH + 2 * ML_V_WIDTH + 2 * ML_HEADS

D_FF = 4 * D_MODEL

EPS = 1e-6

kernel_name = "hybrid_diffattn_mlstm_sqrelu"


def rmsnorm(x, g):
    xf = x.astype(jnp.float32)
    y = xf * lax.rsqrt(jnp.mean(xf * xf, axis=-1, keepdims=True) + EPS)
    return (y * g.astype(jnp.float32)).astype(x.dtype)


def t5_causal_bucket(dist):
    max_exact = REL_BUCKETS // 2
    d = jnp.maximum(dist, 1).astype(jnp.float32)
    large = max_exact + (jnp.log(d / max_exact) / math.log(REL_MAX_DIST / max_exact)
                         * (REL_BUCKETS - max_exact)).astype(jnp.int32)
    large = jnp.minimum(large, REL_BUCKETS - 1)
    return jnp.where(dist < max_exact, dist, large)


def diff_attention(h, w_in, lq1, lk1, lq2, lk2, subln_w, w_out, rel_table, lambda_init):
    B, S, _ = h.shape
    qkv = h @ w_in
    q, k, v = jnp.split(qkv, 3, axis=-1)
    q = q.reshape(B, S, DA_HEADS, 2, DA_HEAD_DIM)
    k = k.reshape(B, S, DA_HEADS, 2, DA_HEAD_DIM)
    v = v.reshape(B, S, DA_HEADS, DA_V_DIM)
    lam = (jnp.exp(jnp.sum(lq1.astype(jnp.float32) * lk1.astype(jnp.float32)))
           - jnp.exp(jnp.sum(lq2.astype(jnp.float32) * lk2.astype(jnp.float32)))
           + lambda_init)
    scale = DA_HEAD_DIM ** -0.5
    outs = []
    for blk in range(S // Q_BLOCK):
        q0 = blk * Q_BLOCK
        kend = q0 + Q_BLOCK
        qb = q[:, q0:kend]
        kb = k[:, :kend]
        vb = v[:, :kend]
        dist = (q0 + jnp.arange(Q_BLOCK))[:, None] - jnp.arange(kend)[None, :]
        bias = rel_table[t5_causal_bucket(jnp.maximum(dist, 0))]
        bias = jnp.transpose(bias, (2, 0, 1)).astype(jnp.float32)
        logits = jnp.einsum('bqhmd,bkhmd->bmhqk', qb, kb).astype(jnp.float32) * scale + bias
        logits = jnp.where(dist >= 0, logits, -jnp.inf)
        p = jax.nn.softmax(logits, axis=-1)
        attn = p[:, 0] - lam * p[:, 1]
        outs.append(jnp.einsum('bhqk,bkhd->bqhd', attn.astype(vb.dtype), vb))
    o = jnp.concatenate(outs, axis=1)
    o = rmsnorm(o, subln_w) * (1.0 - lambda_init)
    return o.reshape(B, S, DA_HEADS * DA_V_DIM) @ w_out


def causal_depthwise_conv(x, w, b):
    C = x.shape[-1]
    y = lax.conv_general_dilated(x, w[:, None, :].astype(x.dtype), window_strides=(1,),
                                 padding=[(CONV_WIDTH - 1, 0)],
                                 dimension_numbers=('NWC', 'WIO', 'NWC'),
                                 feature_group_count=C)
    return y + b.astype(x.dtype)


def mlstm_chunkwise(q, k, v, i_pre, log_f):
    B, S, H, dk = q.shape
    dv = v.shape[-1]
    L = ML_CHUNK
    NC = S // L
    f32 = jnp.float32
    q = (q.astype(f32) * dk ** -0.5).reshape(B, NC, L, H, dk).transpose(0, 3, 1, 2, 4)
    k = k.astype(f32).reshape(B, NC, L, H, dk).transpose(0, 3, 1, 2, 4)
    v = v.astype(f32).reshape(B, NC, L, H, dv).transpose(0, 3, 1, 2, 4)
    ig = i_pre.astype(f32).reshape(B, NC, L, H).transpose(0, 3, 1, 2)
    lf = log_f.astype(f32).reshape(B, NC, L, H).transpose(0, 3, 1, 2)
    b = jnp.cumsum(lf, axis=-1)
    b_last = b[..., -1]

    a = b_last[..., None] - b + ig
    m_loc = jnp.max(a, axis=-1)
    wgt = jnp.exp(a - m_loc[..., None])
    C_loc = jnp.einsum('bhcsv,bhcsk->bhcvk', wgt[..., None] * v, k)
    n_loc = jnp.einsum('bhcs,bhcsk->bhck', wgt, k)

    def step(carry, inp):
        C, n, m = carry
        bl, Cl, nl, ml = inp
        m_new = jnp.maximum(bl + m, ml)
        decay = jnp.exp(bl + m - m_new)
        gain = jnp.exp(ml - m_new)
        C_new = decay[..., None, None] * C + gain[..., None, None] * Cl
        n_new = decay[..., None] * n + gain[..., None] * nl
        return (C_new, n_new, m_new), (C, n, m)

    init = (jnp.zeros((B, H, dv, dk), f32), jnp.zeros((B, H, dk), f32), jnp.zeros((B, H), f32))
    xs = (jnp.moveaxis(b_last, 2, 0), jnp.moveaxis(C_loc, 2, 0),
          jnp.moveaxis(n_loc, 2, 0), jnp.moveaxis(m_loc, 2, 0))
    _, (C_prev, n_prev, m_prev) = lax.scan(step, init, xs)
    C_prev = jnp.moveaxis(C_prev, 0, 2)
    n_prev = jnp.moveaxis(n_prev, 0, 2)
    m_prev = jnp.moveaxis(m_prev, 0, 2)

    causal = jnp.tril(jnp.ones((L, L), dtype=bool))
    D = b[..., :, None] - b[..., None, :] + ig[..., None, :]
    D = jnp.where(causal, D, -jnp.inf)
    m_inter = b + m_prev[..., None]
    m_j = jnp.maximum(m_inter, jnp.max(D, axis=-1))
    Sc = jnp.einsum('bhcjk,bhcsk->bhcjs', q, k) * jnp.exp(D - m_j[..., None])
    inter = jnp.exp(m_inter - m_j)
    num = (jnp.einsum('bhcjs,bhcsv->bhcjv', Sc, v)
           + inter[..., None] * jnp.einsum('bhcjk,bhcvk->bhcjv', q, C_prev))
    den = jnp.sum(Sc, axis=-1) + inter * jnp.einsum('bhcjk,bhck->bhcj', q, n_prev)
    h = num / jnp.maximum(jnp.abs(den), jnp.exp(-m_j))[..., None]
    return h.transpose(0, 2, 3, 1, 4).reshape(B, S, H, dv)


def mlstm_mixer(h, w_in, b_i, b_f, conv_w, conv_b, head_norm_w, w_out):
    B, S, _ = h.shape
    proj = h @ w_in
    qk = proj[..., :ML_QK_WIDTH]
    v = proj[..., ML_QK_WIDTH:ML_QK_WIDTH + ML_V_WIDTH]
    o_pre = proj[..., ML_QK_WIDTH + ML_V_WIDTH:ML_QK_WIDTH + 2 * ML_V_WIDTH]
    gates = proj[..., ML_QK_WIDTH + 2 * ML_V_WIDTH:].astype(jnp.float32)
    qk = jax.nn.silu(causal_depthwise_conv(qk, conv_w, conv_b))
    q = qk[..., :ML_QK_WIDTH // 2].reshape(B, S, ML_HEADS, ML_QK_DIM)
    k = qk[..., ML_QK_WIDTH // 2:].reshape(B, S, ML_HEADS, ML_QK_DIM)
    v = v.reshape(B, S, ML_HEADS, ML_V_DIM)
    i_pre = gates[..., :ML_HEADS] + b_i.astype(jnp.float32)
    log_f = jax.nn.log_sigmoid(gates[..., ML_HEADS:] + b_f.astype(jnp.float32))
    ht = mlstm_chunkwise(q, k, v, i_pre, log_f)
    ht = rmsnorm(ht, head_norm_w.reshape(ML_HEADS, ML_V_DIM))
    out = jax.nn.sigmoid(o_pre.astype(jnp.float32)) * ht.reshape(B, S, ML_V_WIDTH)
    return out.astype(h.dtype) @ w_out


def sqrelu_mlp(h, w1, w2):
    return jnp.square(jax.nn.relu(h @ w1)) @ w2


def setup_inputs(seed: int = 0) -> dict:
    key = jax.random.key(seed)
    ks = jax.random.split(key, 24)
    f32 = jnp.float32
    nA, nM = N_ATTN_LAYERS, N_MLSTM_LAYERS

    def nrm(k, shape, scale):
        return jax.random.normal(k, shape, f32) * scale

    def gain(k, shape):
        return 1.0 + 0.05 * jax.random.normal(k, shape, f32)

    return {
        "x": jax.random.normal(ks[0], (BATCH, SEQ, D_MODEL), f32),
        "rel_bias": nrm(ks[1], (REL_BUCKETS, DA_HEADS), 0.5),
        "attn_norm": gain(ks[2], (nA, D_MODEL)),
        "attn_w_in": nrm(ks[3], (nA, D_MODEL, DA_PROJ), D_MODEL ** -0.5),
        "attn_lambda_q1": nrm(ks[4], (nA, DA_HEAD_DIM), 0.1),
        "attn_lambda_k1": nrm(ks[5], (nA, DA_HEAD_DIM), 0.1),
        "attn_lambda_q2": nrm(ks[6], (nA, DA_HEAD_DIM), 0.1),
        "attn_lambda_k2": nrm(ks[7], (nA, DA_HEAD_DIM), 0.1),
        "attn_subln": gain(ks[8], (nA, DA_V_DIM)),
        "attn_w_out": nrm(ks[9], (nA, DA_HEADS * DA_V_DIM, D_MODEL), (DA_HEADS * DA_V_DIM) ** -0.5),
        "mlstm_norm": gain(ks[10], (nM, D_MODEL)),
        "mlstm_w_in": nrm(ks[11], (nM, D_MODEL, ML_PROJ), D_MODEL ** -0.5),
        "mlstm_b_i": nrm(ks[12], (nM, ML_HEADS), 0.1),
        "mlstm_b_f": jnp.broadcast_to(jnp.linspace(3.0, 6.0, ML_HEADS, dtype=f32), (nM, ML_HEADS))
                     + nrm(ks[13], (nM, ML_HEADS), 0.01),
        "mlstm_conv_w": nrm(ks[14], (nM, CONV_WIDTH, ML_QK_WIDTH), CONV_WIDTH ** -0.5),
        "mlstm_conv_b": nrm(ks[15], (nM, ML_QK_WIDTH), 0.02),
        "mlstm_head_norm": gain(ks[16], (nM, ML_V_WIDTH)),
        "mlstm_w_out": nrm(ks[17], (nM, ML_V_WIDTH, D_MODEL), ML_V_WIDTH ** -0.5),
        "mlp_norm": gain(ks[18], (DEPTH, D_MODEL)),
        "mlp_w1": nrm(ks[19], (DEPTH, D_MODEL, D_FF), D_MODEL ** -0.5),
        "mlp_w2": nrm(ks[20], (DEPTH, D_FF, D_MODEL), D_FF ** -0.5),
        "final_norm": gain(ks[21], (D_MODEL,)),
    }


def reference(x, rel_bias, attn_norm, attn_w_in, attn_lambda_q1, attn_lambda_k1,
              attn_lambda_q2, attn_lambda_k2, attn_subln, attn_w_out,
              mlstm_norm, mlstm_w_in, mlstm_b_i, mlstm_b_f, mlstm_conv_w, mlstm_conv_b,
              mlstm_head_norm, mlstm_w_out, mlp_norm, mlp_w1, mlp_w2, final_norm):
    h = x
    for layer in range(DEPTH):
        j = layer // N_MIXERS
        if layer % N_MIXERS == 0:
            lambda_init = 0.8 - 0.6 * math.exp(-0.3 * layer)
            mix = diff_attention(rmsnorm(h, attn_norm[j]), attn_w_in[j],
                                 attn_lambda_q1[j], attn_lambda_k1[j],
                                 attn_lambda_q2[j], attn_lambda_k2[j],
                                 attn_subln[j], attn_w_out[j], rel_bias, lambda_init)
        else:
            mix = mlstm_mixer(rmsnorm(h, mlstm_norm[j]), mlstm_w_in[j], mlstm_b_i[j],
                              mlstm_b_f[j], mlstm_conv_w[j], mlstm_conv_b[j],
                              mlstm_head_norm[j], mlstm_w_out[j])
        h = h + mix.astype(h.dtype)
        h = h + sqrelu_mlp(rmsnorm(h, mlp_norm[layer]), mlp_w1[layer], mlp_w2[layer]).astype(h.dtype)
    return rmsnorm(h, final_norm)
```

```cpp
#include <hip/hip_runtime.h>
#include <cstdio>
#include <cstdint>
namespace pg8 {
#define PG8_LAS __attribute__((address_space(3)))
typedef unsigned short bf16_t;
typedef short bf16x8 __attribute__((ext_vector_type(8)));
typedef float f32x4 __attribute__((ext_vector_type(4)));
typedef unsigned u32x4 __attribute__((ext_vector_type(4)));
constexpr int BM = 256, BK = 64, HALF = 128, HTB = HALF * BK * 2  , STAGE_BYTES = 8 * HTB, NXCD = 8, WGM = 8;

__host__ __device__ __forceinline__ int lds_byte(int r, int c) { const int st = (r >> 4) * 2 + (c >> 5), rr = r & 15, cc = c & 31, ob = rr * 64 + cc * 2; return st * 1024 + (ob ^ (((ob >> 9) & 1) << 5)); }
__host__ __device__ __forceinline__ void stage_rc(int b, int& R, int& C) { const int st = b / 1024, sb = b % 1024, swz = sb ^ (((sb >> 9) & 1) << 5); R = (st >> 1) * 16 + swz / 64; C = (st & 1) * 32 + (swz % 64) / 2; }
__host__ __device__ __forceinline__ int perm32(int rho) { const int n = rho >> 4, i = rho & 15; return 8 * (i >> 2) + 4 * n + (i & 3); }

struct Unit { int pm, pn; };
struct Gemm { const bf16_t* A; const bf16_t* Bt; int M, N, K; };

struct StaticOrder {
    int nM, nN, nwg, G, c;
    __host__ __device__ void init(int M, int N, int G_, int c_) { nM = M / BM; nN = N / BM; nwg = nM * nN; G = G_; c = c_; }
    __host__ __device__ bool next(int i, Unit& u) const {
        const long L = (long)i * G + c; if (L >= nwg) return false;
        int wgid = (int)L; { const int q = nwg / NXCD, r = nwg % NXCD, xcd = wgid % NXCD, off = wgid / NXCD; wgid = (xcd < r ? xcd * (q + 1) : r * (q + 1) + (xcd - r) * q) + off; }
        const int nig = WGM * nN, gid = wgid / nig, fm = gid * WGM, gsz = (nM - fm) < WGM ? (nM - fm) : WGM;
        u.pm = fm + ((wgid % nig) % gsz); u.pn = (wgid % nig) / gsz; return true;
    }
    __device__ __forceinline__ void a_ready(const Unit&) const {}
    __device__ __forceinline__ void done(const Unit&) const {}
};

__device__ __forceinline__ unsigned cvt_pk_bf16(float lo, float hi) { unsigned r; asm volatile("v_cvt_pk_bf16_f32 %0, %1, %2" : "=v"(r) : "v"(lo), "v"(hi)); return r; }
template <int ACT> struct EpiBf16 {
    static constexpr bool PERM = true, AFTER_DRAIN = false;
    bf16_t* O; int ldc; int scale_cols; float scale0;
    __device__ __forceinline__ void operator()(const f32x4 (&acc)[2][2][4][2], const Unit& u, int wr, int wc, int fr, int fq) const {
        const int row0 = u.pm * BM + wr * 64 + fr; const int colt = u.pn * BM;
        const float sc = (colt < scale_cols) ? scale0 : 1.f;
        const int col0 = colt + wc * 32 + 8 * fq;
#pragma unroll
        for (int ai = 0; ai < 2; ++ai)
#pragma unroll
            for (int m = 0; m < 4; ++m) { bf16_t* rowp = O + (size_t)(row0 + ai * HALF + m * 16) * ldc + col0;
#pragma unroll
                for (int bj = 0; bj < 2; ++bj) { f32x4 v0 = acc[ai][bj][m][0], v1 = acc[ai][bj][m][1];
                    if (ACT == 2) {
#pragma unroll
                        for (int e = 0; e < 4; ++e) { const float a = fmaxf(v0[e], 0.f), b = fmaxf(v1[e], 0.f); v0[e] = a * a; v1[e] = b * b; } }
                    v0 = v0 * sc; v1 = v1 * sc; u32x4 w; w.x = cvt_pk_bf16(v0[0], v0[1]); w.y = cvt_pk_bf16(v0[2], v0[3]); w.z = cvt_pk_bf16(v1[0], v1[1]); w.w = cvt_pk_bf16(v1[2], v1[3]);
                    *(u32x4*)(rowp + bj * HALF) = w; } }
    }
};
struct EpiResF32 {
    static constexpr bool PERM = false, AFTER_DRAIN = false;
    const float* base; float* out; int ldc;
    __device__ __forceinline__ void operator()(const f32x4 (&acc)[2][2][4][2], const Unit& u, int wr, int wc, int fr, int fq) const {
        const int row0 = u.pm * BM + wr * 64 + fr; const int col0 = u.pn * BM + wc * 32 + 4 * fq;
#pragma unroll
        for (int ai = 0; ai < 2; ++ai)
#pragma unroll
            for (int m = 0; m < 4; ++m) { const size_t off = (size_t)(row0 + ai * HALF + m * 16) * ldc + col0;
#pragma unroll
                for (int bj = 0; bj < 2; ++bj)
#pragma unroll
                    for (int n = 0; n < 2; ++n) { const f32x4 bs = *(const f32x4*)(base + off + bj * HALF + n * 16);
                        *(f32x4*)(out + off + bj * HALF + n * 16) = bs + acc[ai][bj][m][n]; } }
    }
};

template <class Epi, class Sched, bool ALIGN_EPI = false, bool SP2 = false>
__device__ __forceinline__ void gemm_phase(PG8_LAS unsigned char* lds, const Gemm g, const Sched& S, const Epi& E) {
    const int tid = threadIdx.x, wid = __builtin_amdgcn_readfirstlane(tid >> 6), lane = tid & 63, wr = wid >> 2, wc = wid & 3, fr = lane & 15, fq = lane >> 4;
    const int K = g.K, nt = K / BK;
    unsigned voffA[2], voffB[2];
#pragma unroll
    for (int i = 0; i < 2; ++i) { int R, C; stage_rc(tid * 16 + i * 8192, R, C); const int Rb = Epi::PERM ? ((R & ~31) + perm32(R & 31)) : R;
        voffA[i] = (unsigned)(R * K + C) * 2u; voffB[i] = (unsigned)(Rb * K + C) * 2u; }
    const size_t kstep = (size_t)(BK * 2);
    const size_t hstep = (size_t)HALF * K * 2;
    const size_t tstep = 2 * hstep;
    const unsigned ldsw = (unsigned)wid * 1024u;
    const int aoff = lds_byte(wr * 64 + fr, fq * 8), boff = lds_byte(wc * 32 + fr, fq * 8);
#define PG8_SA(b, h) (((b) * 2 + (h)) * HTB)
#define PG8_SB(b, h) ((4 + (b) * 2 + (h)) * HTB)
#define PG8_STAGE(bufoff, gbase, voff) do { _Pragma("unroll") for (int _i = 0; _i < 2; ++_i) \
        __builtin_amdgcn_global_load_lds((const unsigned*)((const char*)(gbase) + (voff)[_i]), (PG8_LAS unsigned*)(lds + (bufoff) + ldsw + _i * 8192), 16, 0, 0); } while (0)
#define PG8_LDA(dst, b, h) do { _Pragma("unroll") for (int m = 0; m < 4; ++m) _Pragma("unroll") for (int k = 0; k < 2; ++k) dst[m][k] = *(const PG8_LAS bf16x8*)(lds + PG8_SA(b, h) + aoff + m * 2048 + k * 1024); } while (0)
#define PG8_LDB(dst, b, h) do { _Pragma("unroll") for (int n = 0; n < 2; ++n) _Pragma("unroll") for (int k = 0; k < 2; ++k) dst[n][k] = *(const PG8_LAS bf16x8*)(lds + PG8_SB(b, h) + boff + n * 2048 + k * 1024); } while (0)
#define PG8_MMA(ai, bj, At, Bt) do { __builtin_amdgcn_s_setprio(1); _Pragma("unroll") for (int m = 0; m < 4; ++m) _Pragma("unroll") for (int n = 0; n < 2; ++n) _Pragma("unroll") for (int k = 0; k < 2; ++k) \
        acc[ai][bj][m][n] = __builtin_amdgcn_mfma_f32_16x16x32_bf16(Bt[n][k], At[m][k], acc[ai][bj][m][n], 0, 0, 0); __builtin_amdgcn_s_setprio(0); } while (0)
#define PG8_WAIT_V(n) asm volatile("s_waitcnt vmcnt(" #n ")" ::: "memory")
#define PG8_WAIT_L(n) asm volatile("s_waitcnt lgkmcnt(" #n ")" ::: "memory")
#define PG8_BAR __builtin_amdgcn_s_barrier()
#define PG8_SCHED __builtin_amdgcn_sched_barrier(0)
    Unit cur, nxt; int ui = 0;
    if (!S.next(0, cur)) return;
    f32x4 acc[2][2][4][2];
#pragma unroll
    for (int a = 0; a < 2; ++a)
#pragma unroll
        for (int b = 0; b < 2; ++b)
#pragma unroll
            for (int m = 0; m < 4; ++m)
#pragma unroll
                for (int n = 0; n < 2; ++n) acc[a][b][m][n] = (f32x4){0.f, 0.f, 0.f, 0.f};
    bf16x8 At[4][2], B0[2][2], B1[2][2];
    const char* cA = (const char*)g.A + (size_t)cur.pm * tstep; const char* cB = (const char*)g.Bt + (size_t)cur.pn * tstep;
    S.a_ready(cur);
    if constexpr (SP2) {
        PG8_STAGE(PG8_SB(0, 0), cB, voffB); PG8_STAGE(PG8_SB(0, 1), cB + hstep, voffB); PG8_STAGE(PG8_SA(0, 0), cA, voffA); PG8_STAGE(PG8_SA(0, 1), cA + hstep, voffA);
        if (wr == 1) PG8_BAR;
        PG8_WAIT_V(2); PG8_BAR;
        PG8_STAGE(PG8_SB(1, 0), cB + kstep, voffB); PG8_STAGE(PG8_SA(1, 0), cA + kstep, voffA); PG8_STAGE(PG8_SB(1, 1), cB + hstep + kstep, voffB);
        PG8_WAIT_V(6); PG8_BAR;
    } else {
        PG8_STAGE(PG8_SB(0, 0), cB, voffB); PG8_STAGE(PG8_SA(0, 0), cA, voffA); PG8_STAGE(PG8_SB(0, 1), cB + hstep, voffB); PG8_STAGE(PG8_SA(0, 1), cA + hstep, voffA);
        if (wr == 1) PG8_BAR;
        PG8_WAIT_V(4); PG8_BAR;
        PG8_STAGE(PG8_SB(1, 0), cB + kstep, voffB); PG8_STAGE(PG8_SA(1, 0), cA + kstep, voffA); PG8_STAGE(PG8_SB(1, 1), cB + hstep + kstep, voffB);
        PG8_WAIT_V(6); PG8_BAR;
    }
    for (;;) {
        const bool has_next = S.next(ui + 1, nxt);
        const char* nA = has_next ? (const char*)g.A + (size_t)nxt.pm * tstep : cA; const char* nB = has_next ? (const char*)g.Bt + (size_t)nxt.pn * tstep : cB;
        for (int t = 0; t < nt; t += 2) {
            const bool last = (t == nt - 2);
            const char* a1 = cA + (size_t)(t + 1) * kstep;
            const char* a2 = last ? nA : cA + (size_t)(t + 2) * kstep; const char* b2 = last ? nB : cB + (size_t)(t + 2) * kstep;
            const char* a3 = a2 + kstep; const char* b3 = b2 + kstep;
            if (last && has_next) S.a_ready(nxt);
            if constexpr (SP2) {
            PG8_LDB(B0, 0, 0); PG8_LDB(B1, 0, 1); PG8_SCHED; PG8_LDA(At, 0, 0); PG8_STAGE(PG8_SA(1, 1), a1 + hstep, voffA);
            PG8_WAIT_V(8); PG8_WAIT_L(0); PG8_BAR; PG8_MMA(0, 0, At, B0); PG8_MMA(0, 1, At, B1); PG8_BAR; PG8_SCHED;
            PG8_LDA(At, 0, 1); PG8_STAGE(PG8_SB(0, 0), b2, voffB); PG8_STAGE(PG8_SB(0, 1), b2 + hstep, voffB); PG8_STAGE(PG8_SA(0, 0), a2, voffA);
            PG8_WAIT_V(8); PG8_WAIT_L(0); PG8_BAR; PG8_MMA(1, 0, At, B0); PG8_MMA(1, 1, At, B1); PG8_BAR; PG8_SCHED;
            PG8_LDB(B0, 1, 0); PG8_LDB(B1, 1, 1); PG8_SCHED; PG8_LDA(At, 1, 0); PG8_STAGE(PG8_SA(0, 1), a2 + hstep, voffA);
            PG8_WAIT_V(8); PG8_WAIT_L(0); PG8_BAR; PG8_MMA(0, 0, At, B0); PG8_MMA(0, 1, At, B1); PG8_BAR; PG8_SCHED;
            PG8_LDA(At, 1, 1); PG8_STAGE(PG8_SB(1, 0), b3, voffB); PG8_STAGE(PG8_SB(1, 1), b3 + hstep, voffB); PG8_STAGE(PG8_SA(1, 0), a3, voffA);
            PG8_WAIT_V(8); PG8_WAIT_L(0); PG8_BAR; PG8_MMA(1, 0, At, B0); PG8_MMA(1, 1, At, B1); PG8_BAR; PG8_SCHED;
            } else {
            PG8_LDB(B0, 0, 0); PG8_SCHED; PG8_LDA(At, 0, 0); PG8_STAGE(PG8_SA(1, 1), a1 + hstep, voffA);
            PG8_WAIT_L(8); PG8_BAR; PG8_WAIT_L(0); PG8_MMA(0, 0, At, B0); PG8_BAR; PG8_SCHED;
            PG8_LDB(B1, 0, 1); PG8_STAGE(PG8_SB(0, 0), b2, voffB);
            PG8_BAR; PG8_WAIT_L(0); PG8_MMA(0, 1, At, B1); PG8_BAR;
            PG8_LDA(At, 0, 1); PG8_STAGE(PG8_SA(0, 0), a2, voffA);
            PG8_BAR; PG8_WAIT_L(0); PG8_MMA(1, 0, At, B0); PG8_BAR; PG8_SCHED;
            PG8_STAGE(PG8_SB(0, 1), b2 + hstep, voffB);
            PG8_WAIT_V(6); PG8_BAR; PG8_MMA(1, 1, At, B1); PG8_BAR;
            PG8_LDB(B0, 1, 0); PG8_SCHED; PG8_LDA(At, 1, 0); PG8_STAGE(PG8_SA(0, 1), a2 + hstep, voffA);
            PG8_WAIT_L(8); PG8_BAR; PG8_WAIT_L(0); PG8_MMA(0, 0, At, B0); PG8_BAR; PG8_SCHED;
            PG8_LDB(B1, 1, 1); PG8_STAGE(PG8_SB(1, 0), b3, voffB);
            PG8_BAR; PG8_WAIT_L(0); PG8_MMA(0, 1, At, B1); PG8_BAR;
            PG8_LDA(At, 1, 1); PG8_STAGE(PG8_SA(1, 0), a3, voffA);
            PG8_BAR; PG8_WAIT_L(0); PG8_MMA(1, 0, At, B0); PG8_BAR; PG8_SCHED;
            PG8_STAGE(PG8_SB(1, 1), b3 + hstep, voffB);
            PG8_WAIT_V(6); PG8_BAR; PG8_MMA(1, 1, At, B1); PG8_BAR;
            }
        }
        if constexpr (ALIGN_EPI) { if (wr == 0) PG8_BAR; }
        if constexpr (!Epi::AFTER_DRAIN) { E(acc, cur, wr, wc, fr, fq); S.done(cur); }
        if (!has_next) break;
#pragma unroll
        for (int a = 0; a < 2; ++a)
#pragma unroll
            for (int b = 0; b < 2; ++b)
#pragma unroll
                for (int m = 0; m < 4; ++m)
#pragma unroll
                    for (int n = 0; n < 2; ++n) acc[a][b][m][n] = (f32x4){0.f, 0.f, 0.f, 0.f};
        cur = nxt; cA = nA; cB = nB; ++ui;
        if constexpr (ALIGN_EPI) { if (wr == 1) PG8_BAR; }
    }
    PG8_WAIT_V(0);
    if constexpr (!ALIGN_EPI) { if (wr == 0) PG8_BAR; }
    PG8_BAR;
    if constexpr (Epi::AFTER_DRAIN) { E.fused(acc, cur, wr, wc, fr, fq, lds, wid, lane); S.done(cur); }
#undef PG8_SA
#undef PG8_SB
#undef PG8_STAGE
#undef PG8_LDA
#undef PG8_LDB
#undef PG8_MMA
#undef PG8_WAIT_V
#undef PG8_WAIT_L
#undef PG8_BAR
#undef PG8_SCHED
}
}

#ifndef PG8_SP2
#define PG8_SP2 true
#endif
#ifndef PG8_ALIGN
#define PG8_ALIGN true
#endif
constexpr int NWAVES = 8;
#ifndef MK_N_LAUNCHES
#define MK_N_LAUNCHES 1
#endif
constexpr int BATCH = 16, SEQ = 2048, D = 1024, FF = 4096, M = BATCH * SEQ;
constexpr int NQKV = 3072;
constexpr int MLW = 3080, NPROJ = 3072;
constexpr int NH_A = 8, NH_M = 4;
constexpr float EPS = 1e-6f, LOG2E = 1.4426950408889634f;
constexpr float QSCALE = 0.125f * LOG2E;
constexpr float LAMBDA_INIT0 = 0.2f;
constexpr float MQSCALE = 0.08838834764831845f;
constexpr int NPHASE = 16;

constexpr size_t MiB = 1u << 20;
constexpr size_t WS_CTL = 0, CTL_ZERO_BYTES = 1 * MiB;
constexpr size_t WS_WQKV = 2 * MiB, WS_WAO = 8 * MiB, WS_WML = 10 * MiB, WS_WMO = 16 * MiB, WS_W1 = 18 * MiB  , WS_W2 = 34 * MiB  ;
constexpr size_t WS_WG = 50 * MiB;
constexpr size_t WS_GATES = 51 * MiB;
constexpr size_t WS_SSQ = 52 * MiB;
constexpr size_t WS_XN = 64 * MiB;
constexpr size_t WS_U = 128 * MiB;
constexpr size_t WS_HT = 320 * MiB;
constexpr size_t WS_T0 = 384 * MiB;
constexpr size_t WS_END = 384 * MiB;
constexpr int CW_TMO = 0, CW_CODE = 1;
constexpr int CW_BAR = 4096;
constexpr int RING_OFF = 0, RING_BYTES = 131072;
constexpr int LDSCTL_OFF = RING_BYTES, MISC_OFF = LDSCTL_OFF + 320;
constexpr int LDS_BYTES = 147456;
static_assert(MISC_OFF + 128 <= LDS_BYTES, "LDS map");

#define GAS __attribute__((address_space(1)))
#define LAS __attribute__((address_space(3)))
typedef unsigned short bf16;
typedef unsigned v4u __attribute__((ext_vector_type(4)));
typedef float f32x4 __attribute__((ext_vector_type(4)));
typedef short bf16x8 __attribute__((ext_vector_type(8)));
typedef GAS unsigned gu32;
typedef GAS unsigned long long gu64;
#define RLX_AGENT __ATOMIC_RELAXED, __HIP_MEMORY_SCOPE_AGENT
#define LDS_WAIT() asm volatile("s_waitcnt lgkmcnt(0)" ::: "memory")
#define VM_WAIT() asm volatile("s_waitcnt vmcnt(0)" ::: "memory")
__device__ __forceinline__ unsigned long long rt() { return __builtin_amdgcn_s_memrealtime(); }
__device__ __forceinline__ unsigned f2bf(float f) { unsigned u = __builtin_bit_cast(unsigned, f); return (u + 0x7fffu + ((u >> 16) & 1u)) >> 16; }
__device__ __forceinline__ unsigned pk2(float lo, float hi) { return f2bf(lo) | (f2bf(hi) << 16); }

#define XB_TMO      128
#define XB_XCNT(j)  (256  + 64 * (j))
#define XB_XSUB(j)  (1280 + 64 * (j))
#define XB_XGEN(j)  (2304 + 64 * (j))
#define XB_TOP      3328
#define XB_TOPGEN   3392
#define XCD_BAR_WORDS 3456
#define XB_SPIN_CAP (1u << 18)

__device__ __forceinline__ unsigned xb_ld(unsigned* p)              { return __hip_atomic_load(p, __ATOMIC_RELAXED, __HIP_MEMORY_SCOPE_AGENT); }
__device__ __forceinline__ unsigned xb_add(unsigned* p, unsigned v) { return __hip_atomic_fetch_add(p, v, __ATOMIC_RELAXED, __HIP_MEMORY_SCOPE_AGENT); }
__device__ __forceinline__ unsigned xb_xcc_id() { return (unsigned)__builtin_amdgcn_s_getreg((3 << 11) | 20) & 0xFu; }
#define XB_SPIN(cond, bar) do { unsigned _sp = 0; while (cond) { __builtin_amdgcn_s_sleep(1); \
    if ((++_sp & 255u) == 0u) { if (xb_ld(&(bar)[XB_TMO])) break; if (_sp > XB_SPIN_CAP) { atomicAdd(&(bar)[XB_TMO], 1u); break; } } } } while (0)

struct XcdBarrier {
    unsigned* bar; unsigned x;
    volatile LAS unsigned* st;
};

__device__ __forceinline__ XcdBarrier xcd_barrier_post(unsigned* bar, volatile LAS unsigned* st) {
    XcdBarrier b; b.bar = bar; b.x = xb_xcc_id(); b.st = st;
    if (threadIdx.x == 0) (void)xb_add(&bar[XB_XCNT(b.x)], 1u);
    return b;
}
__device__ __forceinline__ void xcd_barrier_complete(unsigned* bar, unsigned x, unsigned& nloc, unsigned& nx) {
    const unsigned G = gridDim.x * gridDim.y * gridDim.z;
    unsigned sum, cnt, mine, sp = 0u;
    for (;;) {
        sum = 0u; cnt = 0u; mine = 0u;
#pragma unroll
        for (unsigned j = 0; j < 16; ++j) { const unsigned c = xb_ld(&bar[XB_XCNT(j)]); sum += c; cnt += (c > 0u) ? 1u : 0u; mine = (j == x) ? c : mine; }
        if (sum == G) break;
        __builtin_amdgcn_s_sleep(1);
        if ((++sp & 255u) == 0u) { if (xb_ld(&bar[XB_TMO])) break; if (sp > XB_SPIN_CAP) { atomicAdd(&bar[XB_TMO], 1u); break; } }
    }
    nloc = mine > 0u ? mine : 1u; nx = cnt > 0u ? cnt : 1u;
}

__device__ __forceinline__ void xcd_barrier(const XcdBarrier& b) {
    asm volatile("s_waitcnt vmcnt(0)" ::: "memory");
    __syncthreads();
    if (threadIdx.x == 0) {
        unsigned* bar = b.bar;
        __builtin_amdgcn_s_waitcnt(0);
        unsigned nloc = b.st[0], nx = b.st[1];
        if (nloc == 0u) { xcd_barrier_complete(bar, b.x, nloc, nx); b.st[0] = nloc; b.st[1] = nx; }
        const unsigned old = xb_add(&bar[XB_XSUB(b.x)], 1u);
        const unsigned gen = old / nloc;
        if (old + 1u == (gen + 1u) * nloc) {
            __builtin_amdgcn_fence(__ATOMIC_RELEASE, "agent");
            asm volatile("s_waitcnt vmcnt(0)" ::: "memory");
            const unsigned og = xb_add(&bar[XB_TOP], 1u);
            const unsigned tg = og / nx;
            if (og + 1u == (tg + 1u) * nx) xb_add(&bar[XB_TOPGEN], 1u);
            else XB_SPIN(xb_ld(&bar[XB_TOPGEN]) == tg, bar);
            __builtin_amdgcn_fence(__ATOMIC_ACQUIRE, "agent");
            xb_add(&bar[XB_XGEN(b.x)], 1u);
            asm volatile("s_waitcnt vmcnt(0)" ::: "memory");
        } else {
            XB_SPIN(xb_ld(&bar[XB_XGEN(b.x)]) == gen, bar);
            __builtin_amdgcn_fence(__ATOMIC_ACQUIRE, "agent");
            asm volatile("s_waitcnt vmcnt(0)" ::: "memory");
        }
    }
    __syncthreads();
}

struct Frame {
    LAS unsigned char* lds;
    volatile LAS unsigned* MISC;
    gu32* ctl;
    int tid, lane, wave;
    int vcu, G;
};
__device__ __forceinline__ float wave_sum(float v) {
#pragma unroll
    for (int o = 1; o < 64; o <<= 1) v += __shfl_xor(v, o);
    return v;
}
__device__ __forceinline__ void p0_transpose_item(const float* W, int K, int ldw, int nblk, bf16* WT, const float* gk, int gmask, float gs, LAS float* scr, int item, int lane) {
    const int kb = item / nblk, nb = item % nblk, k0 = 64 * kb, n0 = 32 * nb;
#pragma unroll 8
    for (int i = 0; i < 32; ++i) { const int kk = 2 * i + (lane >> 5); const float g = gk ? gk[(k0 + kk) & gmask] * gs : gs;
        scr[kk * 33 + (lane & 31)] = W[(size_t)(k0 + kk) * ldw + n0 + (lane & 31)] * g; }
    LDS_WAIT(); asm volatile("" ::: "memory");
    const int c = lane & 7;
#pragma unroll
    for (int j = 0; j < 4; ++j) { const int n = (lane >> 3) + 8 * j; const LAS float* s = scr + (8 * c) * 33 + n;
        v4u o; o.x = pk2(s[0 * 33], s[1 * 33]); o.y = pk2(s[2 * 33], s[3 * 33]); o.z = pk2(s[4 * 33], s[5 * 33]); o.w = pk2(s[6 * 33], s[7 * 33]);
        *(GAS v4u*)(WT + (size_t)(n0 + n) * K + k0 + 8 * c) = o; }
    LDS_WAIT(); asm volatile("" ::: "memory");
}
__device__ __forceinline__ void rms_row_load(const float* xrow, int lane, f32x4 (&v)[4]) {
    const GAS f32x4* xr = (const GAS f32x4*)xrow + lane; float s2 = 0.f;
#pragma unroll
    for (int j = 0; j < 4; ++j) { v[j] = xr[64 * j]; s2 += (v[j].x * v[j].x + v[j].y * v[j].y) + (v[j].z * v[j].z + v[j].w * v[j].w); }
    const float rstd = 1.f / sqrtf(wave_sum(s2) * (1.f / D) + EPS);
#pragma unroll
    for (int j = 0; j < 4; ++j) v[j] = v[j] * rstd;
}
__device__ __forceinline__ void row_store_bf16(bf16* orow, int lane, const f32x4 (&v)[4]) {
    GAS unsigned long long* o8 = (GAS unsigned long long*)orow + lane;
#pragma unroll
    for (int j = 0; j < 4; ++j) o8[64 * j] = (unsigned long long)pk2(v[j].x, v[j].y) | ((unsigned long long)pk2(v[j].z, v[j].w) << 32);
}
__device__ __forceinline__ float log_sigmoid(float x) { return fminf(x, 0.f) - log1pf(expf(-fabsf(x))); }

struct Args { const float* in[22]; float* out; unsigned char* ws; int ph_lo, ph_hi, li, pad; };

__device__ __forceinline__ void p0_prologue(Frame& F, const Args& a) {
    unsigned char* ws = a.ws;
    LAS float* scr = (LAS float*)(F.lds + RING_OFF + F.wave * 16384);
    const int gw = F.vcu * NWAVES + F.wave, NGW = F.G * NWAVES;
    constexpr int I_QKV = (D / 64) * (NQKV / 32), I_O = (D / 64) * (D / 32), I_ML = (D / 64) * (NPROJ / 32), I_1 = (D / 64) * (FF / 32), I_2 = (FF / 64) * (D / 32);
    constexpr int NITEMS = I_QKV + I_O + I_ML + I_O + 2 * I_1 + 2 * I_2;
    for (int it = gw; it < NITEMS; it += NGW) {
        int r = it;
        if (r < I_QKV) { p0_transpose_item(a.in[3], D, NQKV, NQKV / 32, (bf16*)(ws + WS_WQKV), a.in[2], 0xffff, 1.f, scr, r, F.lane); continue; } r -= I_QKV;
        if (r < I_O) { p0_transpose_item(a.in[9], D, D, D / 32, (bf16*)(ws + WS_WAO), a.in[8], 127, 1.f - LAMBDA_INIT0, scr, r, F.lane); continue; } r -= I_O;
        if (r < I_ML) { p0_transpose_item(a.in[11], D, MLW, NPROJ / 32, (bf16*)(ws + WS_WML), a.in[10], 0xffff, 1.f, scr, r, F.lane); continue; } r -= I_ML;
        if (r < I_O) { p0_transpose_item(a.in[17], D, D, D / 32, (bf16*)(ws + WS_WMO), a.in[16], 0xffff, 1.f, scr, r, F.lane); continue; } r -= I_O;
        if (r < 2 * I_1) { const int l = r / I_1; p0_transpose_item(a.in[19] + (size_t)l * D * FF, D, FF, FF / 32, (bf16*)(ws + WS_W1) + (size_t)l * D * FF, a.in[18] + l * D, 0xffff, 1.f, scr, r % I_1, F.lane); continue; } r -= 2 * I_1;
        { const int l = r / I_2; p0_transpose_item(a.in[20] + (size_t)l * D * FF, FF, D, D / 32, (bf16*)(ws + WS_W2) + (size_t)l * D * FF, nullptr, 0, 1.f, scr, r % I_2, F.lane); }
    }
    { float* WG = (float*)(ws + WS_WG); const int gt = (F.vcu * NWAVES + F.wave) * 64 + F.lane, NGT = F.G * NWAVES * 64;
      for (int i = gt; i < 8 * D; i += NGT) { const int j = i / D, k = i % D; WG[i] = a.in[10][k] * a.in[11][(size_t)k * MLW + NPROJ + j]; } }
    bf16* XN = (bf16*)(ws + WS_XN);
    for (int m = gw; m < M; m += NGW) { f32x4 v[4]; rms_row_load(a.in[0] + (size_t)m * D, F.lane, v); row_store_bf16(XN + (size_t)m * D, F.lane, v); }
}
__device__ __forceinline__ void norm_phase(Frame& F, const float* H, bf16* XN, const float* WG, float* GATES, const float* b_i, const float* b_f) {
    const int gw = F.vcu * NWAVES + F.wave, NGW = F.G * NWAVES;
    LAS f32x4* wg = (LAS f32x4*)(F.lds + RING_OFF);
    if (GATES) { for (int i = F.tid; i < 8 * D / 4; i += NWAVES * 64) wg[i] = ((const GAS f32x4*)WG)[i]; __syncthreads(); }
    for (int m = gw; m < M; m += NGW) {
        f32x4 v[4]; rms_row_load(H + (size_t)m * D, F.lane, v); row_store_bf16(XN + (size_t)m * D, F.lane, v);
        if (GATES) {
            float mine = 0.f;
#pragma unroll
            for (int j = 0; j < 8; ++j) { float s = 0.f;
#pragma unroll
                for (int jj = 0; jj < 4; ++jj) { const f32x4 w = wg[j * 256 + jj * 64 + F.lane]; s += (v[jj].x * w.x + v[jj].y * w.y) + (v[jj].z * w.z + v[jj].w * w.w); }
                s = wave_sum(s); if (F.lane == j) mine = s; }
            if (F.lane < 4) GATES[(size_t)m * 8 + F.lane] = mine + b_i[F.lane];
            else if (F.lane < 8) GATES[(size_t)m * 8 + F.lane] = log_sigmoid(mine + b_f[F.lane - 4]);
        }
    }
    if (GATES) __syncthreads();
}
__device__ __forceinline__ void final_norm_phase(Frame& F, const float* H, const float* g, float* out) {
    const int gw = F.vcu * NWAVES + F.wave, NGW = F.G * NWAVES;
    for (int m = gw; m < M; m += NGW) {
        f32x4 v[4]; rms_row_load(H + (size_t)m * D, F.lane, v);
        GAS f32x4* o = (GAS f32x4*)(out + (size_t)m * D) + F.lane; const GAS f32x4* gg = (const GAS f32x4*)g + F.lane;
#pragma unroll
        for (int j = 0; j < 4; ++j) o[64 * j] = v[j] * gg[64 * j];
    }
}

__global__ void __launch_bounds__(NWAVES * 64, 2) fwd(Args args) {
    extern __shared__ __attribute__((aligned(16))) unsigned char lds[];
    Frame F;
    F.lds = (LAS unsigned char*)lds;
    F.MISC = (volatile LAS unsigned*)(F.lds + MISC_OFF);
    F.tid = threadIdx.x; F.lane = F.tid & 63; F.wave = __builtin_amdgcn_readfirstlane(F.tid >> 6);
    F.G = gridDim.x; { const int bx = blockIdx.x; F.vcu = (F.G % 8 == 0) ? (bx % 8) * (F.G / 8) + bx / 8 : bx; }
    unsigned char* ws = args.ws;
    F.ctl = (gu32*)(ws + WS_CTL);
    for (int u = F.tid; u < (LDS_BYTES - LDSCTL_OFF) / 4; u += NWAVES * 64) ((LAS unsigned*)(F.lds + LDSCTL_OFF))[u] = 0u;
    __syncthreads();
    const int lo = args.ph_lo, hi = args.ph_hi;
    const bool use_bar = (hi - lo) > 1;
    XcdBarrier bar; bar.bar = (unsigned*)(F.ctl + CW_BAR) + args.li * XCD_BAR_WORDS; bar.x = 0; bar.st = nullptr;
    if (use_bar) bar = xcd_barrier_post((unsigned*)(F.ctl + CW_BAR) + args.li * XCD_BAR_WORDS, F.MISC + 8);
#define IN(k) (lo <= (k) && (k) < hi)
#define SEAM(k) do { if (IN(k) && IN((k) + 1)) xcd_barrier(bar); } while (0)
    bf16* const XN = (bf16*)(ws + WS_XN); bf16* const AO = XN; bf16* const QKV = (bf16*)(ws + WS_U); bf16* const U = (bf16*)(ws + WS_U);
    float* const H = args.out;
    using pg8::Gemm; using pg8::StaticOrder; using pg8::EpiBf16; using pg8::EpiResF32;

    if (IN(0)) { p0_prologue(F, args); SEAM(0); }
    if (IN(1)) { Gemm g{XN, (const bf16*)(ws + WS_WQKV), M, NQKV, D}; StaticOrder S; S.init(M, NQKV, F.G, (int)blockIdx.x);
        EpiBf16<0> E{QKV, NQKV, D, QSCALE}; pg8::gemm_phase<EpiBf16<0>, StaticOrder, PG8_ALIGN, PG8_SP2>(F.lds + RING_OFF, g, S, E); SEAM(1); }
    if (IN(3)) { Gemm g{AO, (const bf16*)(ws + WS_WAO), M, D, D}; StaticOrder S; S.init(M, D, F.G, (int)blockIdx.x);
        EpiResF32 E{args.in[0], H, D}; pg8::gemm_phase<EpiResF32, StaticOrder, PG8_ALIGN, PG8_SP2>(F.lds + RING_OFF, g, S, E); SEAM(3); }
    if (IN(4)) { norm_phase(F, H, XN, nullptr, nullptr, nullptr, nullptr); SEAM(4); }
    if (IN(5)) { Gemm g{XN, (const bf16*)(ws + WS_W1), M, FF, D}; StaticOrder S; S.init(M, FF, F.G, (int)blockIdx.x);
        EpiBf16<2> E{U, FF, 0, 1.f}; pg8::gemm_phase<EpiBf16<2>, StaticOrder, PG8_ALIGN, PG8_SP2>(F.lds + RING_OFF, g, S, E); SEAM(5); }
    if (IN(6)) { Gemm g{U, (const bf16*)(ws + WS_W2), M, D, FF}; StaticOrder S; S.init(M, D, F.G, (int)blockIdx.x);
        EpiResF32 E{H, H, D}; pg8::gemm_phase<EpiResF32, StaticOrder, PG8_ALIGN, PG8_SP2>(F.lds + RING_OFF, g, S, E); SEAM(6); }
    if (IN(7)) { norm_phase(F, H, XN, (const float*)(ws + WS_WG), (float*)(ws + WS_GATES), args.in[12], args.in[13]); SEAM(7); }
    if (IN(8)) { Gemm g{XN, (const bf16*)(ws + WS_WML), M, NPROJ, D}; StaticOrder S; S.init(M, NPROJ, F.G, (int)blockIdx.x);
        EpiBf16<0> E{QKV, NPROJ, 0, 1.f}; pg8::gemm_phase<EpiBf16<0>, StaticOrder, PG8_ALIGN, PG8_SP2>(F.lds + RING_OFF, g, S, E); SEAM(8); }
    if (IN(11)) { Gemm g{AO, (const bf16*)(ws + WS_WMO), M, D, D}; StaticOrder S; S.init(M, D, F.G, (int)blockIdx.x);
        EpiResF32 E{H, H, D}; pg8::gemm_phase<EpiResF32, StaticOrder, PG8_ALIGN, PG8_SP2>(F.lds + RING_OFF, g, S, E); SEAM(11); }
    if (IN(12)) { norm_phase(F, H, XN, nullptr, nullptr, nullptr, nullptr); SEAM(12); }
    if (IN(13)) { Gemm g{XN, (const bf16*)(ws + WS_W1) + (size_t)D * FF, M, FF, D}; StaticOrder S; S.init(M, FF, F.G, (int)blockIdx.x);
        EpiBf16<2> E{U, FF, 0, 1.f}; pg8::gemm_phase<EpiBf16<2>, StaticOrder, PG8_ALIGN, PG8_SP2>(F.lds + RING_OFF, g, S, E); SEAM(13); }
    if (IN(14)) { Gemm g{U, (const bf16*)(ws + WS_W2) + (size_t)D * FF, M, D, FF}; StaticOrder S; S.init(M, D, F.G, (int)blockIdx.x);
        EpiResF32 E{H, H, D}; pg8::gemm_phase<EpiResF32, StaticOrder, PG8_ALIGN, PG8_SP2>(F.lds + RING_OFF, g, S, E); SEAM(14); }
    if (IN(15)) { final_norm_phase(F, H, args.in[21], args.out); }
#undef IN
#undef SEAM
}

__device__ __forceinline__ float bf2f(bf16 v) { return __uint_as_float((unsigned)v << 16); }
__device__ __forceinline__ int t5_bucket(int d) {
    if (d < 16) return d;
    const float v = logf((float)d / 16.f) / logf(8.f) * 16.f; int b = 16 + (int)v; return b > 31 ? 31 : b;
}
__global__ void __launch_bounds__(256) naive_attn(const bf16* __restrict__ QKV, const float* __restrict__ rel_bias, const float* __restrict__ lq1, const float* __restrict__ lk1,
                                                  const float* __restrict__ lq2, const float* __restrict__ lk2, float* T0, bf16* AO) {
    __shared__ float lut[128];
    const int tid = threadIdx.x, h = blockIdx.y, b = blockIdx.z, q0 = blockIdx.x * 128, q = q0 + (tid >> 1), half = tid & 1;
    if (tid < 128) lut[tid] = rel_bias[t5_bucket(tid) * NH_A + h] * LOG2E;
    float s1 = 0.f, s2 = 0.f;
    for (int i = 0; i < 64; ++i) { s1 += lq1[i] * lk1[i]; s2 += lq2[i] * lk2[i]; }
    const float lam = expf(s1) - expf(s2) + LAMBDA_INIT0;
    __syncthreads();
    const size_t tok = (size_t)b * SEQ + q;
    float res[64];
    for (int m = 0; m < 2; ++m) {
        float qv[64];
        const bf16* qp = QKV + tok * NQKV + h * 128 + m * 64;
#pragma unroll
        for (int d = 0; d < 64; ++d) qv[d] = bf2f(qp[d]);
        float o[64];
#pragma unroll
        for (int d = 0; d < 64; ++d) o[d] = 0.f;
        float mrun = -1e30f, l = 0.f;
        const int kend = q0 + 128;
        for (int k = 0; k < kend; ++k) {
            const bf16* kr = QKV + ((size_t)b * SEQ + k) * NQKV + D + h * 128 + m * 64;
            const bf16* vr = QKV + ((size_t)b * SEQ + k) * NQKV + 2 * D + h * 128 + half * 64;
            float s = 0.f;
#pragma unroll
            for (int d = 0; d < 64; ++d) s += qv[d] * bf2f(kr[d]);
            const int dist = q - k;
            if (dist >= 0) {
                s += lut[dist < 127 ? dist : 127];
                if (s > mrun) { const float al = exp2f(mrun - s); l *= al;
#pragma unroll
                    for (int d = 0; d < 64; ++d) o[d] *= al;
                    mrun = s; }
                const float p = exp2f(s - mrun); l += p;
#pragma unroll
                for (int d = 0; d < 64; ++d) o[d] += p * bf2f(vr[d]);
            }
        }
        const float il = 1.f / l;
        if (m == 0) {
#pragma unroll
            for (int d = 0; d < 64; ++d) res[d] = o[d] * il;
        } else {
            float ss = 0.f;
#pragma unroll
            for (int d = 0; d < 64; ++d) { res[d] = res[d] - lam * (o[d] * il); ss += res[d] * res[d]; }
            ss += __shfl_xor(ss, 1);
            const float rstd = 1.f / sqrtf(ss * (1.f / 128.f) + EPS);
            bf16* op = AO + tok * D + h * 128 + half * 64;
#pragma unroll
            for (int d = 0; d < 64; d += 2) *(unsigned*)(op + d) = pk2(res[d] * rstd, res[d + 1] * rstd);
        }
    }
    (void)T0;
}
__global__ void __launch_bounds__(512) naive_mlstm(const bf16* __restrict__ PROJ, const float* __restrict__ GATES, const float* __restrict__ conv_w, const float* __restrict__ conv_b, bf16* AO) {
    __shared__ float q_s[128], k_s[128], v_s[256], red[8];
    const int tid = threadIdx.x, h = blockIdx.x & 3, b = blockIdx.x >> 2, dv = tid >> 1, half = tid & 1, lane = tid & 63, wave = tid >> 6;
    float C[64], n[64];
#pragma unroll
    for (int j = 0; j < 64; ++j) { C[j] = 0.f; n[j] = 0.f; }
    float mst = 0.f;
    const int col = (tid < 128) ? (h * 128 + tid) : (512 + h * 128 + (tid - 128));
    float cw0 = 0.f, cw1 = 0.f, cw2 = 0.f, cw3 = 0.f, cb = 0.f;
    if (tid < 256) { cw0 = conv_w[0 * D + col]; cw1 = conv_w[1 * D + col]; cw2 = conv_w[2 * D + col]; cw3 = conv_w[3 * D + col]; cb = conv_b[col]; }
    for (int t = 0; t < SEQ; ++t) {
        const size_t tok = (size_t)b * SEQ + t;
        if (tid < 256) {
            float x3 = bf2f(PROJ[tok * NPROJ + col]);
            float x2 = t >= 1 ? bf2f(PROJ[(tok - 1) * NPROJ + col]) : 0.f;
            float x1 = t >= 2 ? bf2f(PROJ[(tok - 2) * NPROJ + col]) : 0.f;
            float x0 = t >= 3 ? bf2f(PROJ[(tok - 3) * NPROJ + col]) : 0.f;
            float y = cw0 * x0 + cw1 * x1 + cw2 * x2 + cw3 * x3 + cb;
            y = y / (1.f + expf(-y));
            if (tid < 128) q_s[tid] = y * MQSCALE; else k_s[tid - 128] = y;
        } else {
            v_s[tid - 256] = bf2f(PROJ[tok * NPROJ + 1024 + h * 256 + (tid - 256)]);
        }
        const float ig = GATES[tok * 8 + h], lf = GATES[tok * 8 + 4 + h];
        __syncthreads();
        const float mnew = fmaxf(lf + mst, ig), fd = expf(lf + mst - mnew), gi = expf(ig - mnew);
        mst = mnew;
        const float gv = gi * v_s[dv];
        float num = 0.f, den = 0.f;
#pragma unroll
        for (int j = 0; j < 64; ++j) { const float kk = k_s[half * 64 + j], qq = q_s[half * 64 + j];
            C[j] = fd * C[j] + gv * kk; n[j] = fd * n[j] + gi * kk; num += C[j] * qq; den += n[j] * qq; }
        num += __shfl_xor(num, 1); den += __shfl_xor(den, 1);
        const float hv = num / fmaxf(fabsf(den), expf(-mnew));
        float ss = half == 0 ? hv * hv : 0.f;
        ss = wave_sum(ss);
        if (lane == 0) red[wave] = ss;
        __syncthreads();
        float tot = 0.f;
#pragma unroll
        for (int w = 0; w < 8; ++w) tot += red[w];
        const float rstd = 1.f / sqrtf(tot * (1.f / 256.f) + EPS);
        if (half == 0) { const float op = bf2f(PROJ[tok * NPROJ + 2048 + h * 256 + dv]); const float sg = 1.f / (1.f + expf(-op));
            AO[tok * D + h * 256 + dv] = (bf16)f2bf(sg * hv * rstd); }
        __syncthreads();
    }
}

extern "C" void kernel_launch(void* const* d_in, const int* in_sizes, int n_in, void* d_out, int out_size, void* d_ws, size_t ws_size, hipStream_t stream) {
    static int grid = 0;
    if (grid == 0) {
        if (n_in != 22 || in_sizes[0] != M * D || out_size != M * D || ws_size < WS_END) { fprintf(stderr, "kernel_launch: unexpected shapes (n_in %d, in0 %d, out %d, ws %zu); nothing launched\n", n_in, n_in > 0 ? in_sizes[0] : -1, out_size, ws_size); grid = -1; return; }
        int dev = 0, cus = 0, per_cu = 0;
        if (hipGetDevice(&dev) != hipSuccess || hipDeviceGetAttribute(&cus, hipDeviceAttributeMultiprocessorCount, dev) != hipSuccess) { grid = -1; return; }
        if (hipFuncSetAttribute((const void*)fwd, hipFuncAttributeMaxDynamicSharedMemorySize, LDS_BYTES) != hipSuccess) { fprintf(stderr, "kernel_launch: hipFuncSetAttribute failed\n"); grid = -1; return; }
        if (hipOccupancyMaxActiveBlocksPerMultiprocessor(&per_cu, (const void*)fwd, NWAVES * 64, LDS_BYTES) != hipSuccess || per_cu < 1) fprintf(stderr, "kernel_launch: occupancy query says %d\n", per_cu);
        (void)hipGetLastError();
        grid = cus;
    }
    if (grid < 0) return;
    (void)hipMemsetAsync((char*)d_ws + WS_CTL, 0, CTL_ZERO_BYTES, stream);
    Args a{};
    for (int i = 0; i < 22; ++i) a.in[i] = (const float*)d_in[i];
    a.out = (float*)d_out; a.ws = (unsigned char*)d_ws;
    unsigned char* ws = (unsigned char*)d_ws;
    int li = 0;
    auto run = [&](int lo, int hi) { a.ph_lo = lo; a.ph_hi = hi; a.li = li++; hipLaunchKernelGGL(fwd, dim3(grid), dim3(NWAVES * 64), LDS_BYTES, stream, a); };
    run(0, 1); run(1, 2);
    hipLaunchKernelGGL(naive_attn, dim3(SEQ / 128, NH_A, BATCH), dim3(256), 0, stream, (const bf16*)(ws + WS_U), a.in[1], a.in[4], a.in[5], a.in[6], a.in[7], (float*)(ws + WS_T0), (bf16*)(ws + WS_XN));
    run(3, 4); run(4, 5); run(5, 6); run(6, 7); run(7, 8); run(8, 9);
    hipLaunchKernelGGL(naive_mlstm, dim3(BATCH * NH_M), dim3(512), 0, stream, (const bf16*)(ws + WS_U), (const float*)(ws + WS_GATES), a.in[14], a.in[15], (bf16*)(ws + WS_XN));
    run(11, 12); run(12, 13); run(13, 14); run(14, 15); run(15, 16);
}
```

```cpp
#include <hip/hip_runtime.h>
#include <cstdio>
#include <cstdint>
namespace pg8 {
#define PG8_LAS __attribute__((address_space(3)))
typedef unsigned short bf16_t;
typedef short bf16x8 __attribute__((ext_vector_type(8)));
typedef float f32x4 __attribute__((ext_vector_type(4)));
typedef unsigned u32x4 __attribute__((ext_vector_type(4)));
constexpr int BM = 256, BK = 64, HALF = 128, HTB = HALF * BK * 2  , STAGE_BYTES = 8 * HTB, NXCD = 8, WGM = 8;

__host__ __device__ __forceinline__ int lds_byte(int r, int c) { const int st = (r >> 4) * 2 + (c >> 5), rr = r & 15, cc = c & 31, ob = rr * 64 + cc * 2; return st * 1024 + (ob ^ (((ob >> 9) & 1) << 5)); }
__host__ __device__ __forceinline__ void stage_rc(int b, int& R, int& C) { const int st = b / 1024, sb = b % 1024, swz = sb ^ (((sb >> 9) & 1) << 5); R = (st >> 1) * 16 + swz / 64; C = (st & 1) * 32 + (swz % 64) / 2; }
__host__ __device__ __forceinline__ int perm32(int rho) { const int n = rho >> 4, i = rho & 15; return 8 * (i >> 2) + 4 * n + (i & 3); }

struct Unit { int pm, pn; };
struct Gemm { const bf16_t* A; const bf16_t* Bt; int M, N, K; };

struct StaticOrder {
    int nM, nN, nwg, G, c;
    __host__ __device__ void init(int M, int N, int G_, int c_) { nM = M / BM; nN = N / BM; nwg = nM * nN; G = G_; c = c_; }
    __host__ __device__ bool next(int i, Unit& u) const {
        const long L = (long)i * G + c; if (L >= nwg) return false;
        int wgid = (int)L; { const int q = nwg / NXCD, r = nwg % NXCD, xcd = wgid % NXCD, off = wgid / NXCD; wgid = (xcd < r ? xcd * (q + 1) : r * (q + 1) + (xcd - r) * q) + off; }
        const int nig = WGM * nN, gid = wgid / nig, fm = gid * WGM, gsz = (nM - fm) < WGM ? (nM - fm) : WGM;
        u.pm = fm + ((wgid % nig) % gsz); u.pn = (wgid % nig) / gsz; return true;
    }
    __device__ __forceinline__ void a_ready(const Unit&) const {}
    __device__ __forceinline__ void done(const Unit&) const {}
};

__device__ __forceinline__ unsigned cvt_pk_bf16(float lo, float hi) { unsigned r; asm volatile("v_cvt_pk_bf16_f32 %0, %1, %2" : "=v"(r) : "v"(lo), "v"(hi)); return r; }
template <int ACT> struct EpiBf16 {
    static constexpr bool PERM = true, AFTER_DRAIN = false;
    bf16_t* O; int ldc; int scale_cols; float scale0;
    __device__ __forceinline__ void operator()(const f32x4 (&acc)[2][2][4][2], const Unit& u, int wr, int wc, int fr, int fq) const {
        const int row0 = u.pm * BM + wr * 64 + fr; const int colt = u.pn * BM;
        const float sc = (colt < scale_cols) ? scale0 : 1.f;
        const int col0 = colt + wc * 32 + 8 * fq;
#pragma unroll
        for (int ai = 0; ai < 2; ++ai)
#pragma unroll
            for (int m = 0; m < 4; ++m) { bf16_t* rowp = O + (size_t)(row0 + ai * HALF + m * 16) * ldc + col0;
#pragma unroll
                for (int bj = 0; bj < 2; ++bj) { f32x4 v0 = acc[ai][bj][m][0], v1 = acc[ai][bj][m][1];
                    if (ACT == 2) {
#pragma unroll
                        for (int e = 0; e < 4; ++e) { const float a = fmaxf(v0[e], 0.f), b = fmaxf(v1[e], 0.f); v0[e] = a * a; v1[e] = b * b; } }
                    v0 = v0 * sc; v1 = v1 * sc; u32x4 w; w.x = cvt_pk_bf16(v0[0], v0[1]); w.y = cvt_pk_bf16(v0[2], v0[3]); w.z = cvt_pk_bf16(v1[0], v1[1]); w.w = cvt_pk_bf16(v1[2], v1[3]);
                    *(u32x4*)(rowp + bj * HALF) = w; } }
    }
};
struct EpiResF32 {
    static constexpr bool PERM = false, AFTER_DRAIN = false;
    const float* base; float* out; int ldc;
    __device__ __forceinline__ void operator()(const f32x4 (&acc)[2][2][4][2], const Unit& u, int wr, int wc, int fr, int fq) const {
        const int row0 = u.pm * BM + wr * 64 + fr; const int col0 = u.pn * BM + wc * 32 + 4 * fq;
#pragma unroll
        for (int ai = 0; ai < 2; ++ai)
#pragma unroll
            for (int m = 0; m < 4; ++m) { const size_t off = (size_t)(row0 + ai * HALF + m * 16) * ldc + col0;
#pragma unroll
                for (int bj = 0; bj < 2; ++bj)
#pragma unroll
                    for (int n = 0; n < 2; ++n) { const f32x4 bs = *(const f32x4*)(base + off + bj * HALF + n * 16);
                        *(f32x4*)(out + off + bj * HALF + n * 16) = bs + acc[ai][bj][m][n]; } }
    }
};

template <class Epi, class Sched, bool ALIGN_EPI = false, bool SP2 = false>
__device__ __forceinline__ void gemm_phase(PG8_LAS unsigned char* lds, const Gemm g, const Sched& S, const Epi& E) {
    const int tid = threadIdx.x, wid = __builtin_amdgcn_readfirstlane(tid >> 6), lane = tid & 63, wr = wid >> 2, wc = wid & 3, fr = lane & 15, fq = lane >> 4;
    const int K = g.K, nt = K / BK;
    unsigned voffA[2], voffB[2];
#pragma unroll
    for (int i = 0; i < 2; ++i) { int R, C; stage_rc(tid * 16 + i * 8192, R, C); const int Rb = Epi::PERM ? ((R & ~31) + perm32(R & 31)) : R;
        voffA[i] = (unsigned)(R * K + C) * 2u; voffB[i] = (unsigned)(Rb * K + C) * 2u; }
    const size_t kstep = (size_t)(BK * 2);
    const size_t hstep = (size_t)HALF * K * 2;
    const size_t tstep = 2 * hstep;
    const unsigned ldsw = (unsigned)wid * 1024u;
    const int aoff = lds_byte(wr * 64 + fr, fq * 8), boff = lds_byte(wc * 32 + fr, fq * 8);
#define PG8_SA(b, h) (((b) * 2 + (h)) * HTB)
#define PG8_SB(b, h) ((4 + (b) * 2 + (h)) * HTB)
#define PG8_STAGE(bufoff, gbase, voff) do { _Pragma("unroll") for (int _i = 0; _i < 2; ++_i) \
        __builtin_amdgcn_global_load_lds((const unsigned*)((const char*)(gbase) + (voff)[_i]), (PG8_LAS unsigned*)(lds + (bufoff) + ldsw + _i * 8192), 16, 0, 0); } while (0)
#define PG8_LDA(dst, b, h) do { _Pragma("unroll") for (int m = 0; m < 4; ++m) _Pragma("unroll") for (int k = 0; k < 2; ++k) dst[m][k] = *(const PG8_LAS bf16x8*)(lds + PG8_SA(b, h) + aoff + m * 2048 + k * 1024); } while (0)
#define PG8_LDB(dst, b, h) do { _Pragma("unroll") for (int n = 0; n < 2; ++n) _Pragma("unroll") for (int k = 0; k < 2; ++k) dst[n][k] = *(const PG8_LAS bf16x8*)(lds + PG8_SB(b, h) + boff + n * 2048 + k * 1024); } while (0)
#define PG8_MMA(ai, bj, At, Bt) do { __builtin_amdgcn_s_setprio(1); _Pragma("unroll") for (int m = 0; m < 4; ++m) _Pragma("unroll") for (int n = 0; n < 2; ++n) _Pragma("unroll") for (int k = 0; k < 2; ++k) \
        acc[ai][bj][m][n] = __builtin_amdgcn_mfma_f32_16x16x32_bf16(Bt[n][k], At[m][k], acc[ai][bj][m][n], 0, 0, 0); __builtin_amdgcn_s_setprio(0); } while (0)
#define PG8_WAIT_V(n) asm volatile("s_waitcnt vmcnt(" #n ")" ::: "memory")
#define PG8_WAIT_L(n) asm volatile("s_waitcnt lgkmcnt(" #n ")" ::: "memory")
#define PG8_BAR __builtin_amdgcn_s_barrier()
#define PG8_SCHED __builtin_amdgcn_sched_barrier(0)
    Unit cur, nxt; int ui = 0;
    if (!S.next(0, cur)) return;
    f32x4 acc[2][2][4][2];
#pragma unroll
    for (int a = 0; a < 2; ++a)
#pragma unroll
        for (int b = 0; b < 2; ++b)
#pragma unroll
            for (int m = 0; m < 4; ++m)
#pragma unroll
                for (int n = 0; n < 2; ++n) acc[a][b][m][n] = (f32x4){0.f, 0.f, 0.f, 0.f};
    bf16x8 At[4][2], B0[2][2], B1[2][2];
    const char* cA = (const char*)g.A + (size_t)cur.pm * tstep; const char* cB = (const char*)g.Bt + (size_t)cur.pn * tstep;
    S.a_ready(cur);
    if constexpr (SP2) {
        PG8_STAGE(PG8_SB(0, 0), cB, voffB); PG8_STAGE(PG8_SB(0, 1), cB + hstep, voffB); PG8_STAGE(PG8_SA(0, 0), cA, voffA); PG8_STAGE(PG8_SA(0, 1), cA + hstep, voffA);
        if (wr == 1) PG8_BAR;
        PG8_WAIT_V(2); PG8_BAR;
        PG8_STAGE(PG8_SB(1, 0), cB + kstep, voffB); PG8_STAGE(PG8_SA(1, 0), cA + kstep, voffA); PG8_STAGE(PG8_SB(1, 1), cB + hstep + kstep, voffB);
        PG8_WAIT_V(6); PG8_BAR;
    } else {
        PG8_STAGE(PG8_SB(0, 0), cB, voffB); PG8_STAGE(PG8_SA(0, 0), cA, voffA); PG8_STAGE(PG8_SB(0, 1), cB + hstep, voffB); PG8_STAGE(PG8_SA(0, 1), cA + hstep, voffA);
        if (wr == 1) PG8_BAR;
        PG8_WAIT_V(4); PG8_BAR;
        PG8_STAGE(PG8_SB(1, 0), cB + kstep, voffB); PG8_STAGE(PG8_SA(1, 0), cA + kstep, voffA); PG8_STAGE(PG8_SB(1, 1), cB + hstep + kstep, voffB);
        PG8_WAIT_V(6); PG8_BAR;
    }
    for (;;) {
        const bool has_next = S.next(ui + 1, nxt);
        const char* nA = has_next ? (const char*)g.A + (size_t)nxt.pm * tstep : cA; const char* nB = has_next ? (const char*)g.Bt + (size_t)nxt.pn * tstep : cB;
        for (int t = 0; t < nt; t += 2) {
            const bool last = (t == nt - 2);
            const char* a1 = cA + (size_t)(t + 1) * kstep;
            const char* a2 = last ? nA : cA + (size_t)(t + 2) * kstep; const char* b2 = last ? nB : cB + (size_t)(t + 2) * kstep;
            const char* a3 = a2 + kstep; const char* b3 = b2 + kstep;
            if (last && has_next) S.a_ready(nxt);
            if constexpr (SP2) {
            PG8_LDB(B0, 0, 0); PG8_LDB(B1, 0, 1); PG8_SCHED; PG8_LDA(At, 0, 0); PG8_STAGE(PG8_SA(1, 1), a1 + hstep, voffA);
            PG8_WAIT_V(8); PG8_WAIT_L(0); PG8_BAR; PG8_MMA(0, 0, At, B0); PG8_MMA(0, 1, At, B1); PG8_BAR; PG8_SCHED;
            PG8_LDA(At, 0, 1); PG8_STAGE(PG8_SB(0, 0), b2, voffB); PG8_STAGE(PG8_SB(0, 1), b2 + hstep, voffB); PG8_STAGE(PG8_SA(0, 0), a2, voffA);
            PG8_WAIT_V(8); PG8_WAIT_L(0); PG8_BAR; PG8_MMA(1, 0, At, B0); PG8_MMA(1, 1, At, B1); PG8_BAR; PG8_SCHED;
            PG8_LDB(B0, 1, 0); PG8_LDB(B1, 1, 1); PG8_SCHED; PG8_LDA(At, 1, 0); PG8_STAGE(PG8_SA(0, 1), a2 + hstep, voffA);
            PG8_WAIT_V(8); PG8_WAIT_L(0); PG8_BAR; PG8_MMA(0, 0, At, B0); PG8_MMA(0, 1, At, B1); PG8_BAR; PG8_SCHED;
            PG8_LDA(At, 1, 1); PG8_STAGE(PG8_SB(1, 0), b3, voffB); PG8_STAGE(PG8_SB(1, 1), b3 + hstep, voffB); PG8_STAGE(PG8_SA(1, 0), a3, voffA);
            PG8_WAIT_V(8); PG8_WAIT_L(0); PG8_BAR; PG8_MMA(1, 0, At, B0); PG8_MMA(1, 1, At, B1); PG8_BAR; PG8_SCHED;
            } else {
            PG8_LDB(B0, 0, 0); PG8_SCHED; PG8_LDA(At, 0, 0); PG8_STAGE(PG8_SA(1, 1), a1 + hstep, voffA);
            PG8_WAIT_L(8); PG8_BAR; PG8_WAIT_L(0); PG8_MMA(0, 0, At, B0); PG8_BAR; PG8_SCHED;
            PG8_LDB(B1, 0, 1); PG8_STAGE(PG8_SB(0, 0), b2, voffB);
            PG8_BAR; PG8_WAIT_L(0); PG8_MMA(0, 1, At, B1); PG8_BAR;
            PG8_LDA(At, 0, 1); PG8_STAGE(PG8_SA(0, 0), a2, voffA);
            PG8_BAR; PG8_WAIT_L(0); PG8_MMA(1, 0, At, B0); PG8_BAR; PG8_SCHED;
            PG8_STAGE(PG8_SB(0, 1), b2 + hstep, voffB);
            PG8_WAIT_V(6); PG8_BAR; PG8_MMA(1, 1, At, B1); PG8_BAR;
            PG8_LDB(B0, 1, 0); PG8_SCHED; PG8_LDA(At, 1, 0); PG8_STAGE(PG8_SA(0, 1), a2 + hstep, voffA);
            PG8_WAIT_L(8); PG8_BAR; PG8_WAIT_L(0); PG8_MMA(0, 0, At, B0); PG8_BAR; PG8_SCHED;
            PG8_LDB(B1, 1, 1); PG8_STAGE(PG8_SB(1, 0), b3, voffB);
            PG8_BAR; PG8_WAIT_L(0); PG8_MMA(0, 1, At, B1); PG8_BAR;
            PG8_LDA(At, 1, 1); PG8_STAGE(PG8_SA(1, 0), a3, voffA);
            PG8_BAR; PG8_WAIT_L(0); PG8_MMA(1, 0, At, B0); PG8_BAR; PG8_SCHED;
            PG8_STAGE(PG8_SB(1, 1), b3 + hstep, voffB);
            PG8_WAIT_V(6); PG8_BAR; PG8_MMA(1, 1, At, B1); PG8_BAR;
            }
        }
        if constexpr (ALIGN_EPI) { if (wr == 0) PG8_BAR; }
        if constexpr (!Epi::AFTER_DRAIN) { E(acc, cur, wr, wc, fr, fq); S.done(cur); }
        if (!has_next) break;
#pragma unroll
        for (int a = 0; a < 2; ++a)
#pragma unroll
            for (int b = 0; b < 2; ++b)
#pragma unroll
                for (int m = 0; m < 4; ++m)
#pragma unroll
                    for (int n = 0; n < 2; ++n) acc[a][b][m][n] = (f32x4){0.f, 0.f, 0.f, 0.f};
        cur = nxt; cA = nA; cB = nB; ++ui;
        if constexpr (ALIGN_EPI) { if (wr == 1) PG8_BAR; }
    }
    PG8_WAIT_V(0);
    if constexpr (!ALIGN_EPI) { if (wr == 0) PG8_BAR; }
    PG8_BAR;
    if constexpr (Epi::AFTER_DRAIN) { E.fused(acc, cur, wr, wc, fr, fq, lds, wid, lane); S.done(cur); }
#undef PG8_SA
#undef PG8_SB
#undef PG8_STAGE
#undef PG8_LDA
#undef PG8_LDB
#undef PG8_MMA
#undef PG8_WAIT_V
#undef PG8_WAIT_L
#undef PG8_BAR
#undef PG8_SCHED
}
}

#ifndef PG8_SP2
#define PG8_SP2 true
#endif
#ifndef PG8_ALIGN
#define PG8_ALIGN true
#endif
constexpr int NWAVES = 8;
#ifndef MK_N_LAUNCHES
#define MK_N_LAUNCHES 1
#endif
constexpr int BATCH = 16, SEQ = 2048, D = 1024, FF = 4096, M = BATCH * SEQ;
constexpr int NQKV = 3072;
constexpr int MLW = 3080, NPROJ = 3072;
constexpr int NH_A = 8, NH_M = 4;
constexpr float EPS = 1e-6f, LOG2E = 1.4426950408889634f;
constexpr float QSCALE = 0.125f * LOG2E;
constexpr float LAMBDA_INIT0 = 0.2f;
constexpr float MQSCALE = 0.08838834764831845f;
constexpr int NPHASE = 16;

constexpr size_t MiB = 1u << 20;
constexpr size_t WS_CTL = 0, CTL_ZERO_BYTES = 1 * MiB;
constexpr size_t WS_WQKV = 2 * MiB, WS_WAO = 8 * MiB, WS_WML = 10 * MiB, WS_WMO = 16 * MiB, WS_W1 = 18 * MiB  , WS_W2 = 34 * MiB  ;
constexpr size_t WS_WG = 50 * MiB;
constexpr size_t WS_GATES = 51 * MiB;
constexpr size_t WS_SSQ = 52 * MiB;
constexpr size_t WS_XN = 64 * MiB;
constexpr size_t WS_U = 128 * MiB;
constexpr size_t WS_HT = 320 * MiB;
constexpr size_t WS_T0 = 384 * MiB;
constexpr size_t WS_END = 384 * MiB;
constexpr int CW_TMO = 0, CW_CODE = 1;
constexpr int CW_BAR = 4096;
constexpr int RING_OFF = 0, RING_BYTES = 131072;
constexpr int LDSCTL_OFF = RING_BYTES, MISC_OFF = LDSCTL_OFF + 320;
constexpr int LDS_BYTES = 147456;
static_assert(MISC_OFF + 128 <= LDS_BYTES, "LDS map");

#define GAS __attribute__((address_space(1)))
#define LAS __attribute__((address_space(3)))
typedef unsigned short bf16;
typedef unsigned v4u __attribute__((ext_vector_type(4)));
typedef float f32x4 __attribute__((ext_vector_type(4)));
typedef short bf16x8 __attribute__((ext_vector_type(8)));
typedef GAS unsigned gu32;
typedef GAS unsigned long long gu64;
#define RLX_AGENT __ATOMIC_RELAXED, __HIP_MEMORY_SCOPE_AGENT
#define LDS_WAIT() asm volatile("s_waitcnt lgkmcnt(0)" ::: "memory")
#define VM_WAIT() asm volatile("s_waitcnt vmcnt(0)" ::: "memory")
__device__ __forceinline__ unsigned long long rt() { return __builtin_amdgcn_s_memrealtime(); }
__device__ __forceinline__ unsigned f2bf(float f) { unsigned u = __builtin_bit_cast(unsigned, f); return (u + 0x7fffu + ((u >> 16) & 1u)) >> 16; }
__device__ __forceinline__ unsigned pk2(float lo, float hi) { return f2bf(lo) | (f2bf(hi) << 16); }

#define XB_TMO      128
#define XB_XCNT(j)  (256  + 64 * (j))
#define XB_XSUB(j)  (1280 + 64 * (j))
#define XB_XGEN(j)  (2304 + 64 * (j))
#define XB_TOP      3328
#define XB_TOPGEN   3392
#define XCD_BAR_WORDS 3456
#define XB_SPIN_CAP (1u << 23)

__device__ __forceinline__ unsigned xb_ld(unsigned* p)              { return __hip_atomic_load(p, __ATOMIC_RELAXED, __HIP_MEMORY_SCOPE_AGENT); }
__device__ __forceinline__ unsigned xb_add(unsigned* p, unsigned v) { return __hip_atomic_fetch_add(p, v, __ATOMIC_RELAXED, __HIP_MEMORY_SCOPE_AGENT); }
__device__ __forceinline__ unsigned xb_xcc_id() { return (unsigned)__builtin_amdgcn_s_getreg((3 << 11) | 20) & 0xFu; }
#define XB_SPIN(cond, bar) do { unsigned _sp = 0; while (cond) { __builtin_amdgcn_s_sleep(1); \
    if ((++_sp & 255u) == 0u) { if (xb_ld(&(bar)[XB_TMO])) break; if (_sp > XB_SPIN_CAP) { atomicAdd(&(bar)[XB_TMO], 1u); break; } } } } while (0)

struct XcdBarrier {
    unsigned* bar; unsigned x;
    volatile LAS unsigned* st;
};

__device__ __forceinline__ XcdBarrier xcd_barrier_post(unsigned* bar, volatile LAS unsigned* st) {
    XcdBarrier b; b.bar = bar; b.x = xb_xcc_id(); b.st = st;
    if (threadIdx.x == 0) (void)xb_add(&bar[XB_XCNT(b.x)], 1u);
    return b;
}
__device__ __forceinline__ void xcd_barrier_complete(unsigned* bar, unsigned x, unsigned& nloc, unsigned& nx) {
    const unsigned G = gridDim.x * gridDim.y * gridDim.z;
    unsigned sum, cnt, mine, sp = 0u;
    for (;;) {
        sum = 0u; cnt = 0u; mine = 0u;
#pragma unroll
        for (unsigned j = 0; j < 16; ++j) { const unsigned c = xb_ld(&bar[XB_XCNT(j)]); sum += c; cnt += (c > 0u) ? 1u : 0u; mine = (j == x) ? c : mine; }
        if (sum == G) break;
        __builtin_amdgcn_s_sleep(1);
        if ((++sp & 255u) == 0u) { if (xb_ld(&bar[XB_TMO])) break; if (sp > XB_SPIN_CAP) { atomicAdd(&bar[XB_TMO], 1u); break; } }
    }
    nloc = mine > 0u ? mine : 1u; nx = cnt > 0u ? cnt : 1u;
}

__device__ __forceinline__ void xcd_barrier(const XcdBarrier& b) {
    asm volatile("s_waitcnt vmcnt(0)" ::: "memory");
    __syncthreads();
    if (threadIdx.x == 0) {
        unsigned* bar = b.bar;
        __builtin_amdgcn_s_waitcnt(0);
        unsigned nloc = b.st[0], nx = b.st[1];
        if (nloc == 0u) { xcd_barrier_complete(bar, b.x, nloc, nx); b.st[0] = nloc; b.st[1] = nx; }
        const unsigned old = xb_add(&bar[XB_XSUB(b.x)], 1u);
        const unsigned gen = old / nloc;
        if (old + 1u == (gen + 1u) * nloc) {
            __builtin_amdgcn_fence(__ATOMIC_RELEASE, "agent");
            asm volatile("s_waitcnt vmcnt(0)" ::: "memory");
            const unsigned og = xb_add(&bar[XB_TOP], 1u);
            const unsigned tg = og / nx;
            if (og + 1u == (tg + 1u) * nx) xb_add(&bar[XB_TOPGEN], 1u);
            else XB_SPIN(xb_ld(&bar[XB_TOPGEN]) == tg, bar);
            __builtin_amdgcn_fence(__ATOMIC_ACQUIRE, "agent");
            xb_add(&bar[XB_XGEN(b.x)], 1u);
            asm volatile("s_waitcnt vmcnt(0)" ::: "memory");
        } else {
            XB_SPIN(xb_ld(&bar[XB_XGEN(b.x)]) == gen, bar);
            __builtin_amdgcn_fence(__ATOMIC_ACQUIRE, "agent");
            asm volatile("s_waitcnt vmcnt(0)" ::: "memory");
        }
    }
    __syncthreads();
}

struct Frame {
    LAS unsigned char* lds;
    volatile LAS unsigned* MISC;
    gu32* ctl;
    int tid, lane, wave;
    int vcu, G;
};
__device__ __forceinline__ float wave_sum(float v) {
#pragma unroll
    for (int o = 1; o < 64; o <<= 1) v += __shfl_xor(v, o);
    return v;
}
__device__ __forceinline__ void p0_transpose_item(const float* W, int K, int ldw, int nblk, bf16* WT, const float* gk, int gmask, float gs, LAS float* scr, int item, int lane) {
    const int kb = item / nblk, nb = item % nblk, k0 = 64 * kb, n0 = 32 * nb;
#pragma unroll 8
    for (int i = 0; i < 32; ++i) { const int kk = 2 * i + (lane >> 5); const float g = gk ? gk[(k0 + kk) & gmask] * gs : gs;
        scr[kk * 33 + (lane & 31)] = W[(size_t)(k0 + kk) * ldw + n0 + (lane & 31)] * g; }
    LDS_WAIT(); asm volatile("" ::: "memory");
    const int c = lane & 7;
#pragma unroll
    for (int j = 0; j < 4; ++j) { const int n = (lane >> 3) + 8 * j; const LAS float* s = scr + (8 * c) * 33 + n;
        v4u o; o.x = pk2(s[0 * 33], s[1 * 33]); o.y = pk2(s[2 * 33], s[3 * 33]); o.z = pk2(s[4 * 33], s[5 * 33]); o.w = pk2(s[6 * 33], s[7 * 33]);
        *(GAS v4u*)(WT + (size_t)(n0 + n) * K + k0 + 8 * c) = o; }
    LDS_WAIT(); asm volatile("" ::: "memory");
}
__device__ __forceinline__ void rms_row_load(const float* xrow, int lane, f32x4 (&v)[4]) {
    const GAS f32x4* xr = (const GAS f32x4*)xrow + lane; float s2 = 0.f;
#pragma unroll
    for (int j = 0; j < 4; ++j) { v[j] = xr[64 * j]; s2 += (v[j].x * v[j].x + v[j].y * v[j].y) + (v[j].z * v[j].z + v[j].w * v[j].w); }
    const float rstd = 1.f / sqrtf(wave_sum(s2) * (1.f / D) + EPS);
#pragma unroll
    for (int j = 0; j < 4; ++j) v[j] = v[j] * rstd;
}
__device__ __forceinline__ void row_store_bf16(bf16* orow, int lane, const f32x4 (&v)[4]) {
    GAS unsigned long long* o8 = (GAS unsigned long long*)orow + lane;
#pragma unroll
    for (int j = 0; j < 4; ++j) o8[64 * j] = (unsigned long long)pk2(v[j].x, v[j].y) | ((unsigned long long)pk2(v[j].z, v[j].w) << 32);
}
__device__ __forceinline__ float log_sigmoid(float x) { return fminf(x, 0.f) - log1pf(expf(-fabsf(x))); }

struct Args { const float* in[22]; float* out; unsigned char* ws; int ph_lo, ph_hi, li, pad; };

__device__ __forceinline__ void p0_prologue(Frame& F, const Args& a) {
    unsigned char* ws = a.ws;
    LAS float* scr = (LAS float*)(F.lds + RING_OFF + F.wave * 16384);
    const int gw = F.vcu * NWAVES + F.wave, NGW = F.G * NWAVES;
    constexpr int I_QKV = (D / 64) * (NQKV / 32), I_O = (D / 64) * (D / 32), I_ML = (D / 64) * (NPROJ / 32), I_1 = (D / 64) * (FF / 32), I_2 = (FF / 64) * (D / 32);
    constexpr int NITEMS = I_QKV + I_O + I_ML + I_O + 2 * I_1 + 2 * I_2;
    for (int it = gw; it < NITEMS; it += NGW) {
        int r = it;
        if (r < I_QKV) { p0_transpose_item(a.in[3], D, NQKV, NQKV / 32, (bf16*)(ws + WS_WQKV), a.in[2], 0xffff, 1.f, scr, r, F.lane); continue; } r -= I_QKV;
        if (r < I_O) { p0_transpose_item(a.in[9], D, D, D / 32, (bf16*)(ws + WS_WAO), a.in[8], 127, 1.f - LAMBDA_INIT0, scr, r, F.lane); continue; } r -= I_O;
        if (r < I_ML) { p0_transpose_item(a.in[11], D, MLW, NPROJ / 32, (bf16*)(ws + WS_WML), a.in[10], 0xffff, 1.f, scr, r, F.lane); continue; } r -= I_ML;
        if (r < I_O) { p0_transpose_item(a.in[17], D, D, D / 32, (bf16*)(ws + WS_WMO), a.in[16], 0xffff, 1.f, scr, r, F.lane); continue; } r -= I_O;
        if (r < 2 * I_1) { const int l = r / I_1; p0_transpose_item(a.in[19] + (size_t)l * D * FF, D, FF, FF / 32, (bf16*)(ws + WS_W1) + (size_t)l * D * FF, a.in[18] + l * D, 0xffff, 1.f, scr, r % I_1, F.lane); continue; } r -= 2 * I_1;
        { const int l = r / I_2; p0_transpose_item(a.in[20] + (size_t)l * D * FF, FF, D, D / 32, (bf16*)(ws + WS_W2) + (size_t)l * D * FF, nullptr, 0, 1.f, scr, r % I_2, F.lane); }
    }
    { float* WG = (float*)(ws + WS_WG); const int gt = (F.vcu * NWAVES + F.wave) * 64 + F.lane, NGT = F.G * NWAVES * 64;
      for (int i = gt; i < 8 * D; i += NGT) { const int j = i / D, k = i % D; WG[i] = a.in[10][k] * a.in[11][(size_t)k * MLW + NPROJ + j]; } }
    bf16* XN = (bf16*)(ws + WS_XN);
    for (int m = gw; m < M; m += NGW) { f32x4 v[4]; rms_row_load(a.in[0] + (size_t)m * D, F.lane, v); row_store_bf16(XN + (size_t)m * D, F.lane, v); }
}
__device__ __forceinline__ void norm_phase(Frame& F, const float* H, bf16* XN, const float* WG, float* GATES, const float* b_i, const float* b_f) {
    const int gw = F.vcu * NWAVES + F.wave, NGW = F.G * NWAVES;
    LAS f32x4* wg = (LAS f32x4*)(F.lds + RING_OFF);
    if (GATES) { for (int i = F.tid; i < 8 * D / 4; i += NWAVES * 64) wg[i] = ((const GAS f32x4*)WG)[i]; __syncthreads(); }
    for (int m = gw; m < M; m += NGW) {
        f32x4 v[4]; rms_row_load(H + (size_t)m * D, F.lane, v); row_store_bf16(XN + (size_t)m * D, F.lane, v);
        if (GATES) {
            float mine = 0.f;
#pragma unroll
            for (int j = 0; j < 8; ++j) { float s = 0.f;
#pragma unroll
                for (int jj = 0; jj < 4; ++jj) { const f32x4 w = wg[j * 256 + jj * 64 + F.lane]; s += (v[jj].x * w.x + v[jj].y * w.y) + (v[jj].z * w.z + v[jj].w * w.w); }
                s = wave_sum(s); if (F.lane == j) mine = s; }
            if (F.lane < 4) GATES[(size_t)m * 8 + F.lane] = mine + b_i[F.lane];
            else if (F.lane < 8) GATES[(size_t)m * 8 + F.lane] = log_sigmoid(mine + b_f[F.lane - 4]);
        }
    }
    if (GATES) __syncthreads();
}
__device__ __forceinline__ void final_norm_phase(Frame& F, const float* H, const float* g, float* out) {
    const int gw = F.vcu * NWAVES + F.wave, NGW = F.G * NWAVES;
    for (int m = gw; m < M; m += NGW) {
        f32x4 v[4]; rms_row_load(H + (size_t)m * D, F.lane, v);
        GAS f32x4* o = (GAS f32x4*)(out + (size_t)m * D) + F.lane; const GAS f32x4* gg = (const GAS f32x4*)g + F.lane;
#pragma unroll
        for (int j = 0; j < 4; ++j) o[64 * j] = v[j] * gg[64 * j];
    }
}

__device__ __forceinline__ float bf2f(bf16 v) { return __uint_as_float((unsigned)v << 16); }
__device__ __forceinline__ int t5_bucket(int d) {
    if (d < 16) return d;
    const float v = logf((float)d / 16.f) / logf(8.f) * 16.f; int b = 16 + (int)v; return b > 31 ? 31 : b;
}
__device__ __forceinline__ void naive_attn_phase(Frame& F, const bf16* __restrict__ QKV, const float* __restrict__ rel_bias, const float* __restrict__ lq1, const float* __restrict__ lk1,
                                                  const float* __restrict__ lq2, const float* __restrict__ lk2, bf16* AO) {
    LAS float* lut = (LAS float*)(F.lds + RING_OFF);
    const int tid = F.tid, half = tid & 1;
    float s1 = 0.f, s2 = 0.f;
    for (int i = 0; i < 64; ++i) { s1 += lq1[i] * lk1[i]; s2 += lq2[i] * lk2[i]; }
    const float lam = expf(s1) - expf(s2) + LAMBDA_INIT0;
    for (int u = F.vcu; u < BATCH * NH_A * (SEQ / 256); u += F.G) {
        const int qb = u % (SEQ / 256), h = (u / (SEQ / 256)) % NH_A, b = u / (SEQ / 256) / NH_A, q0 = qb * 256, q = q0 + (tid >> 1);
        __syncthreads();
        if (tid < 128) lut[tid] = rel_bias[t5_bucket(tid) * NH_A + h] * LOG2E;
        __syncthreads();
        const size_t tok = (size_t)b * SEQ + q;
        float res[64];
        for (int m = 0; m < 2; ++m) {
            float qv[64];
            const bf16* qp = QKV + tok * NQKV + h * 128 + m * 64;
#pragma unroll
            for (int d = 0; d < 64; ++d) qv[d] = bf2f(qp[d]);
            float o[64];
#pragma unroll
            for (int d = 0; d < 64; ++d) o[d] = 0.f;
            float mrun = -1e30f, l = 0.f;
            const int kend = q0 + 256;
            for (int k = 0; k < kend; ++k) {
                const bf16* kr = QKV + ((size_t)b * SEQ + k) * NQKV + D + h * 128 + m * 64;
                const bf16* vr = QKV + ((size_t)b * SEQ + k) * NQKV + 2 * D + h * 128 + half * 64;
                float s = 0.f;
#pragma unroll
                for (int d = 0; d < 64; ++d) s += qv[d] * bf2f(kr[d]);
                const int dist = q - k;
                if (dist >= 0) {
                    s += lut[dist < 127 ? dist : 127];
                    if (s > mrun) { const float al = exp2f(mrun - s); l *= al;
#pragma unroll
                        for (int d = 0; d < 64; ++d) o[d] *= al;
                        mrun = s; }
                    const float p = exp2f(s - mrun); l += p;
#pragma unroll
                    for (int d = 0; d < 64; ++d) o[d] += p * bf2f(vr[d]);
                }
            }
            const float il = 1.f / l;
            if (m == 0) {
#pragma unroll
                for (int d = 0; d < 64; ++d) res[d] = o[d] * il;
            } else {
                float ss = 0.f;
#pragma unroll
                for (int d = 0; d < 64; ++d) { res[d] = res[d] - lam * (o[d] * il); ss += res[d] * res[d]; }
                ss += __shfl_xor(ss, 1);
                const float rstd = 1.f / sqrtf(ss * (1.f / 128.f) + EPS);
                bf16* op = AO + tok * D + h * 128 + half * 64;
#pragma unroll
                for (int d = 0; d < 64; d += 2) *(unsigned*)(op + d) = pk2(res[d] * rstd, res[d + 1] * rstd);
            }
        }
    }
    __syncthreads();
}
__device__ __forceinline__ void naive_mlstm_phase(Frame& F, const bf16* __restrict__ PROJ, const float* __restrict__ GATES, const float* __restrict__ conv_w, const float* __restrict__ conv_b, bf16* AO) {
    LAS float* q_s = (LAS float*)(F.lds + RING_OFF); LAS float* k_s = q_s + 128; LAS float* v_s = q_s + 256; LAS float* red = q_s + 512;
    const int tid = F.tid, dv = tid >> 1, half = tid & 1, lane = F.lane, wave = F.wave;
    for (int u = (int)blockIdx.x; u < BATCH * NH_M; u += F.G) {
        const int h = u & 3, b = u >> 2;
        float C[64], n[64];
#pragma unroll
        for (int j = 0; j < 64; ++j) { C[j] = 0.f; n[j] = 0.f; }
        float mst = 0.f;
        const int col = (tid < 128) ? (h * 128 + tid) : (512 + h * 128 + ((tid - 128) & 127));
        float cw0 = 0.f, cw1 = 0.f, cw2 = 0.f, cw3 = 0.f, cb = 0.f;
        if (tid < 256) { cw0 = conv_w[0 * D + col]; cw1 = conv_w[1 * D + col]; cw2 = conv_w[2 * D + col]; cw3 = conv_w[3 * D + col]; cb = conv_b[col]; }
        __syncthreads();
        for (int t = 0; t < SEQ; ++t) {
            const size_t tok = (size_t)b * SEQ + t;
            if (tid < 256) {
                float x3 = bf2f(PROJ[tok * NPROJ + col]);
                float x2 = t >= 1 ? bf2f(PROJ[(tok - 1) * NPROJ + col]) : 0.f;
                float x1 = t >= 2 ? bf2f(PROJ[(tok - 2) * NPROJ + col]) : 0.f;
                float x0 = t >= 3 ? bf2f(PROJ[(tok - 3) * NPROJ + col]) : 0.f;
                float y = cw0 * x0 + cw1 * x1 + cw2 * x2 + cw3 * x3 + cb;
                y = y / (1.f + expf(-y));
                if (tid < 128) q_s[tid] = y * MQSCALE; else k_s[tid - 128] = y;
            } else {
                v_s[tid - 256] = bf2f(PROJ[tok * NPROJ + 1024 + h * 256 + (tid - 256)]);
            }
            const float ig = GATES[tok * 8 + h], lf = GATES[tok * 8 + 4 + h];
            __syncthreads();
            const float mnew = fmaxf(lf + mst, ig), fd = expf(lf + mst - mnew), gi = expf(ig - mnew);
            mst = mnew;
            const float gv = gi * v_s[dv];
            float num = 0.f, den = 0.f;
#pragma unroll
            for (int j = 0; j < 64; ++j) { const float kk = k_s[half * 64 + j], qq = q_s[half * 64 + j];
                C[j] = fd * C[j] + gv * kk; n[j] = fd * n[j] + gi * kk; num += C[j] * qq; den += n[j] * qq; }
            num += __shfl_xor(num, 1); den += __shfl_xor(den, 1);
            const float hv = num / fmaxf(fabsf(den), expf(-mnew));
            float ss = half == 0 ? hv * hv : 0.f;
            ss = wave_sum(ss);
            if (lane == 0) red[wave] = ss;
            __syncthreads();
            float tot = 0.f;
#pragma unroll
            for (int w = 0; w < 8; ++w) tot += red[w];
            const float rstd = 1.f / sqrtf(tot * (1.f / 256.f) + EPS);
            if (half == 0) { const float op = bf2f(PROJ[tok * NPROJ + 2048 + h * 256 + dv]); const float sg = 1.f / (1.f + expf(-op));
                AO[tok * D + h * 256 + dv] = (bf16)f2bf(sg * hv * rstd); }
            __syncthreads();
        }
    }
}

__global__ void __launch_bounds__(NWAVES * 64, 2) fwd(Args args) {
    extern __shared__ __attribute__((aligned(16))) unsigned char lds[];
    Frame F;
    F.lds = (LAS unsigned char*)lds;
    F.MISC = (volatile LAS unsigned*)(F.lds + MISC_OFF);
    F.tid = threadIdx.x; F.lane = F.tid & 63; F.wave = __builtin_amdgcn_readfirstlane(F.tid >> 6);
    F.G = gridDim.x; { const int bx = blockIdx.x; F.vcu = (F.G % 8 == 0) ? (bx % 8) * (F.G / 8) + bx / 8 : bx; }
    unsigned char* ws = args.ws;
    F.ctl = (gu32*)(ws + WS_CTL);
    for (int u = F.tid; u < (LDS_BYTES - LDSCTL_OFF) / 4; u += NWAVES * 64) ((LAS unsigned*)(F.lds + LDSCTL_OFF))[u] = 0u;
    __syncthreads();
    const int lo = args.ph_lo, hi = args.ph_hi;
    const bool use_bar = (hi - lo) > 1;
    XcdBarrier bar; bar.bar = (unsigned*)(F.ctl + CW_BAR) + args.li * XCD_BAR_WORDS; bar.x = 0; bar.st = nullptr;
    if (use_bar) bar = xcd_barrier_post((unsigned*)(F.ctl + CW_BAR) + args.li * XCD_BAR_WORDS, F.MISC + 8);
#define IN(k) (lo <= (k) && (k) < hi)
#define SEAM(k) do { if (IN(k) && IN((k) + 1)) xcd_barrier(bar); } while (0)
    bf16* const XN = (bf16*)(ws + WS_XN); bf16* const AO = XN; bf16* const QKV = (bf16*)(ws + WS_U); bf16* const U = (bf16*)(ws + WS_U);
    float* const H = args.out;
    using pg8::Gemm; using pg8::StaticOrder; using pg8::EpiBf16; using pg8::EpiResF32;

    if (IN(0)) { p0_prologue(F, args); SEAM(0); }
    if (IN(1)) { Gemm g{XN, (const bf16*)(ws + WS_WQKV), M, NQKV, D}; StaticOrder S; S.init(M, NQKV, F.G, (int)blockIdx.x);
        EpiBf16<0> E{QKV, NQKV, D, QSCALE}; pg8::gemm_phase<EpiBf16<0>, StaticOrder, PG8_ALIGN, PG8_SP2>(F.lds + RING_OFF, g, S, E); SEAM(1); }
    if (IN(2)) { naive_attn_phase(F, QKV, args.in[1], args.in[4], args.in[5], args.in[6], args.in[7], AO); SEAM(2); }
    if (IN(3)) { Gemm g{AO, (const bf16*)(ws + WS_WAO), M, D, D}; StaticOrder S; S.init(M, D, F.G, (int)blockIdx.x);
        EpiResF32 E{args.in[0], H, D}; pg8::gemm_phase<EpiResF32, StaticOrder, PG8_ALIGN, PG8_SP2>(F.lds + RING_OFF, g, S, E); SEAM(3); }
    if (IN(4)) { norm_phase(F, H, XN, nullptr, nullptr, nullptr, nullptr); SEAM(4); }
    if (IN(5)) { Gemm g{XN, (const bf16*)(ws + WS_W1), M, FF, D}; StaticOrder S; S.init(M, FF, F.G, (int)blockIdx.x);
        EpiBf16<2> E{U, FF, 0, 1.f}; pg8::gemm_phase<EpiBf16<2>, StaticOrder, PG8_ALIGN, PG8_SP2>(F.lds + RING_OFF, g, S, E); SEAM(5); }
    if (IN(6)) { Gemm g{U, (const bf16*)(ws + WS_W2), M, D, FF}; StaticOrder S; S.init(M, D, F.G, (int)blockIdx.x);
        EpiResF32 E{H, H, D}; pg8::gemm_phase<EpiResF32, StaticOrder, PG8_ALIGN, PG8_SP2>(F.lds + RING_OFF, g, S, E); SEAM(6); }
    if (IN(7)) { norm_phase(F, H, XN, (const float*)(ws + WS_WG), (float*)(ws + WS_GATES), args.in[12], args.in[13]); SEAM(7); }
    if (IN(8)) { Gemm g{XN, (const bf16*)(ws + WS_WML), M, NPROJ, D}; StaticOrder S; S.init(M, NPROJ, F.G, (int)blockIdx.x);
        EpiBf16<0> E{QKV, NPROJ, 0, 1.f}; pg8::gemm_phase<EpiBf16<0>, StaticOrder, PG8_ALIGN, PG8_SP2>(F.lds + RING_OFF, g, S, E); SEAM(8); }
    if (IN(9)) { naive_mlstm_phase(F, QKV, (const float*)(ws + WS_GATES), args.in[14], args.in[15], AO); SEAM(9); }
    if (IN(10)) { SEAM(10); }
    if (IN(11)) { Gemm g{AO, (const bf16*)(ws + WS_WMO), M, D, D}; StaticOrder S; S.init(M, D, F.G, (int)blockIdx.x);
        EpiResF32 E{H, H, D}; pg8::gemm_phase<EpiResF32, StaticOrder, PG8_ALIGN, PG8_SP2>(F.lds + RING_OFF, g, S, E); SEAM(11); }
    if (IN(12)) { norm_phase(F, H, XN, nullptr, nullptr, nullptr, nullptr); SEAM(12); }
    if (IN(13)) { Gemm g{XN, (const bf16*)(ws + WS_W1) + (size_t)D * FF, M, FF, D}; StaticOrder S; S.init(M, FF, F.G, (int)blockIdx.x);
        EpiBf16<2> E{U, FF, 0, 1.f}; pg8::gemm_phase<EpiBf16<2>, StaticOrder, PG8_ALIGN, PG8_SP2>(F.lds + RING_OFF, g, S, E); SEAM(13); }
    if (IN(14)) { Gemm g{U, (const bf16*)(ws + WS_W2) + (size_t)D * FF, M, D, FF}; StaticOrder S; S.init(M, D, F.G, (int)blockIdx.x);
        EpiResF32 E{H, H, D}; pg8::gemm_phase<EpiResF32, StaticOrder, PG8_ALIGN, PG8_SP2>(F.lds + RING_OFF, g, S, E); SEAM(14); }
    if (IN(15)) { final_norm_phase(F, H, args.in[21], args.out); }
#undef IN
#undef SEAM
}

extern "C" void kernel_launch(void* const* d_in, const int* in_sizes, int n_in, void* d_out, int out_size, void* d_ws, size_t ws_size, hipStream_t stream) {
    static int grid = 0;
    if (grid == 0) {
        if (n_in != 22 || in_sizes[0] != M * D || out_size != M * D || ws_size < WS_END) { fprintf(stderr, "kernel_launch: unexpected shapes (n_in %d, in0 %d, out %d, ws %zu); nothing launched\n", n_in, n_in > 0 ? in_sizes[0] : -1, out_size, ws_size); grid = -1; return; }
        int dev = 0, cus = 0, per_cu = 0;
        if (hipGetDevice(&dev) != hipSuccess || hipDeviceGetAttribute(&cus, hipDeviceAttributeMultiprocessorCount, dev) != hipSuccess) { grid = -1; return; }
        if (hipFuncSetAttribute((const void*)fwd, hipFuncAttributeMaxDynamicSharedMemorySize, LDS_BYTES) != hipSuccess) { fprintf(stderr, "kernel_launch: hipFuncSetAttribute failed\n"); grid = -1; return; }
        if (hipOccupancyMaxActiveBlocksPerMultiprocessor(&per_cu, (const void*)fwd, NWAVES * 64, LDS_BYTES) != hipSuccess || per_cu < 1) fprintf(stderr, "kernel_launch: occupancy query says %d\n", per_cu);
        (void)hipGetLastError();
        grid = cus;
    }
    if (grid < 0) return;
    (void)hipMemsetAsync((char*)d_ws + WS_CTL, 0, CTL_ZERO_BYTES, stream);
    Args a{};
    for (int i = 0; i < 22; ++i) a.in[i] = (const float*)d_in[i];
    a.out = (float*)d_out; a.ws = (unsigned char*)d_ws;
    int li = 0;
    auto run = [&](int lo, int hi) { a.ph_lo = lo; a.ph_hi = hi; a.li = li++; hipLaunchKernelGGL(fwd, dim3(grid), dim3(NWAVES * 64), LDS_BYTES, stream, a); };
    run(0, NPHASE);
}
```

```cpp
#include <hip/hip_runtime.h>
#include <cstdio>
#include <cstdint>
namespace pg8 {
#define PG8_LAS __attribute__((address_space(3)))
typedef unsigned short bf16_t;
typedef short bf16x8 __attribute__((ext_vector_type(8)));
typedef float f32x4 __attribute__((ext_vector_type(4)));
typedef unsigned u32x4 __attribute__((ext_vector_type(4)));
constexpr int BM = 256, BK = 64, HALF = 128, HTB = HALF * BK * 2  , STAGE_BYTES = 8 * HTB, NXCD = 8, WGM = 8;

__host__ __device__ __forceinline__ int lds_byte(int r, int c) { const int st = (r >> 4) * 2 + (c >> 5), rr = r & 15, cc = c & 31, ob = rr * 64 + cc * 2; return st * 1024 + (ob ^ (((ob >> 9) & 1) << 5)); }
__host__ __device__ __forceinline__ void stage_rc(int b, int& R, int& C) { const int st = b / 1024, sb = b % 1024, swz = sb ^ (((sb >> 9) & 1) << 5); R = (st >> 1) * 16 + swz / 64; C = (st & 1) * 32 + (swz % 64) / 2; }
__host__ __device__ __forceinline__ int perm32(int rho) { const int n = rho >> 4, i = rho & 15; return 8 * (i >> 2) + 4 * n + (i & 3); }

struct Unit { int pm, pn; };
struct Gemm { const bf16_t* A; const bf16_t* Bt; int M, N, K; };

struct StaticOrder {
    int nM, nN, nwg, G, c;
    __host__ __device__ void init(int M, int N, int G_, int c_) { nM = M / BM; nN = N / BM; nwg = nM * nN; G = G_; c = c_; }
    __host__ __device__ bool next(int i, Unit& u) const {
        const long L = (long)i * G + c; if (L >= nwg) return false;
        int wgid = (int)L; { const int q = nwg / NXCD, r = nwg % NXCD, xcd = wgid % NXCD, off = wgid / NXCD; wgid = (xcd < r ? xcd * (q + 1) : r * (q + 1) + (xcd - r) * q) + off; }
        const int nig = WGM * nN, gid = wgid / nig, fm = gid * WGM, gsz = (nM - fm) < WGM ? (nM - fm) : WGM;
        u.pm = fm + ((wgid % nig) % gsz); u.pn = (wgid % nig) / gsz; return true;
    }
    __device__ __forceinline__ void a_ready(const Unit&) const {}
    __device__ __forceinline__ void done(const Unit&) const {}
};

__device__ __forceinline__ unsigned cvt_pk_bf16(float lo, float hi) { unsigned r; asm volatile("v_cvt_pk_bf16_f32 %0, %1, %2" : "=v"(r) : "v"(lo), "v"(hi)); return r; }
template <int ACT> struct EpiBf16 {
    static constexpr bool PERM = true, AFTER_DRAIN = false;
    bf16_t* O; int ldc; int scale_cols; float scale0;
    __device__ __forceinline__ void operator()(const f32x4 (&acc)[2][2][4][2], const Unit& u, int wr, int wc, int fr, int fq) const {
        const int row0 = u.pm * BM + wr * 64 + fr; const int colt = u.pn * BM;
        const float sc = (colt < scale_cols) ? scale0 : 1.f;
        const int col0 = colt + wc * 32 + 8 * fq;
#pragma unroll
        for (int ai = 0; ai < 2; ++ai)
#pragma unroll
            for (int m = 0; m < 4; ++m) { bf16_t* rowp = O + (size_t)(row0 + ai * HALF + m * 16) * ldc + col0;
#pragma unroll
                for (int bj = 0; bj < 2; ++bj) { f32x4 v0 = acc[ai][bj][m][0], v1 = acc[ai][bj][m][1];
                    if (ACT == 2) {
#pragma unroll
                        for (int e = 0; e < 4; ++e) { const float a = fmaxf(v0[e], 0.f), b = fmaxf(v1[e], 0.f); v0[e] = a * a; v1[e] = b * b; } }
                    v0 = v0 * sc; v1 = v1 * sc; u32x4 w; w.x = cvt_pk_bf16(v0[0], v0[1]); w.y = cvt_pk_bf16(v0[2], v0[3]); w.z = cvt_pk_bf16(v1[0], v1[1]); w.w = cvt_pk_bf16(v1[2], v1[3]);
                    *(u32x4*)(rowp + bj * HALF) = w; } }
    }
};
struct EpiResF32 {
    static constexpr bool PERM = false, AFTER_DRAIN = false;
    const float* base; float* out; int ldc;
    __device__ __forceinline__ void operator()(const f32x4 (&acc)[2][2][4][2], const Unit& u, int wr, int wc, int fr, int fq) const {
        const int row0 = u.pm * BM + wr * 64 + fr; const int col0 = u.pn * BM + wc * 32 + 4 * fq;
#pragma unroll
        for (int ai = 0; ai < 2; ++ai)
#pragma unroll
            for (int m = 0; m < 4; ++m) { const size_t off = (size_t)(row0 + ai * HALF + m * 16) * ldc + col0;
#pragma unroll
                for (int bj = 0; bj < 2; ++bj)
#pragma unroll
                    for (int n = 0; n < 2; ++n) { const f32x4 bs = *(const f32x4*)(base + off + bj * HALF + n * 16);
                        *(f32x4*)(out + off + bj * HALF + n * 16) = bs + acc[ai][bj][m][n]; } }
    }
};

template <class Epi, class Sched, bool ALIGN_EPI = false, bool SP2 = false>
__device__ __forceinline__ void gemm_phase(PG8_LAS unsigned char* lds, const Gemm g, const Sched& S, const Epi& E) {
    const int tid = threadIdx.x, wid = __builtin_amdgcn_readfirstlane(tid >> 6), lane = tid & 63, wr = wid >> 2, wc = wid & 3, fr = lane & 15, fq = lane >> 4;
    const int K = g.K, nt = K / BK;
    unsigned voffA[2], voffB[2];
#pragma unroll
    for (int i = 0; i < 2; ++i) { int R, C; stage_rc(tid * 16 + i * 8192, R, C); const int Rb = Epi::PERM ? ((R & ~31) + perm32(R & 31)) : R;
        voffA[i] = (unsigned)(R * K + C) * 2u; voffB[i] = (unsigned)(Rb * K + C) * 2u; }
    const size_t kstep = (size_t)(BK * 2);
    const size_t hstep = (size_t)HALF * K * 2;
    const size_t tstep = 2 * hstep;
    const unsigned ldsw = (unsigned)wid * 1024u;
    const int aoff = lds_byte(wr * 64 + fr, fq * 8), boff = lds_byte(wc * 32 + fr, fq * 8);
#define PG8_SA(b, h) (((b) * 2 + (h)) * HTB)
#define PG8_SB(b, h) ((4 + (b) * 2 + (h)) * HTB)
#define PG8_STAGE(bufoff, gbase, voff) do { _Pragma("unroll") for (int _i = 0; _i < 2; ++_i) \
        __builtin_amdgcn_global_load_lds((const unsigned*)((const char*)(gbase) + (voff)[_i]), (PG8_LAS unsigned*)(lds + (bufoff) + ldsw + _i * 8192), 16, 0, 0); } while (0)
#define PG8_LDA(dst, b, h) do { _Pragma("unroll") for (int m = 0; m < 4; ++m) _Pragma("unroll") for (int k = 0; k < 2; ++k) dst[m][k] = *(const PG8_LAS bf16x8*)(lds + PG8_SA(b, h) + aoff + m * 2048 + k * 1024); } while (0)
#define PG8_LDB(dst, b, h) do { _Pragma("unroll") for (int n = 0; n < 2; ++n) _Pragma("unroll") for (int k = 0; k < 2; ++k) dst[n][k] = *(const PG8_LAS bf16x8*)(lds + PG8_SB(b, h) + boff + n * 2048 + k * 1024); } while (0)
#define PG8_MMA(ai, bj, At, Bt) do { __builtin_amdgcn_s_setprio(1); _Pragma("unroll") for (int m = 0; m < 4; ++m) _Pragma("unroll") for (int n = 0; n < 2; ++n) _Pragma("unroll") for (int k = 0; k < 2; ++k) \
        acc[ai][bj][m][n] = __builtin_amdgcn_mfma_f32_16x16x32_bf16(Bt[n][k], At[m][k], acc[ai][bj][m][n], 0, 0, 0); __builtin_amdgcn_s_setprio(0); } while (0)
#define PG8_WAIT_V(n) asm volatile("s_waitcnt vmcnt(" #n ")" ::: "memory")
#define PG8_WAIT_L(n) asm volatile("s_waitcnt lgkmcnt(" #n ")" ::: "memory")
#define PG8_BAR __builtin_amdgcn_s_barrier()
#define PG8_SCHED __builtin_amdgcn_sched_barrier(0)
    Unit cur, nxt; int ui = 0;
    if (!S.next(0, cur)) return;
    f32x4 acc[2][2][4][2];
#pragma unroll
    for (int a = 0; a < 2; ++a)
#pragma unroll
        for (int b = 0; b < 2; ++b)
#pragma unroll
            for (int m = 0; m < 4; ++m)
#pragma unroll
                for (int n = 0; n < 2; ++n) acc[a][b][m][n] = (f32x4){0.f, 0.f, 0.f, 0.f};
    bf16x8 At[4][2], B0[2][2], B1[2][2];
    const char* cA = (const char*)g.A + (size_t)cur.pm * tstep; const char* cB = (const char*)g.Bt + (size_t)cur.pn * tstep;
    S.a_ready(cur);
    if constexpr (SP2) {
        PG8_STAGE(PG8_SB(0, 0), cB, voffB); PG8_STAGE(PG8_SB(0, 1), cB + hstep, voffB); PG8_STAGE(PG8_SA(0, 0), cA, voffA); PG8_STAGE(PG8_SA(0, 1), cA + hstep, voffA);
        if (wr == 1) PG8_BAR;
        PG8_WAIT_V(2); PG8_BAR;
        PG8_STAGE(PG8_SB(1, 0), cB + kstep, voffB); PG8_STAGE(PG8_SA(1, 0), cA + kstep, voffA); PG8_STAGE(PG8_SB(1, 1), cB + hstep + kstep, voffB);
        PG8_WAIT_V(6); PG8_BAR;
    } else {
        PG8_STAGE(PG8_SB(0, 0), cB, voffB); PG8_STAGE(PG8_SA(0, 0), cA, voffA); PG8_STAGE(PG8_SB(0, 1), cB + hstep, voffB); PG8_STAGE(PG8_SA(0, 1), cA + hstep, voffA);
        if (wr == 1) PG8_BAR;
        PG8_WAIT_V(4); PG8_BAR;
        PG8_STAGE(PG8_SB(1, 0), cB + kstep, voffB); PG8_STAGE(PG8_SA(1, 0), cA + kstep, voffA); PG8_STAGE(PG8_SB(1, 1), cB + hstep + kstep, voffB);
        PG8_WAIT_V(6); PG8_BAR;
    }
    for (;;) {
        const bool has_next = S.next(ui + 1, nxt);
        const char* nA = has_next ? (const char*)g.A + (size_t)nxt.pm * tstep : cA; const char* nB = has_next ? (const char*)g.Bt + (size_t)nxt.pn * tstep : cB;
        for (int t = 0; t < nt; t += 2) {
            const bool last = (t == nt - 2);
            const char* a1 = cA + (size_t)(t + 1) * kstep;
            const char* a2 = last ? nA : cA + (size_t)(t + 2) * kstep; const char* b2 = last ? nB : cB + (size_t)(t + 2) * kstep;
            const char* a3 = a2 + kstep; const char* b3 = b2 + kstep;
            if (last && has_next) S.a_ready(nxt);
            if constexpr (SP2) {
            PG8_LDB(B0, 0, 0); PG8_LDB(B1, 0, 1); PG8_SCHED; PG8_LDA(At, 0, 0); PG8_STAGE(PG8_SA(1, 1), a1 + hstep, voffA);
            PG8_WAIT_V(8); PG8_WAIT_L(0); PG8_BAR; PG8_MMA(0, 0, At, B0); PG8_MMA(0, 1, At, B1); PG8_BAR; PG8_SCHED;
            PG8_LDA(At, 0, 1); PG8_STAGE(PG8_SB(0, 0), b2, voffB); PG8_STAGE(PG8_SB(0, 1), b2 + hstep, voffB); PG8_STAGE(PG8_SA(0, 0), a2, voffA);
            PG8_WAIT_V(8); PG8_WAIT_L(0); PG8_BAR; PG8_MMA(1, 0, At, B0); PG8_MMA(1, 1, At, B1); PG8_BAR; PG8_SCHED;
            PG8_LDB(B0, 1, 0); PG8_LDB(B1, 1, 1); PG8_SCHED; PG8_LDA(At, 1, 0); PG8_STAGE(PG8_SA(0, 1), a2 + hstep, voffA);
            PG8_WAIT_V(8); PG8_WAIT_L(0); PG8_BAR; PG8_MMA(0, 0, At, B0); PG8_MMA(0, 1, At, B1); PG8_BAR; PG8_SCHED;
            PG8_LDA(At, 1, 1); PG8_STAGE(PG8_SB(1, 0), b3, voffB); PG8_STAGE(PG8_SB(1, 1), b3 + hstep, voffB); PG8_STAGE(PG8_SA(1, 0), a3, voffA);
            PG8_WAIT_V(8); PG8_WAIT_L(0); PG8_BAR; PG8_MMA(1, 0, At, B0); PG8_MMA(1, 1, At, B1); PG8_BAR; PG8_SCHED;
            } else {
            PG8_LDB(B0, 0, 0); PG8_SCHED; PG8_LDA(At, 0, 0); PG8_STAGE(PG8_SA(1, 1), a1 + hstep, voffA);
            PG8_WAIT_L(8); PG8_BAR; PG8_WAIT_L(0); PG8_MMA(0, 0, At, B0); PG8_BAR; PG8_SCHED;
            PG8_LDB(B1, 0, 1); PG8_STAGE(PG8_SB(0, 0), b2, voffB);
            PG8_BAR; PG8_WAIT_L(0); PG8_MMA(0, 1, At, B1); PG8_BAR;
            PG8_LDA(At, 0, 1); PG8_STAGE(PG8_SA(0, 0), a2, voffA);
            PG8_BAR; PG8_WAIT_L(0); PG8_MMA(1, 0, At, B0); PG8_BAR; PG8_SCHED;
            PG8_STAGE(PG8_SB(0, 1), b2 + hstep, voffB);
            PG8_WAIT_V(6); PG8_BAR; PG8_MMA(1, 1, At, B1); PG8_BAR;
            PG8_LDB(B0, 1, 0); PG8_SCHED; PG8_LDA(At, 1, 0); PG8_STAGE(PG8_SA(0, 1), a2 + hstep, voffA);
            PG8_WAIT_L(8); PG8_BAR; PG8_WAIT_L(0); PG8_MMA(0, 0, At, B0); PG8_BAR; PG8_SCHED;
            PG8_LDB(B1, 1, 1); PG8_STAGE(PG8_SB(1, 0), b3, voffB);
            PG8_BAR; PG8_WAIT_L(0); PG8_MMA(0, 1, At, B1); PG8_BAR;
            PG8_LDA(At, 1, 1); PG8_STAGE(PG8_SA(1, 0), a3, voffA);
            PG8_BAR; PG8_WAIT_L(0); PG8_MMA(1, 0, At, B0); PG8_BAR; PG8_SCHED;
            PG8_STAGE(PG8_SB(1, 1), b3 + hstep, voffB);
            PG8_WAIT_V(6); PG8_BAR; PG8_MMA(1, 1, At, B1); PG8_BAR;
            }
        }
        if constexpr (ALIGN_EPI) { if (wr == 0) PG8_BAR; }
        if constexpr (!Epi::AFTER_DRAIN) { E(acc, cur, wr, wc, fr, fq); S.done(cur); }
        if (!has_next) break;
#pragma unroll
        for (int a = 0; a < 2; ++a)
#pragma unroll
            for (int b = 0; b < 2; ++b)
#pragma unroll
                for (int m = 0; m < 4; ++m)
#pragma unroll
                    for (int n = 0; n < 2; ++n) acc[a][b][m][n] = (f32x4){0.f, 0.f, 0.f, 0.f};
        cur = nxt; cA = nA; cB = nB; ++ui;
        if constexpr (ALIGN_EPI) { if (wr == 1) PG8_BAR; }
    }
    PG8_WAIT_V(0);
    if constexpr (!ALIGN_EPI) { if (wr == 0) PG8_BAR; }
    PG8_BAR;
    if constexpr (Epi::AFTER_DRAIN) { E.fused(acc, cur, wr, wc, fr, fq, lds, wid, lane); S.done(cur); }
#undef PG8_SA
#undef PG8_SB
#undef PG8_STAGE
#undef PG8_LDA
#undef PG8_LDB
#undef PG8_MMA
#undef PG8_WAIT_V
#undef PG8_WAIT_L
#undef PG8_BAR
#undef PG8_SCHED
}
}

#ifndef PG8_SP2
#define PG8_SP2 true
#endif
#ifndef PG8_ALIGN
#define PG8_ALIGN true
#endif
namespace da {
typedef short bf16x8 __attribute__((ext_vector_type(8)));
typedef short s16x4 __attribute__((ext_vector_type(4)));
typedef float f32x16 __attribute__((ext_vector_type(16)));
typedef float f32x4 __attribute__((ext_vector_type(4)));
typedef unsigned u32x4 __attribute__((ext_vector_type(4)));
#define DLAS __attribute__((address_space(3)))
constexpr int NW = 8, QBLK = 32, KVBLK = 64, QB = NW * QBLK, PITCH = 3072;
constexpr int SHM_V = KVBLK * 128 * 2, SHM_K = KVBLK * 64 * 2;
constexpr int OFF_V = 0, OFF_K = 2 * SHM_V, OFF_WS = OFF_K + 2 * SHM_K, OFF_LUT = OFF_WS + NW * 64 * 4, LDS_BYTES = OFF_LUT + 512;
constexpr float THR = 8.f;
#define DA_KSWZ(row, c) ((row) * 128 + ((((c) ^ (((row) >> 1) & 7))) << 4))
#define DA_SBAR() __builtin_amdgcn_sched_barrier(0)
__device__ __forceinline__ int v_st(int k, int c) { const int kk = (k & ~0xC) | ((k & 4) << 1) | ((k & 8) >> 1); return ((kk >> 3) * 4 + (c >> 5)) * 512 + ((kk & 7) * 32 + (c & 31)) * 2; }
__device__ __forceinline__ int v_rd_base(int lane) { return ((lane & 3) << 3) | (((lane >> 2) & 3) << 6) | (((lane >> 4) & 1) << 5) | (((lane >> 5) & 1) << 8); }
constexpr int v_rd_off(int d0, int ks, int half) { return d0 * 512 + ks * 4096 + half * 2048; }
__device__ __forceinline__ int crow(int r, int hi) { return (r & 3) + 8 * (r >> 2) + 4 * hi; }
__device__ __forceinline__ unsigned cvtpk(float lo, float hi) { unsigned r; asm volatile("v_cvt_pk_bf16_f32 %0, %1, %2" : "=v"(r) : "v"(lo), "v"(hi)); return r; }
__device__ __forceinline__ void mask_tile(f32x16& p0, f32x16& p1, int dq) {
    const float NEG = -__builtin_inff();
#pragma unroll
    for (int r = 0; r < 16; ++r) { const int c = (r & 3) + 8 * (r >> 2); if (dq - c < 0) p0[r] = NEG; if (dq - c - 32 < 0) p1[r] = NEG; }
}
__device__ __forceinline__ void bias_tile(f32x16& p0, f32x16& p1, int dq, const DLAS float* lut) {
#pragma unroll
    for (int g = 0; g < 4; ++g) {
#pragma unroll
        for (int rr = 0; rr < 4; ++rr) { const int r = g * 4 + rr; const int c = (r & 3) + 8 * (r >> 2);
            int i0 = dq - c; i0 = i0 < 0 ? 0 : (i0 > 127 ? 127 : i0); int i1 = dq - c - 32; i1 = i1 < 0 ? 0 : (i1 > 127 ? 127 : i1);
            p0[r] += lut[i0]; p1[r] += lut[i1]; }
        DA_SBAR();
    }
}
__device__ __forceinline__ void partialSM(f32x16& p0, f32x16& p1, float& m_reg, float& alpha, float cb) {
    float pmax = p0[0];
#pragma unroll
    for (int r = 1; r < 16; ++r) pmax = fmaxf(pmax, p0[r]);
#pragma unroll
    for (int r = 0; r < 16; ++r) pmax = fmaxf(pmax, p1[r]);
    { auto rr = __builtin_amdgcn_permlane32_swap(__float_as_uint(pmax), __float_as_uint(pmax), false, false);
      pmax = fmaxf(__uint_as_float(rr[0]), __uint_as_float(rr[1])); }
    pmax += cb;
    float mn;
    if (__builtin_expect(__all(pmax - m_reg <= THR), 1)) { mn = m_reg; alpha = 1.f; }
    else { mn = fmaxf(m_reg, pmax); alpha = __builtin_amdgcn_exp2f(m_reg - mn); m_reg = mn; }
    const float off = cb - mn;
#pragma unroll
    for (int r = 0; r < 16; ++r) p0[r] += off;
#pragma unroll
    for (int r = 0; r < 16; ++r) p1[r] += off;
#pragma unroll
    for (int r = 0; r < 16; ++r) p0[r] = __builtin_amdgcn_exp2f(p0[r]);
}
__device__ __forceinline__ void finishSM(f32x16& p0, f32x16& p1, float alpha, float& l_reg, bf16x8& pa0, bf16x8& pa1, bf16x8& pa2, bf16x8& pa3) {
#pragma unroll
    for (int r = 0; r < 16; ++r) p1[r] = __builtin_amdgcn_exp2f(p1[r]);
    float ps = 0;
#pragma unroll
    for (int r = 0; r < 16; ++r) ps += p0[r];
#pragma unroll
    for (int r = 0; r < 16; ++r) ps += p1[r];
    { auto rr = __builtin_amdgcn_permlane32_swap(__float_as_uint(ps), __float_as_uint(ps), false, false);
      ps = __uint_as_float(rr[0]) + __uint_as_float(rr[1]); }
    l_reg = l_reg * alpha + ps;
#define DA_PK4(P, B_, OUT) do { unsigned a0 = cvtpk(P[B_+0], P[B_+1]), a1 = cvtpk(P[B_+2], P[B_+3]);                          \
        unsigned b0 = cvtpk(P[B_+4], P[B_+5]), b1 = cvtpk(P[B_+6], P[B_+7]);                                             \
        auto r0 = __builtin_amdgcn_permlane32_swap(a0, b0, false, false); auto r1 = __builtin_amdgcn_permlane32_swap(a1, b1, false, false); \
        u32x4 w = {r0[0], r1[0], r0[1], r1[1]}; OUT = *reinterpret_cast<bf16x8*>(&w); } while (0)
    DA_PK4(p0, 0, pa0); DA_PK4(p0, 8, pa1); DA_PK4(p1, 0, pa2); DA_PK4(p1, 8, pa3);
#undef DA_PK4
}
template <int KB>
__device__ __forceinline__ void qkt(f32x16& p0, f32x16& p1, const DLAS char* K_lds, int r32, int hi, const bf16x8* qr) {
    p0 = f32x16{}; p1 = f32x16{};
#pragma unroll
    for (int d0 = 0; d0 < 4; ++d0) { const DLAS char* a = K_lds + KB * SHM_K + DA_KSWZ(r32, d0 * 2 + hi);
        const bf16x8 b0 = *reinterpret_cast<const DLAS bf16x8*>(a);
        const bf16x8 b1 = *reinterpret_cast<const DLAS bf16x8*>(a + 32 * 128);
        p0 = __builtin_amdgcn_mfma_f32_32x32x16_bf16(b0, qr[d0], p0, 0, 0, 0);
        p1 = __builtin_amdgcn_mfma_f32_32x32x16_bf16(b1, qr[d0], p1, 0, 0, 0); }
}
template <int VB>
__device__ __forceinline__ void pv_tile(f32x16* o, int vb0, bf16x8 pa0, bf16x8 pa1, bf16x8 pa2, bf16x8 pa3) {
#define DA_TRRD(dst, off) asm volatile("ds_read_b64_tr_b16 %0, %1 offset:%2" : "=&v"(dst) : "v"(vb0), "i"(off) : "memory")
#define DA_PV_D0(d0) do { s16x4 l0, l1, l2, l3, h0, h1, h2, h3; constexpr int b_ = VB * SHM_V + v_rd_off(d0, 0, 0); \
        DA_TRRD(l0, b_); DA_TRRD(h0, b_ + 2048); DA_TRRD(l1, b_ + 4096); DA_TRRD(h1, b_ + 6144); DA_TRRD(l2, b_ + 8192); DA_TRRD(h2, b_ + 10240); DA_TRRD(l3, b_ + 12288); DA_TRRD(h3, b_ + 14336); \
        asm volatile("s_waitcnt lgkmcnt(0)" ::: "memory"); DA_SBAR();   \
        o[d0] = __builtin_amdgcn_mfma_f32_32x32x16_bf16(pa0, (bf16x8){l0[0], l0[1], l0[2], l0[3], h0[0], h0[1], h0[2], h0[3]}, o[d0], 0, 0, 0);   \
        o[d0] = __builtin_amdgcn_mfma_f32_32x32x16_bf16(pa1, (bf16x8){l1[0], l1[1], l1[2], l1[3], h1[0], h1[1], h1[2], h1[3]}, o[d0], 0, 0, 0);   \
        o[d0] = __builtin_amdgcn_mfma_f32_32x32x16_bf16(pa2, (bf16x8){l2[0], l2[1], l2[2], l2[3], h2[0], h2[1], h2[2], h2[3]}, o[d0], 0, 0, 0);   \
        o[d0] = __builtin_amdgcn_mfma_f32_32x32x16_bf16(pa3, (bf16x8){l3[0], l3[1], l3[2], l3[3], h3[0], h3[1], h3[2], h3[3]}, o[d0], 0, 0, 0); } while (0)
    DA_PV_D0(0); DA_PV_D0(1); DA_PV_D0(2); DA_PV_D0(3);
#undef DA_PV_D0
#undef DA_TRRD
}
__device__ __forceinline__ void attn_block(const unsigned short* __restrict__ Qp, const unsigned short* __restrict__ Kp, const unsigned short* __restrict__ Vp, int P0, DLAS char* lds, float c31, f32x16 (&o)[4]) {
    const int tid = threadIdx.x, wid = __builtin_amdgcn_readfirstlane(tid >> 6), lane = tid & 63, r32 = lane & 31, hi = lane >> 5;
    const int NT = (P0 + QB) / KVBLK;
    const int qlo = P0 + wid * QBLK, qm = qlo + r32 - 4 * hi;
    DLAS char* V_lds = lds + OFF_V; DLAS char* K_lds = lds + OFF_K;
    DLAS float* wsf = (DLAS float*)(lds + OFF_WS) + wid * 64; DLAS float* li_l = wsf; DLAS float* al_l = wsf + 32;
    const DLAS float* lut = (const DLAS float*)(lds + OFF_LUT);
    float m_reg = -1e30f, l_reg = 0.f;
#pragma unroll
    for (int d = 0; d < 4; ++d) o[d] = f32x16{};
    const int sr = tid >> 4, sc = (tid & 15) * 8, vst0 = v_st(sr, sc), vst1 = v_st(32 + sr, sc);
    const int kr = tid >> 3, kc = tid & 7, kws = DA_KSWZ(kr, kc);
    const int vb0 = (int)(uintptr_t)V_lds + v_rd_base(lane);
    bf16x8 qr[4];
#pragma unroll
    for (int d0 = 0; d0 < 4; ++d0) qr[d0] = *reinterpret_cast<const bf16x8*>(Qp + (size_t)(wid * QBLK + r32) * PITCH + d0 * 16 + hi * 8);
    bf16x8 st_v0, st_v1, st_k0;
#define DA_VMW() asm volatile("s_waitcnt vmcnt(0)" ::: "memory")
#define DA_SLOAD(k0) do { st_v0 = *reinterpret_cast<const bf16x8*>(Vp + (size_t)((k0) + sr) * PITCH + sc); st_v1 = *reinterpret_cast<const bf16x8*>(Vp + (size_t)((k0) + 32 + sr) * PITCH + sc); \
                          st_k0 = *reinterpret_cast<const bf16x8*>(Kp + (size_t)((k0) + kr) * PITCH + kc * 8); } while (0)
#define DA_SWRITE(bf) do { *reinterpret_cast<DLAS bf16x8*>(V_lds + (bf) * SHM_V + vst0) = st_v0; *reinterpret_cast<DLAS bf16x8*>(V_lds + (bf) * SHM_V + vst1) = st_v1; \
                           *reinterpret_cast<DLAS bf16x8*>(K_lds + (bf) * SHM_K + kws) = st_k0; } while (0)
#define DA_RESC(a) do { if (__any((a) < 1.f)) { if (hi == 0) al_l[r32] = (a); asm volatile("s_waitcnt lgkmcnt(0)" ::: "memory");              \
                        _Pragma("unroll") for (int d_ = 0; d_ < 4; ++d_) _Pragma("unroll") for (int r = 0; r < 16; ++r) o[d_][r] *= al_l[crow(r, hi)]; } } while (0)
#define DA_BIASMASK(P0_, P1_, t, cbv) do { const int kb_ = (t) * KVBLK; if (kb_ + KVBLK - 1 + 128 > qlo) { bias_tile(P0_, P1_, qm - kb_, lut); cbv = 0.f; if (kb_ + KVBLK - 1 > qlo) mask_tile(P0_, P1_, qm - kb_); } else cbv = c31; } while (0)
    f32x16 pA0, pA1, pB0, pB1; float alA, alB, cbA, cbB; bf16x8 pa0, pa1, pa2, pa3;
    DA_SLOAD(0); DA_VMW(); DA_SWRITE(0); DA_SBAR();
    DA_SLOAD(KVBLK);
    __syncthreads();
    DA_SBAR(); qkt<0>(pA0, pA1, K_lds, r32, hi, qr);
    DA_BIASMASK(pA0, pA1, 0, cbA); partialSM(pA0, pA1, m_reg, alA, cbA);
    DA_VMW(); DA_SWRITE(1);
    __syncthreads();
#define DA_HALF_STEP(PX0, PX1, alX, cbX, PY0, PY1, alY, t, KB, VB, SB) do {                                                      \
        DA_SBAR(); qkt<KB>(PX0, PX1, K_lds, r32, hi, qr);                                             \
        finishSM(PY0, PY1, alY, l_reg, pa0, pa1, pa2, pa3); DA_SBAR();                                                           \
        DA_SLOAD(((t) + 1) * KVBLK); DA_SBAR();                                               \
        pv_tile<VB>(o, vb0, pa0, pa1, pa2, pa3); DA_BIASMASK(PX0, PX1, (t), cbX); partialSM(PX0, PX1, m_reg, alX, cbX);                                        \
        __syncthreads();                                                                                                      \
        DA_VMW(); DA_SWRITE(SB);                                                                          \
        DA_RESC(alX); __syncthreads(); } while (0)
    for (int t = 1; t + 1 < NT; t += 2) {
        DA_HALF_STEP(pB0, pB1, alB, cbB, pA0, pA1, alA, t, 1, 0, 0);
        DA_HALF_STEP(pA0, pA1, alA, cbA, pB0, pB1, alB, t + 1, 0, 1, 1);
    }
    DA_SBAR(); qkt<1>(pB0, pB1, K_lds, r32, hi, qr); DA_SBAR();
    finishSM(pA0, pA1, alA, l_reg, pa0, pa1, pa2, pa3); DA_SBAR();
    pv_tile<0>(o, vb0, pa0, pa1, pa2, pa3);
    DA_BIASMASK(pB0, pB1, NT - 1, cbB); partialSM(pB0, pB1, m_reg, alB, cbB); DA_RESC(alB);
    finishSM(pB0, pB1, alB, l_reg, pa0, pa1, pa2, pa3); DA_SBAR(); pv_tile<1>(o, vb0, pa0, pa1, pa2, pa3);
    if (hi == 0) li_l[r32] = l_reg; asm volatile("s_waitcnt lgkmcnt(0)" ::: "memory");
#pragma unroll
    for (int r = 0; r < 16; ++r) { const float rl = __builtin_amdgcn_rcpf(li_l[crow(r, hi)]);
#pragma unroll
        for (int d0 = 0; d0 < 4; ++d0) o[d0][r] *= rl; }
    __syncthreads();
#undef DA_VMW
#undef DA_SLOAD
#undef DA_SWRITE
#undef DA_RESC
#undef DA_BIASMASK
#undef DA_HALF_STEP
}
}
static_assert(da::LDS_BYTES <= 131072, "attention LDS inside the ring region");
constexpr int NWAVES = 8;
#ifndef MK_N_LAUNCHES
#define MK_N_LAUNCHES 1
#endif
constexpr int BATCH = 16, SEQ = 2048, D = 1024, FF = 4096, M = BATCH * SEQ;
constexpr int NQKV = 3072;
constexpr int MLW = 3080, NPROJ = 3072;
constexpr int NH_A = 8, NH_M = 4;
constexpr float EPS = 1e-6f, LOG2E = 1.4426950408889634f;
constexpr float QSCALE = 0.125f * LOG2E;
constexpr float LAMBDA_INIT0 = 0.2f;
constexpr float MQSCALE = 0.08838834764831845f;
constexpr int NPHASE = 16;

constexpr size_t MiB = 1u << 20;
constexpr size_t WS_CTL = 0, CTL_ZERO_BYTES = 1 * MiB;
constexpr size_t WS_WQKV = 2 * MiB, WS_WAO = 8 * MiB, WS_WML = 10 * MiB, WS_WMO = 16 * MiB, WS_W1 = 18 * MiB  , WS_W2 = 34 * MiB  ;
constexpr size_t WS_WG = 50 * MiB;
constexpr size_t WS_GATES = 51 * MiB;
constexpr size_t WS_SSQ = 52 * MiB;
constexpr size_t WS_XN = 64 * MiB;
constexpr size_t WS_U = 128 * MiB;
constexpr size_t WS_HT = 320 * MiB;
constexpr size_t WS_T0 = 384 * MiB;
constexpr size_t WS_END = 384 * MiB;
constexpr int CW_TMO = 0, CW_CODE = 1;
constexpr int CW_BAR = 4096;
constexpr int RING_OFF = 0, RING_BYTES = 131072;
constexpr int LDSCTL_OFF = RING_BYTES, MISC_OFF = LDSCTL_OFF + 320;
constexpr int LDS_BYTES = 147456;
static_assert(MISC_OFF + 128 <= LDS_BYTES, "LDS map");

#define GAS __attribute__((address_space(1)))
#define LAS __attribute__((address_space(3)))
typedef unsigned short bf16;
typedef unsigned v4u __attribute__((ext_vector_type(4)));
typedef float f32x4 __attribute__((ext_vector_type(4)));
typedef short bf16x8 __attribute__((ext_vector_type(8)));
typedef GAS unsigned gu32;
typedef GAS unsigned long long gu64;
#define RLX_AGENT __ATOMIC_RELAXED, __HIP_MEMORY_SCOPE_AGENT
#define LDS_WAIT() asm volatile("s_waitcnt lgkmcnt(0)" ::: "memory")
#define VM_WAIT() asm volatile("s_waitcnt vmcnt(0)" ::: "memory")
__device__ __forceinline__ unsigned long long rt() { return __builtin_amdgcn_s_memrealtime(); }
__device__ __forceinline__ unsigned f2bf(float f) { unsigned u = __builtin_bit_cast(unsigned, f); return (u + 0x7fffu + ((u >> 16) & 1u)) >> 16; }
__device__ __forceinline__ unsigned pk2(float lo, float hi) { return f2bf(lo) | (f2bf(hi) << 16); }

#define XB_TMO      128
#define XB_XCNT(j)  (256  + 64 * (j))
#define XB_XSUB(j)  (1280 + 64 * (j))
#define XB_XGEN(j)  (2304 + 64 * (j))
#define XB_TOP      3328
#define XB_TOPGEN   3392
#define XCD_BAR_WORDS 3456
#define XB_SPIN_CAP (1u << 23)

__device__ __forceinline__ unsigned xb_ld(unsigned* p)              { return __hip_atomic_load(p, __ATOMIC_RELAXED, __HIP_MEMORY_SCOPE_AGENT); }
__device__ __forceinline__ unsigned xb_add(unsigned* p, unsigned v) { return __hip_atomic_fetch_add(p, v, __ATOMIC_RELAXED, __HIP_MEMORY_SCOPE_AGENT); }
__device__ __forceinline__ unsigned xb_xcc_id() { return (unsigned)__builtin_amdgcn_s_getreg((3 << 11) | 20) & 0xFu; }
#define XB_SPIN(cond, bar) do { unsigned _sp = 0; while (cond) { __builtin_amdgcn_s_sleep(1); \
    if ((++_sp & 255u) == 0u) { if (xb_ld(&(bar)[XB_TMO])) break; if (_sp > XB_SPIN_CAP) { atomicAdd(&(bar)[XB_TMO], 1u); break; } } } } while (0)

struct XcdBarrier {
    unsigned* bar; unsigned x;
    volatile LAS unsigned* st;
};

__device__ __forceinline__ XcdBarrier xcd_barrier_post(unsigned* bar, volatile LAS unsigned* st) {
    XcdBarrier b; b.bar = bar; b.x = xb_xcc_id(); b.st = st;
    if (threadIdx.x == 0) (void)xb_add(&bar[XB_XCNT(b.x)], 1u);
    return b;
}
__device__ __forceinline__ void xcd_barrier_complete(unsigned* bar, unsigned x, unsigned& nloc, unsigned& nx) {
    const unsigned G = gridDim.x * gridDim.y * gridDim.z;
    unsigned sum, cnt, mine, sp = 0u;
    for (;;) {
        sum = 0u; cnt = 0u; mine = 0u;
#pragma unroll
        for (unsigned j = 0; j < 16; ++j) { const unsigned c = xb_ld(&bar[XB_XCNT(j)]); sum += c; cnt += (c > 0u) ? 1u : 0u; mine = (j == x) ? c : mine; }
        if (sum == G) break;
        __builtin_amdgcn_s_sleep(1);
        if ((++sp & 255u) == 0u) { if (xb_ld(&bar[XB_TMO])) break; if (sp > XB_SPIN_CAP) { atomicAdd(&bar[XB_TMO], 1u); break; } }
    }
    nloc = mine > 0u ? mine : 1u; nx = cnt > 0u ? cnt : 1u;
}

__device__ __forceinline__ void xcd_barrier(const XcdBarrier& b) {
    asm volatile("s_waitcnt vmcnt(0)" ::: "memory");
    __syncthreads();
    if (threadIdx.x == 0) {
        unsigned* bar = b.bar;
        __builtin_amdgcn_s_waitcnt(0);
        unsigned nloc = b.st[0], nx = b.st[1];
        if (nloc == 0u) { xcd_barrier_complete(bar, b.x, nloc, nx); b.st[0] = nloc; b.st[1] = nx; }
        const unsigned old = xb_add(&bar[XB_XSUB(b.x)], 1u);
        const unsigned gen = old / nloc;
        if (old + 1u == (gen + 1u) * nloc) {
            __builtin_amdgcn_fence(__ATOMIC_RELEASE, "agent");
            asm volatile("s_waitcnt vmcnt(0)" ::: "memory");
            const unsigned og = xb_add(&bar[XB_TOP], 1u);
            const unsigned tg = og / nx;
            if (og + 1u == (tg + 1u) * nx) xb_add(&bar[XB_TOPGEN], 1u);
            else XB_SPIN(xb_ld(&bar[XB_TOPGEN]) == tg, bar);
            __builtin_amdgcn_fence(__ATOMIC_ACQUIRE, "agent");
            xb_add(&bar[XB_XGEN(b.x)], 1u);
            asm volatile("s_waitcnt vmcnt(0)" ::: "memory");
        } else {
            XB_SPIN(xb_ld(&bar[XB_XGEN(b.x)]) == gen, bar);
            __builtin_amdgcn_fence(__ATOMIC_ACQUIRE, "agent");
            asm volatile("s_waitcnt vmcnt(0)" ::: "memory");
        }
    }
    __syncthreads();
}

struct Frame {
    LAS unsigned char* lds;
    volatile LAS unsigned* MISC;
    gu32* ctl;
    int tid, lane, wave;
    int vcu, G;
};
__device__ __forceinline__ float wave_sum(float v) {
#pragma unroll
    for (int o = 1; o < 64; o <<= 1) v += __shfl_xor(v, o);
    return v;
}
__device__ __forceinline__ void p0_transpose_item(const float* W, int K, int ldw, int nblk, bf16* WT, const float* gk, int gmask, float gs, LAS float* scr, int item, int lane) {
    const int kb = item / nblk, nb = item % nblk, k0 = 64 * kb, n0 = 32 * nb;
#pragma unroll 8
    for (int i = 0; i < 32; ++i) { const int kk = 2 * i + (lane >> 5); const float g = gk ? gk[(k0 + kk) & gmask] * gs : gs;
        scr[kk * 33 + (lane & 31)] = W[(size_t)(k0 + kk) * ldw + n0 + (lane & 31)] * g; }
    LDS_WAIT(); asm volatile("" ::: "memory");
    const int c = lane & 7;
#pragma unroll
    for (int j = 0; j < 4; ++j) { const int n = (lane >> 3) + 8 * j; const LAS float* s = scr + (8 * c) * 33 + n;
        v4u o; o.x = pk2(s[0 * 33], s[1 * 33]); o.y = pk2(s[2 * 33], s[3 * 33]); o.z = pk2(s[4 * 33], s[5 * 33]); o.w = pk2(s[6 * 33], s[7 * 33]);
        *(GAS v4u*)(WT + (size_t)(n0 + n) * K + k0 + 8 * c) = o; }
    LDS_WAIT(); asm volatile("" ::: "memory");
}
__device__ __forceinline__ void rms_row_load(const float* xrow, int lane, f32x4 (&v)[4]) {
    const GAS f32x4* xr = (const GAS f32x4*)xrow + lane; float s2 = 0.f;
#pragma unroll
    for (int j = 0; j < 4; ++j) { v[j] = xr[64 * j]; s2 += (v[j].x * v[j].x + v[j].y * v[j].y) + (v[j].z * v[j].z + v[j].w * v[j].w); }
    const float rstd = 1.f / sqrtf(wave_sum(s2) * (1.f / D) + EPS);
#pragma unroll
    for (int j = 0; j < 4; ++j) v[j] = v[j] * rstd;
}
__device__ __forceinline__ void row_store_bf16(bf16* orow, int lane, const f32x4 (&v)[4]) {
    GAS unsigned long long* o8 = (GAS unsigned long long*)orow + lane;
#pragma unroll
    for (int j = 0; j < 4; ++j) o8[64 * j] = (unsigned long long)pk2(v[j].x, v[j].y) | ((unsigned long long)pk2(v[j].z, v[j].w) << 32);
}
__device__ __forceinline__ float log_sigmoid(float x) { return fminf(x, 0.f) - log1pf(expf(-fabsf(x))); }

struct Args { const float* in[22]; float* out; unsigned char* ws; int ph_lo, ph_hi, li, pad; };

__device__ __forceinline__ void p0_prologue(Frame& F, const Args& a) {
    unsigned char* ws = a.ws;
    LAS float* scr = (LAS float*)(F.lds + RING_OFF + F.wave * 16384);
    const int gw = F.vcu * NWAVES + F.wave, NGW = F.G * NWAVES;
    constexpr int I_QKV = (D / 64) * (NQKV / 32), I_O = (D / 64) * (D / 32), I_ML = (D / 64) * (NPROJ / 32), I_1 = (D / 64) * (FF / 32), I_2 = (FF / 64) * (D / 32);
    constexpr int NITEMS = I_QKV + I_O + I_ML + I_O + 2 * I_1 + 2 * I_2;
    for (int it = gw; it < NITEMS; it += NGW) {
        int r = it;
        if (r < I_QKV) { p0_transpose_item(a.in[3], D, NQKV, NQKV / 32, (bf16*)(ws + WS_WQKV), a.in[2], 0xffff, 1.f, scr, r, F.lane); continue; } r -= I_QKV;
        if (r < I_O) { p0_transpose_item(a.in[9], D, D, D / 32, (bf16*)(ws + WS_WAO), a.in[8], 127, 1.f - LAMBDA_INIT0, scr, r, F.lane); continue; } r -= I_O;
        if (r < I_ML) { p0_transpose_item(a.in[11], D, MLW, NPROJ / 32, (bf16*)(ws + WS_WML), a.in[10], 0xffff, 1.f, scr, r, F.lane); continue; } r -= I_ML;
        if (r < I_O) { p0_transpose_item(a.in[17], D, D, D / 32, (bf16*)(ws + WS_WMO), a.in[16], 0xffff, 1.f, scr, r, F.lane); continue; } r -= I_O;
        if (r < 2 * I_1) { const int l = r / I_1; p0_transpose_item(a.in[19] + (size_t)l * D * FF, D, FF, FF / 32, (bf16*)(ws + WS_W1) + (size_t)l * D * FF, a.in[18] + l * D, 0xffff, 1.f, scr, r % I_1, F.lane); continue; } r -= 2 * I_1;
        { const int l = r / I_2; p0_transpose_item(a.in[20] + (size_t)l * D * FF, FF, D, D / 32, (bf16*)(ws + WS_W2) + (size_t)l * D * FF, nullptr, 0, 1.f, scr, r % I_2, F.lane); }
    }
    { float* WG = (float*)(ws + WS_WG); const int gt = (F.vcu * NWAVES + F.wave) * 64 + F.lane, NGT = F.G * NWAVES * 64;
      for (int i = gt; i < 8 * D; i += NGT) { const int j = i / D, k = i % D; WG[i] = a.in[10][k] * a.in[11][(size_t)k * MLW + NPROJ + j]; } }
    bf16* XN = (bf16*)(ws + WS_XN);
    for (int m = gw; m < M; m += NGW) { f32x4 v[4]; rms_row_load(a.in[0] + (size_t)m * D, F.lane, v); row_store_bf16(XN + (size_t)m * D, F.lane, v); }
}
__device__ __forceinline__ void norm_phase(Frame& F, const float* H, bf16* XN, const float* WG, float* GATES, const float* b_i, const float* b_f) {
    const int gw = F.vcu * NWAVES + F.wave, NGW = F.G * NWAVES;
    LAS f32x4* wg = (LAS f32x4*)(F.lds + RING_OFF);
    if (GATES) { for (int i = F.tid; i < 8 * D / 4; i += NWAVES * 64) wg[i] = ((const GAS f32x4*)WG)[i]; __syncthreads(); }
    for (int m = gw; m < M; m += NGW) {
        f32x4 v[4]; rms_row_load(H + (size_t)m * D, F.lane, v); row_store_bf16(XN + (size_t)m * D, F.lane, v);
        if (GATES) {
            float mine = 0.f;
#pragma unroll
            for (int j = 0; j < 8; ++j) { float s = 0.f;
#pragma unroll
                for (int jj = 0; jj < 4; ++jj) { const f32x4 w = wg[j * 256 + jj * 64 + F.lane]; s += (v[jj].x * w.x + v[jj].y * w.y) + (v[jj].z * w.z + v[jj].w * w.w); }
                s = wave_sum(s); if (F.lane == j) mine = s; }
            if (F.lane < 4) GATES[(size_t)m * 8 + F.lane] = mine + b_i[F.lane];
            else if (F.lane < 8) GATES[(size_t)m * 8 + F.lane] = log_sigmoid(mine + b_f[F.lane - 4]);
        }
    }
    if (GATES) __syncthreads();
}
__device__ __forceinline__ void final_norm_phase(Frame& F, const float* H, const float* g, float* out) {
    const int gw = F.vcu * NWAVES + F.wave, NGW = F.G * NWAVES;
    for (int m = gw; m < M; m += NGW) {
        f32x4 v[4]; rms_row_load(H + (size_t)m * D, F.lane, v);
        GAS f32x4* o = (GAS f32x4*)(out + (size_t)m * D) + F.lane; const GAS f32x4* gg = (const GAS f32x4*)g + F.lane;
#pragma unroll
        for (int j = 0; j < 4; ++j) o[64 * j] = v[j] * gg[64 * j];
    }
}

__device__ __forceinline__ float bf2f(bf16 v) { return __uint_as_float((unsigned)v << 16); }
__device__ __forceinline__ int t5_bucket(int d) {
    if (d < 16) return d;
    const float v = logf((float)d / 16.f) / logf(8.f) * 16.f; int b = 16 + (int)v; return b > 31 ? 31 : b;
}
__device__ __forceinline__ void naive_attn_phase(Frame& F, const bf16* __restrict__ QKV, const float* __restrict__ rel_bias, const float* __restrict__ lq1, const float* __restrict__ lk1,
                                                  const float* __restrict__ lq2, const float* __restrict__ lk2, bf16* AO) {
    LAS float* lut = (LAS float*)(F.lds + RING_OFF);
    const int tid = F.tid, half = tid & 1;
    float s1 = 0.f, s2 = 0.f;
    for (int i = 0; i < 64; ++i) { s1 += lq1[i] * lk1[i]; s2 += lq2[i] * lk2[i]; }
    const float lam = expf(s1) - expf(s2) + LAMBDA_INIT0;
    for (int u = F.vcu; u < BATCH * NH_A * (SEQ / 256); u += F.G) {
        const int qb = u % (SEQ / 256), h = (u / (SEQ / 256)) % NH_A, b = u / (SEQ / 256) / NH_A, q0 = qb * 256, q = q0 + (tid >> 1);
        __syncthreads();
        if (tid < 128) lut[tid] = rel_bias[t5_bucket(tid) * NH_A + h] * LOG2E;
        __syncthreads();
        const size_t tok = (size_t)b * SEQ + q;
        float res[64];
        for (int m = 0; m < 2; ++m) {
            float qv[64];
            const bf16* qp = QKV + tok * NQKV + h * 128 + m * 64;
#pragma unroll
            for (int d = 0; d < 64; ++d) qv[d] = bf2f(qp[d]);
            float o[64];
#pragma unroll
            for (int d = 0; d < 64; ++d) o[d] = 0.f;
            float mrun = -1e30f, l = 0.f;
            const int kend = q0 + 256;
            for (int k = 0; k < kend; ++k) {
                const bf16* kr = QKV + ((size_t)b * SEQ + k) * NQKV + D + h * 128 + m * 64;
                const bf16* vr = QKV + ((size_t)b * SEQ + k) * NQKV + 2 * D + h * 128 + half * 64;
                float s = 0.f;
#pragma unroll
                for (int d = 0; d < 64; ++d) s += qv[d] * bf2f(kr[d]);
                const int dist = q - k;
                if (dist >= 0) {
                    s += lut[dist < 127 ? dist : 127];
                    if (s > mrun) { const float al = exp2f(mrun - s); l *= al;
#pragma unroll
                        for (int d = 0; d < 64; ++d) o[d] *= al;
                        mrun = s; }
                    const float p = exp2f(s - mrun); l += p;
#pragma unroll
                    for (int d = 0; d < 64; ++d) o[d] += p * bf2f(vr[d]);
                }
            }
            const float il = 1.f / l;
            if (m == 0) {
#pragma unroll
                for (int d = 0; d < 64; ++d) res[d] = o[d] * il;
            } else {
                float ss = 0.f;
#pragma unroll
                for (int d = 0; d < 64; ++d) { res[d] = res[d] - lam * (o[d] * il); ss += res[d] * res[d]; }
                ss += __shfl_xor(ss, 1);
                const float rstd = 1.f / sqrtf(ss * (1.f / 128.f) + EPS);
                bf16* op = AO + tok * D + h * 128 + half * 64;
#pragma unroll
                for (int d = 0; d < 64; d += 2) *(unsigned*)(op + d) = pk2(res[d] * rstd, res[d + 1] * rstd);
            }
        }
    }
    __syncthreads();
}
__device__ __forceinline__ void naive_mlstm_phase(Frame& F, const bf16* __restrict__ PROJ, const float* __restrict__ GATES, const float* __restrict__ conv_w, const float* __restrict__ conv_b, bf16* AO) {
    LAS float* q_s = (LAS float*)(F.lds + RING_OFF); LAS float* k_s = q_s + 128; LAS float* v_s = q_s + 256; LAS float* red = q_s + 512;
    const int tid = F.tid, dv = tid >> 1, half = tid & 1, lane = F.lane, wave = F.wave;
    for (int u = (int)blockIdx.x; u < BATCH * NH_M; u += F.G) {
        const int h = u & 3, b = u >> 2;
        float C[64], n[64];
#pragma unroll
        for (int j = 0; j < 64; ++j) { C[j] = 0.f; n[j] = 0.f; }
        float mst = 0.f;
        const int col = (tid < 128) ? (h * 128 + tid) : (512 + h * 128 + ((tid - 128) & 127));
        float cw0 = 0.f, cw1 = 0.f, cw2 = 0.f, cw3 = 0.f, cb = 0.f;
        if (tid < 256) { cw0 = conv_w[0 * D + col]; cw1 = conv_w[1 * D + col]; cw2 = conv_w[2 * D + col]; cw3 = conv_w[3 * D + col]; cb = conv_b[col]; }
        __syncthreads();
        for (int t = 0; t < SEQ; ++t) {
            const size_t tok = (size_t)b * SEQ + t;
            if (tid < 256) {
                float x3 = bf2f(PROJ[tok * NPROJ + col]);
                float x2 = t >= 1 ? bf2f(PROJ[(tok - 1) * NPROJ + col]) : 0.f;
                float x1 = t >= 2 ? bf2f(PROJ[(tok - 2) * NPROJ + col]) : 0.f;
                float x0 = t >= 3 ? bf2f(PROJ[(tok - 3) * NPROJ + col]) : 0.f;
                float y = cw0 * x0 + cw1 * x1 + cw2 * x2 + cw3 * x3 + cb;
                y = y / (1.f + expf(-y));
                if (tid < 128) q_s[tid] = y * MQSCALE; else k_s[tid - 128] = y;
            } else {
                v_s[tid - 256] = bf2f(PROJ[tok * NPROJ + 1024 + h * 256 + (tid - 256)]);
            }
            const float ig = GATES[tok * 8 + h], lf = GATES[tok * 8 + 4 + h];
            __syncthreads();
            const float mnew = fmaxf(lf + mst, ig), fd = expf(lf + mst - mnew), gi = expf(ig - mnew);
            mst = mnew;
            const float gv = gi * v_s[dv];
            float num = 0.f, den = 0.f;
#pragma unroll
            for (int j = 0; j < 64; ++j) { const float kk = k_s[half * 64 + j], qq = q_s[half * 64 + j];
                C[j] = fd * C[j] + gv * kk; n[j] = fd * n[j] + gi * kk; num += C[j] * qq; den += n[j] * qq; }
            num += __shfl_xor(num, 1); den += __shfl_xor(den, 1);
            const float hv = num / fmaxf(fabsf(den), expf(-mnew));
            float ss = half == 0 ? hv * hv : 0.f;
            ss = wave_sum(ss);
            if (lane == 0) red[wave] = ss;
            __syncthreads();
            float tot = 0.f;
#pragma unroll
            for (int w = 0; w < 8; ++w) tot += red[w];
            const float rstd = 1.f / sqrtf(tot * (1.f / 256.f) + EPS);
            if (half == 0) { const float op = bf2f(PROJ[tok * NPROJ + 2048 + h * 256 + dv]); const float sg = 1.f / (1.f + expf(-op));
                AO[tok * D + h * 256 + dv] = (bf16)f2bf(sg * hv * rstd); }
            __syncthreads();
        }
    }
}

__device__ __forceinline__ void attn_phase(Frame& F, const bf16* __restrict__ QKV, bf16* AO, float* stash, const float* __restrict__ rel_bias, const float* __restrict__ lq1, const float* __restrict__ lk1,
                                           const float* __restrict__ lq2, const float* __restrict__ lk2) {
    using da::f32x16; using da::f32x4;
    LAS char* lds = (LAS char*)(F.lds + RING_OFF);
    LAS float* lut = (LAS float*)(lds + da::OFF_LUT);
    const int tid = F.tid, lane = F.lane, wid = F.wave, r32 = lane & 31, hi = lane >> 5;
    float s1 = 0.f, s2 = 0.f;
    for (int i = 0; i < 64; ++i) { s1 += lq1[i] * lk1[i]; s2 += lq2[i] * lk2[i]; }
    const float lam = expf(s1) - expf(s2) + LAMBDA_INIT0;
    f32x4* st = (f32x4*)(stash + (((size_t)blockIdx.x * NWAVES + wid) * 64 + lane) * 64);
    for (int L = F.vcu; L < BATCH * NH_A * 4; L += F.G) {
        const int bh = L >> 2, x = L & 3, b = bh >> 3, h = bh & 7;
        __syncthreads();
        if (tid < 128) lut[tid] = rel_bias[t5_bucket(tid) * NH_A + h] * LOG2E;
        __syncthreads();
        const float c31 = lut[127];
        for (int s = 0; s < 4; ++s) {
            const int qb = (s >> 1) ? 7 - x : x, m = s & 1, P0 = qb * 256;
            const bf16* Qp = QKV + ((size_t)b * SEQ + P0) * NQKV + h * 128 + m * 64;
            const bf16* Kp = QKV + (size_t)b * SEQ * NQKV + D + h * 128 + m * 64;
            const bf16* Vp = QKV + (size_t)b * SEQ * NQKV + 2 * D + h * 128;
            f32x16 o[4];
            da::attn_block(Qp, Kp, Vp, P0, lds, c31, o);
            if (m == 0) {
#pragma unroll
                for (int i = 0; i < 16; ++i) st[i] = (f32x4){o[i >> 2][(i & 3) * 4 + 0], o[i >> 2][(i & 3) * 4 + 1], o[i >> 2][(i & 3) * 4 + 2], o[i >> 2][(i & 3) * 4 + 3]};
            } else {
#pragma unroll
                for (int i = 0; i < 16; ++i) { const f32x4 a = st[i];
#pragma unroll
                    for (int e = 0; e < 4; ++e) o[i >> 2][(i & 3) * 4 + e] = a[e] - lam * o[i >> 2][(i & 3) * 4 + e]; }
                bf16* Ow = AO + ((size_t)b * SEQ + P0 + wid * 32) * D + h * 128;
#pragma unroll
                for (int r = 0; r < 16; ++r) {
                    float ss = (o[0][r] * o[0][r] + o[1][r] * o[1][r]) + (o[2][r] * o[2][r] + o[3][r] * o[3][r]);
#pragma unroll
                    for (int off = 1; off < 32; off <<= 1) ss += __shfl_xor(ss, off);
                    const float rstd = 1.f / sqrtf(ss * (1.f / 128.f) + EPS);
                    const int orow = da::crow(r, hi);
#pragma unroll
                    for (int d0 = 0; d0 < 4; ++d0) { const float v = o[d0][r] * rstd; const float vn = __shfl_xor(v, 1);
                        if ((r32 & 1) == 0) *(unsigned*)(Ow + (size_t)orow * D + d0 * 32 + r32) = da::cvtpk(v, vn); }
                }
            }
        }
    }
    __syncthreads();
}

__global__ void __launch_bounds__(NWAVES * 64, 2) fwd(Args args) {
    extern __shared__ __attribute__((aligned(16))) unsigned char lds[];
    Frame F;
    F.lds = (LAS unsigned char*)lds;
    F.MISC = (volatile LAS unsigned*)(F.lds + MISC_OFF);
    F.tid = threadIdx.x; F.lane = F.tid & 63; F.wave = __builtin_amdgcn_readfirstlane(F.tid >> 6);
    F.G = gridDim.x; { const int bx = blockIdx.x; F.vcu = (F.G % 8 == 0) ? (bx % 8) * (F.G / 8) + bx / 8 : bx; }
    unsigned char* ws = args.ws;
    F.ctl = (gu32*)(ws + WS_CTL);
    for (int u = F.tid; u < (LDS_BYTES - LDSCTL_OFF) / 4; u += NWAVES * 64) ((LAS unsigned*)(F.lds + LDSCTL_OFF))[u] = 0u;
    __syncthreads();
    const int lo = args.ph_lo, hi = args.ph_hi;
    const bool use_bar = (hi - lo) > 1;
    XcdBarrier bar; bar.bar = (unsigned*)(F.ctl + CW_BAR) + args.li * XCD_BAR_WORDS; bar.x = 0; bar.st = nullptr;
    if (use_bar) bar = xcd_barrier_post((unsigned*)(F.ctl + CW_BAR) + args.li * XCD_BAR_WORDS, F.MISC + 8);
#define IN(k) (lo <= (k) && (k) < hi)
#define SEAM(k) do { if (IN(k) && IN((k) + 1)) xcd_barrier(bar); } while (0)
    bf16* const XN = (bf16*)(ws + WS_XN); bf16* const AO = XN; bf16* const QKV = (bf16*)(ws + WS_U); bf16* const U = (bf16*)(ws + WS_U);
    float* const H = args.out;
    using pg8::Gemm; using pg8::StaticOrder; using pg8::EpiBf16; using pg8::EpiResF32;

    if (IN(0)) { p0_prologue(F, args); SEAM(0); }
    if (IN(1)) { Gemm g{XN, (const bf16*)(ws + WS_WQKV), M, NQKV, D}; StaticOrder S; S.init(M, NQKV, F.G, (int)blockIdx.x);
        EpiBf16<0> E{QKV, NQKV, D, QSCALE}; pg8::gemm_phase<EpiBf16<0>, StaticOrder, PG8_ALIGN, PG8_SP2>(F.lds + RING_OFF, g, S, E); SEAM(1); }
#ifdef NAIVE_ATTN
    if (IN(2)) { naive_attn_phase(F, QKV, args.in[1], args.in[4], args.in[5], args.in[6], args.in[7], AO); SEAM(2); }
#else
    if (IN(2)) { attn_phase(F, QKV, AO, (float*)(ws + WS_HT), args.in[1], args.in[4], args.in[5], args.in[6], args.in[7]); SEAM(2); }
#endif
    if (IN(3)) { Gemm g{AO, (const bf16*)(ws + WS_WAO), M, D, D}; StaticOrder S; S.init(M, D, F.G, (int)blockIdx.x);
        EpiResF32 E{args.in[0], H, D}; pg8::gemm_phase<EpiResF32, StaticOrder, PG8_ALIGN, PG8_SP2>(F.lds + RING_OFF, g, S, E); SEAM(3); }
    if (IN(4)) { norm_phase(F, H, XN, nullptr, nullptr, nullptr, nullptr); SEAM(4); }
    if (IN(5)) { Gemm g{XN, (const bf16*)(ws + WS_W1), M, FF, D}; StaticOrder S; S.init(M, FF, F.G, (int)blockIdx.x);
        EpiBf16<2> E{U, FF, 0, 1.f}; pg8::gemm_phase<EpiBf16<2>, StaticOrder, PG8_ALIGN, PG8_SP2>(F.lds + RING_OFF, g, S, E); SEAM(5); }
    if (IN(6)) { Gemm g{U, (const bf16*)(ws + WS_W2), M, D, FF}; StaticOrder S; S.init(M, D, F.G, (int)blockIdx.x);
        EpiResF32 E{H, H, D}; pg8::gemm_phase<EpiResF32, StaticOrder, PG8_ALIGN, PG8_SP2>(F.lds + RING_OFF, g, S, E); SEAM(6); }
    if (IN(7)) { norm_phase(F, H, XN, (const float*)(ws + WS_WG), (float*)(ws + WS_GATES), args.in[12], args.in[13]); SEAM(7); }
    if (IN(8)) { Gemm g{XN, (const bf16*)(ws + WS_WML), M, NPROJ, D}; StaticOrder S; S.init(M, NPROJ, F.G, (int)blockIdx.x);
        EpiBf16<0> E{QKV, NPROJ, 0, 1.f}; pg8::gemm_phase<EpiBf16<0>, StaticOrder, PG8_ALIGN, PG8_SP2>(F.lds + RING_OFF, g, S, E); SEAM(8); }
    if (IN(9)) { naive_mlstm_phase(F, QKV, (const float*)(ws + WS_GATES), args.in[14], args.in[15], AO); SEAM(9); }
    if (IN(10)) { SEAM(10); }
    if (IN(11)) { Gemm g{AO, (const bf16*)(ws + WS_WMO), M, D, D}; StaticOrder S; S.init(M, D, F.G, (int)blockIdx.x);
        EpiResF32 E{H, H, D}; pg8::gemm_phase<EpiResF32, StaticOrder, PG8_ALIGN, PG8_SP2>(F.lds + RING_OFF, g, S, E); SEAM(11); }
    if (IN(12)) { norm_phase(F, H, XN, nullptr, nullptr, nullptr, nullptr); SEAM(12); }
    if (IN(13)) { Gemm g{XN, (const bf16*)(ws + WS_W1) + (size_t)D * FF, M, FF, D}; StaticOrder S; S.init(M, FF, F.G, (int)blockIdx.x);
        EpiBf16<2> E{U, FF, 0, 1.f}; pg8::gemm_phase<EpiBf16<2>, StaticOrder, PG8_ALIGN, PG8_SP2>(F.lds + RING_OFF, g, S, E); SEAM(13); }
    if (IN(14)) { Gemm g{U, (const bf16*)(ws + WS_W2) + (size_t)D * FF, M, D, FF}; StaticOrder S; S.init(M, D, F.G, (int)blockIdx.x);
        EpiResF32 E{H, H, D}; pg8::gemm_phase<EpiResF32, StaticOrder, PG8_ALIGN, PG8_SP2>(F.lds + RING_OFF, g, S, E); SEAM(14); }
    if (IN(15)) { final_norm_phase(F, H, args.in[21], args.out); }
#undef IN
#undef SEAM
}

extern "C" void kernel_launch(void* const* d_in, const int* in_sizes, int n_in, void* d_out, int out_size, void* d_ws, size_t ws_size, hipStream_t stream) {
    static int grid = 0;
    if (grid == 0) {
        if (n_in != 22 || in_sizes[0] != M * D || out_size != M * D || ws_size < WS_END) { fprintf(stderr, "kernel_launch: unexpected shapes (n_in %d, in0 %d, out %d, ws %zu); nothing launched\n", n_in, n_in > 0 ? in_sizes[0] : -1, out_size, ws_size); grid = -1; return; }
        int dev = 0, cus = 0, per_cu = 0;
        if (hipGetDevice(&dev) != hipSuccess || hipDeviceGetAttribute(&cus, hipDeviceAttributeMultiprocessorCount, dev) != hipSuccess) { grid = -1; return; }
        if (hipFuncSetAttribute((const void*)fwd, hipFuncAttributeMaxDynamicSharedMemorySize, LDS_BYTES) != hipSuccess) { fprintf(stderr, "kernel_launch: hipFuncSetAttribute failed\n"); grid = -1; return; }
        if (hipOccupancyMaxActiveBlocksPerMultiprocessor(&per_cu, (const void*)fwd, NWAVES * 64, LDS_BYTES) != hipSuccess || per_cu < 1) fprintf(stderr, "kernel_launch: occupancy query says %d\n", per_cu);
        (void)hipGetLastError();
        grid = cus;
    }
    if (grid < 0) return;
    (void)hipMemsetAsync((char*)d_ws + WS_CTL, 0, CTL_ZERO_BYTES, stream);
    Args a{};
    for (int i = 0; i < 22; ++i) a.in[i] = (const float*)d_in[i];
    a.out = (float*)d_out; a.ws = (unsigned char*)d_ws;
    int li = 0;
    auto run = [&](int lo, int hi) { a.ph_lo = lo; a.ph_hi = hi; a.li = li++; hipLaunchKernelGGL(fwd, dim3(grid), dim3(NWAVES * 64), LDS_BYTES, stream, a); };
    run(0, NPHASE);
}
```

```cpp
#include <hip/hip_runtime.h>
#include <cstdio>
#include <cstdint>
namespace pg8 {
#define PG8_LAS __attribute__((address_space(3)))
typedef unsigned short bf16_t;
typedef short bf16x8 __attribute__((ext_vector_type(8)));
typedef float f32x4 __attribute__((ext_vector_type(4)));
typedef unsigned u32x4 __attribute__((ext_vector_type(4)));
constexpr int BM = 256, BK = 64, HALF = 128, HTB = HALF * BK * 2  , STAGE_BYTES = 8 * HTB, NXCD = 8, WGM = 8;

__host__ __device__ __forceinline__ int lds_byte(int r, int c) { const int st = (r >> 4) * 2 + (c >> 5), rr = r & 15, cc = c & 31, ob = rr * 64 + cc * 2; return st * 1024 + (ob ^ (((ob >> 9) & 1) << 5)); }
__host__ __device__ __forceinline__ void stage_rc(int b, int& R, int& C) { const int st = b / 1024, sb = b % 1024, swz = sb ^ (((sb >> 9) & 1) << 5); R = (st >> 1) * 16 + swz / 64; C = (st & 1) * 32 + (swz % 64) / 2; }
__host__ __device__ __forceinline__ int perm32(int rho) { const int n = rho >> 4, i = rho & 15; return 8 * (i >> 2) + 4 * n + (i & 3); }

struct Unit { int pm, pn; };
struct Gemm { const bf16_t* A; const bf16_t* Bt; int M, N, K; };

struct StaticOrder {
    int nM, nN, nwg, G, c;
    __host__ __device__ void init(int M, int N, int G_, int c_) { nM = M / BM; nN = N / BM; nwg = nM * nN; G = G_; c = c_; }
    __host__ __device__ bool next(int i, Unit& u) const {
        const long L = (long)i * G + c; if (L >= nwg) return false;
        int wgid = (int)L; { const int q = nwg / NXCD, r = nwg % NXCD, xcd = wgid % NXCD, off = wgid / NXCD; wgid = (xcd < r ? xcd * (q + 1) : r * (q + 1) + (xcd - r) * q) + off; }
        const int nig = WGM * nN, gid = wgid / nig, fm = gid * WGM, gsz = (nM - fm) < WGM ? (nM - fm) : WGM;
        u.pm = fm + ((wgid % nig) % gsz); u.pn = (wgid % nig) / gsz; return true;
    }
    __device__ __forceinline__ void a_ready(const Unit&) const {}
    __device__ __forceinline__ void done(const Unit&) const {}
};

__device__ __forceinline__ unsigned cvt_pk_bf16(float lo, float hi) { unsigned r; asm volatile("v_cvt_pk_bf16_f32 %0, %1, %2" : "=v"(r) : "v"(lo), "v"(hi)); return r; }
template <int ACT> struct EpiBf16 {
    static constexpr bool PERM = true, AFTER_DRAIN = false;
    bf16_t* O; int ldc; int scale_cols; float scale0;
    __device__ __forceinline__ void operator()(const f32x4 (&acc)[2][2][4][2], const Unit& u, int wr, int wc, int fr, int fq) const {
        const int row0 = u.pm * BM + wr * 64 + fr; const int colt = u.pn * BM;
        const float sc = (colt < scale_cols) ? scale0 : 1.f;
        const int col0 = colt + wc * 32 + 8 * fq;
#pragma unroll
        for (int ai = 0; ai < 2; ++ai)
#pragma unroll
            for (int m = 0; m < 4; ++m) { bf16_t* rowp = O + (size_t)(row0 + ai * HALF + m * 16) * ldc + col0;
#pragma unroll
                for (int bj = 0; bj < 2; ++bj) { f32x4 v0 = acc[ai][bj][m][0], v1 = acc[ai][bj][m][1];
                    if (ACT == 2) {
#pragma unroll
                        for (int e = 0; e < 4; ++e) { const float a = fmaxf(v0[e], 0.f), b = fmaxf(v1[e], 0.f); v0[e] = a * a; v1[e] = b * b; } }
                    v0 = v0 * sc; v1 = v1 * sc; u32x4 w; w.x = cvt_pk_bf16(v0[0], v0[1]); w.y = cvt_pk_bf16(v0[2], v0[3]); w.z = cvt_pk_bf16(v1[0], v1[1]); w.w = cvt_pk_bf16(v1[2], v1[3]);
                    *(u32x4*)(rowp + bj * HALF) = w; } }
    }
};
struct EpiResF32 {
    static constexpr bool PERM = false, AFTER_DRAIN = false;
    const float* base; float* out; int ldc;
    __device__ __forceinline__ void operator()(const f32x4 (&acc)[2][2][4][2], const Unit& u, int wr, int wc, int fr, int fq) const {
        const int row0 = u.pm * BM + wr * 64 + fr; const int col0 = u.pn * BM + wc * 32 + 4 * fq;
#pragma unroll
        for (int ai = 0; ai < 2; ++ai)
#pragma unroll
            for (int m = 0; m < 4; ++m) { const size_t off = (size_t)(row0 + ai * HALF + m * 16) * ldc + col0;
#pragma unroll
                for (int bj = 0; bj < 2; ++bj)
#pragma unroll
                    for (int n = 0; n < 2; ++n) { const f32x4 bs = *(const f32x4*)(base + off + bj * HALF + n * 16);
                        *(f32x4*)(out + off + bj * HALF + n * 16) = bs + acc[ai][bj][m][n]; } }
    }
};

template <class Epi, class Sched, bool ALIGN_EPI = false, bool SP2 = false>
__device__ __forceinline__ void gemm_phase(PG8_LAS unsigned char* lds, const Gemm g, const Sched& S, const Epi& E) {
    const int tid = threadIdx.x, wid = __builtin_amdgcn_readfirstlane(tid >> 6), lane = tid & 63, wr = wid >> 2, wc = wid & 3, fr = lane & 15, fq = lane >> 4;
    const int K = g.K, nt = K / BK;
    unsigned voffA[2], voffB[2];
#pragma unroll
    for (int i = 0; i < 2; ++i) { int R, C; stage_rc(tid * 16 + i * 8192, R, C); const int Rb = Epi::PERM ? ((R & ~31) + perm32(R & 31)) : R;
        voffA[i] = (unsigned)(R * K + C) * 2u; voffB[i] = (unsigned)(Rb * K + C) * 2u; }
    const size_t kstep = (size_t)(BK * 2);
    const size_t hstep = (size_t)HALF * K * 2;
    const size_t tstep = 2 * hstep;
    const unsigned ldsw = (unsigned)wid * 1024u;
    const int aoff = lds_byte(wr * 64 + fr, fq * 8), boff = lds_byte(wc * 32 + fr, fq * 8);
#define PG8_SA(b, h) (((b) * 2 + (h)) * HTB)
#define PG8_SB(b, h) ((4 + (b) * 2 + (h)) * HTB)
#define PG8_STAGE(bufoff, gbase, voff) do { _Pragma("unroll") for (int _i = 0; _i < 2; ++_i) \
        __builtin_amdgcn_global_load_lds((const unsigned*)((const char*)(gbase) + (voff)[_i]), (PG8_LAS unsigned*)(lds + (bufoff) + ldsw + _i * 8192), 16, 0, 0); } while (0)
#define PG8_LDA(dst, b, h) do { _Pragma("unroll") for (int m = 0; m < 4; ++m) _Pragma("unroll") for (int k = 0; k < 2; ++k) dst[m][k] = *(const PG8_LAS bf16x8*)(lds + PG8_SA(b, h) + aoff + m * 2048 + k * 1024); } while (0)
#define PG8_LDB(dst, b, h) do { _Pragma("unroll") for (int n = 0; n < 2; ++n) _Pragma("unroll") for (int k = 0; k < 2; ++k) dst[n][k] = *(const PG8_LAS bf16x8*)(lds + PG8_SB(b, h) + boff + n * 2048 + k * 1024); } while (0)
#define PG8_MMA(ai, bj, At, Bt) do { __builtin_amdgcn_s_setprio(1); _Pragma("unroll") for (int m = 0; m < 4; ++m) _Pragma("unroll") for (int n = 0; n < 2; ++n) _Pragma("unroll") for (int k = 0; k < 2; ++k) \
        acc[ai][bj][m][n] = __builtin_amdgcn_mfma_f32_16x16x32_bf16(Bt[n][k], At[m][k], acc[ai][bj][m][n], 0, 0, 0); __builtin_amdgcn_s_setprio(0); } while (0)
#define PG8_WAIT_V(n) asm volatile("s_waitcnt vmcnt(" #n ")" ::: "memory")
#define PG8_WAIT_L(n) asm volatile("s_waitcnt lgkmcnt(" #n ")" ::: "memory")
#define PG8_BAR __builtin_amdgcn_s_barrier()
#define PG8_SCHED __builtin_amdgcn_sched_barrier(0)
    Unit cur, nxt; int ui = 0;
    if (!S.next(0, cur)) return;
    f32x4 acc[2][2][4][2];
#pragma unroll
    for (int a = 0; a < 2; ++a)
#pragma unroll
        for (int b = 0; b < 2; ++b)
#pragma unroll
            for (int m = 0; m < 4; ++m)
#pragma unroll
                for (int n = 0; n < 2; ++n) acc[a][b][m][n] = (f32x4){0.f, 0.f, 0.f, 0.f};
    bf16x8 At[4][2], B0[2][2], B1[2][2];
    const char* cA = (const char*)g.A + (size_t)cur.pm * tstep; const char* cB = (const char*)g.Bt + (size_t)cur.pn * tstep;
    S.a_ready(cur);
    if constexpr (SP2) {
        PG8_STAGE(PG8_SB(0, 0), cB, voffB); PG8_STAGE(PG8_SB(0, 1), cB + hstep, voffB); PG8_STAGE(PG8_SA(0, 0), cA, voffA); PG8_STAGE(PG8_SA(0, 1), cA + hstep, voffA);
        if (wr == 1) PG8_BAR;
        PG8_WAIT_V(2); PG8_BAR;
        PG8_STAGE(PG8_SB(1, 0), cB + kstep, voffB); PG8_STAGE(PG8_SA(1, 0), cA + kstep, voffA); PG8_STAGE(PG8_SB(1, 1), cB + hstep + kstep, voffB);
        PG8_WAIT_V(6); PG8_BAR;
    } else {
        PG8_STAGE(PG8_SB(0, 0), cB, voffB); PG8_STAGE(PG8_SA(0, 0), cA, voffA); PG8_STAGE(PG8_SB(0, 1), cB + hstep, voffB); PG8_STAGE(PG8_SA(0, 1), cA + hstep, voffA);
        if (wr == 1) PG8_BAR;
        PG8_WAIT_V(4); PG8_BAR;
        PG8_STAGE(PG8_SB(1, 0), cB + kstep, voffB); PG8_STAGE(PG8_SA(1, 0), cA + kstep, voffA); PG8_STAGE(PG8_SB(1, 1), cB + hstep + kstep, voffB);
        PG8_WAIT_V(6); PG8_BAR;
    }
    for (;;) {
        const bool has_next = S.next(ui + 1, nxt);
        const char* nA = has_next ? (const char*)g.A + (size_t)nxt.pm * tstep : cA; const char* nB = has_next ? (const char*)g.Bt + (size_t)nxt.pn * tstep : cB;
        for (int t = 0; t < nt; t += 2) {
            const bool last = (t == nt - 2);
            const char* a1 = cA + (size_t)(t + 1) * kstep;
            const char* a2 = last ? nA : cA + (size_t)(t + 2) * kstep; const char* b2 = last ? nB : cB + (size_t)(t + 2) * kstep;
            const char* a3 = a2 + kstep; const char* b3 = b2 + kstep;
            if (last && has_next) S.a_ready(nxt);
            if constexpr (SP2) {
            PG8_LDB(B0, 0, 0); PG8_LDB(B1, 0, 1); PG8_SCHED; PG8_LDA(At, 0, 0); PG8_STAGE(PG8_SA(1, 1), a1 + hstep, voffA);
            PG8_WAIT_V(8); PG8_WAIT_L(0); PG8_BAR; PG8_MMA(0, 0, At, B0); PG8_MMA(0, 1, At, B1); PG8_BAR; PG8_SCHED;
            PG8_LDA(At, 0, 1); PG8_STAGE(PG8_SB(0, 0), b2, voffB); PG8_STAGE(PG8_SB(0, 1), b2 + hstep, voffB); PG8_STAGE(PG8_SA(0, 0), a2, voffA);
            PG8_WAIT_V(8); PG8_WAIT_L(0); PG8_BAR; PG8_MMA(1, 0, At, B0); PG8_MMA(1, 1, At, B1); PG8_BAR; PG8_SCHED;
            PG8_LDB(B0, 1, 0); PG8_LDB(B1, 1, 1); PG8_SCHED; PG8_LDA(At, 1, 0); PG8_STAGE(PG8_SA(0, 1), a2 + hstep, voffA);
            PG8_WAIT_V(8); PG8_WAIT_L(0); PG8_BAR; PG8_MMA(0, 0, At, B0); PG8_MMA(0, 1, At, B1); PG8_BAR; PG8_SCHED;
            PG8_LDA(At, 1, 1); PG8_STAGE(PG8_SB(1, 0), b3, voffB); PG8_STAGE(PG8_SB(1, 1), b3 + hstep, voffB); PG8_STAGE(PG8_SA(1, 0), a3, voffA);
            PG8_WAIT_V(8); PG8_WAIT_L(0); PG8_BAR; PG8_MMA(1, 0, At, B0); PG8_MMA(1, 1, At, B1); PG8_BAR; PG8_SCHED;
            } else {
            PG8_LDB(B0, 0, 0); PG8_SCHED; PG8_LDA(At, 0, 0); PG8_STAGE(PG8_SA(1, 1), a1 + hstep, voffA);
            PG8_WAIT_L(8); PG8_BAR; PG8_WAIT_L(0); PG8_MMA(0, 0, At, B0); PG8_BAR; PG8_SCHED;
            PG8_LDB(B1, 0, 1); PG8_STAGE(PG8_SB(0, 0), b2, voffB);
            PG8_BAR; PG8_WAIT_L(0); PG8_MMA(0, 1, At, B1); PG8_BAR;
            PG8_LDA(At, 0, 1); PG8_STAGE(PG8_SA(0, 0), a2, voffA);
            PG8_BAR; PG8_WAIT_L(0); PG8_MMA(1, 0, At, B0); PG8_BAR; PG8_SCHED;
            PG8_STAGE(PG8_SB(0, 1), b2 + hstep, voffB);
            PG8_WAIT_V(6); PG8_BAR; PG8_MMA(1, 1, At, B1); PG8_BAR;
            PG8_LDB(B0, 1, 0); PG8_SCHED; PG8_LDA(At, 1, 0); PG8_STAGE(PG8_SA(0, 1), a2 + hstep, voffA);
            PG8_WAIT_L(8); PG8_BAR; PG8_WAIT_L(0); PG8_MMA(0, 0, At, B0); PG8_BAR; PG8_SCHED;
            PG8_LDB(B1, 1, 1); PG8_STAGE(PG8_SB(1, 0), b3, voffB);
            PG8_BAR; PG8_WAIT_L(0); PG8_MMA(0, 1, At, B1); PG8_BAR;
            PG8_LDA(At, 1, 1); PG8_STAGE(PG8_SA(1, 0), a3, voffA);
            PG8_BAR; PG8_WAIT_L(0); PG8_MMA(1, 0, At, B0); PG8_BAR; PG8_SCHED;
            PG8_STAGE(PG8_SB(1, 1), b3 + hstep, voffB);
            PG8_WAIT_V(6); PG8_BAR; PG8_MMA(1, 1, At, B1); PG8_BAR;
            }
        }
        if constexpr (ALIGN_EPI) { if (wr == 0) PG8_BAR; }
        if constexpr (!Epi::AFTER_DRAIN) { E(acc, cur, wr, wc, fr, fq); S.done(cur); }
        if (!has_next) break;
#pragma unroll
        for (int a = 0; a < 2; ++a)
#pragma unroll
            for (int b = 0; b < 2; ++b)
#pragma unroll
                for (int m = 0; m < 4; ++m)
#pragma unroll
                    for (int n = 0; n < 2; ++n) acc[a][b][m][n] = (f32x4){0.f, 0.f, 0.f, 0.f};
        cur = nxt; cA = nA; cB = nB; ++ui;
        if constexpr (ALIGN_EPI) { if (wr == 1) PG8_BAR; }
    }
    PG8_WAIT_V(0);
    if constexpr (!ALIGN_EPI) { if (wr == 0) PG8_BAR; }
    PG8_BAR;
    if constexpr (Epi::AFTER_DRAIN) { E.fused(acc, cur, wr, wc, fr, fq, lds, wid, lane); S.done(cur); }
#undef PG8_SA
#undef PG8_SB
#undef PG8_STAGE
#undef PG8_LDA
#undef PG8_LDB
#undef PG8_MMA
#undef PG8_WAIT_V
#undef PG8_WAIT_L
#undef PG8_BAR
#undef PG8_SCHED
}
}

#ifndef PG8_SP2
#define PG8_SP2 true
#endif
#ifndef PG8_ALIGN
#define PG8_ALIGN true
#endif
namespace da {
typedef short bf16x8 __attribute__((ext_vector_type(8)));
typedef short s16x4 __attribute__((ext_vector_type(4)));
typedef float f32x16 __attribute__((ext_vector_type(16)));
typedef float f32x4 __attribute__((ext_vector_type(4)));
typedef unsigned u32x4 __attribute__((ext_vector_type(4)));
#define DLAS __attribute__((address_space(3)))
constexpr int NW = 8, QBLK = 32, KVBLK = 64, QB = NW * QBLK, PITCH = 3072;
constexpr int SHM_V = KVBLK * 128 * 2, SHM_K = KVBLK * 64 * 2;
constexpr int OFF_V = 0, OFF_K = 2 * SHM_V, OFF_WS = OFF_K + 2 * SHM_K, OFF_LUT = OFF_WS + NW * 64 * 4, LDS_BYTES = OFF_LUT + 512;
constexpr float THR = 8.f;
#define DA_KSWZ(row, c) ((row) * 128 + ((((c) ^ (((row) >> 1) & 7))) << 4))
#define DA_SBAR() __builtin_amdgcn_sched_barrier(0)
__device__ __forceinline__ int v_st(int k, int c) { const int kk = (k & ~0xC) | ((k & 4) << 1) | ((k & 8) >> 1); return ((kk >> 3) * 4 + (c >> 5)) * 512 + ((kk & 7) * 32 + (c & 31)) * 2; }
__device__ __forceinline__ int v_rd_base(int lane) { return ((lane & 3) << 3) | (((lane >> 2) & 3) << 6) | (((lane >> 4) & 1) << 5) | (((lane >> 5) & 1) << 8); }
constexpr int v_rd_off(int d0, int ks, int half) { return d0 * 512 + ks * 4096 + half * 2048; }
__device__ __forceinline__ int crow(int r, int hi) { return (r & 3) + 8 * (r >> 2) + 4 * hi; }
__device__ __forceinline__ unsigned cvtpk(float lo, float hi) { unsigned r; asm volatile("v_cvt_pk_bf16_f32 %0, %1, %2" : "=v"(r) : "v"(lo), "v"(hi)); return r; }
__device__ __forceinline__ void mask_tile(f32x16& p0, f32x16& p1, int dq) {
    const float NEG = -__builtin_inff();
#pragma unroll
    for (int r = 0; r < 16; ++r) { const int c = (r & 3) + 8 * (r >> 2); if (dq - c < 0) p0[r] = NEG; if (dq - c - 32 < 0) p1[r] = NEG; }
}
__device__ __forceinline__ void bias_tile(f32x16& p0, f32x16& p1, int dq, const DLAS float* lut) {
#pragma unroll
    for (int g = 0; g < 4; ++g) {
#pragma unroll
        for (int rr = 0; rr < 4; ++rr) { const int r = g * 4 + rr; const int c = (r & 3) + 8 * (r >> 2);
            int i0 = dq - c; i0 = i0 < 0 ? 0 : (i0 > 127 ? 127 : i0); int i1 = dq - c - 32; i1 = i1 < 0 ? 0 : (i1 > 127 ? 127 : i1);
            p0[r] += lut[i0]; p1[r] += lut[i1]; }
        DA_SBAR();
    }
}
__device__ __forceinline__ void partialSM(f32x16& p0, f32x16& p1, float& m_reg, float& alpha, float cb) {
    float pmax = p0[0];
#pragma unroll
    for (int r = 1; r < 16; ++r) pmax = fmaxf(pmax, p0[r]);
#pragma unroll
    for (int r = 0; r < 16; ++r) pmax = fmaxf(pmax, p1[r]);
    { auto rr = __builtin_amdgcn_permlane32_swap(__float_as_uint(pmax), __float_as_uint(pmax), false, false);
      pmax = fmaxf(__uint_as_float(rr[0]), __uint_as_float(rr[1])); }
    pmax += cb;
    float mn;
    if (__builtin_expect(__all(pmax - m_reg <= THR), 1)) { mn = m_reg; alpha = 1.f; }
    else { mn = fmaxf(m_reg, pmax); alpha = __builtin_amdgcn_exp2f(m_reg - mn); m_reg = mn; }
    const float off = cb - mn;
#pragma unroll
    for (int r = 0; r < 16; ++r) p0[r] += off;
#pragma unroll
    for (int r = 0; r < 16; ++r) p1[r] += off;
#pragma unroll
    for (int r = 0; r < 16; ++r) p0[r] = __builtin_amdgcn_exp2f(p0[r]);
}
__device__ __forceinline__ void finishSM(f32x16& p0, f32x16& p1, float alpha, float& l_reg, bf16x8& pa0, bf16x8& pa1, bf16x8& pa2, bf16x8& pa3) {
#pragma unroll
    for (int r = 0; r < 16; ++r) p1[r] = __builtin_amdgcn_exp2f(p1[r]);
    float ps = 0;
#pragma unroll
    for (int r = 0; r < 16; ++r) ps += p0[r];
#pragma unroll
    for (int r = 0; r < 16; ++r) ps += p1[r];
    { auto rr = __builtin_amdgcn_permlane32_swap(__float_as_uint(ps), __float_as_uint(ps), false, false);
      ps = __uint_as_float(rr[0]) + __uint_as_float(rr[1]); }
    l_reg = l_reg * alpha + ps;
#define DA_PK4(P, B_, OUT) do { unsigned a0 = cvtpk(P[B_+0], P[B_+1]), a1 = cvtpk(P[B_+2], P[B_+3]);                          \
        unsigned b0 = cvtpk(P[B_+4], P[B_+5]), b1 = cvtpk(P[B_+6], P[B_+7]);                                             \
        auto r0 = __builtin_amdgcn_permlane32_swap(a0, b0, false, false); auto r1 = __builtin_amdgcn_permlane32_swap(a1, b1, false, false); \
        u32x4 w = {r0[0], r1[0], r0[1], r1[1]}; OUT = *reinterpret_cast<bf16x8*>(&w); } while (0)
    DA_PK4(p0, 0, pa0); DA_PK4(p0, 8, pa1); DA_PK4(p1, 0, pa2); DA_PK4(p1, 8, pa3);
#undef DA_PK4
}
template <int KB>
__device__ __forceinline__ void qkt(f32x16& p0, f32x16& p1, const DLAS char* K_lds, int r32, int hi, const bf16x8* qr) {
    p0 = f32x16{}; p1 = f32x16{};
#pragma unroll
    for (int d0 = 0; d0 < 4; ++d0) { const DLAS char* a = K_lds + KB * SHM_K + DA_KSWZ(r32, d0 * 2 + hi);
        const bf16x8 b0 = *reinterpret_cast<const DLAS bf16x8*>(a);
        const bf16x8 b1 = *reinterpret_cast<const DLAS bf16x8*>(a + 32 * 128);
        p0 = __builtin_amdgcn_mfma_f32_32x32x16_bf16(b0, qr[d0], p0, 0, 0, 0);
        p1 = __builtin_amdgcn_mfma_f32_32x32x16_bf16(b1, qr[d0], p1, 0, 0, 0); }
}
template <int VB>
__device__ __forceinline__ void pv_tile(f32x16* o, int vb0, bf16x8 pa0, bf16x8 pa1, bf16x8 pa2, bf16x8 pa3) {
#define DA_TRRD(dst, off) asm volatile("ds_read_b64_tr_b16 %0, %1 offset:%2" : "=&v"(dst) : "v"(vb0), "i"(off) : "memory")
#define DA_PV_D0(d0) do { s16x4 l0, l1, l2, l3, h0, h1, h2, h3; constexpr int b_ = VB * SHM_V + v_rd_off(d0, 0, 0); \
        DA_TRRD(l0, b_); DA_TRRD(h0, b_ + 2048); DA_TRRD(l1, b_ + 4096); DA_TRRD(h1, b_ + 6144); DA_TRRD(l2, b_ + 8192); DA_TRRD(h2, b_ + 10240); DA_TRRD(l3, b_ + 12288); DA_TRRD(h3, b_ + 14336); \
        asm volatile("s_waitcnt lgkmcnt(0)" ::: "memory"); DA_SBAR();   \
        o[d0] = __builtin_amdgcn_mfma_f32_32x32x16_bf16(pa0, (bf16x8){l0[0], l0[1], l0[2], l0[3], h0[0], h0[1], h0[2], h0[3]}, o[d0], 0, 0, 0);   \
        o[d0] = __builtin_amdgcn_mfma_f32_32x32x16_bf16(pa1, (bf16x8){l1[0], l1[1], l1[2], l1[3], h1[0], h1[1], h1[2], h1[3]}, o[d0], 0, 0, 0);   \
        o[d0] = __builtin_amdgcn_mfma_f32_32x32x16_bf16(pa2, (bf16x8){l2[0], l2[1], l2[2], l2[3], h2[0], h2[1], h2[2], h2[3]}, o[d0], 0, 0, 0);   \
        o[d0] = __builtin_amdgcn_mfma_f32_32x32x16_bf16(pa3, (bf16x8){l3[0], l3[1], l3[2], l3[3], h3[0], h3[1], h3[2], h3[3]}, o[d0], 0, 0, 0); } while (0)
    DA_PV_D0(0); DA_PV_D0(1); DA_PV_D0(2); DA_PV_D0(3);
#undef DA_PV_D0
#undef DA_TRRD
}
__device__ __forceinline__ void attn_block(const unsigned short* __restrict__ Qp, const unsigned short* __restrict__ Kp, const unsigned short* __restrict__ Vp, int P0, DLAS char* lds, float c31, f32x16 (&o)[4]) {
    const int tid = threadIdx.x, wid = __builtin_amdgcn_readfirstlane(tid >> 6), lane = tid & 63, r32 = lane & 31, hi = lane >> 5;
    const int NT = (P0 + QB) / KVBLK;
    const int qlo = P0 + wid * QBLK, qm = qlo + r32 - 4 * hi;
    DLAS char* V_lds = lds + OFF_V; DLAS char* K_lds = lds + OFF_K;
    DLAS float* wsf = (DLAS float*)(lds + OFF_WS) + wid * 64; DLAS float* li_l = wsf; DLAS float* al_l = wsf + 32;
    const DLAS float* lut = (const DLAS float*)(lds + OFF_LUT);
    float m_reg = -1e30f, l_reg = 0.f;
#pragma unroll
    for (int d = 0; d < 4; ++d) o[d] = f32x16{};
    const int sr = tid >> 4, sc = (tid & 15) * 8, vst0 = v_st(sr, sc), vst1 = v_st(32 + sr, sc);
    const int kr = tid >> 3, kc = tid & 7, kws = DA_KSWZ(kr, kc);
    const int vb0 = (int)(uintptr_t)V_lds + v_rd_base(lane);
    bf16x8 qr[4];
#pragma unroll
    for (int d0 = 0; d0 < 4; ++d0) qr[d0] = *reinterpret_cast<const bf16x8*>(Qp + (size_t)(wid * QBLK + r32) * PITCH + d0 * 16 + hi * 8);
    bf16x8 st_v0, st_v1, st_k0;
#define DA_VMW() asm volatile("s_waitcnt vmcnt(0)" ::: "memory")
#define DA_SLOAD(k0) do { st_v0 = *reinterpret_cast<const bf16x8*>(Vp + (size_t)((k0) + sr) * PITCH + sc); st_v1 = *reinterpret_cast<const bf16x8*>(Vp + (size_t)((k0) + 32 + sr) * PITCH + sc); \
                          st_k0 = *reinterpret_cast<const bf16x8*>(Kp + (size_t)((k0) + kr) * PITCH + kc * 8); } while (0)
#define DA_SWRITE(bf) do { *reinterpret_cast<DLAS bf16x8*>(V_lds + (bf) * SHM_V + vst0) = st_v0; *reinterpret_cast<DLAS bf16x8*>(V_lds + (bf) * SHM_V + vst1) = st_v1; \
                           *reinterpret_cast<DLAS bf16x8*>(K_lds + (bf) * SHM_K + kws) = st_k0; } while (0)
#define DA_RESC(a) do { if (__any((a) < 1.f)) { if (hi == 0) al_l[r32] = (a); asm volatile("s_waitcnt lgkmcnt(0)" ::: "memory");              \
                        _Pragma("unroll") for (int d_ = 0; d_ < 4; ++d_) _Pragma("unroll") for (int r = 0; r < 16; ++r) o[d_][r] *= al_l[crow(r, hi)]; } } while (0)
#define DA_BIASMASK(P0_, P1_, t, cbv) do { const int kb_ = (t) * KVBLK; if (kb_ + KVBLK - 1 + 128 > qlo) { bias_tile(P0_, P1_, qm - kb_, lut); cbv = 0.f; if (kb_ + KVBLK - 1 > qlo) mask_tile(P0_, P1_, qm - kb_); } else cbv = c31; } while (0)
    f32x16 pA0, pA1, pB0, pB1; float alA, alB, cbA, cbB; bf16x8 pa0, pa1, pa2, pa3;
    DA_SLOAD(0); DA_VMW(); DA_SWRITE(0); DA_SBAR();
    DA_SLOAD(KVBLK);
    __syncthreads();
    DA_SBAR(); qkt<0>(pA0, pA1, K_lds, r32, hi, qr);
    DA_BIASMASK(pA0, pA1, 0, cbA); partialSM(pA0, pA1, m_reg, alA, cbA);
    DA_VMW(); DA_SWRITE(1);
    __syncthreads();
#define DA_HALF_STEP(PX0, PX1, alX, cbX, PY0, PY1, alY, t, KB, VB, SB) do {                                                      \
        DA_SBAR(); qkt<KB>(PX0, PX1, K_lds, r32, hi, qr);                                             \
        finishSM(PY0, PY1, alY, l_reg, pa0, pa1, pa2, pa3); DA_SBAR();                                                           \
        DA_SLOAD(((t) + 1) * KVBLK); DA_SBAR();                                               \
        pv_tile<VB>(o, vb0, pa0, pa1, pa2, pa3); DA_BIASMASK(PX0, PX1, (t), cbX); partialSM(PX0, PX1, m_reg, alX, cbX);                                        \
        __syncthreads();                                                                                                      \
        DA_VMW(); DA_SWRITE(SB);                                                                          \
        DA_RESC(alX); __syncthreads(); } while (0)
    for (int t = 1; t + 1 < NT; t += 2) {
        DA_HALF_STEP(pB0, pB1, alB, cbB, pA0, pA1, alA, t, 1, 0, 0);
        DA_HALF_STEP(pA0, pA1, alA, cbA, pB0, pB1, alB, t + 1, 0, 1, 1);
    }
    DA_SBAR(); qkt<1>(pB0, pB1, K_lds, r32, hi, qr); DA_SBAR();
    finishSM(pA0, pA1, alA, l_reg, pa0, pa1, pa2, pa3); DA_SBAR();
    pv_tile<0>(o, vb0, pa0, pa1, pa2, pa3);
    DA_BIASMASK(pB0, pB1, NT - 1, cbB); partialSM(pB0, pB1, m_reg, alB, cbB); DA_RESC(alB);
    finishSM(pB0, pB1, alB, l_reg, pa0, pa1, pa2, pa3); DA_SBAR(); pv_tile<1>(o, vb0, pa0, pa1, pa2, pa3);
    if (hi == 0) li_l[r32] = l_reg; asm volatile("s_waitcnt lgkmcnt(0)" ::: "memory");
#pragma unroll
    for (int r = 0; r < 16; ++r) { const float rl = __builtin_amdgcn_rcpf(li_l[crow(r, hi)]);
#pragma unroll
        for (int d0 = 0; d0 < 4; ++d0) o[d0][r] *= rl; }
    __syncthreads();
#undef DA_VMW
#undef DA_SLOAD
#undef DA_SWRITE
#undef DA_RESC
#undef DA_BIASMASK
#undef DA_HALF_STEP
}
}
static_assert(da::LDS_BYTES <= 131072, "attention LDS inside the ring region");
constexpr int NWAVES = 8;
#ifndef MK_N_LAUNCHES
#define MK_N_LAUNCHES 1
#endif
constexpr int BATCH = 16, SEQ = 2048, D = 1024, FF = 4096, M = BATCH * SEQ;
constexpr int NQKV = 3072;
constexpr int MLW = 3080, NPROJ = 3072;
constexpr int NH_A = 8, NH_M = 4;
constexpr float EPS = 1e-6f, LOG2E = 1.4426950408889634f;
constexpr float QSCALE = 0.125f * LOG2E;
constexpr float LAMBDA_INIT0 = 0.2f;
constexpr float MQSCALE = 0.08838834764831845f;
constexpr int NPHASE = 16;

namespace ml {
typedef short bf16x8 __attribute__((ext_vector_type(8)));
typedef short s16x4 __attribute__((ext_vector_type(4)));
typedef float f32x16 __attribute__((ext_vector_type(16)));
typedef float f32x4 __attribute__((ext_vector_type(4)));
typedef unsigned u32x4 __attribute__((ext_vector_type(4)));
typedef unsigned u32x2 __attribute__((ext_vector_type(2)));
#define MLAS __attribute__((address_space(3)))
constexpr int L = 64, NC = 2048 / L, PITCH = 3072;
constexpr int PQ = 272, PS = 144;
constexpr int O_Q = 0, O_K = O_Q + 64 * PQ, O_C = O_K + 64 * PQ, O_KW = O_C + 64 * PQ, O_V = O_KW + 16384, O_SC = O_V + 16384, O_ARR = O_SC + 64 * PS, O_NP = O_ARR + 9 * 256, O_N = O_NP + 4096, LDS_BYTES = O_N + 512;
enum { A_E = 0, A_BM = 64, A_INTER = 128, A_EMJ = 192, A_WP = 256, A_RS0 = 320, A_RS1 = 384, A_QN = 448, A_SCAL = 512 };
__device__ __forceinline__ float bf2f_lo(unsigned w) { return __uint_as_float(w << 16); }
__device__ __forceinline__ float bf2f_hi(unsigned w) { return __uint_as_float(w & 0xffff0000u); }
typedef float f32x2_t __attribute__((ext_vector_type(2))); typedef __bf16 bf16x2_t __attribute__((ext_vector_type(2)));
__device__ __forceinline__ unsigned cvtpk(float lo, float hi) { f32x2_t v = {lo, hi}; bf16x2_t b = __builtin_convertvector(v, bf16x2_t); return __builtin_bit_cast(unsigned, b); }
__device__ __forceinline__ int crow(int r, int hi) { return (r & 3) + 8 * (r >> 2) + 4 * hi; }
__device__ __forceinline__ int v_st(int k, int c) { const int kk = (k & ~0xC) | ((k & 4) << 1) | ((k & 8) >> 1); return ((kk >> 3) * 4 + (c >> 5)) * 512 + ((kk & 7) * 32 + (c & 31)) * 2; }
__device__ __forceinline__ int v_rd_base(int lane) { return ((lane & 3) << 3) | (((lane >> 2) & 3) << 6) | (((lane >> 4) & 1) << 5) | (((lane >> 5) & 1) << 8); }
#define ML_TRRD(dst, base, off) asm volatile("ds_read_b64_tr_b16 %0, %1 offset:%2" : "=&v"(dst) : "v"(base), "i"(off) : "memory")
#define ML_SBAR() __builtin_amdgcn_sched_barrier(0)
#define ML_FR(lo, hi_) (bf16x8){lo[0], lo[1], lo[2], lo[3], hi_[0], hi_[1], hi_[2], hi_[3]}
struct Pre { bf16x8 x[7]; bf16x8 v; float lf, ig; };

__device__ __forceinline__ void mlstm_unit(int b, int h, int s4, const unsigned short* __restrict__ PROJ, const float* __restrict__ GATES, const float* __restrict__ conv_w, const float* __restrict__ conv_b,
                                           unsigned short* HT, float* SSQ, MLAS char* lds) {
    const int tid = threadIdx.x, wid = __builtin_amdgcn_readfirstlane(tid >> 6), lane = tid & 63, r32 = lane & 31, hi = lane >> 5;
    MLAS char* QIMG = lds + O_Q; MLAS char* KIMG = lds + O_K; MLAS char* CIMG = lds + O_C; MLAS char* KWTR = lds + O_KW; MLAS char* VTR = lds + O_V; MLAS char* SC = lds + O_SC;
    MLAS float* arr = (MLAS float*)(lds + O_ARR); MLAS float* npart = (MLAS float*)(lds + O_NP); MLAS float* nvec = (MLAS float*)(lds + O_N);
    const int a4 = (tid >> 5) * 4, cg = tid & 31; const bool is_k = cg >= 16;
    const int qkcol = is_k ? 512 + h * 128 + (cg - 16) * 8 : h * 128 + cg * 8;
    const int vrow = tid >> 3, vcol = (tid & 7) * 8;
    float cw[4][8], cbias[8];
#pragma unroll
    for (int i = 0; i < 8; ++i) { cbias[i] = conv_b[qkcol + i];
#pragma unroll
        for (int t = 0; t < 4; ++t) cw[t][i] = conv_w[t * 1024 + qkcol + i]; }
    const size_t tok0 = (size_t)b * 2048;
    const unsigned short* xq = PROJ + tok0 * PITCH + qkcol;
    const unsigned short* xv = PROJ + tok0 * PITCH + 1024 + h * 256 + s4 * 64 + vcol;
    const float* gt = GATES + tok0 * 8 + h;
    const int dkb = wid >> 1, dvb = wid & 1;
    const int tb0 = (wid & 3) >> 1, jb = wid & 1;
    f32x16 cst = f32x16{};
    float m_prev = 0.f;
    for (int i = tid; i < (64 * PQ) / 16; i += 512) ((MLAS u32x4*)CIMG)[i] = (u32x4){0u, 0u, 0u, 0u};
    if (tid < 128) nvec[tid] = 0.f;
    Pre P;
#pragma unroll
    for (int i = 0; i < 7; ++i) { const int row = a4 - 3 + i; P.x[i] = row >= 0 ? *reinterpret_cast<const bf16x8*>(xq + (size_t)row * PITCH) : (bf16x8){0, 0, 0, 0, 0, 0, 0, 0}; }
    P.v = *reinterpret_cast<const bf16x8*>(xv + (size_t)vrow * PITCH);
    P.lf = gt[(size_t)lane * 8 + 4]; P.ig = gt[(size_t)lane * 8];
    const int trb_kw = (int)(uintptr_t)KWTR + v_rd_base(lane), trb_v = (int)(uintptr_t)VTR + v_rd_base(lane);
    __syncthreads();
    for (int c = 0; c < NC; ++c) {
        const int t0 = c * L;
        float bsum = P.lf;
#pragma unroll
        for (int off = 1; off < 64; off <<= 1) { const float t = __shfl_up(bsum, off); if (lane >= off) bsum += t; }
        const float b_last = __shfl(bsum, 63);
        const float aval = b_last - bsum + P.ig;
        float m_loc = aval;
#pragma unroll
        for (int off = 1; off < 64; off <<= 1) m_loc = fmaxf(m_loc, __shfl_xor(m_loc, off));
        const float m_new = fmaxf(b_last + m_prev, m_loc), decay = __expf(b_last + m_prev - m_new);
        const float wp = __expf(aval - m_new);
        const float e = P.ig - bsum;
        float pm = e;
#pragma unroll
        for (int off = 1; off < 64; off <<= 1) { const float t = __shfl_up(pm, off); if (lane >= off) pm = fmaxf(pm, t); }
        const float m_inter = bsum + m_prev, m_j = fmaxf(m_inter, bsum + pm);
        if (wid == 0) { arr[A_E + lane] = e; arr[A_BM + lane] = bsum - m_j; arr[A_INTER + lane] = __expf(m_inter - m_j); arr[A_EMJ + lane] = __expf(-m_j); arr[A_WP + lane] = wp; }
        m_prev = m_new;
        {
            float xf[7][8];
#pragma unroll
            for (int i = 0; i < 7; ++i) { const u32x4 w = __builtin_bit_cast(u32x4, P.x[i]);
#pragma unroll
                for (int q = 0; q < 4; ++q) { xf[i][2 * q] = bf2f_lo(w[q]); xf[i][2 * q + 1] = bf2f_hi(w[q]); } }
#pragma unroll
            for (int rr = 0; rr < 4; ++rr) {
                const int row = a4 + rr; const float wrow = __shfl(wp, row);
                float y[8], yw[8];
#pragma unroll
                for (int i = 0; i < 8; ++i) { float s = cbias[i] + cw[0][i] * xf[rr][i] + cw[1][i] * xf[rr + 1][i] + cw[2][i] * xf[rr + 2][i] + cw[3][i] * xf[rr + 3][i];
                    s = s / (1.f + __expf(-s)); y[i] = is_k ? s : s * MQSCALE; yw[i] = s * wrow; }
                const u32x4 o = {cvtpk(y[0], y[1]), cvtpk(y[2], y[3]), cvtpk(y[4], y[5]), cvtpk(y[6], y[7])};
                if (is_k) { *reinterpret_cast<MLAS u32x4*>(KIMG + row * PQ + (cg - 16) * 16) = o;
                    const u32x4 ow = {cvtpk(yw[0], yw[1]), cvtpk(yw[2], yw[3]), cvtpk(yw[4], yw[5]), cvtpk(yw[6], yw[7])};
                    *reinterpret_cast<MLAS u32x4*>(KWTR + v_st(row, (cg - 16) * 8)) = ow; }
                else *reinterpret_cast<MLAS u32x4*>(QIMG + row * PQ + cg * 16) = o;
            }
            *reinterpret_cast<MLAS bf16x8*>(VTR + v_st(vrow, vcol)) = P.v;
        }
        __syncthreads();
        if (c + 1 < NC) {
#pragma unroll
            for (int i = 0; i < 7; ++i) P.x[i] = *reinterpret_cast<const bf16x8*>(xq + (size_t)(t0 + L + a4 - 3 + i) * PITCH);
            P.v = *reinterpret_cast<const bf16x8*>(xv + (size_t)(t0 + L + vrow) * PITCH);
            P.lf = gt[(size_t)(t0 + L + lane) * 8 + 4]; P.ig = gt[(size_t)(t0 + L + lane) * 8];
        }
        f32x16 acc_qc = f32x16{};
        if (wid < 4) {
            f32x16 g = f32x16{};
            if (!(tb0 == 1 && jb == 0)) {
                const MLAS char* ka = KIMG + (32 * tb0 + r32) * PQ + hi * 16; const MLAS char* qa = QIMG + (32 * jb + r32) * PQ + hi * 16;
#pragma unroll
                for (int kk = 0; kk < 8; ++kk) g = __builtin_amdgcn_mfma_f32_32x32x16_bf16(*reinterpret_cast<const MLAS bf16x8*>(ka + kk * 32), *reinterpret_cast<const MLAS bf16x8*>(qa + kk * 32), g, 0, 0, 0);
            }
            const int j = 32 * jb + r32; const float bm = arr[A_BM + j]; float rsum = 0.f;
#pragma unroll
            for (int q4 = 0; q4 < 4; ++q4) { const f32x4 ev = *reinterpret_cast<const MLAS f32x4*>(arr + A_E + 32 * tb0 + 8 * q4 + 4 * hi);
                float sc4[4];
#pragma unroll
                for (int i = 0; i < 4; ++i) { const int s = 32 * tb0 + 8 * q4 + 4 * hi + i; const float v = (s <= j) ? g[4 * q4 + i] * __expf(bm + ev[i]) : 0.f; sc4[i] = v; rsum += v; }
                const u32x2 w = {cvtpk(sc4[0], sc4[1]), cvtpk(sc4[2], sc4[3])};
                *reinterpret_cast<MLAS u32x2*>(SC + j * PS + (32 * tb0 + 8 * q4 + 4 * hi) * 2) = w; }
            rsum += __shfl_xor(rsum, 32);
            if (hi == 0) arr[(tb0 ? A_RS1 : A_RS0) + j] = rsum;
        } else {
            const MLAS char* ca = CIMG + (32 * tb0 + r32) * PQ + hi * 16; const MLAS char* qa = QIMG + (32 * jb + r32) * PQ + hi * 16;
#pragma unroll
            for (int kk = 0; kk < 8; ++kk) acc_qc = __builtin_amdgcn_mfma_f32_32x32x16_bf16(*reinterpret_cast<const MLAS bf16x8*>(ca + kk * 32), *reinterpret_cast<const MLAS bf16x8*>(qa + kk * 32), acc_qc, 0, 0, 0);
        }
        {
            const int j = tid >> 3, part = tid & 7;
            const u32x4 q0 = *reinterpret_cast<const MLAS u32x4*>(QIMG + j * PQ + part * 32), q1 = *reinterpret_cast<const MLAS u32x4*>(QIMG + j * PQ + part * 32 + 16);
            float s = 0.f;
#pragma unroll
            for (int q = 0; q < 4; ++q) { const f32x4 n4 = *reinterpret_cast<const MLAS f32x4*>(nvec + part * 16 + 4 * q);
                const unsigned w0 = q < 2 ? q0[2 * q] : q1[2 * q - 4], w1 = q < 2 ? q0[2 * q + 1] : q1[2 * q - 3];
                s += bf2f_lo(w0) * n4[0] + bf2f_hi(w0) * n4[1] + bf2f_lo(w1) * n4[2] + bf2f_hi(w1) * n4[3]; }
            s += __shfl_xor(s, 1); s += __shfl_xor(s, 2); s += __shfl_xor(s, 4);
            if (part == 0) arr[A_QN + j] = s;
            float n0 = 0.f, n1 = 0.f;
#pragma unroll
            for (int i = 0; i < 8; ++i) { const int srow = 8 * wid + i; const unsigned kw = *reinterpret_cast<const MLAS unsigned*>(KIMG + srow * PQ + lane * 4); const float w = arr[A_WP + srow];
                n0 += w * bf2f_lo(kw); n1 += w * bf2f_hi(kw); }
            npart[wid * 128 + 2 * lane] = n0; npart[wid * 128 + 2 * lane + 1] = n1;
        }
        __syncthreads();
        if (wid >= 4) {
            f32x16 acc_n = f32x16{};
            const MLAS char* sa = SC + (32 * jb + r32) * PS + hi * 16;
            {   s16x4 l0, l1, l2, l3, h0, h1, h2, h3;
                if (tb0 == 0) { ML_TRRD(l0, trb_v, 0); ML_TRRD(h0, trb_v, 2048); ML_TRRD(l1, trb_v, 4096); ML_TRRD(h1, trb_v, 6144); ML_TRRD(l2, trb_v, 8192); ML_TRRD(h2, trb_v, 10240); ML_TRRD(l3, trb_v, 12288); ML_TRRD(h3, trb_v, 14336); }
                else { ML_TRRD(l0, trb_v, 512); ML_TRRD(h0, trb_v, 512 + 2048); ML_TRRD(l1, trb_v, 512 + 4096); ML_TRRD(h1, trb_v, 512 + 6144); ML_TRRD(l2, trb_v, 512 + 8192); ML_TRRD(h2, trb_v, 512 + 10240); ML_TRRD(l3, trb_v, 512 + 12288); ML_TRRD(h3, trb_v, 512 + 14336); }
                const bf16x8 s0 = *reinterpret_cast<const MLAS bf16x8*>(sa), s1 = *reinterpret_cast<const MLAS bf16x8*>(sa + 32), s2 = *reinterpret_cast<const MLAS bf16x8*>(sa + 64), s3 = *reinterpret_cast<const MLAS bf16x8*>(sa + 96);
                asm volatile("s_waitcnt lgkmcnt(0)" ::: "memory"); ML_SBAR();
                acc_n = __builtin_amdgcn_mfma_f32_32x32x16_bf16(ML_FR(l0, h0), s0, acc_n, 0, 0, 0);
                acc_n = __builtin_amdgcn_mfma_f32_32x32x16_bf16(ML_FR(l1, h1), s1, acc_n, 0, 0, 0);
                acc_n = __builtin_amdgcn_mfma_f32_32x32x16_bf16(ML_FR(l2, h2), s2, acc_n, 0, 0, 0);
                acc_n = __builtin_amdgcn_mfma_f32_32x32x16_bf16(ML_FR(l3, h3), s3, acc_n, 0, 0, 0); }
            const int j = 32 * jb + r32; const float inter = arr[A_INTER + j];
            const float den = arr[A_RS0 + j] + arr[A_RS1 + j] + inter * arr[A_QN + j];
            const float rden = 1.f / fmaxf(fabsf(den), arr[A_EMJ + j]);
            float ss = 0.f; unsigned short* hp = HT + (tok0 + t0 + j) * 1024 + h * 256 + s4 * 64 + 32 * tb0 + 4 * hi;
#pragma unroll
            for (int q4 = 0; q4 < 4; ++q4) { float hv[4];
#pragma unroll
                for (int i = 0; i < 4; ++i) { hv[i] = (acc_n[4 * q4 + i] + inter * acc_qc[4 * q4 + i]) * rden; ss += hv[i] * hv[i]; }
                const u32x2 w = {cvtpk(hv[0], hv[1]), cvtpk(hv[2], hv[3])};
                *reinterpret_cast<u32x2*>(hp + 8 * q4) = w; }
            ss += __shfl_xor(ss, 32);
            if (hi == 0) SSQ[(tok0 + t0 + j) * 32 + h * 8 + s4 * 2 + tb0] = ss;
        }
        {
            s16x4 al[4], ah[4], bl[4], bh[4];
#define ML_LD4(d0k, d0v) do { ML_TRRD(al[0], trb_kw, (d0k) * 512); ML_TRRD(ah[0], trb_kw, (d0k) * 512 + 2048); ML_TRRD(al[1], trb_kw, (d0k) * 512 + 4096); ML_TRRD(ah[1], trb_kw, (d0k) * 512 + 6144); \
            ML_TRRD(al[2], trb_kw, (d0k) * 512 + 8192); ML_TRRD(ah[2], trb_kw, (d0k) * 512 + 10240); ML_TRRD(al[3], trb_kw, (d0k) * 512 + 12288); ML_TRRD(ah[3], trb_kw, (d0k) * 512 + 14336); \
            ML_TRRD(bl[0], trb_v, (d0v) * 512); ML_TRRD(bh[0], trb_v, (d0v) * 512 + 2048); ML_TRRD(bl[1], trb_v, (d0v) * 512 + 4096); ML_TRRD(bh[1], trb_v, (d0v) * 512 + 6144); \
            ML_TRRD(bl[2], trb_v, (d0v) * 512 + 8192); ML_TRRD(bh[2], trb_v, (d0v) * 512 + 10240); ML_TRRD(bl[3], trb_v, (d0v) * 512 + 12288); ML_TRRD(bh[3], trb_v, (d0v) * 512 + 14336); } while (0)
            switch (wid) { case 0: ML_LD4(0, 0); break; case 1: ML_LD4(0, 1); break; case 2: ML_LD4(1, 0); break; case 3: ML_LD4(1, 1); break;
                           case 4: ML_LD4(2, 0); break; case 5: ML_LD4(2, 1); break; case 6: ML_LD4(3, 0); break; default: ML_LD4(3, 1); break; }
#undef ML_LD4
#pragma unroll
            for (int r = 0; r < 16; ++r) cst[r] *= decay;
            asm volatile("s_waitcnt lgkmcnt(0)" ::: "memory"); ML_SBAR();
#pragma unroll
            for (int ks = 0; ks < 4; ++ks) cst = __builtin_amdgcn_mfma_f32_32x32x16_bf16(ML_FR(al[ks], ah[ks]), ML_FR(bl[ks], bh[ks]), cst, 0, 0, 0);
            const int dv = 32 * dvb + r32;
#pragma unroll
            for (int q4 = 0; q4 < 4; ++q4) { const u32x2 w = {cvtpk(cst[4 * q4], cst[4 * q4 + 1]), cvtpk(cst[4 * q4 + 2], cst[4 * q4 + 3])};
                *reinterpret_cast<MLAS u32x2*>(CIMG + dv * PQ + (32 * dkb + 8 * q4 + 4 * hi) * 2) = w; }
        }
        if (tid < 128) { float s = nvec[tid] * decay;
#pragma unroll
            for (int w = 0; w < 8; ++w) s += npart[w * 128 + tid];
            nvec[tid] = s; }
        __syncthreads();
    }
}
}
static_assert(ml::LDS_BYTES <= 131072, "mLSTM LDS inside the ring region");
constexpr size_t MiB = 1u << 20;
constexpr size_t WS_CTL = 0, CTL_ZERO_BYTES = 1 * MiB;
constexpr size_t WS_WQKV = 2 * MiB, WS_WAO = 8 * MiB, WS_WML = 10 * MiB, WS_WMO = 16 * MiB, WS_W1 = 18 * MiB  , WS_W2 = 34 * MiB  ;
constexpr size_t WS_WG = 50 * MiB;
constexpr size_t WS_GATES = 51 * MiB;
constexpr size_t WS_SSQ = 52 * MiB;
constexpr size_t WS_XN = 64 * MiB;
constexpr size_t WS_U = 128 * MiB;
constexpr size_t WS_HT = 320 * MiB;
constexpr size_t WS_T0 = 384 * MiB;
constexpr size_t WS_END = 384 * MiB;
constexpr int CW_TMO = 0, CW_CODE = 1;
constexpr int CW_BAR = 4096;
constexpr int RING_OFF = 0, RING_BYTES = 131072;
constexpr int LDSCTL_OFF = RING_BYTES, MISC_OFF = LDSCTL_OFF + 320;
constexpr int LDS_BYTES = 147456;
static_assert(MISC_OFF + 128 <= LDS_BYTES, "LDS map");

#define GAS __attribute__((address_space(1)))
#define LAS __attribute__((address_space(3)))
typedef unsigned short bf16;
typedef unsigned v4u __attribute__((ext_vector_type(4)));
typedef float f32x4 __attribute__((ext_vector_type(4)));
typedef short bf16x8 __attribute__((ext_vector_type(8)));
typedef GAS unsigned gu32;
typedef GAS unsigned long long gu64;
#define RLX_AGENT __ATOMIC_RELAXED, __HIP_MEMORY_SCOPE_AGENT
#define LDS_WAIT() asm volatile("s_waitcnt lgkmcnt(0)" ::: "memory")
#define VM_WAIT() asm volatile("s_waitcnt vmcnt(0)" ::: "memory")
__device__ __forceinline__ unsigned long long rt() { return __builtin_amdgcn_s_memrealtime(); }
__device__ __forceinline__ unsigned f2bf(float f) { unsigned u = __builtin_bit_cast(unsigned, f); return (u + 0x7fffu + ((u >> 16) & 1u)) >> 16; }
__device__ __forceinline__ unsigned pk2(float lo, float hi) { return f2bf(lo) | (f2bf(hi) << 16); }

#define XB_TMO      128
#define XB_XCNT(j)  (256  + 64 * (j))
#define XB_XSUB(j)  (1280 + 64 * (j))
#define XB_XGEN(j)  (2304 + 64 * (j))
#define XB_TOP      3328
#define XB_TOPGEN   3392
#define XCD_BAR_WORDS 3456
#define XB_SPIN_CAP (1u << 23)

__device__ __forceinline__ unsigned xb_ld(unsigned* p)              { return __hip_atomic_load(p, __ATOMIC_RELAXED, __HIP_MEMORY_SCOPE_AGENT); }
__device__ __forceinline__ unsigned xb_add(unsigned* p, unsigned v) { return __hip_atomic_fetch_add(p, v, __ATOMIC_RELAXED, __HIP_MEMORY_SCOPE_AGENT); }
__device__ __forceinline__ unsigned xb_xcc_id() { return (unsigned)__builtin_amdgcn_s_getreg((3 << 11) | 20) & 0xFu; }
#define XB_SPIN(cond, bar) do { unsigned _sp = 0; while (cond) { __builtin_amdgcn_s_sleep(1); \
    if ((++_sp & 255u) == 0u) { if (xb_ld(&(bar)[XB_TMO])) break; if (_sp > XB_SPIN_CAP) { atomicAdd(&(bar)[XB_TMO], 1u); break; } } } } while (0)

struct XcdBarrier {
    unsigned* bar; unsigned x;
    volatile LAS unsigned* st;
};

__device__ __forceinline__ XcdBarrier xcd_barrier_post(unsigned* bar, volatile LAS unsigned* st) {
    XcdBarrier b; b.bar = bar; b.x = xb_xcc_id(); b.st = st;
    if (threadIdx.x == 0) (void)xb_add(&bar[XB_XCNT(b.x)], 1u);
    return b;
}
__device__ __forceinline__ void xcd_barrier_complete(unsigned* bar, unsigned x, unsigned& nloc, unsigned& nx) {
    const unsigned G = gridDim.x * gridDim.y * gridDim.z;
    unsigned sum, cnt, mine, sp = 0u;
    for (;;) {
        sum = 0u; cnt = 0u; mine = 0u;
#pragma unroll
        for (unsigned j = 0; j < 16; ++j) { const unsigned c = xb_ld(&bar[XB_XCNT(j)]); sum += c; cnt += (c > 0u) ? 1u : 0u; mine = (j == x) ? c : mine; }
        if (sum == G) break;
        __builtin_amdgcn_s_sleep(1);
        if ((++sp & 255u) == 0u) { if (xb_ld(&bar[XB_TMO])) break; if (sp > XB_SPIN_CAP) { atomicAdd(&bar[XB_TMO], 1u); break; } }
    }
    nloc = mine > 0u ? mine : 1u; nx = cnt > 0u ? cnt : 1u;
}

__device__ __forceinline__ void xcd_barrier(const XcdBarrier& b) {
    asm volatile("s_waitcnt vmcnt(0)" ::: "memory");
    __syncthreads();
    if (threadIdx.x == 0) {
        unsigned* bar = b.bar;
        __builtin_amdgcn_s_waitcnt(0);
        unsigned nloc = b.st[0], nx = b.st[1];
        if (nloc == 0u) { xcd_barrier_complete(bar, b.x, nloc, nx); b.st[0] = nloc; b.st[1] = nx; }
        const unsigned old = xb_add(&bar[XB_XSUB(b.x)], 1u);
        const unsigned gen = old / nloc;
        if (old + 1u == (gen + 1u) * nloc) {
            __builtin_amdgcn_fence(__ATOMIC_RELEASE, "agent");
            asm volatile("s_waitcnt vmcnt(0)" ::: "memory");
            const unsigned og = xb_add(&bar[XB_TOP], 1u);
            const unsigned tg = og / nx;
            if (og + 1u == (tg + 1u) * nx) xb_add(&bar[XB_TOPGEN], 1u);
            else XB_SPIN(xb_ld(&bar[XB_TOPGEN]) == tg, bar);
            __builtin_amdgcn_fence(__ATOMIC_ACQUIRE, "agent");
            xb_add(&bar[XB_XGEN(b.x)], 1u);
            asm volatile("s_waitcnt vmcnt(0)" ::: "memory");
        } else {
            XB_SPIN(xb_ld(&bar[XB_XGEN(b.x)]) == gen, bar);
            __builtin_amdgcn_fence(__ATOMIC_ACQUIRE, "agent");
            asm volatile("s_waitcnt vmcnt(0)" ::: "memory");
        }
    }
    __syncthreads();
}

struct Frame {
    LAS unsigned char* lds;
    volatile LAS unsigned* MISC;
    gu32* ctl;
    int tid, lane, wave;
    int vcu, G;
};
__device__ __forceinline__ float wave_sum(float v) {
#pragma unroll
    for (int o = 1; o < 64; o <<= 1) v += __shfl_xor(v, o);
    return v;
}
__device__ __forceinline__ void p0_transpose_item(const float* W, int K, int ldw, int nblk, bf16* WT, const float* gk, int gmask, float gs, LAS float* scr, int item, int lane) {
    const int kb = item / nblk, nb = item % nblk, k0 = 64 * kb, n0 = 32 * nb;
#pragma unroll 8
    for (int i = 0; i < 32; ++i) { const int kk = 2 * i + (lane >> 5); const float g = gk ? gk[(k0 + kk) & gmask] * gs : gs;
        scr[kk * 33 + (lane & 31)] = W[(size_t)(k0 + kk) * ldw + n0 + (lane & 31)] * g; }
    LDS_WAIT(); asm volatile("" ::: "memory");
    const int c = lane & 7;
#pragma unroll
    for (int j = 0; j < 4; ++j) { const int n = (lane >> 3) + 8 * j; const LAS float* s = scr + (8 * c) * 33 + n;
        v4u o; o.x = pk2(s[0 * 33], s[1 * 33]); o.y = pk2(s[2 * 33], s[3 * 33]); o.z = pk2(s[4 * 33], s[5 * 33]); o.w = pk2(s[6 * 33], s[7 * 33]);
        *(GAS v4u*)(WT + (size_t)(n0 + n) * K + k0 + 8 * c) = o; }
    LDS_WAIT(); asm volatile("" ::: "memory");
}
__device__ __forceinline__ void rms_row_load(const float* xrow, int lane, f32x4 (&v)[4]) {
    const GAS f32x4* xr = (const GAS f32x4*)xrow + lane; float s2 = 0.f;
#pragma unroll
    for (int j = 0; j < 4; ++j) { v[j] = xr[64 * j]; s2 += (v[j].x * v[j].x + v[j].y * v[j].y) + (v[j].z * v[j].z + v[j].w * v[j].w); }
    const float rstd = 1.f / sqrtf(wave_sum(s2) * (1.f / D) + EPS);
#pragma unroll
    for (int j = 0; j < 4; ++j) v[j] = v[j] * rstd;
}
__device__ __forceinline__ void row_store_bf16(bf16* orow, int lane, const f32x4 (&v)[4]) {
    GAS unsigned long long* o8 = (GAS unsigned long long*)orow + lane;
#pragma unroll
    for (int j = 0; j < 4; ++j) o8[64 * j] = (unsigned long long)pk2(v[j].x, v[j].y) | ((unsigned long long)pk2(v[j].z, v[j].w) << 32);
}
__device__ __forceinline__ float log_sigmoid(float x) { return fminf(x, 0.f) - log1pf(expf(-fabsf(x))); }

struct Args { const float* in[22]; float* out; unsigned char* ws; int ph_lo, ph_hi, li, pad; };

__device__ __forceinline__ void p0_prologue(Frame& F, const Args& a) {
    unsigned char* ws = a.ws;
    LAS float* scr = (LAS float*)(F.lds + RING_OFF + F.wave * 16384);
    const int gw = F.vcu * NWAVES + F.wave, NGW = F.G * NWAVES;
    constexpr int I_QKV = (D / 64) * (NQKV / 32), I_O = (D / 64) * (D / 32), I_ML = (D / 64) * (NPROJ / 32), I_1 = (D / 64) * (FF / 32), I_2 = (FF / 64) * (D / 32);
    constexpr int NITEMS = I_QKV + I_O + I_ML + I_O + 2 * I_1 + 2 * I_2;
    for (int it = gw; it < NITEMS; it += NGW) {
        int r = it;
        if (r < I_QKV) { p0_transpose_item(a.in[3], D, NQKV, NQKV / 32, (bf16*)(ws + WS_WQKV), a.in[2], 0xffff, 1.f, scr, r, F.lane); continue; } r -= I_QKV;
        if (r < I_O) { p0_transpose_item(a.in[9], D, D, D / 32, (bf16*)(ws + WS_WAO), a.in[8], 127, 1.f - LAMBDA_INIT0, scr, r, F.lane); continue; } r -= I_O;
        if (r < I_ML) { p0_transpose_item(a.in[11], D, MLW, NPROJ / 32, (bf16*)(ws + WS_WML), a.in[10], 0xffff, 1.f, scr, r, F.lane); continue; } r -= I_ML;
        if (r < I_O) { p0_transpose_item(a.in[17], D, D, D / 32, (bf16*)(ws + WS_WMO), a.in[16], 0xffff, 1.f, scr, r, F.lane); continue; } r -= I_O;
        if (r < 2 * I_1) { const int l = r / I_1; p0_transpose_item(a.in[19] + (size_t)l * D * FF, D, FF, FF / 32, (bf16*)(ws + WS_W1) + (size_t)l * D * FF, a.in[18] + l * D, 0xffff, 1.f, scr, r % I_1, F.lane); continue; } r -= 2 * I_1;
        { const int l = r / I_2; p0_transpose_item(a.in[20] + (size_t)l * D * FF, FF, D, D / 32, (bf16*)(ws + WS_W2) + (size_t)l * D * FF, nullptr, 0, 1.f, scr, r % I_2, F.lane); }
    }
    { float* WG = (float*)(ws + WS_WG); const int gt = (F.vcu * NWAVES + F.wave) * 64 + F.lane, NGT = F.G * NWAVES * 64;
      for (int i = gt; i < 8 * D; i += NGT) { const int j = i / D, k = i % D; WG[i] = a.in[10][k] * a.in[11][(size_t)k * MLW + NPROJ + j]; } }
    bf16* XN = (bf16*)(ws + WS_XN);
    for (int m = gw; m < M; m += NGW) { f32x4 v[4]; rms_row_load(a.in[0] + (size_t)m * D, F.lane, v); row_store_bf16(XN + (size_t)m * D, F.lane, v); }
}
__device__ __forceinline__ void norm_phase(Frame& F, const float* H, bf16* XN, const float* WG, float* GATES, const float* b_i, const float* b_f) {
    const int gw = F.vcu * NWAVES + F.wave, NGW = F.G * NWAVES;
    LAS f32x4* wg = (LAS f32x4*)(F.lds + RING_OFF);
    if (GATES) { for (int i = F.tid; i < 8 * D / 4; i += NWAVES * 64) wg[i] = ((const GAS f32x4*)WG)[i]; __syncthreads(); }
    for (int m = gw; m < M; m += NGW) {
        f32x4 v[4]; rms_row_load(H + (size_t)m * D, F.lane, v); row_store_bf16(XN + (size_t)m * D, F.lane, v);
        if (GATES) {
            float mine = 0.f;
#pragma unroll
            for (int j = 0; j < 8; ++j) { float s = 0.f;
#pragma unroll
                for (int jj = 0; jj < 4; ++jj) { const f32x4 w = wg[j * 256 + jj * 64 + F.lane]; s += (v[jj].x * w.x + v[jj].y * w.y) + (v[jj].z * w.z + v[jj].w * w.w); }
                s = wave_sum(s); if (F.lane == j) mine = s; }
            if (F.lane < 4) GATES[(size_t)m * 8 + F.lane] = mine + b_i[F.lane];
            else if (F.lane < 8) GATES[(size_t)m * 8 + F.lane] = log_sigmoid(mine + b_f[F.lane - 4]);
        }
    }
    if (GATES) __syncthreads();
}
__device__ __forceinline__ void final_norm_phase(Frame& F, const float* H, const float* g, float* out) {
    const int gw = F.vcu * NWAVES + F.wave, NGW = F.G * NWAVES;
    for (int m = gw; m < M; m += NGW) {
        f32x4 v[4]; rms_row_load(H + (size_t)m * D, F.lane, v);
        GAS f32x4* o = (GAS f32x4*)(out + (size_t)m * D) + F.lane; const GAS f32x4* gg = (const GAS f32x4*)g + F.lane;
#pragma unroll
        for (int j = 0; j < 4; ++j) o[64 * j] = v[j] * gg[64 * j];
    }
}

__device__ __forceinline__ float bf2f(bf16 v) { return __uint_as_float((unsigned)v << 16); }
__device__ __forceinline__ int t5_bucket(int d) {
    if (d < 16) return d;
    const float v = logf((float)d / 16.f) / logf(8.f) * 16.f; int b = 16 + (int)v; return b > 31 ? 31 : b;
}
__device__ __forceinline__ void naive_attn_phase(Frame& F, const bf16* __restrict__ QKV, const float* __restrict__ rel_bias, const float* __restrict__ lq1, const float* __restrict__ lk1,
                                                  const float* __restrict__ lq2, const float* __restrict__ lk2, bf16* AO) {
    LAS float* lut = (LAS float*)(F.lds + RING_OFF);
    const int tid = F.tid, half = tid & 1;
    float s1 = 0.f, s2 = 0.f;
    for (int i = 0; i < 64; ++i) { s1 += lq1[i] * lk1[i]; s2 += lq2[i] * lk2[i]; }
    const float lam = expf(s1) - expf(s2) + LAMBDA_INIT0;
    for (int u = F.vcu; u < BATCH * NH_A * (SEQ / 256); u += F.G) {
        const int qb = u % (SEQ / 256), h = (u / (SEQ / 256)) % NH_A, b = u / (SEQ / 256) / NH_A, q0 = qb * 256, q = q0 + (tid >> 1);
        __syncthreads();
        if (tid < 128) lut[tid] = rel_bias[t5_bucket(tid) * NH_A + h] * LOG2E;
        __syncthreads();
        const size_t tok = (size_t)b * SEQ + q;
        float res[64];
        for (int m = 0; m < 2; ++m) {
            float qv[64];
            const bf16* qp = QKV + tok * NQKV + h * 128 + m * 64;
#pragma unroll
            for (int d = 0; d < 64; ++d) qv[d] = bf2f(qp[d]);
            float o[64];
#pragma unroll
            for (int d = 0; d < 64; ++d) o[d] = 0.f;
            float mrun = -1e30f, l = 0.f;
            const int kend = q0 + 256;
            for (int k = 0; k < kend; ++k) {
                const bf16* kr = QKV + ((size_t)b * SEQ + k) * NQKV + D + h * 128 + m * 64;
                const bf16* vr = QKV + ((size_t)b * SEQ + k) * NQKV + 2 * D + h * 128 + half * 64;
                float s = 0.f;
#pragma unroll
                for (int d = 0; d < 64; ++d) s += qv[d] * bf2f(kr[d]);
                const int dist = q - k;
                if (dist >= 0) {
                    s += lut[dist < 127 ? dist : 127];
                    if (s > mrun) { const float al = exp2f(mrun - s); l *= al;
#pragma unroll
                        for (int d = 0; d < 64; ++d) o[d] *= al;
                        mrun = s; }
                    const float p = exp2f(s - mrun); l += p;
#pragma unroll
                    for (int d = 0; d < 64; ++d) o[d] += p * bf2f(vr[d]);
                }
            }
            const float il = 1.f / l;
            if (m == 0) {
#pragma unroll
                for (int d = 0; d < 64; ++d) res[d] = o[d] * il;
            } else {
                float ss = 0.f;
#pragma unroll
                for (int d = 0; d < 64; ++d) { res[d] = res[d] - lam * (o[d] * il); ss += res[d] * res[d]; }
                ss += __shfl_xor(ss, 1);
                const float rstd = 1.f / sqrtf(ss * (1.f / 128.f) + EPS);
                bf16* op = AO + tok * D + h * 128 + half * 64;
#pragma unroll
                for (int d = 0; d < 64; d += 2) *(unsigned*)(op + d) = pk2(res[d] * rstd, res[d + 1] * rstd);
            }
        }
    }
    __syncthreads();
}
__device__ __forceinline__ void naive_mlstm_phase(Frame& F, const bf16* __restrict__ PROJ, const float* __restrict__ GATES, const float* __restrict__ conv_w, const float* __restrict__ conv_b, bf16* AO) {
    LAS float* q_s = (LAS float*)(F.lds + RING_OFF); LAS float* k_s = q_s + 128; LAS float* v_s = q_s + 256; LAS float* red = q_s + 512;
    const int tid = F.tid, dv = tid >> 1, half = tid & 1, lane = F.lane, wave = F.wave;
    for (int u = (int)blockIdx.x; u < BATCH * NH_M; u += F.G) {
        const int h = u & 3, b = u >> 2;
        float C[64], n[64];
#pragma unroll
        for (int j = 0; j < 64; ++j) { C[j] = 0.f; n[j] = 0.f; }
        float mst = 0.f;
        const int col = (tid < 128) ? (h * 128 + tid) : (512 + h * 128 + ((tid - 128) & 127));
        float cw0 = 0.f, cw1 = 0.f, cw2 = 0.f, cw3 = 0.f, cb = 0.f;
        if (tid < 256) { cw0 = conv_w[0 * D + col]; cw1 = conv_w[1 * D + col]; cw2 = conv_w[2 * D + col]; cw3 = conv_w[3 * D + col]; cb = conv_b[col]; }
        __syncthreads();
        for (int t = 0; t < SEQ; ++t) {
            const size_t tok = (size_t)b * SEQ + t;
            if (tid < 256) {
                float x3 = bf2f(PROJ[tok * NPROJ + col]);
                float x2 = t >= 1 ? bf2f(PROJ[(tok - 1) * NPROJ + col]) : 0.f;
                float x1 = t >= 2 ? bf2f(PROJ[(tok - 2) * NPROJ + col]) : 0.f;
                float x0 = t >= 3 ? bf2f(PROJ[(tok - 3) * NPROJ + col]) : 0.f;
                float y = cw0 * x0 + cw1 * x1 + cw2 * x2 + cw3 * x3 + cb;
                y = y / (1.f + expf(-y));
                if (tid < 128) q_s[tid] = y * MQSCALE; else k_s[tid - 128] = y;
            } else {
                v_s[tid - 256] = bf2f(PROJ[tok * NPROJ + 1024 + h * 256 + (tid - 256)]);
            }
            const float ig = GATES[tok * 8 + h], lf = GATES[tok * 8 + 4 + h];
            __syncthreads();
            const float mnew = fmaxf(lf + mst, ig), fd = expf(lf + mst - mnew), gi = expf(ig - mnew);
            mst = mnew;
            const float gv = gi * v_s[dv];
            float num = 0.f, den = 0.f;
#pragma unroll
            for (int j = 0; j < 64; ++j) { const float kk = k_s[half * 64 + j], qq = q_s[half * 64 + j];
                C[j] = fd * C[j] + gv * kk; n[j] = fd * n[j] + gi * kk; num += C[j] * qq; den += n[j] * qq; }
            num += __shfl_xor(num, 1); den += __shfl_xor(den, 1);
            const float hv = num / fmaxf(fabsf(den), expf(-mnew));
            float ss = half == 0 ? hv * hv : 0.f;
            ss = wave_sum(ss);
            if (lane == 0) red[wave] = ss;
            __syncthreads();
            float tot = 0.f;
#pragma unroll
            for (int w = 0; w < 8; ++w) tot += red[w];
            const float rstd = 1.f / sqrtf(tot * (1.f / 256.f) + EPS);
            if (half == 0) { const float op = bf2f(PROJ[tok * NPROJ + 2048 + h * 256 + dv]); const float sg = 1.f / (1.f + expf(-op));
                AO[tok * D + h * 256 + dv] = (bf16)f2bf(sg * hv * rstd); }
            __syncthreads();
        }
    }
}

__device__ __forceinline__ void attn_phase(Frame& F, const bf16* __restrict__ QKV, bf16* AO, float* stash, const float* __restrict__ rel_bias, const float* __restrict__ lq1, const float* __restrict__ lk1,
                                           const float* __restrict__ lq2, const float* __restrict__ lk2) {
    using da::f32x16; using da::f32x4;
    LAS char* lds = (LAS char*)(F.lds + RING_OFF);
    LAS float* lut = (LAS float*)(lds + da::OFF_LUT);
    const int tid = F.tid, lane = F.lane, wid = F.wave, r32 = lane & 31, hi = lane >> 5;
    float s1 = 0.f, s2 = 0.f;
    for (int i = 0; i < 64; ++i) { s1 += lq1[i] * lk1[i]; s2 += lq2[i] * lk2[i]; }
    const float lam = expf(s1) - expf(s2) + LAMBDA_INIT0;
    f32x4* st = (f32x4*)(stash + (((size_t)blockIdx.x * NWAVES + wid) * 64 + lane) * 64);
    for (int L = F.vcu; L < BATCH * NH_A * 4; L += F.G) {
        const int bh = L >> 2, x = L & 3, b = bh >> 3, h = bh & 7;
        __syncthreads();
        if (tid < 128) lut[tid] = rel_bias[t5_bucket(tid) * NH_A + h] * LOG2E;
        __syncthreads();
        const float c31 = lut[127];
        for (int s = 0; s < 4; ++s) {
            const int qb = (s >> 1) ? 7 - x : x, m = s & 1, P0 = qb * 256;
            const bf16* Qp = QKV + ((size_t)b * SEQ + P0) * NQKV + h * 128 + m * 64;
            const bf16* Kp = QKV + (size_t)b * SEQ * NQKV + D + h * 128 + m * 64;
            const bf16* Vp = QKV + (size_t)b * SEQ * NQKV + 2 * D + h * 128;
            f32x16 o[4];
            da::attn_block(Qp, Kp, Vp, P0, lds, c31, o);
            if (m == 0) {
#pragma unroll
                for (int i = 0; i < 16; ++i) st[i] = (f32x4){o[i >> 2][(i & 3) * 4 + 0], o[i >> 2][(i & 3) * 4 + 1], o[i >> 2][(i & 3) * 4 + 2], o[i >> 2][(i & 3) * 4 + 3]};
            } else {
#pragma unroll
                for (int i = 0; i < 16; ++i) { const f32x4 a = st[i];
#pragma unroll
                    for (int e = 0; e < 4; ++e) o[i >> 2][(i & 3) * 4 + e] = a[e] - lam * o[i >> 2][(i & 3) * 4 + e]; }
                bf16* Ow = AO + ((size_t)b * SEQ + P0 + wid * 32) * D + h * 128;
#pragma unroll
                for (int r = 0; r < 16; ++r) {
                    float ss = (o[0][r] * o[0][r] + o[1][r] * o[1][r]) + (o[2][r] * o[2][r] + o[3][r] * o[3][r]);
#pragma unroll
                    for (int off = 1; off < 32; off <<= 1) ss += __shfl_xor(ss, off);
                    const float rstd = 1.f / sqrtf(ss * (1.f / 128.f) + EPS);
                    const int orow = da::crow(r, hi);
#pragma unroll
                    for (int d0 = 0; d0 < 4; ++d0) { const float v = o[d0][r] * rstd; const float vn = __shfl_xor(v, 1);
                        if ((r32 & 1) == 0) *(unsigned*)(Ow + (size_t)orow * D + d0 * 32 + r32) = da::cvtpk(v, vn); }
                }
            }
        }
    }
    __syncthreads();
}

__device__ __forceinline__ void mlstm_phase(Frame& F, const bf16* __restrict__ PROJ, const float* __restrict__ GATES, const float* __restrict__ conv_w, const float* __restrict__ conv_b, bf16* HT, float* SSQ) {
    for (int u = F.vcu; u < BATCH * NH_M * 4; u += F.G) {
        __syncthreads();
        ml::mlstm_unit(u >> 4, (u >> 2) & 3, u & 3, PROJ, GATES, conv_w, conv_b, HT, SSQ, (LAS char*)(F.lds + RING_OFF));
    }
    __syncthreads();
}
__device__ __forceinline__ void gatenorm_phase(Frame& F, const bf16* __restrict__ PROJ, const bf16* __restrict__ HT, const float* __restrict__ SSQ, bf16* AO) {
    const int gw = F.vcu * NWAVES + F.wave, NGW = F.G * NWAVES, lane = F.lane;
    for (int m = gw; m < M; m += NGW) {
        const int hd = lane >> 4;
        const f32x4 s0 = *(const GAS f32x4*)(SSQ + (size_t)m * 32 + hd * 8), s1 = *(const GAS f32x4*)(SSQ + (size_t)m * 32 + hd * 8 + 4);
        const float tot = ((s0.x + s0.y) + (s0.z + s0.w)) + ((s1.x + s1.y) + (s1.z + s1.w));
        const float rstd = 1.f / sqrtf(tot * (1.f / 256.f) + EPS);
        const v4u h0 = *(const GAS v4u*)(HT + (size_t)m * D + lane * 16), h1 = *(const GAS v4u*)(HT + (size_t)m * D + lane * 16 + 8);
        const v4u o0 = *(const GAS v4u*)(PROJ + (size_t)m * NPROJ + 2048 + lane * 16), o1 = *(const GAS v4u*)(PROJ + (size_t)m * NPROJ + 2048 + lane * 16 + 8);
        v4u r0, r1;
#pragma unroll
        for (int q = 0; q < 4; ++q) {
            { const float ha = __uint_as_float(h0[q] << 16) * rstd, hb = __uint_as_float(h0[q] & 0xffff0000u) * rstd, oa = __uint_as_float(o0[q] << 16), ob = __uint_as_float(o0[q] & 0xffff0000u);
              r0[q] = pk2(ha / (1.f + __expf(-oa)), hb / (1.f + __expf(-ob))); }
            { const float ha = __uint_as_float(h1[q] << 16) * rstd, hb = __uint_as_float(h1[q] & 0xffff0000u) * rstd, oa = __uint_as_float(o1[q] << 16), ob = __uint_as_float(o1[q] & 0xffff0000u);
              r1[q] = pk2(ha / (1.f + __expf(-oa)), hb / (1.f + __expf(-ob))); }
        }
        *(GAS v4u*)(AO + (size_t)m * D + lane * 16) = r0; *(GAS v4u*)(AO + (size_t)m * D + lane * 16 + 8) = r1;
    }
}

__global__ void __launch_bounds__(NWAVES * 64, 2) fwd(Args args) {
    extern __shared__ __attribute__((aligned(16))) unsigned char lds[];
    Frame F;
    F.lds = (LAS unsigned char*)lds;
    F.MISC = (volatile LAS unsigned*)(F.lds + MISC_OFF);
    F.tid = threadIdx.x; F.lane = F.tid & 63; F.wave = __builtin_amdgcn_readfirstlane(F.tid >> 6);
    F.G = gridDim.x; { const int bx = blockIdx.x; F.vcu = (F.G % 8 == 0) ? (bx % 8) * (F.G / 8) + bx / 8 : bx; }
    unsigned char* ws = args.ws;
    F.ctl = (gu32*)(ws + WS_CTL);
    for (int u = F.tid; u < (LDS_BYTES - LDSCTL_OFF) / 4; u += NWAVES * 64) ((LAS unsigned*)(F.lds + LDSCTL_OFF))[u] = 0u;
    __syncthreads();
    const int lo = args.ph_lo, hi = args.ph_hi;
    const bool use_bar = (hi - lo) > 1;
    XcdBarrier bar; bar.bar = (unsigned*)(F.ctl + CW_BAR) + args.li * XCD_BAR_WORDS; bar.x = 0; bar.st = nullptr;
    if (use_bar) bar = xcd_barrier_post((unsigned*)(F.ctl + CW_BAR) + args.li * XCD_BAR_WORDS, F.MISC + 8);
#define IN(k) (lo <= (k) && (k) < hi)
#define SEAM(k) do { if (IN(k) && IN((k) + 1)) xcd_barrier(bar); } while (0)
    bf16* const XN = (bf16*)(ws + WS_XN); bf16* const AO = XN; bf16* const QKV = (bf16*)(ws + WS_U); bf16* const U = (bf16*)(ws + WS_U);
    float* const H = args.out;
    using pg8::Gemm; using pg8::StaticOrder; using pg8::EpiBf16; using pg8::EpiResF32;

    if (IN(0)) { p0_prologue(F, args); SEAM(0); }
    if (IN(1)) { Gemm g{XN, (const bf16*)(ws + WS_WQKV), M, NQKV, D}; StaticOrder S; S.init(M, NQKV, F.G, (int)blockIdx.x);
        EpiBf16<0> E{QKV, NQKV, D, QSCALE}; pg8::gemm_phase<EpiBf16<0>, StaticOrder, PG8_ALIGN, PG8_SP2>(F.lds + RING_OFF, g, S, E); SEAM(1); }
#ifdef NAIVE_ATTN
    if (IN(2)) { naive_attn_phase(F, QKV, args.in[1], args.in[4], args.in[5], args.in[6], args.in[7], AO); SEAM(2); }
#else
    if (IN(2)) { attn_phase(F, QKV, AO, (float*)(ws + WS_HT), args.in[1], args.in[4], args.in[5], args.in[6], args.in[7]); SEAM(2); }
#endif
    if (IN(3)) { Gemm g{AO, (const bf16*)(ws + WS_WAO), M, D, D}; StaticOrder S; S.init(M, D, F.G, (int)blockIdx.x);
        EpiResF32 E{args.in[0], H, D}; pg8::gemm_phase<EpiResF32, StaticOrder, PG8_ALIGN, PG8_SP2>(F.lds + RING_OFF, g, S, E); SEAM(3); }
    if (IN(4)) { norm_phase(F, H, XN, nullptr, nullptr, nullptr, nullptr); SEAM(4); }
    if (IN(5)) { Gemm g{XN, (const bf16*)(ws + WS_W1), M, FF, D}; StaticOrder S; S.init(M, FF, F.G, (int)blockIdx.x);
        EpiBf16<2> E{U, FF, 0, 1.f}; pg8::gemm_phase<EpiBf16<2>, StaticOrder, PG8_ALIGN, PG8_SP2>(F.lds + RING_OFF, g, S, E); SEAM(5); }
    if (IN(6)) { Gemm g{U, (const bf16*)(ws + WS_W2), M, D, FF}; StaticOrder S; S.init(M, D, F.G, (int)blockIdx.x);
        EpiResF32 E{H, H, D}; pg8::gemm_phase<EpiResF32, StaticOrder, PG8_ALIGN, PG8_SP2>(F.lds + RING_OFF, g, S, E); SEAM(6); }
    if (IN(7)) { norm_phase(F, H, XN, (const float*)(ws + WS_WG), (float*)(ws + WS_GATES), args.in[12], args.in[13]); SEAM(7); }
    if (IN(8)) { Gemm g{XN, (const bf16*)(ws + WS_WML), M, NPROJ, D}; StaticOrder S; S.init(M, NPROJ, F.G, (int)blockIdx.x);
        EpiBf16<0> E{QKV, NPROJ, 0, 1.f}; pg8::gemm_phase<EpiBf16<0>, StaticOrder, PG8_ALIGN, PG8_SP2>(F.lds + RING_OFF, g, S, E); SEAM(8); }
#ifdef NAIVE_MLSTM
    if (IN(9)) { naive_mlstm_phase(F, QKV, (const float*)(ws + WS_GATES), args.in[14], args.in[15], AO); SEAM(9); }
    if (IN(10)) { SEAM(10); }
#else
    if (IN(9)) { mlstm_phase(F, QKV, (const float*)(ws + WS_GATES), args.in[14], args.in[15], (bf16*)(ws + WS_HT), (float*)(ws + WS_SSQ)); SEAM(9); }
    if (IN(10)) { gatenorm_phase(F, QKV, (const bf16*)(ws + WS_HT), (const float*)(ws + WS_SSQ), AO); SEAM(10); }
#endif
    if (IN(11)) { Gemm g{AO, (const bf16*)(ws + WS_WMO), M, D, D}; StaticOrder S; S.init(M, D, F.G, (int)blockIdx.x);
        EpiResF32 E{H, H, D}; pg8::gemm_phase<EpiResF32, StaticOrder, PG8_ALIGN, PG8_SP2>(F.lds + RING_OFF, g, S, E); SEAM(11); }
    if (IN(12)) { norm_phase(F, H, XN, nullptr, nullptr, nullptr, nullptr); SEAM(12); }
    if (IN(13)) { Gemm g{XN, (const bf16*)(ws + WS_W1) + (size_t)D * FF, M, FF, D}; StaticOrder S; S.init(M, FF, F.G, (int)blockIdx.x);
        EpiBf16<2> E{U, FF, 0, 1.f}; pg8::gemm_phase<EpiBf16<2>, StaticOrder, PG8_ALIGN, PG8_SP2>(F.lds + RING_OFF, g, S, E); SEAM(13); }
    if (IN(14)) { Gemm g{U, (const bf16*)(ws + WS_W2) + (size_t)D * FF, M, D, FF}; StaticOrder S; S.init(M, D, F.G, (int)blockIdx.x);
        EpiResF32 E{H, H, D}; pg8::gemm_phase<EpiResF32, StaticOrder, PG8_ALIGN, PG8_SP2>(F.lds + RING_OFF, g, S, E); SEAM(14); }
    if (IN(15)) { final_norm_phase(F, H, args.in[21], args.out); }
#undef IN
#undef SEAM
}

extern "C" void kernel_launch(void* const* d_in, const int* in_sizes, int n_in, void* d_out, int out_size, void* d_ws, size_t ws_size, hipStream_t stream) {
    static int grid = 0;
    if (grid == 0) {
        if (n_in != 22 || in_sizes[0] != M * D || out_size != M * D || ws_size < WS_END) { fprintf(stderr, "kernel_launch: unexpected shapes (n_in %d, in0 %d, out %d, ws %zu); nothing launched\n", n_in, n_in > 0 ? in_sizes[0] : -1, out_size, ws_size); grid = -1; return; }
        int dev = 0, cus = 0, per_cu = 0;
        if (hipGetDevice(&dev) != hipSuccess || hipDeviceGetAttribute(&cus, hipDeviceAttributeMultiprocessorCount, dev) != hipSuccess) { grid = -1; return; }
        if (hipFuncSetAttribute((const void*)fwd, hipFuncAttributeMaxDynamicSharedMemorySize, LDS_BYTES) != hipSuccess) { fprintf(stderr, "kernel_launch: hipFuncSetAttribute failed\n"); grid = -1; return; }
        if (hipOccupancyMaxActiveBlocksPerMultiprocessor(&per_cu, (const void*)fwd, NWAVES * 64, LDS_BYTES) != hipSuccess || per_cu < 1) fprintf(stderr, "kernel_launch: occupancy query says %d\n", per_cu);
        (void)hipGetLastError();
        grid = cus;
    }
    if (grid < 0) return;
    (void)hipMemsetAsync((char*)d_ws + WS_CTL, 0, CTL_ZERO_BYTES, stream);
    Args a{};
    for (int i = 0; i < 22; ++i) a.in[i] = (const float*)d_in[i];
    a.out = (float*)d_out; a.ws = (unsigned char*)d_ws;
    int li = 0;
    auto run = [&](int lo, int hi) { a.ph_lo = lo; a.ph_hi = hi; a.li = li++; hipLaunchKernelGGL(fwd, dim3(grid), dim3(NWAVES * 64), LDS_BYTES, stream, a); };
    run(0, NPHASE);
}
```

```cpp
#include <hip/hip_runtime.h>
#include <cstdio>
#include <cstdint>
namespace pg8 {
#define PG8_LAS __attribute__((address_space(3)))
typedef unsigned short bf16_t;
typedef short bf16x8 __attribute__((ext_vector_type(8)));
typedef float f32x4 __attribute__((ext_vector_type(4)));
typedef unsigned u32x4 __attribute__((ext_vector_type(4)));
constexpr int BM = 256, BK = 64, HALF = 128, HTB = HALF * BK * 2  , STAGE_BYTES = 8 * HTB, NXCD = 8, WGM = 8;

__host__ __device__ __forceinline__ int lds_byte(int r, int c) { const int st = (r >> 4) * 2 + (c >> 5), rr = r & 15, cc = c & 31, ob = rr * 64 + cc * 2; return st * 1024 + (ob ^ (((ob >> 9) & 1) << 5)); }
__host__ __device__ __forceinline__ void stage_rc(int b, int& R, int& C) { const int st = b / 1024, sb = b % 1024, swz = sb ^ (((sb >> 9) & 1) << 5); R = (st >> 1) * 16 + swz / 64; C = (st & 1) * 32 + (swz % 64) / 2; }
__host__ __device__ __forceinline__ int perm32(int rho) { const int n = rho >> 4, i = rho & 15; return 8 * (i >> 2) + 4 * n + (i & 3); }

struct Unit { int pm, pn; };
struct Gemm { const bf16_t* A; const bf16_t* Bt; int M, N, K; };

struct StaticOrder {
    int nM, nN, nwg, G, c;
    __host__ __device__ void init(int M, int N, int G_, int c_) { nM = M / BM; nN = N / BM; nwg = nM * nN; G = G_; c = c_; }
    __host__ __device__ bool next(int i, Unit& u) const {
        const long L = (long)i * G + c; if (L >= nwg) return false;
        int wgid = (int)L; { const int q = nwg / NXCD, r = nwg % NXCD, xcd = wgid % NXCD, off = wgid / NXCD; wgid = (xcd < r ? xcd * (q + 1) : r * (q + 1) + (xcd - r) * q) + off; }
        const int nig = WGM * nN, gid = wgid / nig, fm = gid * WGM, gsz = (nM - fm) < WGM ? (nM - fm) : WGM;
        u.pm = fm + ((wgid % nig) % gsz); u.pn = (wgid % nig) / gsz; return true;
    }
    __device__ __forceinline__ void a_ready(const Unit&) const {}
    __device__ __forceinline__ void done(const Unit&) const {}
};

__device__ __forceinline__ unsigned cvt_pk_bf16(float lo, float hi) { unsigned r; asm volatile("v_cvt_pk_bf16_f32 %0, %1, %2" : "=v"(r) : "v"(lo), "v"(hi)); return r; }
template <int ACT> struct EpiBf16 {
    static constexpr bool PERM = true, AFTER_DRAIN = false;
    bf16_t* O; int ldc; int scale_cols; float scale0;
    __device__ __forceinline__ void operator()(const f32x4 (&acc)[2][2][4][2], const Unit& u, int wr, int wc, int fr, int fq) const {
        const int row0 = u.pm * BM + wr * 64 + fr; const int colt = u.pn * BM;
        const float sc = (colt < scale_cols) ? scale0 : 1.f;
        const int col0 = colt + wc * 32 + 8 * fq;
#pragma unroll
        for (int ai = 0; ai < 2; ++ai)
#pragma unroll
            for (int m = 0; m < 4; ++m) { bf16_t* rowp = O + (size_t)(row0 + ai * HALF + m * 16) * ldc + col0;
#pragma unroll
                for (int bj = 0; bj < 2; ++bj) { f32x4 v0 = acc[ai][bj][m][0], v1 = acc[ai][bj][m][1];
                    if (ACT == 2) {
#pragma unroll
                        for (int e = 0; e < 4; ++e) { const float a = fmaxf(v0[e], 0.f), b = fmaxf(v1[e], 0.f); v0[e] = a * a; v1[e] = b * b; } }
                    v0 = v0 * sc; v1 = v1 * sc; u32x4 w; w.x = cvt_pk_bf16(v0[0], v0[1]); w.y = cvt_pk_bf16(v0[2], v0[3]); w.z = cvt_pk_bf16(v1[0], v1[1]); w.w = cvt_pk_bf16(v1[2], v1[3]);
                    *(u32x4*)(rowp + bj * HALF) = w; } }
    }
};
struct EpiResF32 {
    static constexpr bool PERM = false, AFTER_DRAIN = false;
    const float* base; float* out; int ldc;
    __device__ __forceinline__ void operator()(const f32x4 (&acc)[2][2][4][2], const Unit& u, int wr, int wc, int fr, int fq) const {
        const int row0 = u.pm * BM + wr * 64 + fr; const int col0 = u.pn * BM + wc * 32 + 4 * fq;
#pragma unroll
        for (int ai = 0; ai < 2; ++ai)
#pragma unroll
            for (int m = 0; m < 4; ++m) { const size_t off = (size_t)(row0 + ai * HALF + m * 16) * ldc + col0;
#pragma unroll
                for (int bj = 0; bj < 2; ++bj)
#pragma unroll
                    for (int n = 0; n < 2; ++n) { const f32x4 bs = *(const f32x4*)(base + off + bj * HALF + n * 16);
                        *(f32x4*)(out + off + bj * HALF + n * 16) = bs + acc[ai][bj][m][n]; } }
    }
};

template <class Epi, class Sched, bool ALIGN_EPI = false, bool SP2 = false>
__device__ __forceinline__ void gemm_phase(PG8_LAS unsigned char* lds, const Gemm g, const Sched& S, const Epi& E) {
    const int tid = threadIdx.x, wid = __builtin_amdgcn_readfirstlane(tid >> 6), lane = tid & 63, wr = wid >> 2, wc = wid & 3, fr = lane & 15, fq = lane >> 4;
    const int K = g.K, nt = K / BK;
    unsigned voffA[2], voffB[2];
#pragma unroll
    for (int i = 0; i < 2; ++i) { int R, C; stage_rc(tid * 16 + i * 8192, R, C); const int Rb = Epi::PERM ? ((R & ~31) + perm32(R & 31)) : R;
        voffA[i] = (unsigned)(R * K + C) * 2u; voffB[i] = (unsigned)(Rb * K + C) * 2u; }
    const size_t kstep = (size_t)(BK * 2);
    const size_t hstep = (size_t)HALF * K * 2;
    const size_t tstep = 2 * hstep;
    const unsigned ldsw = (unsigned)wid * 1024u;
    const int aoff = lds_byte(wr * 64 + fr, fq * 8), boff = lds_byte(wc * 32 + fr, fq * 8);
#define PG8_SA(b, h) (((b) * 2 + (h)) * HTB)
#define PG8_SB(b, h) ((4 + (b) * 2 + (h)) * HTB)
#define PG8_STAGE(bufoff, gbase, voff) do { _Pragma("unroll") for (int _i = 0; _i < 2; ++_i) \
        __builtin_amdgcn_global_load_lds((const unsigned*)((const char*)(gbase) + (voff)[_i]), (PG8_LAS unsigned*)(lds + (bufoff) + ldsw + _i * 8192), 16, 0, 0); } while (0)
#define PG8_LDA(dst, b, h) do { _Pragma("unroll") for (int m = 0; m < 4; ++m) _Pragma("unroll") for (int k = 0; k < 2; ++k) dst[m][k] = *(const PG8_LAS bf16x8*)(lds + PG8_SA(b, h) + aoff + m * 2048 + k * 1024); } while (0)
#define PG8_LDB(dst, b, h) do { _Pragma("unroll") for (int n = 0; n < 2; ++n) _Pragma("unroll") for (int k = 0; k < 2; ++k) dst[n][k] = *(const PG8_LAS bf16x8*)(lds + PG8_SB(b, h) + boff + n * 2048 + k * 1024); } while (0)
#define PG8_MMA(ai, bj, At, Bt) do { __builtin_amdgcn_s_setprio(1); _Pragma("unroll") for (int m = 0; m < 4; ++m) _Pragma("unroll") for (int n = 0; n < 2; ++n) _Pragma("unroll") for (int k = 0; k < 2; ++k) \
        acc[ai][bj][m][n] = __builtin_amdgcn_mfma_f32_16x16x32_bf16(Bt[n][k], At[m][k], acc[ai][bj][m][n], 0, 0, 0); __builtin_amdgcn_s_setprio(0); } while (0)
#define PG8_WAIT_V(n) asm volatile("s_waitcnt vmcnt(" #n ")" ::: "memory")
#define PG8_WAIT_L(n) asm volatile("s_waitcnt lgkmcnt(" #n ")" ::: "memory")
#define PG8_BAR __builtin_amdgcn_s_barrier()
#define PG8_SCHED __builtin_amdgcn_sched_barrier(0)
    Unit cur, nxt; int ui = 0;
    if (!S.next(0, cur)) return;
    f32x4 acc[2][2][4][2];
#pragma unroll
    for (int a = 0; a < 2; ++a)
#pragma unroll
        for (int b = 0; b < 2; ++b)
#pragma unroll
            for (int m = 0; m < 4; ++m)
#pragma unroll
                for (int n = 0; n < 2; ++n) acc[a][b][m][n] = (f32x4){0.f, 0.f, 0.f, 0.f};
    bf16x8 At[4][2], B0[2][2], B1[2][2];
    const char* cA = (const char*)g.A + (size_t)cur.pm * tstep; const char* cB = (const char*)g.Bt + (size_t)cur.pn * tstep;
    S.a_ready(cur);
    if constexpr (SP2) {
        PG8_STAGE(PG8_SB(0, 0), cB, voffB); PG8_STAGE(PG8_SB(0, 1), cB + hstep, voffB); PG8_STAGE(PG8_SA(0, 0), cA, voffA); PG8_STAGE(PG8_SA(0, 1), cA + hstep, voffA);
        if (wr == 1) PG8_BAR;
        PG8_WAIT_V(2); PG8_BAR;
        PG8_STAGE(PG8_SB(1, 0), cB + kstep, voffB); PG8_STAGE(PG8_SA(1, 0), cA + kstep, voffA); PG8_STAGE(PG8_SB(1, 1), cB + hstep + kstep, voffB);
        PG8_WAIT_V(6); PG8_BAR;
    } else {
        PG8_STAGE(PG8_SB(0, 0), cB, voffB); PG8_STAGE(PG8_SA(0, 0), cA, voffA); PG8_STAGE(PG8_SB(0, 1), cB + hstep, voffB); PG8_STAGE(PG8_SA(0, 1), cA + hstep, voffA);
        if (wr == 1) PG8_BAR;
        PG8_WAIT_V(4); PG8_BAR;
        PG8_STAGE(PG8_SB(1, 0), cB + kstep, voffB); PG8_STAGE(PG8_SA(1, 0), cA + kstep, voffA); PG8_STAGE(PG8_SB(1, 1), cB + hstep + kstep, voffB);
        PG8_WAIT_V(6); PG8_BAR;
    }
    for (;;) {
        const bool has_next = S.next(ui + 1, nxt);
        const char* nA = has_next ? (const char*)g.A + (size_t)nxt.pm * tstep : cA; const char* nB = has_next ? (const char*)g.Bt + (size_t)nxt.pn * tstep : cB;
        for (int t = 0; t < nt; t += 2) {
            const bool last = (t == nt - 2);
            const char* a1 = cA + (size_t)(t + 1) * kstep;
            const char* a2 = last ? nA : cA + (size_t)(t + 2) * kstep; const char* b2 = last ? nB : cB + (size_t)(t + 2) * kstep;
            const char* a3 = a2 + kstep; const char* b3 = b2 + kstep;
            if (last && has_next) S.a_ready(nxt);
            if constexpr (SP2) {
            PG8_LDB(B0, 0, 0); PG8_LDB(B1, 0, 1); PG8_SCHED; PG8_LDA(At, 0, 0); PG8_STAGE(PG8_SA(1, 1), a1 + hstep, voffA);
            PG8_WAIT_V(8); PG8_WAIT_L(0); PG8_BAR; PG8_MMA(0, 0, At, B0); PG8_MMA(0, 1, At, B1); PG8_BAR; PG8_SCHED;
            PG8_LDA(At, 0, 1); PG8_STAGE(PG8_SB(0, 0), b2, voffB); PG8_STAGE(PG8_SB(0, 1), b2 + hstep, voffB); PG8_STAGE(PG8_SA(0, 0), a2, voffA);
            PG8_WAIT_V(8); PG8_WAIT_L(0); PG8_BAR; PG8_MMA(1, 0, At, B0); PG8_MMA(1, 1, At, B1); PG8_BAR; PG8_SCHED;
            PG8_LDB(B0, 1, 0); PG8_LDB(B1, 1, 1); PG8_SCHED; PG8_LDA(At, 1, 0); PG8_STAGE(PG8_SA(0, 1), a2 + hstep, voffA);
            PG8_WAIT_V(8); PG8_WAIT_L(0); PG8_BAR; PG8_MMA(0, 0, At, B0); PG8_MMA(0, 1, At, B1); PG8_BAR; PG8_SCHED;
            PG8_LDA(At, 1, 1); PG8_STAGE(PG8_SB(1, 0), b3, voffB); PG8_STAGE(PG8_SB(1, 1), b3 + hstep, voffB); PG8_STAGE(PG8_SA(1, 0), a3, voffA);
            PG8_WAIT_V(8); PG8_WAIT_L(0); PG8_BAR; PG8_MMA(1, 0, At, B0); PG8_MMA(1, 1, At, B1); PG8_BAR; PG8_SCHED;
            } else {
            PG8_LDB(B0, 0, 0); PG8_SCHED; PG8_LDA(At, 0, 0); PG8_STAGE(PG8_SA(1, 1), a1 + hstep, voffA);
            PG8_WAIT_L(8); PG8_BAR; PG8_WAIT_L(0); PG8_MMA(0, 0, At, B0); PG8_BAR; PG8_SCHED;
            PG8_LDB(B1, 0, 1); PG8_STAGE(PG8_SB(0, 0), b2, voffB);
            PG8_BAR; PG8_WAIT_L(0); PG8_MMA(0, 1, At, B1); PG8_BAR;
            PG8_LDA(At, 0, 1); PG8_STAGE(PG8_SA(0, 0), a2, voffA);
            PG8_BAR; PG8_WAIT_L(0); PG8_MMA(1, 0, At, B0); PG8_BAR; PG8_SCHED;
            PG8_STAGE(PG8_SB(0, 1), b2 + hstep, voffB);
            PG8_WAIT_V(6); PG8_BAR; PG8_MMA(1, 1, At, B1); PG8_BAR;
            PG8_LDB(B0, 1, 0); PG8_SCHED; PG8_LDA(At, 1, 0); PG8_STAGE(PG8_SA(0, 1), a2 + hstep, voffA);
            PG8_WAIT_L(8); PG8_BAR; PG8_WAIT_L(0); PG8_MMA(0, 0, At, B0); PG8_BAR; PG8_SCHED;
            PG8_LDB(B1, 1, 1); PG8_STAGE(PG8_SB(1, 0), b3, voffB);
            PG8_BAR; PG8_WAIT_L(0); PG8_MMA(0, 1, At, B1); PG8_BAR;
            PG8_LDA(At, 1, 1); PG8_STAGE(PG8_SA(1, 0), a3, voffA);
            PG8_BAR; PG8_WAIT_L(0); PG8_MMA(1, 0, At, B0); PG8_BAR; PG8_SCHED;
            PG8_STAGE(PG8_SB(1, 1), b3 + hstep, voffB);
            PG8_WAIT_V(6); PG8_BAR; PG8_MMA(1, 1, At, B1); PG8_BAR;
            }
        }
        if constexpr (ALIGN_EPI) { if (wr == 0) PG8_BAR; }
        if constexpr (!Epi::AFTER_DRAIN) { E(acc, cur, wr, wc, fr, fq); S.done(cur); }
        if (!has_next) break;
#pragma unroll
        for (int a = 0; a < 2; ++a)
#pragma unroll
            for (int b = 0; b < 2; ++b)
#pragma unroll
                for (int m = 0; m < 4; ++m)
#pragma unroll
                    for (int n = 0; n < 2; ++n) acc[a][b][m][n] = (f32x4){0.f, 0.f, 0.f, 0.f};
        cur = nxt; cA = nA; cB = nB; ++ui;
        if constexpr (ALIGN_EPI) { if (wr == 1) PG8_BAR; }
    }
    PG8_WAIT_V(0);
    if constexpr (!ALIGN_EPI) { if (wr == 0) PG8_BAR; }
    PG8_BAR;
    if constexpr (Epi::AFTER_DRAIN) { E.fused(acc, cur, wr, wc, fr, fq, lds, wid, lane); S.done(cur); }
#undef PG8_SA
#undef PG8_SB
#undef PG8_STAGE
#undef PG8_LDA
#undef PG8_LDB
#undef PG8_MMA
#undef PG8_WAIT_V
#undef PG8_WAIT_L
#undef PG8_BAR
#undef PG8_SCHED
}
}

#ifndef PG8_SP2
#define PG8_SP2 true
#endif
#ifndef PG8_ALIGN
#define PG8_ALIGN true
#endif
namespace da {
typedef short bf16x8 __attribute__((ext_vector_type(8)));
typedef short s16x4 __attribute__((ext_vector_type(4)));
typedef float f32x16 __attribute__((ext_vector_type(16)));
typedef float f32x4 __attribute__((ext_vector_type(4)));
typedef unsigned u32x4 __attribute__((ext_vector_type(4)));
#define DLAS __attribute__((address_space(3)))
constexpr int NW = 8, QBLK = 32, KVBLK = 64, QB = NW * QBLK, PITCH = 3072;
constexpr int SHM_V = KVBLK * 128 * 2, SHM_K = KVBLK * 64 * 2;
constexpr int OFF_V = 0, OFF_K = 2 * SHM_V, OFF_WS = OFF_K + 2 * SHM_K, OFF_LUT = OFF_WS + NW * 64 * 4, LDS_BYTES = OFF_LUT + 512;
constexpr float THR = 8.f;
#define DA_KSWZ(row, c) ((row) * 128 + ((((c) ^ (((row) >> 1) & 7))) << 4))
#define DA_SBAR() __builtin_amdgcn_sched_barrier(0)
__device__ __forceinline__ int v_st(int k, int c) { const int kk = (k & ~0xC) | ((k & 4) << 1) | ((k & 8) >> 1); return ((kk >> 3) * 4 + (c >> 5)) * 512 + ((kk & 7) * 32 + (c & 31)) * 2; }
__device__ __forceinline__ int v_rd_base(int lane) { return ((lane & 3) << 3) | (((lane >> 2) & 3) << 6) | (((lane >> 4) & 1) << 5) | (((lane >> 5) & 1) << 8); }
constexpr int v_rd_off(int d0, int ks, int half) { return d0 * 512 + ks * 4096 + half * 2048; }
__device__ __forceinline__ int crow(int r, int hi) { return (r & 3) + 8 * (r >> 2) + 4 * hi; }
__device__ __forceinline__ unsigned cvtpk(float lo, float hi) { unsigned r; asm volatile("v_cvt_pk_bf16_f32 %0, %1, %2" : "=v"(r) : "v"(lo), "v"(hi)); return r; }
__device__ __forceinline__ void mask_tile(f32x16& p0, f32x16& p1, int dq) {
    const float NEG = -__builtin_inff();
#pragma unroll
    for (int r = 0; r < 16; ++r) { const int c = (r & 3) + 8 * (r >> 2); if (dq - c < 0) p0[r] = NEG; if (dq - c - 32 < 0) p1[r] = NEG; }
}
__device__ __forceinline__ void bias_tile(f32x16& p0, f32x16& p1, int dq, const DLAS float* lut) {
#pragma unroll
    for (int g = 0; g < 4; ++g) {
#pragma unroll
        for (int rr = 0; rr < 4; ++rr) { const int r = g * 4 + rr; const int c = (r & 3) + 8 * (r >> 2);
            int i0 = dq - c; i0 = i0 < 0 ? 0 : (i0 > 127 ? 127 : i0); int i1 = dq - c - 32; i1 = i1 < 0 ? 0 : (i1 > 127 ? 127 : i1);
            p0[r] += lut[i0]; p1[r] += lut[i1]; }
        DA_SBAR();
    }
}
__device__ __forceinline__ void partialSM(f32x16& p0, f32x16& p1, float& m_reg, float& alpha, float cb) {
    float pmax = p0[0];
#pragma unroll
    for (int r = 1; r < 16; ++r) pmax = fmaxf(pmax, p0[r]);
#pragma unroll
    for (int r = 0; r < 16; ++r) pmax = fmaxf(pmax, p1[r]);
    { auto rr = __builtin_amdgcn_permlane32_swap(__float_as_uint(pmax), __float_as_uint(pmax), false, false);
      pmax = fmaxf(__uint_as_float(rr[0]), __uint_as_float(rr[1])); }
    pmax += cb;
    float mn;
    if (__builtin_expect(__all(pmax - m_reg <= THR), 1)) { mn = m_reg; alpha = 1.f; }
    else { mn = fmaxf(m_reg, pmax); alpha = __builtin_amdgcn_exp2f(m_reg - mn); m_reg = mn; }
    const float off = cb - mn;
#pragma unroll
    for (int r = 0; r < 16; ++r) p0[r] += off;
#pragma unroll
    for (int r = 0; r < 16; ++r) p1[r] += off;
#pragma unroll
    for (int r = 0; r < 16; ++r) p0[r] = __builtin_amdgcn_exp2f(p0[r]);
}
__device__ __forceinline__ void finishSM(f32x16& p0, f32x16& p1, float alpha, float& l_reg, bf16x8& pa0, bf16x8& pa1, bf16x8& pa2, bf16x8& pa3) {
#pragma unroll
    for (int r = 0; r < 16; ++r) p1[r] = __builtin_amdgcn_exp2f(p1[r]);
    float ps = 0;
#pragma unroll
    for (int r = 0; r < 16; ++r) ps += p0[r];
#pragma unroll
    for (int r = 0; r < 16; ++r) ps += p1[r];
    { auto rr = __builtin_amdgcn_permlane32_swap(__float_as_uint(ps), __float_as_uint(ps), false, false);
      ps = __uint_as_float(rr[0]) + __uint_as_float(rr[1]); }
    l_reg = l_reg * alpha + ps;
#define DA_PK4(P, B_, OUT) do { unsigned a0 = cvtpk(P[B_+0], P[B_+1]), a1 = cvtpk(P[B_+2], P[B_+3]);                          \
        unsigned b0 = cvtpk(P[B_+4], P[B_+5]), b1 = cvtpk(P[B_+6], P[B_+7]);                                             \
        auto r0 = __builtin_amdgcn_permlane32_swap(a0, b0, false, false); auto r1 = __builtin_amdgcn_permlane32_swap(a1, b1, false, false); \
        u32x4 w = {r0[0], r1[0], r0[1], r1[1]}; OUT = *reinterpret_cast<bf16x8*>(&w); } while (0)
    DA_PK4(p0, 0, pa0); DA_PK4(p0, 8, pa1); DA_PK4(p1, 0, pa2); DA_PK4(p1, 8, pa3);
#undef DA_PK4
}
template <int KB>
__device__ __forceinline__ void qkt(f32x16& p0, f32x16& p1, const DLAS char* K_lds, int r32, int hi, const bf16x8* qr) {
    p0 = f32x16{}; p1 = f32x16{};
#pragma unroll
    for (int d0 = 0; d0 < 4; ++d0) { const DLAS char* a = K_lds + KB * SHM_K + DA_KSWZ(r32, d0 * 2 + hi);
        const bf16x8 b0 = *reinterpret_cast<const DLAS bf16x8*>(a);
        const bf16x8 b1 = *reinterpret_cast<const DLAS bf16x8*>(a + 32 * 128);
        p0 = __builtin_amdgcn_mfma_f32_32x32x16_bf16(b0, qr[d0], p0, 0, 0, 0);
        p1 = __builtin_amdgcn_mfma_f32_32x32x16_bf16(b1, qr[d0], p1, 0, 0, 0); }
}
template <int VB>
__device__ __forceinline__ void pv_tile(f32x16* o, int vb0, bf16x8 pa0, bf16x8 pa1, bf16x8 pa2, bf16x8 pa3) {
#define DA_TRRD(dst, off) asm volatile("ds_read_b64_tr_b16 %0, %1 offset:%2" : "=&v"(dst) : "v"(vb0), "i"(off) : "memory")
#define DA_PV_D0(d0) do { s16x4 l0, l1, l2, l3, h0, h1, h2, h3; constexpr int b_ = VB * SHM_V + v_rd_off(d0, 0, 0); \
        DA_TRRD(l0, b_); DA_TRRD(h0, b_ + 2048); DA_TRRD(l1, b_ + 4096); DA_TRRD(h1, b_ + 6144); DA_TRRD(l2, b_ + 8192); DA_TRRD(h2, b_ + 10240); DA_TRRD(l3, b_ + 12288); DA_TRRD(h3, b_ + 14336); \
        asm volatile("s_waitcnt lgkmcnt(0)" ::: "memory"); DA_SBAR();   \
        o[d0] = __builtin_amdgcn_mfma_f32_32x32x16_bf16(pa0, (bf16x8){l0[0], l0[1], l0[2], l0[3], h0[0], h0[1], h0[2], h0[3]}, o[d0], 0, 0, 0);   \
        o[d0] = __builtin_amdgcn_mfma_f32_32x32x16_bf16(pa1, (bf16x8){l1[0], l1[1], l1[2], l1[3], h1[0], h1[1], h1[2], h1[3]}, o[d0], 0, 0, 0);   \
        o[d0] = __builtin_amdgcn_mfma_f32_32x32x16_bf16(pa2, (bf16x8){l2[0], l2[1], l2[2], l2[3], h2[0], h2[1], h2[2], h2[3]}, o[d0], 0, 0, 0);   \
        o[d0] = __builtin_amdgcn_mfma_f32_32x32x16_bf16(pa3, (bf16x8){l3[0], l3[1], l3[2], l3[3], h3[0], h3[1], h3[2], h3[3]}, o[d0], 0, 0, 0); } while (0)
    DA_PV_D0(0); DA_PV_D0(1); DA_PV_D0(2); DA_PV_D0(3);
#undef DA_PV_D0
#undef DA_TRRD
}
__device__ __forceinline__ void attn_block(const unsigned short* __restrict__ Qp, const unsigned short* __restrict__ Kp, const unsigned short* __restrict__ Vp, int P0, DLAS char* lds, float c31, f32x16 (&o)[4]) {
    const int tid = threadIdx.x, wid = __builtin_amdgcn_readfirstlane(tid >> 6), lane = tid & 63, r32 = lane & 31, hi = lane >> 5;
    const int NT = (P0 + QB) / KVBLK;
    const int qlo = P0 + wid * QBLK, qm = qlo + r32 - 4 * hi;
    DLAS char* V_lds = lds + OFF_V; DLAS char* K_lds = lds + OFF_K;
    DLAS float* wsf = (DLAS float*)(lds + OFF_WS) + wid * 64; DLAS float* li_l = wsf; DLAS float* al_l = wsf + 32;
    const DLAS float* lut = (const DLAS float*)(lds + OFF_LUT);
    float m_reg = -1e30f, l_reg = 0.f;
#pragma unroll
    for (int d = 0; d < 4; ++d) o[d] = f32x16{};
    const int sr = tid >> 4, sc = (tid & 15) * 8, vst0 = v_st(sr, sc), vst1 = v_st(32 + sr, sc);
    const int kr = tid >> 3, kc = tid & 7, kws = DA_KSWZ(kr, kc);
    const int vb0 = (int)(uintptr_t)V_lds + v_rd_base(lane);
    bf16x8 qr[4];
#pragma unroll
    for (int d0 = 0; d0 < 4; ++d0) qr[d0] = *reinterpret_cast<const bf16x8*>(Qp + (size_t)(wid * QBLK + r32) * PITCH + d0 * 16 + hi * 8);
    bf16x8 st_v0, st_v1, st_k0;
#define DA_VMW() asm volatile("s_waitcnt vmcnt(0)" ::: "memory")
#define DA_SLOAD(k0) do { st_v0 = *reinterpret_cast<const bf16x8*>(Vp + (size_t)((k0) + sr) * PITCH + sc); st_v1 = *reinterpret_cast<const bf16x8*>(Vp + (size_t)((k0) + 32 + sr) * PITCH + sc); \
                          st_k0 = *reinterpret_cast<const bf16x8*>(Kp + (size_t)((k0) + kr) * PITCH + kc * 8); } while (0)
#define DA_SWRITE(bf) do { *reinterpret_cast<DLAS bf16x8*>(V_lds + (bf) * SHM_V + vst0) = st_v0; *reinterpret_cast<DLAS bf16x8*>(V_lds + (bf) * SHM_V + vst1) = st_v1; \
                           *reinterpret_cast<DLAS bf16x8*>(K_lds + (bf) * SHM_K + kws) = st_k0; } while (0)
#define DA_RESC(a) do { if (__any((a) < 1.f)) { if (hi == 0) al_l[r32] = (a); asm volatile("s_waitcnt lgkmcnt(0)" ::: "memory");              \
                        _Pragma("unroll") for (int d_ = 0; d_ < 4; ++d_) _Pragma("unroll") for (int r = 0; r < 16; ++r) o[d_][r] *= al_l[crow(r, hi)]; } } while (0)
#define DA_BIASMASK(P0_, P1_, t, cbv) do { const int kb_ = (t) * KVBLK; if (kb_ + KVBLK - 1 + 128 > qlo) { bias_tile(P0_, P1_, qm - kb_, lut); cbv = 0.f; if (kb_ + KVBLK - 1 > qlo) mask_tile(P0_, P1_, qm - kb_); } else cbv = c31; } while (0)
    f32x16 pA0, pA1, pB0, pB1; float alA, alB, cbA, cbB; bf16x8 pa0, pa1, pa2, pa3;
    DA_SLOAD(0); DA_VMW(); DA_SWRITE(0); DA_SBAR();
    DA_SLOAD(KVBLK);
    __syncthreads();
    DA_SBAR(); qkt<0>(pA0, pA1, K_lds, r32, hi, qr);
    DA_BIASMASK(pA0, pA1, 0, cbA); partialSM(pA0, pA1, m_reg, alA, cbA);
    DA_VMW(); DA_SWRITE(1);
    __syncthreads();
#define DA_HALF_STEP(PX0, PX1, alX, cbX, PY0, PY1, alY, t, KB, VB, SB) do {                                                      \
        DA_SBAR(); qkt<KB>(PX0, PX1, K_lds, r32, hi, qr);                                             \
        finishSM(PY0, PY1, alY, l_reg, pa0, pa1, pa2, pa3); DA_SBAR();                                                           \
        DA_SLOAD(((t) + 1) * KVBLK); DA_SBAR();                                               \
        pv_tile<VB>(o, vb0, pa0, pa1, pa2, pa3); DA_BIASMASK(PX0, PX1, (t), cbX); partialSM(PX0, PX1, m_reg, alX, cbX);                                        \
        __syncthreads();                                                                                                      \
        DA_VMW(); DA_SWRITE(SB);                                                                          \
        DA_RESC(alX); __syncthreads(); } while (0)
    for (int t = 1; t + 1 < NT; t += 2) {
        DA_HALF_STEP(pB0, pB1, alB, cbB, pA0, pA1, alA, t, 1, 0, 0);
        DA_HALF_STEP(pA0, pA1, alA, cbA, pB0, pB1, alB, t + 1, 0, 1, 1);
    }
    DA_SBAR(); qkt<1>(pB0, pB1, K_lds, r32, hi, qr); DA_SBAR();
    finishSM(pA0, pA1, alA, l_reg, pa0, pa1, pa2, pa3); DA_SBAR();
    pv_tile<0>(o, vb0, pa0, pa1, pa2, pa3);
    DA_BIASMASK(pB0, pB1, NT - 1, cbB); partialSM(pB0, pB1, m_reg, alB, cbB); DA_RESC(alB);
    finishSM(pB0, pB1, alB, l_reg, pa0, pa1, pa2, pa3); DA_SBAR(); pv_tile<1>(o, vb0, pa0, pa1, pa2, pa3);
    if (hi == 0) li_l[r32] = l_reg; asm volatile("s_waitcnt lgkmcnt(0)" ::: "memory");
#pragma unroll
    for (int r = 0; r < 16; ++r) { const float rl = __builtin_amdgcn_rcpf(li_l[crow(r, hi)]);
#pragma unroll
        for (int d0 = 0; d0 < 4; ++d0) o[d0][r] *= rl; }
    __syncthreads();
#undef DA_VMW
#undef DA_SLOAD
#undef DA_SWRITE
#undef DA_RESC
#undef DA_BIASMASK
#undef DA_HALF_STEP
}
}
static_assert(da::LDS_BYTES <= 131072, "attention LDS inside the ring region");
constexpr int NWAVES = 8;
#ifndef MK_N_LAUNCHES
#define MK_N_LAUNCHES 1
#endif
constexpr int BATCH = 16, SEQ = 2048, D = 1024, FF = 4096, M = BATCH * SEQ;
constexpr int NQKV = 3072;
constexpr int MLW = 3080, NPROJ = 3072;
constexpr int NH_A = 8, NH_M = 4;
constexpr float EPS = 1e-6f, LOG2E = 1.4426950408889634f;
constexpr float QSCALE = 0.125f * LOG2E;
constexpr float LAMBDA_INIT0 = 0.2f;
constexpr float MQSCALE = 0.08838834764831845f;
constexpr int NPHASE = 16;
constexpr int DUP_PHASE = -1;

namespace ml {
typedef short bf16x8 __attribute__((ext_vector_type(8)));
typedef short s16x4 __attribute__((ext_vector_type(4)));
typedef float f32x16 __attribute__((ext_vector_type(16)));
typedef float f32x4 __attribute__((ext_vector_type(4)));
typedef unsigned u32x4 __attribute__((ext_vector_type(4)));
typedef unsigned u32x2 __attribute__((ext_vector_type(2)));
#define MLAS __attribute__((address_space(3)))
constexpr int L = 64, NC = 2048 / L, PITCH = 3072;
constexpr int PQ = 272, PS = 144;
constexpr int O_Q = 0, O_K = O_Q + 64 * PQ, O_C = O_K + 64 * PQ, O_KW = O_C + 64 * PQ, O_V = O_KW + 16384, O_SC = O_V + 16384, O_ARR = O_SC + 64 * PS, O_NP = O_ARR + 9 * 256, O_N = O_NP + 4096, LDS_BYTES = O_N + 512;
enum { A_E = 0, A_BM = 64, A_INTER = 128, A_EMJ = 192, A_WP = 256, A_RS0 = 320, A_RS1 = 384, A_QN = 448, A_SCAL = 512 };
__device__ __forceinline__ float bf2f_lo(unsigned w) { return __uint_as_float(w << 16); }
__device__ __forceinline__ float bf2f_hi(unsigned w) { return __uint_as_float(w & 0xffff0000u); }
typedef float f32x2_t __attribute__((ext_vector_type(2))); typedef __bf16 bf16x2_t __attribute__((ext_vector_type(2)));
__device__ __forceinline__ unsigned cvtpk(float lo, float hi) { f32x2_t v = {lo, hi}; bf16x2_t b = __builtin_convertvector(v, bf16x2_t); return __builtin_bit_cast(unsigned, b); }
__device__ __forceinline__ int crow(int r, int hi) { return (r & 3) + 8 * (r >> 2) + 4 * hi; }
__device__ __forceinline__ int v_st(int k, int c) { const int kk = (k & ~0xC) | ((k & 4) << 1) | ((k & 8) >> 1); return ((kk >> 3) * 4 + (c >> 5)) * 512 + ((kk & 7) * 32 + (c & 31)) * 2; }
__device__ __forceinline__ int v_rd_base(int lane) { return ((lane & 3) << 3) | (((lane >> 2) & 3) << 6) | (((lane >> 4) & 1) << 5) | (((lane >> 5) & 1) << 8); }
#define ML_TRRD(dst, base, off) asm volatile("ds_read_b64_tr_b16 %0, %1 offset:%2" : "=&v"(dst) : "v"(base), "i"(off) : "memory")
#define ML_SBAR() __builtin_amdgcn_sched_barrier(0)
#define ML_FR(lo, hi_) (bf16x8){lo[0], lo[1], lo[2], lo[3], hi_[0], hi_[1], hi_[2], hi_[3]}
struct Pre { bf16x8 q[2], k[2], v; f32x4 g; };

__device__ __forceinline__ void mlstm_unit(int b, int h, int s4, const unsigned short* __restrict__ PROJ, const unsigned short* __restrict__ QKC, const float* __restrict__ GS,
                                           unsigned short* HT, float* SSQ, MLAS char* lds) {
    const int tid = threadIdx.x, wid = __builtin_amdgcn_readfirstlane(tid >> 6), lane = tid & 63, r32 = lane & 31, hi = lane >> 5;
    MLAS char* QIMG = lds + O_Q; MLAS char* KIMG = lds + O_K; MLAS char* CIMG = lds + O_C; MLAS char* KWTR = lds + O_KW; MLAS char* VTR = lds + O_V; MLAS char* SC = lds + O_SC;
    MLAS float* arr = (MLAS float*)(lds + O_ARR); MLAS float* npart = (MLAS float*)(lds + O_NP); MLAS float* nvec = (MLAS float*)(lds + O_N);
    const int srow = tid >> 4, cg = tid & 15;
    const int vrow = tid >> 3, vcol = (tid & 7) * 8;
    const size_t tok0 = (size_t)b * 2048;
    const unsigned short* xq = QKC + tok0 * 1024 + h * 128 + cg * 8;
    const unsigned short* xk = xq + 512;
    const unsigned short* xv = PROJ + tok0 * PITCH + 1024 + h * 256 + s4 * 64 + vcol;
    const float* gs = GS + tok0 * 16 + h * 4;
    const int dkb = wid >> 1, dvb = wid & 1;
    const int tb0 = (wid & 3) >> 1, jb = wid & 1;
    f32x16 cst = f32x16{};
    float m_prev = 0.f;
    for (int i = tid; i < (64 * PQ) / 16; i += 512) ((MLAS u32x4*)CIMG)[i] = (u32x4){0u, 0u, 0u, 0u};
    if (tid < 128) nvec[tid] = 0.f;
    Pre P;
#define ML_LOAD(t0_) do { P.q[0] = *reinterpret_cast<const bf16x8*>(xq + (size_t)((t0_) + srow) * 1024); P.q[1] = *reinterpret_cast<const bf16x8*>(xq + (size_t)((t0_) + srow + 32) * 1024); \
        P.k[0] = *reinterpret_cast<const bf16x8*>(xk + (size_t)((t0_) + srow) * 1024); P.k[1] = *reinterpret_cast<const bf16x8*>(xk + (size_t)((t0_) + srow + 32) * 1024); \
        P.v = *reinterpret_cast<const bf16x8*>(xv + (size_t)((t0_) + vrow) * PITCH); P.g = *reinterpret_cast<const f32x4*>(gs + (size_t)((t0_) + lane) * 16); } while (0)
    ML_LOAD(0);
    u32x2 dst_w[4] = {}; float dst_ss = 0.f;
    const int trb_kw = (int)(uintptr_t)KWTR + v_rd_base(lane), trb_v = (int)(uintptr_t)VTR + v_rd_base(lane);
    __syncthreads();
    for (int c = 0; c < NC; ++c) {
        const int t0 = c * L;
        const float bsum = P.g[0], e = P.g[1], pm = P.g[2];
        asm volatile("" :: "v"(P.g[3]));
        const float b_last = __int_as_float(__builtin_amdgcn_readlane(__float_as_int(bsum), 63)), m_loc = b_last + __int_as_float(__builtin_amdgcn_readlane(__float_as_int(pm), 63));
        const float m_new = fmaxf(b_last + m_prev, m_loc), decay = __expf(b_last + m_prev - m_new);
        const float wp = __expf(b_last + e - m_new);
        const float m_inter = bsum + m_prev, m_j = fmaxf(m_inter, bsum + pm);
        if (wid == 0) { arr[A_E + lane] = e; arr[A_BM + lane] = bsum - m_j; arr[A_INTER + lane] = __expf(m_inter - m_j); arr[A_EMJ + lane] = __expf(-m_j); arr[A_WP + lane] = wp; }
        m_prev = m_new;
#pragma unroll
        for (int i = 0; i < 2; ++i) { const int row = srow + 32 * i; const float wrow = __shfl(wp, row);
            *reinterpret_cast<MLAS bf16x8*>(QIMG + row * PQ + cg * 16) = P.q[i];
            *reinterpret_cast<MLAS bf16x8*>(KIMG + row * PQ + cg * 16) = P.k[i];
            const u32x4 kw = __builtin_bit_cast(u32x4, P.k[i]); u32x4 ow;
#pragma unroll
            for (int q = 0; q < 4; ++q) ow[q] = cvtpk(bf2f_lo(kw[q]) * wrow, bf2f_hi(kw[q]) * wrow);
            *reinterpret_cast<MLAS u32x4*>(KWTR + v_st(row, cg * 8)) = ow; }
        *reinterpret_cast<MLAS bf16x8*>(VTR + v_st(vrow, vcol)) = P.v;
        __syncthreads();
#define ML_STORE_OUT(tt) do { if (wid >= 4) { const int j_ = 32 * jb + r32; unsigned short* hp_ = HT + (tok0 + (tt) + j_) * 1024 + h * 256 + s4 * 64 + 32 * tb0 + 4 * hi; \
            _Pragma("unroll") for (int q4 = 0; q4 < 4; ++q4) *reinterpret_cast<u32x2*>(hp_ + 8 * q4) = dst_w[q4]; \
            if (hi == 0) SSQ[(tok0 + (tt) + j_) * 32 + h * 8 + s4 * 2 + tb0] = dst_ss; } } while (0)
        if (c > 0) ML_STORE_OUT(t0 - L);
        { const int tn = (c + 1 < NC) ? t0 + L : t0; ML_LOAD(tn); }
        f32x16 acc_qc = f32x16{};
        if (wid < 4) {
            f32x16 g = f32x16{};
            if (!(tb0 == 1 && jb == 0)) {
                const MLAS char* ka = KIMG + (32 * tb0 + r32) * PQ + hi * 16; const MLAS char* qa = QIMG + (32 * jb + r32) * PQ + hi * 16;
bf16x8 fa[8], fb[8];
#pragma unroll
                for (int kk = 0; kk < 8; ++kk) { fa[kk] = *reinterpret_cast<const MLAS bf16x8*>(ka + kk * 32); fb[kk] = *reinterpret_cast<const MLAS bf16x8*>(qa + kk * 32); }
                ML_SBAR();
#pragma unroll
                for (int kk = 0; kk < 8; ++kk) g = __builtin_amdgcn_mfma_f32_32x32x16_bf16(fa[kk], fb[kk], g, 0, 0, 0);
            }
            const int j = 32 * jb + r32; const float bm = arr[A_BM + j]; float rsum = 0.f;
#pragma unroll
            for (int q4 = 0; q4 < 4; ++q4) { const f32x4 ev = *reinterpret_cast<const MLAS f32x4*>(arr + A_E + 32 * tb0 + 8 * q4 + 4 * hi);
                float sc4[4];
#pragma unroll
                for (int i = 0; i < 4; ++i) { const int s = 32 * tb0 + 8 * q4 + 4 * hi + i; const float v = (s <= j) ? g[4 * q4 + i] * __expf(bm + ev[i]) : 0.f; sc4[i] = v; rsum += v; }
                const u32x2 w = {cvtpk(sc4[0], sc4[1]), cvtpk(sc4[2], sc4[3])};
                *reinterpret_cast<MLAS u32x2*>(SC + j * PS + (32 * tb0 + 8 * q4 + 4 * hi) * 2) = w; }
            rsum += __shfl_xor(rsum, 32);
            if (hi == 0) arr[(tb0 ? A_RS1 : A_RS0) + j] = rsum;
        } else {
            const MLAS char* ca = CIMG + (32 * tb0 + r32) * PQ + hi * 16; const MLAS char* qa = QIMG + (32 * jb + r32) * PQ + hi * 16;
bf16x8 fa[8], fb[8];
#pragma unroll
            for (int kk = 0; kk < 8; ++kk) { fa[kk] = *reinterpret_cast<const MLAS bf16x8*>(ca + kk * 32); fb[kk] = *reinterpret_cast<const MLAS bf16x8*>(qa + kk * 32); }
            ML_SBAR();
#pragma unroll
            for (int kk = 0; kk < 8; ++kk) acc_qc = __builtin_amdgcn_mfma_f32_32x32x16_bf16(fa[kk], fb[kk], acc_qc, 0, 0, 0);
        }
        {
            const int j = tid >> 3, part = tid & 7;
            const u32x4 q0 = *reinterpret_cast<const MLAS u32x4*>(QIMG + j * PQ + part * 32), q1 = *reinterpret_cast<const MLAS u32x4*>(QIMG + j * PQ + part * 32 + 16);
            float s = 0.f;
#pragma unroll
            for (int q = 0; q < 4; ++q) { const f32x4 n4 = *reinterpret_cast<const MLAS f32x4*>(nvec + part * 16 + 4 * q);
                const unsigned w0 = q < 2 ? q0[2 * q] : q1[2 * q - 4], w1 = q < 2 ? q0[2 * q + 1] : q1[2 * q - 3];
                s += bf2f_lo(w0) * n4[0] + bf2f_hi(w0) * n4[1] + bf2f_lo(w1) * n4[2] + bf2f_hi(w1) * n4[3]; }
            s += __shfl_xor(s, 1); s += __shfl_xor(s, 2); s += __shfl_xor(s, 4);
            if (part == 0) arr[A_QN + j] = s;
            float n0 = 0.f, n1 = 0.f;
#pragma unroll
            for (int i = 0; i < 8; ++i) { const int srow = 8 * wid + i; const unsigned kw = *reinterpret_cast<const MLAS unsigned*>(KIMG + srow * PQ + lane * 4); const float w = arr[A_WP + srow];
                n0 += w * bf2f_lo(kw); n1 += w * bf2f_hi(kw); }
            npart[wid * 128 + 2 * lane] = n0; npart[wid * 128 + 2 * lane + 1] = n1;
        }
        __syncthreads();
        if (wid >= 4) {
            f32x16 acc_n = f32x16{};
            const MLAS char* sa = SC + (32 * jb + r32) * PS + hi * 16;
            {   s16x4 l0, l1, l2, l3, h0, h1, h2, h3;
                if (tb0 == 0) { ML_TRRD(l0, trb_v, 0); ML_TRRD(h0, trb_v, 2048); ML_TRRD(l1, trb_v, 4096); ML_TRRD(h1, trb_v, 6144); ML_TRRD(l2, trb_v, 8192); ML_TRRD(h2, trb_v, 10240); ML_TRRD(l3, trb_v, 12288); ML_TRRD(h3, trb_v, 14336); }
                else { ML_TRRD(l0, trb_v, 512); ML_TRRD(h0, trb_v, 512 + 2048); ML_TRRD(l1, trb_v, 512 + 4096); ML_TRRD(h1, trb_v, 512 + 6144); ML_TRRD(l2, trb_v, 512 + 8192); ML_TRRD(h2, trb_v, 512 + 10240); ML_TRRD(l3, trb_v, 512 + 12288); ML_TRRD(h3, trb_v, 512 + 14336); }
                const bf16x8 s0 = *reinterpret_cast<const MLAS bf16x8*>(sa), s1 = *reinterpret_cast<const MLAS bf16x8*>(sa + 32), s2 = *reinterpret_cast<const MLAS bf16x8*>(sa + 64), s3 = *reinterpret_cast<const MLAS bf16x8*>(sa + 96);
                asm volatile("s_waitcnt lgkmcnt(0)" ::: "memory"); ML_SBAR();
                acc_n = __builtin_amdgcn_mfma_f32_32x32x16_bf16(ML_FR(l0, h0), s0, acc_n, 0, 0, 0);
                acc_n = __builtin_amdgcn_mfma_f32_32x32x16_bf16(ML_FR(l1, h1), s1, acc_n, 0, 0, 0);
                acc_n = __builtin_amdgcn_mfma_f32_32x32x16_bf16(ML_FR(l2, h2), s2, acc_n, 0, 0, 0);
                acc_n = __builtin_amdgcn_mfma_f32_32x32x16_bf16(ML_FR(l3, h3), s3, acc_n, 0, 0, 0); }
            const int j = 32 * jb + r32; const float inter = arr[A_INTER + j];
            const float den = arr[A_RS0 + j] + arr[A_RS1 + j] + inter * arr[A_QN + j];
            const float rden = 1.f / fmaxf(fabsf(den), arr[A_EMJ + j]);
            float ss = 0.f;
#pragma unroll
            for (int q4 = 0; q4 < 4; ++q4) { float hv[4];
#pragma unroll
                for (int i = 0; i < 4; ++i) { hv[i] = (acc_n[4 * q4 + i] + inter * acc_qc[4 * q4 + i]) * rden; ss += hv[i] * hv[i]; }
                dst_w[q4] = (u32x2){cvtpk(hv[0], hv[1]), cvtpk(hv[2], hv[3])}; }
            ss += __shfl_xor(ss, 32);
            dst_ss = ss;
        }
        {
            s16x4 al[4], ah[4], bl[4], bh[4];
#define ML_LD4(d0k, d0v) do { ML_TRRD(al[0], trb_kw, (d0k) * 512); ML_TRRD(ah[0], trb_kw, (d0k) * 512 + 2048); ML_TRRD(al[1], trb_kw, (d0k) * 512 + 4096); ML_TRRD(ah[1], trb_kw, (d0k) * 512 + 6144); \
            ML_TRRD(al[2], trb_kw, (d0k) * 512 + 8192); ML_TRRD(ah[2], trb_kw, (d0k) * 512 + 10240); ML_TRRD(al[3], trb_kw, (d0k) * 512 + 12288); ML_TRRD(ah[3], trb_kw, (d0k) * 512 + 14336); \
            ML_TRRD(bl[0], trb_v, (d0v) * 512); ML_TRRD(bh[0], trb_v, (d0v) * 512 + 2048); ML_TRRD(bl[1], trb_v, (d0v) * 512 + 4096); ML_TRRD(bh[1], trb_v, (d0v) * 512 + 6144); \
            ML_TRRD(bl[2], trb_v, (d0v) * 512 + 8192); ML_TRRD(bh[2], trb_v, (d0v) * 512 + 10240); ML_TRRD(bl[3], trb_v, (d0v) * 512 + 12288); ML_TRRD(bh[3], trb_v, (d0v) * 512 + 14336); } while (0)
            switch (wid) { case 0: ML_LD4(0, 0); break; case 1: ML_LD4(0, 1); break; case 2: ML_LD4(1, 0); break; case 3: ML_LD4(1, 1); break;
                           case 4: ML_LD4(2, 0); break; case 5: ML_LD4(2, 1); break; case 6: ML_LD4(3, 0); break; default: ML_LD4(3, 1); break; }
#undef ML_LD4
#pragma unroll
            for (int r = 0; r < 16; ++r) cst[r] *= decay;
            asm volatile("s_waitcnt lgkmcnt(0)" ::: "memory"); ML_SBAR();
#pragma unroll
            for (int ks = 0; ks < 4; ++ks) cst = __builtin_amdgcn_mfma_f32_32x32x16_bf16(ML_FR(al[ks], ah[ks]), ML_FR(bl[ks], bh[ks]), cst, 0, 0, 0);
            const int dv = 32 * dvb + r32;
#pragma unroll
            for (int q4 = 0; q4 < 4; ++q4) { const u32x2 w = {cvtpk(cst[4 * q4], cst[4 * q4 + 1]), cvtpk(cst[4 * q4 + 2], cst[4 * q4 + 3])};
                *reinterpret_cast<MLAS u32x2*>(CIMG + dv * PQ + (32 * dkb + 8 * q4 + 4 * hi) * 2) = w; }
        }
        if (tid < 128) { float s = nvec[tid] * decay;
#pragma unroll
            for (int w = 0; w < 8; ++w) s += npart[w * 128 + tid];
            nvec[tid] = s; }
        __syncthreads();
    }
    ML_STORE_OUT((NC - 1) * L);
#undef ML_STORE_OUT
#undef ML_LOAD
}
}
static_assert(ml::LDS_BYTES <= 131072, "mLSTM LDS inside the ring region");
constexpr size_t MiB = 1u << 20;
constexpr size_t WS_CTL = 0, CTL_ZERO_BYTES = 1 * MiB;
constexpr size_t WS_WQKV = 2 * MiB, WS_WAO = 8 * MiB, WS_WML = 10 * MiB, WS_WMO = 16 * MiB, WS_W1 = 18 * MiB  , WS_W2 = 34 * MiB  ;
constexpr size_t WS_WG = 50 * MiB;
constexpr size_t WS_GATES = 51 * MiB;
constexpr size_t WS_SSQ = 52 * MiB;
constexpr size_t WS_GS = 56 * MiB;
constexpr size_t WS_XN = 64 * MiB;
constexpr size_t WS_U = 128 * MiB;
constexpr size_t WS_HT = 320 * MiB;
constexpr size_t WS_T0 = 384 * MiB;
constexpr size_t WS_END = 384 * MiB;
constexpr int CW_TMO = 0, CW_CODE = 1;
constexpr int CW_BAR = 4096;
constexpr int RING_OFF = 0, RING_BYTES = 131072;
constexpr int LDSCTL_OFF = RING_BYTES, MISC_OFF = LDSCTL_OFF + 320;
constexpr int LDS_BYTES = 147456;
static_assert(MISC_OFF + 128 <= LDS_BYTES, "LDS map");

#define GAS __attribute__((address_space(1)))
#define LAS __attribute__((address_space(3)))
typedef unsigned short bf16;
typedef unsigned v4u __attribute__((ext_vector_type(4)));
typedef float f32x4 __attribute__((ext_vector_type(4)));
typedef short bf16x8 __attribute__((ext_vector_type(8)));
typedef GAS unsigned gu32;
typedef GAS unsigned long long gu64;
#define RLX_AGENT __ATOMIC_RELAXED, __HIP_MEMORY_SCOPE_AGENT
#define LDS_WAIT() asm volatile("s_waitcnt lgkmcnt(0)" ::: "memory")
#define VM_WAIT() asm volatile("s_waitcnt vmcnt(0)" ::: "memory")
__device__ __forceinline__ unsigned long long rt() { return __builtin_amdgcn_s_memrealtime(); }
__device__ __forceinline__ unsigned f2bf(float f) { unsigned u = __builtin_bit_cast(unsigned, f); return (u + 0x7fffu + ((u >> 16) & 1u)) >> 16; }
__device__ __forceinline__ unsigned pk2(float lo, float hi) { return f2bf(lo) | (f2bf(hi) << 16); }

#define XB_TMO      128
#define XB_XCNT(j)  (256  + 64 * (j))
#define XB_XSUB(j)  (1280 + 64 * (j))
#define XB_XGEN(j)  (2304 + 64 * (j))
#define XB_TOP      3328
#define XB_TOPGEN   3392
#define XCD_BAR_WORDS 3456
#define XB_SPIN_CAP (1u << 23)

__device__ __forceinline__ unsigned xb_ld(unsigned* p)              { return __hip_atomic_load(p, __ATOMIC_RELAXED, __HIP_MEMORY_SCOPE_AGENT); }
__device__ __forceinline__ unsigned xb_add(unsigned* p, unsigned v) { return __hip_atomic_fetch_add(p, v, __ATOMIC_RELAXED, __HIP_MEMORY_SCOPE_AGENT); }
__device__ __forceinline__ unsigned xb_xcc_id() { return (unsigned)__builtin_amdgcn_s_getreg((3 << 11) | 20) & 0xFu; }
#define XB_SPIN(cond, bar) do { unsigned _sp = 0; while (cond) { __builtin_amdgcn_s_sleep(1); \
    if ((++_sp & 255u) == 0u) { if (xb_ld(&(bar)[XB_TMO])) break; if (_sp > XB_SPIN_CAP) { atomicAdd(&(bar)[XB_TMO], 1u); break; } } } } while (0)

struct XcdBarrier {
    unsigned* bar; unsigned x;
    volatile LAS unsigned* st;
};

__device__ __forceinline__ XcdBarrier xcd_barrier_post(unsigned* bar, volatile LAS unsigned* st) {
    XcdBarrier b; b.bar = bar; b.x = xb_xcc_id(); b.st = st;
    if (threadIdx.x == 0) (void)xb_add(&bar[XB_XCNT(b.x)], 1u);
    return b;
}
__device__ __forceinline__ void xcd_barrier_complete(unsigned* bar, unsigned x, unsigned& nloc, unsigned& nx) {
    const unsigned G = gridDim.x * gridDim.y * gridDim.z;
    unsigned sum, cnt, mine, sp = 0u;
    for (;;) {
        sum = 0u; cnt = 0u; mine = 0u;
#pragma unroll
        for (unsigned j = 0; j < 16; ++j) { const unsigned c = xb_ld(&bar[XB_XCNT(j)]); sum += c; cnt += (c > 0u) ? 1u : 0u; mine = (j == x) ? c : mine; }
        if (sum == G) break;
        __builtin_amdgcn_s_sleep(1);
        if ((++sp & 255u) == 0u) { if (xb_ld(&bar[XB_TMO])) break; if (sp > XB_SPIN_CAP) { atomicAdd(&bar[XB_TMO], 1u); break; } }
    }
    nloc = mine > 0u ? mine : 1u; nx = cnt > 0u ? cnt : 1u;
}

__device__ __forceinline__ void xcd_barrier(const XcdBarrier& b) {
    asm volatile("s_waitcnt vmcnt(0)" ::: "memory");
    __syncthreads();
    if (threadIdx.x == 0) {
        unsigned* bar = b.bar;
        __builtin_amdgcn_s_waitcnt(0);
        unsigned nloc = b.st[0], nx = b.st[1];
        if (nloc == 0u) { xcd_barrier_complete(bar, b.x, nloc, nx); b.st[0] = nloc; b.st[1] = nx; }
        const unsigned old = xb_add(&bar[XB_XSUB(b.x)], 1u);
        const unsigned gen = old / nloc;
        if (old + 1u == (gen + 1u) * nloc) {
            __builtin_amdgcn_fence(__ATOMIC_RELEASE, "agent");
            asm volatile("s_waitcnt vmcnt(0)" ::: "memory");
            const unsigned og = xb_add(&bar[XB_TOP], 1u);
            const unsigned tg = og / nx;
            if (og + 1u == (tg + 1u) * nx) xb_add(&bar[XB_TOPGEN], 1u);
            else XB_SPIN(xb_ld(&bar[XB_TOPGEN]) == tg, bar);
            __builtin_amdgcn_fence(__ATOMIC_ACQUIRE, "agent");
            xb_add(&bar[XB_XGEN(b.x)], 1u);
            asm volatile("s_waitcnt vmcnt(0)" ::: "memory");
        } else {
            XB_SPIN(xb_ld(&bar[XB_XGEN(b.x)]) == gen, bar);
            __builtin_amdgcn_fence(__ATOMIC_ACQUIRE, "agent");
            asm volatile("s_waitcnt vmcnt(0)" ::: "memory");
        }
    }
    __syncthreads();
}

struct Frame {
    LAS unsigned char* lds;
    volatile LAS unsigned* MISC;
    gu32* ctl;
    int tid, lane, wave;
    int vcu, G;
};
__device__ __forceinline__ float wave_sum(float v) {
#pragma unroll
    for (int o = 1; o < 64; o <<= 1) v += __shfl_xor(v, o);
    return v;
}
__device__ __forceinline__ void p0_transpose_item(const float* W, int K, int ldw, int nblk, bf16* WT, const float* gk, int gmask, float gs, LAS float* scr, int item, int lane) {
    const int kb = item / nblk, nb = item % nblk, k0 = 64 * kb, n0 = 64 * nb;
    f32x4 v[16];
#pragma unroll
    for (int i = 0; i < 16; ++i) v[i] = *(const GAS f32x4*)(W + (size_t)(k0 + 4 * i + (lane >> 4)) * ldw + n0 + (lane & 15) * 4);
#pragma unroll
    for (int i = 0; i < 16; ++i) { const int kk = 4 * i + (lane >> 4); const float g = gk ? gk[(k0 + kk) & gmask] * gs : gs; LAS float* d = scr + kk * 64; const int nn = (lane & 15) * 4 + kk;
        d[nn & 63] = v[i].x * g; d[(nn + 1) & 63] = v[i].y * g; d[(nn + 2) & 63] = v[i].z * g; d[(nn + 3) & 63] = v[i].w * g; }
    LDS_WAIT(); asm volatile("" ::: "memory");
    const int c = lane & 7;
#pragma unroll
    for (int j = 0; j < 8; ++j) { const int n = (lane >> 3) + 8 * j; const LAS float* s = scr + (8 * c) * 64; const int nn = n + 8 * c;
        v4u o; o.x = pk2(s[0 * 64 + (nn & 63)], s[1 * 64 + ((nn + 1) & 63)]); o.y = pk2(s[2 * 64 + ((nn + 2) & 63)], s[3 * 64 + ((nn + 3) & 63)]);
        o.z = pk2(s[4 * 64 + ((nn + 4) & 63)], s[5 * 64 + ((nn + 5) & 63)]); o.w = pk2(s[6 * 64 + ((nn + 6) & 63)], s[7 * 64 + ((nn + 7) & 63)]);
        *(GAS v4u*)(WT + (size_t)(n0 + n) * K + k0 + 8 * c) = o; }
    LDS_WAIT(); asm volatile("" ::: "memory");
}
__device__ __forceinline__ void rms_row_load(const float* xrow, int lane, f32x4 (&v)[4]) {
    const GAS f32x4* xr = (const GAS f32x4*)xrow + lane; float s2 = 0.f;
#pragma unroll
    for (int j = 0; j < 4; ++j) { v[j] = xr[64 * j]; s2 += (v[j].x * v[j].x + v[j].y * v[j].y) + (v[j].z * v[j].z + v[j].w * v[j].w); }
    const float rstd = 1.f / sqrtf(wave_sum(s2) * (1.f / D) + EPS);
#pragma unroll
    for (int j = 0; j < 4; ++j) v[j] = v[j] * rstd;
}
__device__ __forceinline__ void row_store_bf16(bf16* orow, int lane, const f32x4 (&v)[4]) {
    GAS unsigned long long* o8 = (GAS unsigned long long*)orow + lane;
#pragma unroll
    for (int j = 0; j < 4; ++j) o8[64 * j] = (unsigned long long)pk2(v[j].x, v[j].y) | ((unsigned long long)pk2(v[j].z, v[j].w) << 32);
}
__device__ __forceinline__ float log_sigmoid(float x) { return fminf(x, 0.f) - log1pf(expf(-fabsf(x))); }

struct Args { const float* in[22]; float* out; unsigned char* ws; int ph_lo, ph_hi, li, pad; };

__device__ __forceinline__ void p0_prologue(Frame& F, const Args& a) {
    unsigned char* ws = a.ws;
    LAS float* scr = (LAS float*)(F.lds + RING_OFF + F.wave * 16384);
    const int gw = F.vcu * NWAVES + F.wave, NGW = F.G * NWAVES;
    constexpr int I_QKV = (D / 64) * (NQKV / 64), I_O = (D / 64) * (D / 64), I_ML = (D / 64) * (NPROJ / 64), I_1 = (D / 64) * (FF / 64), I_2 = (FF / 64) * (D / 64);
    constexpr int NITEMS = I_QKV + I_O + I_ML + I_O + 2 * I_1 + 2 * I_2;
    for (int it = gw; it < NITEMS; it += NGW) {
        int r = it;
        if (r < I_QKV) { p0_transpose_item(a.in[3], D, NQKV, NQKV / 64, (bf16*)(ws + WS_WQKV), a.in[2], 0xffff, 1.f, scr, r, F.lane); continue; } r -= I_QKV;
        if (r < I_O) { p0_transpose_item(a.in[9], D, D, D / 64, (bf16*)(ws + WS_WAO), a.in[8], 127, 1.f - LAMBDA_INIT0, scr, r, F.lane); continue; } r -= I_O;
        if (r < I_ML) { p0_transpose_item(a.in[11], D, MLW, NPROJ / 64, (bf16*)(ws + WS_WML), a.in[10], 0xffff, 1.f, scr, r, F.lane); continue; } r -= I_ML;
        if (r < I_O) { p0_transpose_item(a.in[17], D, D, D / 64, (bf16*)(ws + WS_WMO), a.in[16], 0xffff, 1.f, scr, r, F.lane); continue; } r -= I_O;
        if (r < 2 * I_1) { const int l = r / I_1; p0_transpose_item(a.in[19] + (size_t)l * D * FF, D, FF, FF / 64, (bf16*)(ws + WS_W1) + (size_t)l * D * FF, a.in[18] + l * D, 0xffff, 1.f, scr, r % I_1, F.lane); continue; } r -= 2 * I_1;
        { const int l = r / I_2; p0_transpose_item(a.in[20] + (size_t)l * D * FF, FF, D, D / 64, (bf16*)(ws + WS_W2) + (size_t)l * D * FF, nullptr, 0, 1.f, scr, r % I_2, F.lane); }
    }
    { float* WG = (float*)(ws + WS_WG); const int gt = (F.vcu * NWAVES + F.wave) * 64 + F.lane, NGT = F.G * NWAVES * 64;
      for (int i = gt; i < 8 * D; i += NGT) { const int j = i / D, k = i % D; WG[i] = a.in[10][k] * a.in[11][(size_t)k * MLW + NPROJ + j]; } }
    bf16* XN = (bf16*)(ws + WS_XN);
    for (int m = gw; m < M; m += NGW) { f32x4 v[4]; rms_row_load(a.in[0] + (size_t)m * D, F.lane, v); row_store_bf16(XN + (size_t)m * D, F.lane, v); }
}
__device__ __forceinline__ void norm_phase(Frame& F, const float* H, bf16* XN, const float* WG, float* GATES, const float* b_i, const float* b_f) {
    const int gw = F.vcu * NWAVES + F.wave, NGW = F.G * NWAVES;
    LAS f32x4* wg = (LAS f32x4*)(F.lds + RING_OFF);
    if (GATES) { for (int i = F.tid; i < 8 * D / 4; i += NWAVES * 64) wg[i] = ((const GAS f32x4*)WG)[i]; __syncthreads(); }
    for (int m = gw; m < M; m += NGW) {
        f32x4 v[4]; rms_row_load(H + (size_t)m * D, F.lane, v); row_store_bf16(XN + (size_t)m * D, F.lane, v);
        if (GATES) {
            float mine = 0.f;
#pragma unroll
            for (int j = 0; j < 8; ++j) { float s = 0.f;
#pragma unroll
                for (int jj = 0; jj < 4; ++jj) { const f32x4 w = wg[j * 256 + jj * 64 + F.lane]; s += (v[jj].x * w.x + v[jj].y * w.y) + (v[jj].z * w.z + v[jj].w * w.w); }
                s = wave_sum(s); if (F.lane == j) mine = s; }
            if (F.lane < 4) GATES[(size_t)m * 8 + F.lane] = mine + b_i[F.lane];
            else if (F.lane < 8) GATES[(size_t)m * 8 + F.lane] = log_sigmoid(mine + b_f[F.lane - 4]);
        }
    }
    if (GATES) __syncthreads();
}
__device__ __forceinline__ void final_norm_phase(Frame& F, const float* H, const float* g, float* out) {
    const int gw = F.vcu * NWAVES + F.wave, NGW = F.G * NWAVES;
    for (int m = gw; m < M; m += NGW) {
        f32x4 v[4]; rms_row_load(H + (size_t)m * D, F.lane, v);
        GAS f32x4* o = (GAS f32x4*)(out + (size_t)m * D) + F.lane; const GAS f32x4* gg = (const GAS f32x4*)g + F.lane;
#pragma unroll
        for (int j = 0; j < 4; ++j) o[64 * j] = v[j] * gg[64 * j];
    }
}

__device__ __forceinline__ float bf2f(bf16 v) { return __uint_as_float((unsigned)v << 16); }
__device__ __forceinline__ int t5_bucket(int d) {
    if (d < 16) return d;
    const float v = logf((float)d / 16.f) / logf(8.f) * 16.f; int b = 16 + (int)v; return b > 31 ? 31 : b;
}
__device__ __forceinline__ void naive_attn_phase(Frame& F, const bf16* __restrict__ QKV, const float* __restrict__ rel_bias, const float* __restrict__ lq1, const float* __restrict__ lk1,
                                                  const float* __restrict__ lq2, const float* __restrict__ lk2, bf16* AO) {
    LAS float* lut = (LAS float*)(F.lds + RING_OFF);
    const int tid = F.tid, half = tid & 1;
    float s1 = 0.f, s2 = 0.f;
    for (int i = 0; i < 64; ++i) { s1 += lq1[i] * lk1[i]; s2 += lq2[i] * lk2[i]; }
    const float lam = expf(s1) - expf(s2) + LAMBDA_INIT0;
    for (int u = F.vcu; u < BATCH * NH_A * (SEQ / 256); u += F.G) {
        const int qb = u % (SEQ / 256), h = (u / (SEQ / 256)) % NH_A, b = u / (SEQ / 256) / NH_A, q0 = qb * 256, q = q0 + (tid >> 1);
        __syncthreads();
        if (tid < 128) lut[tid] = rel_bias[t5_bucket(tid) * NH_A + h] * LOG2E;
        __syncthreads();
        const size_t tok = (size_t)b * SEQ + q;
        float res[64];
        for (int m = 0; m < 2; ++m) {
            float qv[64];
            const bf16* qp = QKV + tok * NQKV + h * 128 + m * 64;
#pragma unroll
            for (int d = 0; d < 64; ++d) qv[d] = bf2f(qp[d]);
            float o[64];
#pragma unroll
            for (int d = 0; d < 64; ++d) o[d] = 0.f;
            float mrun = -1e30f, l = 0.f;
            const int kend = q0 + 256;
            for (int k = 0; k < kend; ++k) {
                const bf16* kr = QKV + ((size_t)b * SEQ + k) * NQKV + D + h * 128 + m * 64;
                const bf16* vr = QKV + ((size_t)b * SEQ + k) * NQKV + 2 * D + h * 128 + half * 64;
                float s = 0.f;
#pragma unroll
                for (int d = 0; d < 64; ++d) s += qv[d] * bf2f(kr[d]);
                const int dist = q - k;
                if (dist >= 0) {
                    s += lut[dist < 127 ? dist : 127];
                    if (s > mrun) { const float al = exp2f(mrun - s); l *= al;
#pragma unroll
                        for (int d = 0; d < 64; ++d) o[d] *= al;
                        mrun = s; }
                    const float p = exp2f(s - mrun); l += p;
#pragma unroll
                    for (int d = 0; d < 64; ++d) o[d] += p * bf2f(vr[d]);
                }
            }
            const float il = 1.f / l;
            if (m == 0) {
#pragma unroll
                for (int d = 0; d < 64; ++d) res[d] = o[d] * il;
            } else {
                float ss = 0.f;
#pragma unroll
                for (int d = 0; d < 64; ++d) { res[d] = res[d] - lam * (o[d] * il); ss += res[d] * res[d]; }
                ss += __shfl_xor(ss, 1);
                const float rstd = 1.f / sqrtf(ss * (1.f / 128.f) + EPS);
                bf16* op = AO + tok * D + h * 128 + half * 64;
#pragma unroll
                for (int d = 0; d < 64; d += 2) *(unsigned*)(op + d) = pk2(res[d] * rstd, res[d + 1] * rstd);
            }
        }
    }
    __syncthreads();
}
__device__ __forceinline__ void naive_mlstm_phase(Frame& F, const bf16* __restrict__ PROJ, const float* __restrict__ GATES, const float* __restrict__ conv_w, const float* __restrict__ conv_b, bf16* AO) {
    LAS float* q_s = (LAS float*)(F.lds + RING_OFF); LAS float* k_s = q_s + 128; LAS float* v_s = q_s + 256; LAS float* red = q_s + 512;
    const int tid = F.tid, dv = tid >> 1, half = tid & 1, lane = F.lane, wave = F.wave;
    for (int u = (int)blockIdx.x; u < BATCH * NH_M; u += F.G) {
        const int h = u & 3, b = u >> 2;
        float C[64], n[64];
#pragma unroll
        for (int j = 0; j < 64; ++j) { C[j] = 0.f; n[j] = 0.f; }
        float mst = 0.f;
        const int col = (tid < 128) ? (h * 128 + tid) : (512 + h * 128 + ((tid - 128) & 127));
        float cw0 = 0.f, cw1 = 0.f, cw2 = 0.f, cw3 = 0.f, cb = 0.f;
        if (tid < 256) { cw0 = conv_w[0 * D + col]; cw1 = conv_w[1 * D + col]; cw2 = conv_w[2 * D + col]; cw3 = conv_w[3 * D + col]; cb = conv_b[col]; }
        __syncthreads();
        for (int t = 0; t < SEQ; ++t) {
            const size_t tok = (size_t)b * SEQ + t;
            if (tid < 256) {
                float x3 = bf2f(PROJ[tok * NPROJ + col]);
                float x2 = t >= 1 ? bf2f(PROJ[(tok - 1) * NPROJ + col]) : 0.f;
                float x1 = t >= 2 ? bf2f(PROJ[(tok - 2) * NPROJ + col]) : 0.f;
                float x0 = t >= 3 ? bf2f(PROJ[(tok - 3) * NPROJ + col]) : 0.f;
                float y = cw0 * x0 + cw1 * x1 + cw2 * x2 + cw3 * x3 + cb;
                y = y / (1.f + expf(-y));
                if (tid < 128) q_s[tid] = y * MQSCALE; else k_s[tid - 128] = y;
            } else {
                v_s[tid - 256] = bf2f(PROJ[tok * NPROJ + 1024 + h * 256 + (tid - 256)]);
            }
            const float ig = GATES[tok * 8 + h], lf = GATES[tok * 8 + 4 + h];
            __syncthreads();
            const float mnew = fmaxf(lf + mst, ig), fd = expf(lf + mst - mnew), gi = expf(ig - mnew);
            mst = mnew;
            const float gv = gi * v_s[dv];
            float num = 0.f, den = 0.f;
#pragma unroll
            for (int j = 0; j < 64; ++j) { const float kk = k_s[half * 64 + j], qq = q_s[half * 64 + j];
                C[j] = fd * C[j] + gv * kk; n[j] = fd * n[j] + gi * kk; num += C[j] * qq; den += n[j] * qq; }
            num += __shfl_xor(num, 1); den += __shfl_xor(den, 1);
            const float hv = num / fmaxf(fabsf(den), expf(-mnew));
            float ss = half == 0 ? hv * hv : 0.f;
            ss = wave_sum(ss);
            if (lane == 0) red[wave] = ss;
            __syncthreads();
            float tot = 0.f;
#pragma unroll
            for (int w = 0; w < 8; ++w) tot += red[w];
            const float rstd = 1.f / sqrtf(tot * (1.f / 256.f) + EPS);
            if (half == 0) { const float op = bf2f(PROJ[tok * NPROJ + 2048 + h * 256 + dv]); const float sg = 1.f / (1.f + expf(-op));
                AO[tok * D + h * 256 + dv] = (bf16)f2bf(sg * hv * rstd); }
            __syncthreads();
        }
    }
}

__device__ __forceinline__ void attn_phase(Frame& F, const bf16* __restrict__ QKV, bf16* AO, float* stash, const float* __restrict__ rel_bias, const float* __restrict__ lq1, const float* __restrict__ lk1,
                                           const float* __restrict__ lq2, const float* __restrict__ lk2) {
    using da::f32x16; using da::f32x4;
    LAS char* lds = (LAS char*)(F.lds + RING_OFF);
    LAS float* lut = (LAS float*)(lds + da::OFF_LUT);
    const int tid = F.tid, lane = F.lane, wid = F.wave, r32 = lane & 31, hi = lane >> 5;
    float s1 = 0.f, s2 = 0.f;
    for (int i = 0; i < 64; ++i) { s1 += lq1[i] * lk1[i]; s2 += lq2[i] * lk2[i]; }
    const float lam = expf(s1) - expf(s2) + LAMBDA_INIT0;
    f32x4* st = (f32x4*)(stash + (((size_t)blockIdx.x * NWAVES + wid) * 64 + lane) * 64);
    for (int L = F.vcu; L < BATCH * NH_A * 4; L += F.G) {
        const int bh = L >> 2, x = L & 3, b = bh >> 3, h = bh & 7;
        __syncthreads();
        if (tid < 128) lut[tid] = rel_bias[t5_bucket(tid) * NH_A + h] * LOG2E;
        __syncthreads();
        const float c31 = lut[127];
        for (int s = 0; s < 4; ++s) {
            const int qb = (s >> 1) ? 7 - x : x, m = s & 1, P0 = qb * 256;
            const bf16* Qp = QKV + ((size_t)b * SEQ + P0) * NQKV + h * 128 + m * 64;
            const bf16* Kp = QKV + (size_t)b * SEQ * NQKV + D + h * 128 + m * 64;
            const bf16* Vp = QKV + (size_t)b * SEQ * NQKV + 2 * D + h * 128;
            f32x16 o[4];
            da::attn_block(Qp, Kp, Vp, P0, lds, c31, o);
            if (m == 0) {
#pragma unroll
                for (int i = 0; i < 16; ++i) st[i] = (f32x4){o[i >> 2][(i & 3) * 4 + 0], o[i >> 2][(i & 3) * 4 + 1], o[i >> 2][(i & 3) * 4 + 2], o[i >> 2][(i & 3) * 4 + 3]};
            } else {
#pragma unroll
                for (int i = 0; i < 16; ++i) { const f32x4 a = st[i];
#pragma unroll
                    for (int e = 0; e < 4; ++e) o[i >> 2][(i & 3) * 4 + e] = a[e] - lam * o[i >> 2][(i & 3) * 4 + e]; }
                bf16* Ow = AO + ((size_t)b * SEQ + P0 + wid * 32) * D + h * 128;
#pragma unroll
                for (int r = 0; r < 16; ++r) {
                    float ss = (o[0][r] * o[0][r] + o[1][r] * o[1][r]) + (o[2][r] * o[2][r] + o[3][r] * o[3][r]);
#pragma unroll
                    for (int off = 1; off < 32; off <<= 1) ss += __shfl_xor(ss, off);
                    const float rstd = 1.f / sqrtf(ss * (1.f / 128.f) + EPS);
                    const int orow = da::crow(r, hi);
#pragma unroll
                    for (int d0 = 0; d0 < 4; ++d0) { const float v = o[d0][r] * rstd; const float vn = __shfl_xor(v, 1);
                        if ((r32 & 1) == 0) *(unsigned*)(Ow + (size_t)orow * D + d0 * 32 + r32) = da::cvtpk(v, vn); }
                }
            }
        }
    }
    __syncthreads();
}

__device__ __forceinline__ void convscan_phase(Frame& F, const bf16* __restrict__ PROJ, const float* __restrict__ GATES, const float* __restrict__ conv_w, const float* __restrict__ conv_b, bf16* QKC, float* GS) {
    {   const int pc = F.tid & 127, col = pc * 8;
        float cw[4][8], cbias[8];
#pragma unroll
        for (int i = 0; i < 8; ++i) { cbias[i] = conv_b[col + i];
#pragma unroll
            for (int t = 0; t < 4; ++t) cw[t][i] = conv_w[t * 1024 + col + i]; }
        const float osc = col < 512 ? MQSCALE : 1.f;
        for (int seg = F.vcu * 4 + (F.tid >> 7); seg < M / 32; seg += F.G * 4) {
            const int tokb = seg * 32;
#pragma unroll 1
            for (int run = 0; run < 4; ++run) {
                const int t8 = tokb + run * 8; const bool first = (t8 & (SEQ - 1)) == 0;
                const bf16* p = PROJ + (size_t)t8 * NPROJ + col;
                v4u r[11];
#pragma unroll
                for (int i = 0; i < 3; ++i) r[i] = first ? (v4u){0u, 0u, 0u, 0u} : *(const GAS v4u*)(p + ((ptrdiff_t)i - 3) * NPROJ);
#pragma unroll
                for (int i = 3; i < 11; ++i) r[i] = *(const GAS v4u*)(p + (size_t)(i - 3) * NPROJ);
#pragma unroll
                for (int t = 0; t < 8; ++t) {
                    unsigned o[4];
#pragma unroll
                    for (int q = 0; q < 4; ++q) {
                        float s0 = cbias[2 * q], s1 = cbias[2 * q + 1];
#pragma unroll
                        for (int tap = 0; tap < 4; ++tap) { const unsigned w = r[t + tap][q]; s0 += cw[tap][2 * q] * __uint_as_float(w << 16); s1 += cw[tap][2 * q + 1] * __uint_as_float(w & 0xffff0000u); }
                        s0 = s0 / (1.f + __expf(-s0)) * osc; s1 = s1 / (1.f + __expf(-s1)) * osc; o[q] = pk2(s0, s1); }
                    *(GAS v4u*)(QKC + (size_t)(t8 + t) * D + col) = (v4u){o[0], o[1], o[2], o[3]};
                }
            }
        }
    }
    {   const int gw = F.vcu * NWAVES + F.wave, NGW = F.G * NWAVES, lane = F.lane;
        for (int task = gw; task < BATCH * NH_M * (SEQ / 64); task += NGW) {
            const int c = task % (SEQ / 64), h = (task / (SEQ / 64)) % NH_M, b = task / (SEQ / 64) / NH_M;
            const size_t tok = (size_t)b * SEQ + c * 64 + lane;
            const float ig = GATES[tok * 8 + h], lf = GATES[tok * 8 + 4 + h];
            float bsum = lf;
#pragma unroll
            for (int off = 1; off < 64; off <<= 1) { const float t = __shfl_up(bsum, off); if (lane >= off) bsum += t; }
            const float e = ig - bsum; float pm = e;
#pragma unroll
            for (int off = 1; off < 64; off <<= 1) { const float t = __shfl_up(pm, off); if (lane >= off) pm = fmaxf(pm, t); }
            *(GAS f32x4*)(GS + tok * 16 + h * 4) = (f32x4){bsum, e, pm, 0.f};
        }
    }
}
__device__ __forceinline__ void mlstm_phase(Frame& F, const bf16* __restrict__ PROJ, const bf16* __restrict__ QKC, const float* __restrict__ GS, bf16* HT, float* SSQ) {
    for (int u = F.vcu; u < BATCH * NH_M * 4; u += F.G) {
        __syncthreads();
        ml::mlstm_unit(u >> 4, (u >> 2) & 3, u & 3, PROJ, QKC, GS, HT, SSQ, (LAS char*)(F.lds + RING_OFF));
    }
    __syncthreads();
}
__device__ __forceinline__ void gatenorm_phase(Frame& F, const bf16* __restrict__ PROJ, const bf16* __restrict__ HT, const float* __restrict__ SSQ, bf16* AO) {
    const int gw = F.vcu * NWAVES + F.wave, NGW = F.G * NWAVES, lane = F.lane;
    for (int m = gw; m < M; m += NGW) {
        const int hd = lane >> 4;
        const f32x4 s0 = *(const GAS f32x4*)(SSQ + (size_t)m * 32 + hd * 8), s1 = *(const GAS f32x4*)(SSQ + (size_t)m * 32 + hd * 8 + 4);
        const float tot = ((s0.x + s0.y) + (s0.z + s0.w)) + ((s1.x + s1.y) + (s1.z + s1.w));
        const float rstd = 1.f / sqrtf(tot * (1.f / 256.f) + EPS);
        const v4u h0 = *(const GAS v4u*)(HT + (size_t)m * D + lane * 16), h1 = *(const GAS v4u*)(HT + (size_t)m * D + lane * 16 + 8);
        const v4u o0 = *(const GAS v4u*)(PROJ + (size_t)m * NPROJ + 2048 + lane * 16), o1 = *(const GAS v4u*)(PROJ + (size_t)m * NPROJ + 2048 + lane * 16 + 8);
        v4u r0, r1;
#pragma unroll
        for (int q = 0; q < 4; ++q) {
            { const float ha = __uint_as_float(h0[q] << 16) * rstd, hb = __uint_as_float(h0[q] & 0xffff0000u) * rstd, oa = __uint_as_float(o0[q] << 16), ob = __uint_as_float(o0[q] & 0xffff0000u);
              r0[q] = pk2(ha / (1.f + __expf(-oa)), hb / (1.f + __expf(-ob))); }
            { const float ha = __uint_as_float(h1[q] << 16) * rstd, hb = __uint_as_float(h1[q] & 0xffff0000u) * rstd, oa = __uint_as_float(o1[q] << 16), ob = __uint_as_float(o1[q] & 0xffff0000u);
              r1[q] = pk2(ha / (1.f + __expf(-oa)), hb / (1.f + __expf(-ob))); }
        }
        *(GAS v4u*)(AO + (size_t)m * D + lane * 16) = r0; *(GAS v4u*)(AO + (size_t)m * D + lane * 16 + 8) = r1;
    }
}

template <class Epi>
__device__ __forceinline__ void run_gemm(Frame& F, const bf16* A, const bf16* Bt, int N, int K, const Epi& E) {
    pg8::Gemm g{A, Bt, M, N, K}; pg8::StaticOrder S; S.init(M, N, F.G, (int)blockIdx.x);
    pg8::gemm_phase<Epi, pg8::StaticOrder, PG8_ALIGN, PG8_SP2>(F.lds + RING_OFF, g, S, E);
}
__global__ void __launch_bounds__(NWAVES * 64, 2) fwd(Args args) {
    extern __shared__ __attribute__((aligned(16))) unsigned char lds[];
    Frame F;
    F.lds = (LAS unsigned char*)lds;
    F.MISC = (volatile LAS unsigned*)(F.lds + MISC_OFF);
    F.tid = threadIdx.x; F.lane = F.tid & 63; F.wave = __builtin_amdgcn_readfirstlane(F.tid >> 6);
    F.G = gridDim.x; { const int bx = blockIdx.x; F.vcu = (F.G % 8 == 0) ? (bx % 8) * (F.G / 8) + bx / 8 : bx; }
    unsigned char* ws = args.ws;
    F.ctl = (gu32*)(ws + WS_CTL);
    for (int u = F.tid; u < (LDS_BYTES - LDSCTL_OFF) / 4; u += NWAVES * 64) ((LAS unsigned*)(F.lds + LDSCTL_OFF))[u] = 0u;
    __syncthreads();
    const int lo = args.ph_lo, hi = args.ph_hi;
    const bool use_bar = (hi - lo) > 1;
    XcdBarrier bar; bar.bar = (unsigned*)(F.ctl + CW_BAR) + args.li * XCD_BAR_WORDS; bar.x = 0; bar.st = nullptr;
    if (use_bar) bar = xcd_barrier_post((unsigned*)(F.ctl + CW_BAR) + args.li * XCD_BAR_WORDS, F.MISC + 8);
#define IN(k) (lo <= (k) && (k) < hi)
#define SEAM(k) do { if (IN(k) && IN((k) + 1)) xcd_barrier(bar); } while (0)
#define REP(k) for (int rep_ = 0; rep_ < ((DUP_PHASE == (k)) ? 2 : 1); ++rep_)
#define DUPBAR(k) do { if (DUP_PHASE == (k) && rep_ == 0) xcd_barrier(bar); } while (0)
    bf16* const XN = (bf16*)(ws + WS_XN); bf16* const AO = XN; bf16* const QKV = (bf16*)(ws + WS_U); bf16* const U = (bf16*)(ws + WS_U);
    float* const H = args.out;
    using pg8::Gemm; using pg8::StaticOrder; using pg8::EpiBf16; using pg8::EpiResF32;

    if (IN(0)) { REP(0) { p0_prologue(F, args); DUPBAR(0); } SEAM(0); }
    if (IN(1)) { EpiBf16<0> E{QKV, NQKV, D, QSCALE}; if (DUP_PHASE == 1) { run_gemm(F, XN, (const bf16*)(ws + WS_WQKV), NQKV, D, E); xcd_barrier(bar); } run_gemm(F, XN, (const bf16*)(ws + WS_WQKV), NQKV, D, E); SEAM(1); }
#ifdef NAIVE_ATTN
    if (IN(2)) { REP(2) { naive_attn_phase(F, QKV, args.in[1], args.in[4], args.in[5], args.in[6], args.in[7], AO); DUPBAR(2); } SEAM(2); }
#else
    if (IN(2)) { REP(2) { attn_phase(F, QKV, AO, (float*)(ws + WS_HT), args.in[1], args.in[4], args.in[5], args.in[6], args.in[7]); DUPBAR(2); } SEAM(2); }
#endif
    if (IN(3)) { EpiResF32 E{args.in[0], H, D}; if (DUP_PHASE == 3) { run_gemm(F, AO, (const bf16*)(ws + WS_WAO), D, D, E); xcd_barrier(bar); } run_gemm(F, AO, (const bf16*)(ws + WS_WAO), D, D, E); SEAM(3); }
    if (IN(4)) { REP(4) { norm_phase(F, H, XN, nullptr, nullptr, nullptr, nullptr); DUPBAR(4); } SEAM(4); }
    if (IN(5)) { EpiBf16<2> E{U, FF, 0, 1.f}; if (DUP_PHASE == 5) { run_gemm(F, XN, (const bf16*)(ws + WS_W1), FF, D, E); xcd_barrier(bar); } run_gemm(F, XN, (const bf16*)(ws + WS_W1), FF, D, E); SEAM(5); }
    if (IN(6)) { EpiResF32 E{H, H, D}; run_gemm(F, U, (const bf16*)(ws + WS_W2), D, FF, E); SEAM(6); }
    if (IN(7)) { REP(7) { norm_phase(F, H, XN, (const float*)(ws + WS_WG), (float*)(ws + WS_GATES), args.in[12], args.in[13]); DUPBAR(7); } SEAM(7); }
    if (IN(8)) { EpiBf16<0> E{QKV, NPROJ, 0, 1.f}; if (DUP_PHASE == 8) { run_gemm(F, XN, (const bf16*)(ws + WS_WML), NPROJ, D, E); xcd_barrier(bar); } run_gemm(F, XN, (const bf16*)(ws + WS_WML), NPROJ, D, E); SEAM(8); }
#ifdef NAIVE_MLSTM
    if (IN(9)) { REP(9) { naive_mlstm_phase(F, QKV, (const float*)(ws + WS_GATES), args.in[14], args.in[15], AO); DUPBAR(9); } SEAM(9); }
    if (IN(10)) { SEAM(10); }
#else
    if (IN(9)) { REP(16) { convscan_phase(F, QKV, (const float*)(ws + WS_GATES), args.in[14], args.in[15], XN, (float*)(ws + WS_GS)); xcd_barrier(bar); }
        REP(9) { mlstm_phase(F, QKV, XN, (const float*)(ws + WS_GS), (bf16*)(ws + WS_HT), (float*)(ws + WS_SSQ)); DUPBAR(9); } SEAM(9); }
    if (IN(10)) { REP(10) { gatenorm_phase(F, QKV, (const bf16*)(ws + WS_HT), (const float*)(ws + WS_SSQ), AO); DUPBAR(10); } SEAM(10); }
#endif
    if (IN(11)) { EpiResF32 E{H, H, D}; run_gemm(F, AO, (const bf16*)(ws + WS_WMO), D, D, E); SEAM(11); }
    if (IN(12)) { REP(12) { norm_phase(F, H, XN, nullptr, nullptr, nullptr, nullptr); DUPBAR(12); } SEAM(12); }
    if (IN(13)) { EpiBf16<2> E{U, FF, 0, 1.f}; if (DUP_PHASE == 13) { run_gemm(F, XN, (const bf16*)(ws + WS_W1) + (size_t)D * FF, FF, D, E); xcd_barrier(bar); } run_gemm(F, XN, (const bf16*)(ws + WS_W1) + (size_t)D * FF, FF, D, E); SEAM(13); }
    if (IN(14)) { EpiResF32 E{H, H, D}; run_gemm(F, U, (const bf16*)(ws + WS_W2) + (size_t)D * FF, D, FF, E); SEAM(14); }
    if (IN(15)) { final_norm_phase(F, H, args.in[21], args.out); }
#undef IN
#undef SEAM
}

extern "C" void kernel_launch(void* const* d_in, const int* in_sizes, int n_in, void* d_out, int out_size, void* d_ws, size_t ws_size, hipStream_t stream) {
    static int grid = 0;
    if (grid == 0) {
        if (n_in != 22 || in_sizes[0] != M * D || out_size != M * D || ws_size < WS_END) { fprintf(stderr, "kernel_launch: unexpected shapes (n_in %d, in0 %d, out %d, ws %zu); nothing launched\n", n_in, n_in > 0 ? in_sizes[0] : -1, out_size, ws_size); grid = -1; return; }
        int dev = 0, cus = 0, per_cu = 0;
        if (hipGetDevice(&dev) != hipSuccess || hipDeviceGetAttribute(&cus, hipDeviceAttributeMultiprocessorCount, dev) != hipSuccess) { grid = -1; return; }
        if (hipFuncSetAttribute((const void*)fwd, hipFuncAttributeMaxDynamicSharedMemorySize, LDS_BYTES) != hipSuccess) { fprintf(stderr, "kernel_launch: hipFuncSetAttribute failed\n"); grid = -1; return; }
        if (hipOccupancyMaxActiveBlocksPerMultiprocessor(&per_cu, (const void*)fwd, NWAVES * 64, LDS_BYTES) != hipSuccess || per_cu < 1) fprintf(stderr, "kernel_launch: occupancy query says %d\n", per_cu);
        (void)hipGetLastError();
        grid = cus;
    }
    if (grid < 0) return;
    (void)hipMemsetAsync((char*)d_ws + WS_CTL, 0, CTL_ZERO_BYTES, stream);
    Args a{};
    for (int i = 0; i < 22; ++i) a.in[i] = (const float*)d_in[i];
    a.out = (float*)d_out; a.ws = (unsigned char*)d_ws;
    int li = 0;
    auto run = [&](int lo, int hi) { a.ph_lo = lo; a.ph_hi = hi; a.li = li++; hipLaunchKernelGGL(fwd, dim3(grid), dim3(NWAVES * 64), LDS_BYTES, stream, a); };
    run(0, NPHASE);
}
```

```cpp
#include <hip/hip_runtime.h>
#include <cstdio>
#include <cstdint>
namespace pg8 {
#define PG8_LAS __attribute__((address_space(3)))
typedef unsigned short bf16_t;
typedef short bf16x8 __attribute__((ext_vector_type(8)));
typedef float f32x4 __attribute__((ext_vector_type(4)));
typedef unsigned u32x4 __attribute__((ext_vector_type(4)));
constexpr int BM = 256, BK = 64, HALF = 128, HTB = HALF * BK * 2  , STAGE_BYTES = 8 * HTB, NXCD = 8, WGM = 8;

__host__ __device__ __forceinline__ int lds_byte(int r, int c) { const int st = (r >> 4) * 2 + (c >> 5), rr = r & 15, cc = c & 31, ob = rr * 64 + cc * 2; return st * 1024 + (ob ^ (((ob >> 9) & 1) << 5)); }
__host__ __device__ __forceinline__ void stage_rc(int b, int& R, int& C) { const int st = b / 1024, sb = b % 1024, swz = sb ^ (((sb >> 9) & 1) << 5); R = (st >> 1) * 16 + swz / 64; C = (st & 1) * 32 + (swz % 64) / 2; }
__host__ __device__ __forceinline__ int perm32(int rho) { const int n = rho >> 4, i = rho & 15; return 8 * (i >> 2) + 4 * n + (i & 3); }

struct Unit { int pm, pn; };
struct Gemm { const bf16_t* A; const bf16_t* Bt; int M, N, K; };

struct StaticOrder {
    int nM, nN, nwg, G, c;
    __host__ __device__ void init(int M, int N, int G_, int c_) { nM = M / BM; nN = N / BM; nwg = nM * nN; G = G_; c = c_; }
    __host__ __device__ bool next(int i, Unit& u) const {
        const long L = (long)i * G + c; if (L >= nwg) return false;
        int wgid = (int)L; { const int q = nwg / NXCD, r = nwg % NXCD, xcd = wgid % NXCD, off = wgid / NXCD; wgid = (xcd < r ? xcd * (q + 1) : r * (q + 1) + (xcd - r) * q) + off; }
        const int nig = WGM * nN, gid = wgid / nig, fm = gid * WGM, gsz = (nM - fm) < WGM ? (nM - fm) : WGM;
        u.pm = fm + ((wgid % nig) % gsz); u.pn = (wgid % nig) / gsz; return true;
    }
    __device__ __forceinline__ void a_ready(const Unit&) const {}
    __device__ __forceinline__ void done(const Unit&) const {}
};

__device__ __forceinline__ unsigned cvt_pk_bf16(float lo, float hi) { unsigned r; asm volatile("v_cvt_pk_bf16_f32 %0, %1, %2" : "=v"(r) : "v"(lo), "v"(hi)); return r; }
__device__ __forceinline__ float row_rstd(const float* ssq, int row) {
    const f32x4* p = (const f32x4*)(ssq + (size_t)row * 16); const f32x4 a = p[0], b = p[1], c = p[2], d = p[3];
    const float s = ((a[0] + a[1]) + (a[2] + a[3])) + ((b[0] + b[1]) + (b[2] + b[3])) + ((c[0] + c[1]) + (c[2] + c[3])) + ((d[0] + d[1]) + (d[2] + d[3]));
    return 1.0f / sqrtf(s * (1.0f / 1024.0f) + 1e-6f);
}
__device__ __forceinline__ float log_sigmoid_f(float x) { return fminf(x, 0.f) - log1pf(expf(-fabsf(x))); }
template <int ACT> struct EpiBf16 {
    static constexpr bool PERM = true, AFTER_DRAIN = false;
    bf16_t* O; int ldc; int scale_cols; float scale0; const float* ssq; int gate_tile; float* gates; const float* b_i; const float* b_f;
    __device__ __forceinline__ void operator()(const f32x4 (&acc)[2][2][4][2], const Unit& u, int wr, int wc, int fr, int fq) const {
        const int row0 = u.pm * BM + wr * 64 + fr; const int colt = u.pn * BM;
        const float sc = (colt < scale_cols) ? scale0 : 1.f;
        const int col0 = colt + wc * 32 + 8 * fq;
        float rs[2][4];
#pragma unroll
        for (int ai = 0; ai < 2; ++ai)
#pragma unroll
            for (int m = 0; m < 4; ++m) rs[ai][m] = ssq ? row_rstd(ssq, row0 + ai * HALF + m * 16) * sc : sc;
        if (u.pn == gate_tile) {
            if (wc == 0 && fq == 0) { const f32x4 bi = *(const f32x4*)b_i, bf = *(const f32x4*)b_f;
#pragma unroll
                for (int ai = 0; ai < 2; ++ai)
#pragma unroll
                    for (int m = 0; m < 4; ++m) { const int row = row0 + ai * HALF + m * 16; const f32x4 gi = acc[ai][0][m][0] * rs[ai][m] + bi; f32x4 gf = acc[ai][0][m][1] * rs[ai][m] + bf;
#pragma unroll
                        for (int e = 0; e < 4; ++e) gf[e] = log_sigmoid_f(gf[e]);
                        *(f32x4*)(gates + (size_t)row * 8) = gi; *(f32x4*)(gates + (size_t)row * 8 + 4) = gf; } }
            return;
        }
#pragma unroll
        for (int ai = 0; ai < 2; ++ai)
#pragma unroll
            for (int m = 0; m < 4; ++m) { bf16_t* rowp = O + (size_t)(row0 + ai * HALF + m * 16) * ldc + col0; const float r = rs[ai][m];
#pragma unroll
                for (int bj = 0; bj < 2; ++bj) { f32x4 v0 = acc[ai][bj][m][0] * r, v1 = acc[ai][bj][m][1] * r;
                    if (ACT == 2) {
#pragma unroll
                        for (int e = 0; e < 4; ++e) { const float a = fmaxf(v0[e], 0.f), b = fmaxf(v1[e], 0.f); v0[e] = a * a; v1[e] = b * b; } }
                    u32x4 w; w.x = cvt_pk_bf16(v0[0], v0[1]); w.y = cvt_pk_bf16(v0[2], v0[3]); w.z = cvt_pk_bf16(v1[0], v1[1]); w.w = cvt_pk_bf16(v1[2], v1[3]);
                    *(u32x4*)(rowp + bj * HALF) = w; } }
    }
};
template <bool BASE_F32> struct EpiResNorm {
    static constexpr bool PERM = true, AFTER_DRAIN = false;
    const float* basef; const bf16_t* baseh; bf16_t* xn; float* ssq; int ldc;
    __device__ __forceinline__ void operator()(const f32x4 (&acc)[2][2][4][2], const Unit& u, int wr, int wc, int fr, int fq) const {
        const int row0 = u.pm * BM + wr * 64 + fr; const int col0 = u.pn * BM + wc * 32 + 8 * fq;
#pragma unroll
        for (int ai = 0; ai < 2; ++ai)
#pragma unroll
            for (int m = 0; m < 4; ++m) { const int row = row0 + ai * HALF + m * 16; const size_t off = (size_t)row * ldc + col0; float s = 0.f;
#pragma unroll
                for (int bj = 0; bj < 2; ++bj) { f32x4 v0, v1;
                    if (BASE_F32) { v0 = *(const f32x4*)(basef + off + bj * HALF); v1 = *(const f32x4*)(basef + off + bj * HALF + 4); }
                    else { const u32x4 h = *(const u32x4*)(baseh + off + bj * HALF);
                        v0 = (f32x4){__uint_as_float(h.x << 16), __uint_as_float(h.x & 0xffff0000u), __uint_as_float(h.y << 16), __uint_as_float(h.y & 0xffff0000u)};
                        v1 = (f32x4){__uint_as_float(h.z << 16), __uint_as_float(h.z & 0xffff0000u), __uint_as_float(h.w << 16), __uint_as_float(h.w & 0xffff0000u)}; }
                    v0 = v0 + acc[ai][bj][m][0]; v1 = v1 + acc[ai][bj][m][1];
                    s += ((v0[0] * v0[0] + v0[1] * v0[1]) + (v0[2] * v0[2] + v0[3] * v0[3])) + ((v1[0] * v1[0] + v1[1] * v1[1]) + (v1[2] * v1[2] + v1[3] * v1[3]));
                    u32x4 w; w.x = cvt_pk_bf16(v0[0], v0[1]); w.y = cvt_pk_bf16(v0[2], v0[3]); w.z = cvt_pk_bf16(v1[0], v1[1]); w.w = cvt_pk_bf16(v1[2], v1[3]);
                    *(u32x4*)(xn + off + bj * HALF) = w; }
                s += __shfl_xor(s, 16); s += __shfl_xor(s, 32);
                if (fq == 0) ssq[(size_t)row * 16 + u.pn * 4 + wc] = s; }
    }
};

template <class Epi, class Sched, bool ALIGN_EPI = false, bool SP2 = false>
__device__ __forceinline__ void gemm_phase(PG8_LAS unsigned char* lds, const Gemm g, const Sched& S, const Epi& E) {
    const int tid = threadIdx.x, wid = __builtin_amdgcn_readfirstlane(tid >> 6), lane = tid & 63, wr = wid >> 2, wc = wid & 3, fr = lane & 15, fq = lane >> 4;
    const int K = g.K, nt = K / BK;
    unsigned voffA[2], voffB[2];
#pragma unroll
    for (int i = 0; i < 2; ++i) { int R, C; stage_rc(tid * 16 + i * 8192, R, C); const int Rb = Epi::PERM ? ((R & ~31) + perm32(R & 31)) : R;
        voffA[i] = (unsigned)(R * K + C) * 2u; voffB[i] = (unsigned)(Rb * K + C) * 2u; }
    const size_t kstep = (size_t)(BK * 2);
    const size_t hstep = (size_t)HALF * K * 2;
    const size_t tstep = 2 * hstep;
    const unsigned ldsw = (unsigned)wid * 1024u;
    const int aoff = lds_byte(wr * 64 + fr, fq * 8), boff = lds_byte(wc * 32 + fr, fq * 8);
#define PG8_SA(b, h) (((b) * 2 + (h)) * HTB)
#define PG8_SB(b, h) ((4 + (b) * 2 + (h)) * HTB)
#define PG8_STAGE(bufoff, gbase, voff) do { _Pragma("unroll") for (int _i = 0; _i < 2; ++_i) \
        __builtin_amdgcn_global_load_lds((const unsigned*)((const char*)(gbase) + (voff)[_i]), (PG8_LAS unsigned*)(lds + (bufoff) + ldsw + _i * 8192), 16, 0, 0); } while (0)
#define PG8_LDA(dst, b, h) do { _Pragma("unroll") for (int m = 0; m < 4; ++m) _Pragma("unroll") for (int k = 0; k < 2; ++k) dst[m][k] = *(const PG8_LAS bf16x8*)(lds + PG8_SA(b, h) + aoff + m * 2048 + k * 1024); } while (0)
#define PG8_LDB(dst, b, h) do { _Pragma("unroll") for (int n = 0; n < 2; ++n) _Pragma("unroll") for (int k = 0; k < 2; ++k) dst[n][k] = *(const PG8_LAS bf16x8*)(lds + PG8_SB(b, h) + boff + n * 2048 + k * 1024); } while (0)
#define PG8_MMA(ai, bj, At, Bt) do { __builtin_amdgcn_s_setprio(1); _Pragma("unroll") for (int m = 0; m < 4; ++m) _Pragma("unroll") for (int n = 0; n < 2; ++n) _Pragma("unroll") for (int k = 0; k < 2; ++k) \
        acc[ai][bj][m][n] = __builtin_amdgcn_mfma_f32_16x16x32_bf16(Bt[n][k], At[m][k], acc[ai][bj][m][n], 0, 0, 0); __builtin_amdgcn_s_setprio(0); } while (0)
#define PG8_WAIT_V(n) asm volatile("s_waitcnt vmcnt(" #n ")" ::: "memory")
#define PG8_WAIT_L(n) asm volatile("s_waitcnt lgkmcnt(" #n ")" ::: "memory")
#define PG8_BAR __builtin_amdgcn_s_barrier()
#define PG8_SCHED __builtin_amdgcn_sched_barrier(0)
    Unit cur, nxt; int ui = 0;
    if (!S.next(0, cur)) return;
    f32x4 acc[2][2][4][2];
#pragma unroll
    for (int a = 0; a < 2; ++a)
#pragma unroll
        for (int b = 0; b < 2; ++b)
#pragma unroll
            for (int m = 0; m < 4; ++m)
#pragma unroll
                for (int n = 0; n < 2; ++n) acc[a][b][m][n] = (f32x4){0.f, 0.f, 0.f, 0.f};
    bf16x8 At[4][2], B0[2][2], B1[2][2];
    const char* cA = (const char*)g.A + (size_t)cur.pm * tstep; const char* cB = (const char*)g.Bt + (size_t)cur.pn * tstep;
    S.a_ready(cur);
    if constexpr (SP2) {
        PG8_STAGE(PG8_SB(0, 0), cB, voffB); PG8_STAGE(PG8_SB(0, 1), cB + hstep, voffB); PG8_STAGE(PG8_SA(0, 0), cA, voffA); PG8_STAGE(PG8_SA(0, 1), cA + hstep, voffA);
        if (wr == 1) PG8_BAR;
        PG8_WAIT_V(2); PG8_BAR;
        PG8_STAGE(PG8_SB(1, 0), cB + kstep, voffB); PG8_STAGE(PG8_SA(1, 0), cA + kstep, voffA); PG8_STAGE(PG8_SB(1, 1), cB + hstep + kstep, voffB);
        PG8_WAIT_V(6); PG8_BAR;
    } else {
        PG8_STAGE(PG8_SB(0, 0), cB, voffB); PG8_STAGE(PG8_SA(0, 0), cA, voffA); PG8_STAGE(PG8_SB(0, 1), cB + hstep, voffB); PG8_STAGE(PG8_SA(0, 1), cA + hstep, voffA);
        if (wr == 1) PG8_BAR;
        PG8_WAIT_V(4); PG8_BAR;
        PG8_STAGE(PG8_SB(1, 0), cB + kstep, voffB); PG8_STAGE(PG8_SA(1, 0), cA + kstep, voffA); PG8_STAGE(PG8_SB(1, 1), cB + hstep + kstep, voffB);
        PG8_WAIT_V(6); PG8_BAR;
    }
    for (;;) {
        const bool has_next = S.next(ui + 1, nxt);
        const char* nA = has_next ? (const char*)g.A + (size_t)nxt.pm * tstep : cA; const char* nB = has_next ? (const char*)g.Bt + (size_t)nxt.pn * tstep : cB;
        for (int t = 0; t < nt; t += 2) {
            const bool last = (t == nt - 2);
            const char* a1 = cA + (size_t)(t + 1) * kstep;
            const char* a2 = last ? nA : cA + (size_t)(t + 2) * kstep; const char* b2 = last ? nB : cB + (size_t)(t + 2) * kstep;
            const char* a3 = a2 + kstep; const char* b3 = b2 + kstep;
            if (last && has_next) S.a_ready(nxt);
            if constexpr (SP2) {
            PG8_LDB(B0, 0, 0); PG8_LDB(B1, 0, 1); PG8_SCHED; PG8_LDA(At, 0, 0); PG8_STAGE(PG8_SA(1, 1), a1 + hstep, voffA);
            PG8_WAIT_V(8); PG8_WAIT_L(0); PG8_BAR; PG8_MMA(0, 0, At, B0); PG8_MMA(0, 1, At, B1); PG8_BAR; PG8_SCHED;
            PG8_LDA(At, 0, 1); PG8_STAGE(PG8_SB(0, 0), b2, voffB); PG8_STAGE(PG8_SB(0, 1), b2 + hstep, voffB); PG8_STAGE(PG8_SA(0, 0), a2, voffA);
            PG8_WAIT_V(8); PG8_WAIT_L(0); PG8_BAR; PG8_MMA(1, 0, At, B0); PG8_MMA(1, 1, At, B1); PG8_BAR; PG8_SCHED;
            PG8_LDB(B0, 1, 0); PG8_LDB(B1, 1, 1); PG8_SCHED; PG8_LDA(At, 1, 0); PG8_STAGE(PG8_SA(0, 1), a2 + hstep, voffA);
            PG8_WAIT_V(8); PG8_WAIT_L(0); PG8_BAR; PG8_MMA(0, 0, At, B0); PG8_MMA(0, 1, At, B1); PG8_BAR; PG8_SCHED;
            PG8_LDA(At, 1, 1); PG8_STAGE(PG8_SB(1, 0), b3, voffB); PG8_STAGE(PG8_SB(1, 1), b3 + hstep, voffB); PG8_STAGE(PG8_SA(1, 0), a3, voffA);
            PG8_WAIT_V(8); PG8_WAIT_L(0); PG8_BAR; PG8_MMA(1, 0, At, B0); PG8_MMA(1, 1, At, B1); PG8_BAR; PG8_SCHED;
            } else {
            PG8_LDB(B0, 0, 0); PG8_SCHED; PG8_LDA(At, 0, 0); PG8_STAGE(PG8_SA(1, 1), a1 + hstep, voffA);
            PG8_WAIT_L(8); PG8_BAR; PG8_WAIT_L(0); PG8_MMA(0, 0, At, B0); PG8_BAR; PG8_SCHED;
            PG8_LDB(B1, 0, 1); PG8_STAGE(PG8_SB(0, 0), b2, voffB);
            PG8_BAR; PG8_WAIT_L(0); PG8_MMA(0, 1, At, B1); PG8_BAR;
            PG8_LDA(At, 0, 1); PG8_STAGE(PG8_SA(0, 0), a2, voffA);
            PG8_BAR; PG8_WAIT_L(0); PG8_MMA(1, 0, At, B0); PG8_BAR; PG8_SCHED;
            PG8_STAGE(PG8_SB(0, 1), b2 + hstep, voffB);
            PG8_WAIT_V(6); PG8_BAR; PG8_MMA(1, 1, At, B1); PG8_BAR;
            PG8_LDB(B0, 1, 0); PG8_SCHED; PG8_LDA(At, 1, 0); PG8_STAGE(PG8_SA(0, 1), a2 + hstep, voffA);
            PG8_WAIT_L(8); PG8_BAR; PG8_WAIT_L(0); PG8_MMA(0, 0, At, B0); PG8_BAR; PG8_SCHED;
            PG8_LDB(B1, 1, 1); PG8_STAGE(PG8_SB(1, 0), b3, voffB);
            PG8_BAR; PG8_WAIT_L(0); PG8_MMA(0, 1, At, B1); PG8_BAR;
            PG8_LDA(At, 1, 1); PG8_STAGE(PG8_SA(1, 0), a3, voffA);
            PG8_BAR; PG8_WAIT_L(0); PG8_MMA(1, 0, At, B0); PG8_BAR; PG8_SCHED;
            PG8_STAGE(PG8_SB(1, 1), b3 + hstep, voffB);
            PG8_WAIT_V(6); PG8_BAR; PG8_MMA(1, 1, At, B1); PG8_BAR;
            }
        }
        if constexpr (ALIGN_EPI) { if (wr == 0) PG8_BAR; }
        if constexpr (!Epi::AFTER_DRAIN) { E(acc, cur, wr, wc, fr, fq); S.done(cur); }
        if (!has_next) break;
#pragma unroll
        for (int a = 0; a < 2; ++a)
#pragma unroll
            for (int b = 0; b < 2; ++b)
#pragma unroll
                for (int m = 0; m < 4; ++m)
#pragma unroll
                    for (int n = 0; n < 2; ++n) acc[a][b][m][n] = (f32x4){0.f, 0.f, 0.f, 0.f};
        cur = nxt; cA = nA; cB = nB; ++ui;
        if constexpr (ALIGN_EPI) { if (wr == 1) PG8_BAR; }
    }
    PG8_WAIT_V(0);
    if constexpr (!ALIGN_EPI) { if (wr == 0) PG8_BAR; }
    PG8_BAR;
    if constexpr (Epi::AFTER_DRAIN) { E.fused(acc, cur, wr, wc, fr, fq, lds, wid, lane); S.done(cur); }
#undef PG8_SA
#undef PG8_SB
#undef PG8_STAGE
#undef PG8_LDA
#undef PG8_LDB
#undef PG8_MMA
#undef PG8_WAIT_V
#undef PG8_WAIT_L
#undef PG8_BAR
#undef PG8_SCHED
}
}

#ifndef PG8_SP2
#define PG8_SP2 true
#endif
#ifndef PG8_ALIGN
#define PG8_ALIGN true
#endif
namespace da {
typedef short bf16x8 __attribute__((ext_vector_type(8)));
typedef short s16x4 __attribute__((ext_vector_type(4)));
typedef float f32x16 __attribute__((ext_vector_type(16)));
typedef float f32x4 __attribute__((ext_vector_type(4)));
typedef unsigned u32x4 __attribute__((ext_vector_type(4)));
#define DLAS __attribute__((address_space(3)))
constexpr int NW = 8, QBLK = 32, KVBLK = 64, QB = NW * QBLK, PITCH = 3072;
constexpr int SHM_V = KVBLK * 128 * 2, SHM_K = KVBLK * 64 * 2;
constexpr int OFF_V = 0, OFF_K = 2 * SHM_V, OFF_WS = OFF_K + 2 * SHM_K, OFF_LUT = OFF_WS + NW * 64 * 4, LDS_BYTES = OFF_LUT + 512;
constexpr float THR = 8.f;
#define DA_KSWZ(row, c) ((row) * 128 + ((((c) ^ (((row) >> 1) & 7))) << 4))
#define DA_SBAR() __builtin_amdgcn_sched_barrier(0)
__device__ __forceinline__ int v_st(int k, int c) { const int kk = (k & ~0xC) | ((k & 4) << 1) | ((k & 8) >> 1); return ((kk >> 3) * 4 + (c >> 5)) * 512 + ((kk & 7) * 32 + (c & 31)) * 2; }
__device__ __forceinline__ int v_rd_base(int lane) { return ((lane & 3) << 3) | (((lane >> 2) & 3) << 6) | (((lane >> 4) & 1) << 5) | (((lane >> 5) & 1) << 8); }
constexpr int v_rd_off(int d0, int ks, int half) { return d0 * 512 + ks * 4096 + half * 2048; }
__device__ __forceinline__ int crow(int r, int hi) { return (r & 3) + 8 * (r >> 2) + 4 * hi; }
__device__ __forceinline__ unsigned cvtpk(float lo, float hi) { unsigned r; asm volatile("v_cvt_pk_bf16_f32 %0, %1, %2" : "=v"(r) : "v"(lo), "v"(hi)); return r; }
__device__ __forceinline__ void mask_tile(f32x16& p0, f32x16& p1, int dq) {
    const float NEG = -__builtin_inff();
#pragma unroll
    for (int r = 0; r < 16; ++r) { const int c = (r & 3) + 8 * (r >> 2); if (dq - c < 0) p0[r] = NEG; if (dq - c - 32 < 0) p1[r] = NEG; }
}
__device__ __forceinline__ void bias_tile(f32x16& p0, f32x16& p1, int dq, const DLAS float* lut) {
#pragma unroll
    for (int g = 0; g < 4; ++g) {
#pragma unroll
        for (int rr = 0; rr < 4; ++rr) { const int r = g * 4 + rr; const int c = (r & 3) + 8 * (r >> 2);
            int i0 = dq - c; i0 = i0 < 0 ? 0 : (i0 > 127 ? 127 : i0); int i1 = dq - c - 32; i1 = i1 < 0 ? 0 : (i1 > 127 ? 127 : i1);
            p0[r] += lut[i0]; p1[r] += lut[i1]; }
        DA_SBAR();
    }
}
__device__ __forceinline__ void partialSM(f32x16& p0, f32x16& p1, float& m_reg, float& alpha, float cb) {
    float pmax = p0[0];
#pragma unroll
    for (int r = 1; r < 16; ++r) pmax = fmaxf(pmax, p0[r]);
#pragma unroll
    for (int r = 0; r < 16; ++r) pmax = fmaxf(pmax, p1[r]);
    { auto rr = __builtin_amdgcn_permlane32_swap(__float_as_uint(pmax), __float_as_uint(pmax), false, false);
      pmax = fmaxf(__uint_as_float(rr[0]), __uint_as_float(rr[1])); }
    pmax += cb;
    float mn;
    if (__builtin_expect(__all(pmax - m_reg <= THR), 1)) { mn = m_reg; alpha = 1.f; }
    else { mn = fmaxf(m_reg, pmax); alpha = __builtin_amdgcn_exp2f(m_reg - mn); m_reg = mn; }
    const float off = cb - mn;
#pragma unroll
    for (int r = 0; r < 16; ++r) p0[r] += off;
#pragma unroll
    for (int r = 0; r < 16; ++r) p1[r] += off;
#pragma unroll
    for (int r = 0; r < 16; ++r) p0[r] = __builtin_amdgcn_exp2f(p0[r]);
}
__device__ __forceinline__ void finishSM(f32x16& p0, f32x16& p1, float alpha, float& l_reg, bf16x8& pa0, bf16x8& pa1, bf16x8& pa2, bf16x8& pa3) {
#pragma unroll
    for (int r = 0; r < 16; ++r) p1[r] = __builtin_amdgcn_exp2f(p1[r]);
    float ps = 0;
#pragma unroll
    for (int r = 0; r < 16; ++r) ps += p0[r];
#pragma unroll
    for (int r = 0; r < 16; ++r) ps += p1[r];
    { auto rr = __builtin_amdgcn_permlane32_swap(__float_as_uint(ps), __float_as_uint(ps), false, false);
      ps = __uint_as_float(rr[0]) + __uint_as_float(rr[1]); }
    l_reg = l_reg * alpha + ps;
#define DA_PK4(P, B_, OUT) do { unsigned a0 = cvtpk(P[B_+0], P[B_+1]), a1 = cvtpk(P[B_+2], P[B_+3]);                          \
        unsigned b0 = cvtpk(P[B_+4], P[B_+5]), b1 = cvtpk(P[B_+6], P[B_+7]);                                             \
        auto r0 = __builtin_amdgcn_permlane32_swap(a0, b0, false, false); auto r1 = __builtin_amdgcn_permlane32_swap(a1, b1, false, false); \
        u32x4 w = {r0[0], r1[0], r0[1], r1[1]}; OUT = *reinterpret_cast<bf16x8*>(&w); } while (0)
    DA_PK4(p0, 0, pa0); DA_PK4(p0, 8, pa1); DA_PK4(p1, 0, pa2); DA_PK4(p1, 8, pa3);
#undef DA_PK4
}
template <int KB>
__device__ __forceinline__ void qkt(f32x16& p0, f32x16& p1, const DLAS char* K_lds, int r32, int hi, const bf16x8* qr) {
    p0 = f32x16{}; p1 = f32x16{};
#pragma unroll
    for (int d0 = 0; d0 < 4; ++d0) { const DLAS char* a = K_lds + KB * SHM_K + DA_KSWZ(r32, d0 * 2 + hi);
        const bf16x8 b0 = *reinterpret_cast<const DLAS bf16x8*>(a);
        const bf16x8 b1 = *reinterpret_cast<const DLAS bf16x8*>(a + 32 * 128);
        p0 = __builtin_amdgcn_mfma_f32_32x32x16_bf16(b0, qr[d0], p0, 0, 0, 0);
        p1 = __builtin_amdgcn_mfma_f32_32x32x16_bf16(b1, qr[d0], p1, 0, 0, 0); }
}
template <int VB>
__device__ __forceinline__ void pv_tile(f32x16* o, int vb0, bf16x8 pa0, bf16x8 pa1, bf16x8 pa2, bf16x8 pa3) {
#define DA_TRRD(dst, off) asm volatile("ds_read_b64_tr_b16 %0, %1 offset:%2" : "=&v"(dst) : "v"(vb0), "i"(off) : "memory")
#define DA_PV_D0(d0) do { s16x4 l0, l1, l2, l3, h0, h1, h2, h3; constexpr int b_ = VB * SHM_V + v_rd_off(d0, 0, 0); \
        DA_TRRD(l0, b_); DA_TRRD(h0, b_ + 2048); DA_TRRD(l1, b_ + 4096); DA_TRRD(h1, b_ + 6144); DA_TRRD(l2, b_ + 8192); DA_TRRD(h2, b_ + 10240); DA_TRRD(l3, b_ + 12288); DA_TRRD(h3, b_ + 14336); \
        asm volatile("s_waitcnt lgkmcnt(0)" ::: "memory"); DA_SBAR();   \
        o[d0] = __builtin_amdgcn_mfma_f32_32x32x16_bf16(pa0, (bf16x8){l0[0], l0[1], l0[2], l0[3], h0[0], h0[1], h0[2], h0[3]}, o[d0], 0, 0, 0);   \
        o[d0] = __builtin_amdgcn_mfma_f32_32x32x16_bf16(pa1, (bf16x8){l1[0], l1[1], l1[2], l1[3], h1[0], h1[1], h1[2], h1[3]}, o[d0], 0, 0, 0);   \
        o[d0] = __builtin_amdgcn_mfma_f32_32x32x16_bf16(pa2, (bf16x8){l2[0], l2[1], l2[2], l2[3], h2[0], h2[1], h2[2], h2[3]}, o[d0], 0, 0, 0);   \
        o[d0] = __builtin_amdgcn_mfma_f32_32x32x16_bf16(pa3, (bf16x8){l3[0], l3[1], l3[2], l3[3], h3[0], h3[1], h3[2], h3[3]}, o[d0], 0, 0, 0); } while (0)
    DA_PV_D0(0); DA_PV_D0(1); DA_PV_D0(2); DA_PV_D0(3);
#undef DA_PV_D0
#undef DA_TRRD
}
__device__ __forceinline__ void attn_block(const unsigned short* __restrict__ Qp, const unsigned short* __restrict__ Kp, const unsigned short* __restrict__ Vp, int P0, DLAS char* lds, float c31, f32x16 (&o)[4]) {
    const int tid = threadIdx.x, wid = __builtin_amdgcn_readfirstlane(tid >> 6), lane = tid & 63, r32 = lane & 31, hi = lane >> 5;
    const int NT = (P0 + QB) / KVBLK;
    const int qlo = P0 + wid * QBLK, qm = qlo + r32 - 4 * hi;
    DLAS char* V_lds = lds + OFF_V; DLAS char* K_lds = lds + OFF_K;
    DLAS float* wsf = (DLAS float*)(lds + OFF_WS) + wid * 64; DLAS float* li_l = wsf; DLAS float* al_l = wsf + 32;
    const DLAS float* lut = (const DLAS float*)(lds + OFF_LUT);
    float m_reg = -1e30f, l_reg = 0.f;
#pragma unroll
    for (int d = 0; d < 4; ++d) o[d] = f32x16{};
    const int sr = tid >> 4, sc = (tid & 15) * 8, vst0 = v_st(sr, sc), vst1 = v_st(32 + sr, sc);
    const int kr = tid >> 3, kc = tid & 7, kws = DA_KSWZ(kr, kc);
    const int vb0 = (int)(uintptr_t)V_lds + v_rd_base(lane);
    bf16x8 qr[4];
#pragma unroll
    for (int d0 = 0; d0 < 4; ++d0) qr[d0] = *reinterpret_cast<const bf16x8*>(Qp + (size_t)(wid * QBLK + r32) * PITCH + d0 * 16 + hi * 8);
    bf16x8 st_v0, st_v1, st_k0;
#define DA_VMW() asm volatile("s_waitcnt vmcnt(0)" ::: "memory")
#define DA_SLOAD(k0) do { st_v0 = *reinterpret_cast<const bf16x8*>(Vp + (size_t)((k0) + sr) * PITCH + sc); st_v1 = *reinterpret_cast<const bf16x8*>(Vp + (size_t)((k0) + 32 + sr) * PITCH + sc); \
                          st_k0 = *reinterpret_cast<const bf16x8*>(Kp + (size_t)((k0) + kr) * PITCH + kc * 8); } while (0)
#define DA_SWRITE(bf) do { *reinterpret_cast<DLAS bf16x8*>(V_lds + (bf) * SHM_V + vst0) = st_v0; *reinterpret_cast<DLAS bf16x8*>(V_lds + (bf) * SHM_V + vst1) = st_v1; \
                           *reinterpret_cast<DLAS bf16x8*>(K_lds + (bf) * SHM_K + kws) = st_k0; } while (0)
#define DA_RESC(a) do { if (__any((a) < 1.f)) { if (hi == 0) al_l[r32] = (a); asm volatile("s_waitcnt lgkmcnt(0)" ::: "memory");              \
                        _Pragma("unroll") for (int d_ = 0; d_ < 4; ++d_) _Pragma("unroll") for (int r = 0; r < 16; ++r) o[d_][r] *= al_l[crow(r, hi)]; } } while (0)
#define DA_BIASMASK(P0_, P1_, t, cbv) do { const int kb_ = (t) * KVBLK; if (kb_ + KVBLK - 1 + 128 > qlo) { bias_tile(P0_, P1_, qm - kb_, lut); cbv = 0.f; if (kb_ + KVBLK - 1 > qlo) mask_tile(P0_, P1_, qm - kb_); } else cbv = c31; } while (0)
    f32x16 pA0, pA1, pB0, pB1; float alA, alB, cbA, cbB; bf16x8 pa0, pa1, pa2, pa3;
    DA_SLOAD(0); DA_VMW(); DA_SWRITE(0); DA_SBAR();
    DA_SLOAD(KVBLK);
    __syncthreads();
    DA_SBAR(); qkt<0>(pA0, pA1, K_lds, r32, hi, qr);
    DA_BIASMASK(pA0, pA1, 0, cbA); partialSM(pA0, pA1, m_reg, alA, cbA);
    DA_VMW(); DA_SWRITE(1);
    __syncthreads();
#define DA_HALF_STEP(PX0, PX1, alX, cbX, PY0, PY1, alY, t, KB, VB, SB) do {                                                      \
        DA_SBAR(); qkt<KB>(PX0, PX1, K_lds, r32, hi, qr);                                             \
        finishSM(PY0, PY1, alY, l_reg, pa0, pa1, pa2, pa3); DA_SBAR();                                                           \
        DA_SLOAD(((t) + 1) * KVBLK); DA_SBAR();                                               \
        pv_tile<VB>(o, vb0, pa0, pa1, pa2, pa3); DA_BIASMASK(PX0, PX1, (t), cbX); partialSM(PX0, PX1, m_reg, alX, cbX);                                        \
        __syncthreads();                                                                                                      \
        DA_VMW(); DA_SWRITE(SB);                                                                          \
        DA_RESC(alX); __syncthreads(); } while (0)
    for (int t = 1; t + 1 < NT; t += 2) {
        DA_HALF_STEP(pB0, pB1, alB, cbB, pA0, pA1, alA, t, 1, 0, 0);
        DA_HALF_STEP(pA0, pA1, alA, cbA, pB0, pB1, alB, t + 1, 0, 1, 1);
    }
    DA_SBAR(); qkt<1>(pB0, pB1, K_lds, r32, hi, qr); DA_SBAR();
    finishSM(pA0, pA1, alA, l_reg, pa0, pa1, pa2, pa3); DA_SBAR();
    pv_tile<0>(o, vb0, pa0, pa1, pa2, pa3);
    DA_BIASMASK(pB0, pB1, NT - 1, cbB); partialSM(pB0, pB1, m_reg, alB, cbB); DA_RESC(alB);
    finishSM(pB0, pB1, alB, l_reg, pa0, pa1, pa2, pa3); DA_SBAR(); pv_tile<1>(o, vb0, pa0, pa1, pa2, pa3);
    if (hi == 0) li_l[r32] = l_reg; asm volatile("s_waitcnt lgkmcnt(0)" ::: "memory");
#pragma unroll
    for (int r = 0; r < 16; ++r) { const float rl = __builtin_amdgcn_rcpf(li_l[crow(r, hi)]);
#pragma unroll
        for (int d0 = 0; d0 < 4; ++d0) o[d0][r] *= rl; }
    __syncthreads();
#undef DA_VMW
#undef DA_SLOAD
#undef DA_SWRITE
#undef DA_RESC
#undef DA_BIASMASK
#undef DA_HALF_STEP
}
}
static_assert(da::LDS_BYTES <= 131072, "attention LDS inside the ring region");
constexpr int NWAVES = 8;
#ifndef MK_N_LAUNCHES
#define MK_N_LAUNCHES 1
#endif
constexpr int BATCH = 16, SEQ = 2048, D = 1024, FF = 4096, M = BATCH * SEQ;
constexpr int NQKV = 3072;
constexpr int MLW = 3080, NPROJ = 3072;
constexpr int NH_A = 8, NH_M = 4;
constexpr float EPS = 1e-6f, LOG2E = 1.4426950408889634f;
constexpr float QSCALE = 0.125f * LOG2E;
constexpr float LAMBDA_INIT0 = 0.2f;
constexpr float MQSCALE = 0.08838834764831845f;
constexpr int NPHASE = 16;
constexpr int DUP_PHASE = -1;

namespace ml {
typedef short bf16x8 __attribute__((ext_vector_type(8)));
typedef short s16x4 __attribute__((ext_vector_type(4)));
typedef float f32x16 __attribute__((ext_vector_type(16)));
typedef float f32x4 __attribute__((ext_vector_type(4)));
typedef unsigned u32x4 __attribute__((ext_vector_type(4)));
typedef unsigned u32x2 __attribute__((ext_vector_type(2)));
#define MLAS __attribute__((address_space(3)))
constexpr int L = 64, NC = 2048 / L, PITCH = 3072;
constexpr int PQ = 272, PS = 144;
constexpr int O_Q = 0, O_K = O_Q + 64 * PQ, O_C = O_K + 64 * PQ, O_KW = O_C + 64 * PQ, O_V = O_KW + 16384, O_SC = O_V + 16384, O_ARR = O_SC + 64 * PS, O_NP = O_ARR + 9 * 256, O_N = O_NP + 4096, LDS_BYTES = O_N + 512;
enum { A_E = 0, A_BM = 64, A_INTER = 128, A_EMJ = 192, A_WP = 256, A_RS0 = 320, A_RS1 = 384, A_QN = 448, A_SCAL = 512 };
__device__ __forceinline__ float bf2f_lo(unsigned w) { return __uint_as_float(w << 16); }
__device__ __forceinline__ float bf2f_hi(unsigned w) { return __uint_as_float(w & 0xffff0000u); }
typedef float f32x2_t __attribute__((ext_vector_type(2))); typedef __bf16 bf16x2_t __attribute__((ext_vector_type(2)));
__device__ __forceinline__ unsigned cvtpk(float lo, float hi) { f32x2_t v = {lo, hi}; bf16x2_t b = __builtin_convertvector(v, bf16x2_t); return __builtin_bit_cast(unsigned, b); }
__device__ __forceinline__ int crow(int r, int hi) { return (r & 3) + 8 * (r >> 2) + 4 * hi; }
__device__ __forceinline__ int v_st(int k, int c) { const int kk = (k & ~0xC) | ((k & 4) << 1) | ((k & 8) >> 1); return ((kk >> 3) * 4 + (c >> 5)) * 512 + ((kk & 7) * 32 + (c & 31)) * 2; }
__device__ __forceinline__ int v_rd_base(int lane) { return ((lane & 3) << 3) | (((lane >> 2) & 3) << 6) | (((lane >> 4) & 1) << 5) | (((lane >> 5) & 1) << 8); }
#define ML_TRRD(dst, base, off) asm volatile("ds_read_b64_tr_b16 %0, %1 offset:%2" : "=&v"(dst) : "v"(base), "i"(off) : "memory")
#define ML_SBAR() __builtin_amdgcn_sched_barrier(0)
#define ML_FR(lo, hi_) (bf16x8){lo[0], lo[1], lo[2], lo[3], hi_[0], hi_[1], hi_[2], hi_[3]}
struct Pre { bf16x8 q[2], k[2], v; f32x4 g; };

__device__ __forceinline__ void mlstm_unit(int b, int h, int s4, const unsigned short* __restrict__ PROJ, const unsigned short* __restrict__ QKC, const float* __restrict__ GS,
                                           unsigned short* HT, float* SSQ, MLAS char* lds) {
    const int tid = threadIdx.x, wid = __builtin_amdgcn_readfirstlane(tid >> 6), lane = tid & 63, r32 = lane & 31, hi = lane >> 5;
    MLAS char* QIMG = lds + O_Q; MLAS char* KIMG = lds + O_K; MLAS char* CIMG = lds + O_C; MLAS char* KWTR = lds + O_KW; MLAS char* VTR = lds + O_V; MLAS char* SC = lds + O_SC;
    MLAS float* arr = (MLAS float*)(lds + O_ARR); MLAS float* npart = (MLAS float*)(lds + O_NP); MLAS float* nvec = (MLAS float*)(lds + O_N);
    const int srow = tid >> 4, cg = tid & 15;
    const int vrow = tid >> 3, vcol = (tid & 7) * 8;
    const size_t tok0 = (size_t)b * 2048;
    const unsigned short* xq = QKC + tok0 * 1024 + h * 128 + cg * 8;
    const unsigned short* xk = xq + 512;
    const unsigned short* xv = PROJ + tok0 * PITCH + 1024 + h * 256 + s4 * 64 + vcol;
    const float* gs = GS + tok0 * 16 + h * 4;
    const int dkb = wid >> 1, dvb = wid & 1;
    const int tb0 = (wid & 3) >> 1, jb = wid & 1;
    f32x16 cst = f32x16{};
    float m_prev = 0.f;
    for (int i = tid; i < (64 * PQ) / 16; i += 512) ((MLAS u32x4*)CIMG)[i] = (u32x4){0u, 0u, 0u, 0u};
    if (tid < 128) nvec[tid] = 0.f;
    Pre P;
#define ML_LOAD(t0_) do { P.q[0] = *reinterpret_cast<const bf16x8*>(xq + (size_t)((t0_) + srow) * 1024); P.q[1] = *reinterpret_cast<const bf16x8*>(xq + (size_t)((t0_) + srow + 32) * 1024); \
        P.k[0] = *reinterpret_cast<const bf16x8*>(xk + (size_t)((t0_) + srow) * 1024); P.k[1] = *reinterpret_cast<const bf16x8*>(xk + (size_t)((t0_) + srow + 32) * 1024); \
        P.v = *reinterpret_cast<const bf16x8*>(xv + (size_t)((t0_) + vrow) * PITCH); P.g = *reinterpret_cast<const f32x4*>(gs + (size_t)((t0_) + lane) * 16); } while (0)
    ML_LOAD(0);
    u32x2 dst_w[4] = {}; float dst_ss = 0.f;
    const int trb_kw = (int)(uintptr_t)KWTR + v_rd_base(lane), trb_v = (int)(uintptr_t)VTR + v_rd_base(lane);
    __syncthreads();
    for (int c = 0; c < NC; ++c) {
        const int t0 = c * L;
        const float bsum = P.g[0], e = P.g[1], pm = P.g[2];
        asm volatile("" :: "v"(P.g[3]));
        const float b_last = __int_as_float(__builtin_amdgcn_readlane(__float_as_int(bsum), 63)), m_loc = b_last + __int_as_float(__builtin_amdgcn_readlane(__float_as_int(pm), 63));
        const float m_new = fmaxf(b_last + m_prev, m_loc), decay = __expf(b_last + m_prev - m_new);
        const float wp = __expf(b_last + e - m_new);
        const float m_inter = bsum + m_prev, m_j = fmaxf(m_inter, bsum + pm);
        if (wid == 0) { arr[A_E + lane] = e; arr[A_BM + lane] = bsum - m_j; arr[A_INTER + lane] = __expf(m_inter - m_j); arr[A_EMJ + lane] = __expf(-m_j); arr[A_WP + lane] = wp; }
        m_prev = m_new;
#pragma unroll
        for (int i = 0; i < 2; ++i) { const int row = srow + 32 * i; const float wrow = __shfl(wp, row);
            *reinterpret_cast<MLAS bf16x8*>(QIMG + row * PQ + cg * 16) = P.q[i];
            *reinterpret_cast<MLAS bf16x8*>(KIMG + row * PQ + cg * 16) = P.k[i];
            const u32x4 kw = __builtin_bit_cast(u32x4, P.k[i]); u32x4 ow;
#pragma unroll
            for (int q = 0; q < 4; ++q) ow[q] = cvtpk(bf2f_lo(kw[q]) * wrow, bf2f_hi(kw[q]) * wrow);
            *reinterpret_cast<MLAS u32x4*>(KWTR + v_st(row, cg * 8)) = ow; }
        *reinterpret_cast<MLAS bf16x8*>(VTR + v_st(vrow, vcol)) = P.v;
        __syncthreads();
#define ML_STORE_OUT(tt) do { if (wid >= 4) { const int j_ = 32 * jb + r32; unsigned short* hp_ = HT + (tok0 + (tt) + j_) * 1024 + h * 256 + s4 * 64 + 32 * tb0 + 4 * hi; \
            _Pragma("unroll") for (int q4 = 0; q4 < 4; ++q4) *reinterpret_cast<u32x2*>(hp_ + 8 * q4) = dst_w[q4]; \
            if (hi == 0) SSQ[(tok0 + (tt) + j_) * 32 + h * 8 + s4 * 2 + tb0] = dst_ss; } } while (0)
        if (c > 0) ML_STORE_OUT(t0 - L);
        { const int tn = (c + 1 < NC) ? t0 + L : t0; ML_LOAD(tn); }
        f32x16 acc_qc = f32x16{};
        if (wid < 4) {
            f32x16 g = f32x16{};
            if (!(tb0 == 1 && jb == 0)) {
                const MLAS char* ka = KIMG + (32 * tb0 + r32) * PQ + hi * 16; const MLAS char* qa = QIMG + (32 * jb + r32) * PQ + hi * 16;
bf16x8 fa[8], fb[8];
#pragma unroll
                for (int kk = 0; kk < 8; ++kk) { fa[kk] = *reinterpret_cast<const MLAS bf16x8*>(ka + kk * 32); fb[kk] = *reinterpret_cast<const MLAS bf16x8*>(qa + kk * 32); }
                ML_SBAR();
#pragma unroll
                for (int kk = 0; kk < 8; ++kk) g = __builtin_amdgcn_mfma_f32_32x32x16_bf16(fa[kk], fb[kk], g, 0, 0, 0);
            }
            const int j = 32 * jb + r32; const float bm = arr[A_BM + j]; float rsum = 0.f;
#pragma unroll
            for (int q4 = 0; q4 < 4; ++q4) { const f32x4 ev = *reinterpret_cast<const MLAS f32x4*>(arr + A_E + 32 * tb0 + 8 * q4 + 4 * hi);
                float sc4[4];
#pragma unroll
                for (int i = 0; i < 4; ++i) { const int s = 32 * tb0 + 8 * q4 + 4 * hi + i; const float v = (s <= j) ? g[4 * q4 + i] * __expf(bm + ev[i]) : 0.f; sc4[i] = v; rsum += v; }
                const u32x2 w = {cvtpk(sc4[0], sc4[1]), cvtpk(sc4[2], sc4[3])};
                *reinterpret_cast<MLAS u32x2*>(SC + j * PS + (32 * tb0 + 8 * q4 + 4 * hi) * 2) = w; }
            rsum += __shfl_xor(rsum, 32);
            if (hi == 0) arr[(tb0 ? A_RS1 : A_RS0) + j] = rsum;
        } else {
            const MLAS char* ca = CIMG + (32 * tb0 + r32) * PQ + hi * 16; const MLAS char* qa = QIMG + (32 * jb + r32) * PQ + hi * 16;
bf16x8 fa[8], fb[8];
#pragma unroll
            for (int kk = 0; kk < 8; ++kk) { fa[kk] = *reinterpret_cast<const MLAS bf16x8*>(ca + kk * 32); fb[kk] = *reinterpret_cast<const MLAS bf16x8*>(qa + kk * 32); }
            ML_SBAR();
#pragma unroll
            for (int kk = 0; kk < 8; ++kk) acc_qc = __builtin_amdgcn_mfma_f32_32x32x16_bf16(fa[kk], fb[kk], acc_qc, 0, 0, 0);
        }
        {
            const int j = tid >> 3, part = tid & 7;
            const u32x4 q0 = *reinterpret_cast<const MLAS u32x4*>(QIMG + j * PQ + part * 32), q1 = *reinterpret_cast<const MLAS u32x4*>(QIMG + j * PQ + part * 32 + 16);
            float s = 0.f;
#pragma unroll
            for (int q = 0; q < 4; ++q) { const f32x4 n4 = *reinterpret_cast<const MLAS f32x4*>(nvec + part * 16 + 4 * q);
                const unsigned w0 = q < 2 ? q0[2 * q] : q1[2 * q - 4], w1 = q < 2 ? q0[2 * q + 1] : q1[2 * q - 3];
                s += bf2f_lo(w0) * n4[0] + bf2f_hi(w0) * n4[1] + bf2f_lo(w1) * n4[2] + bf2f_hi(w1) * n4[3]; }
            s += __shfl_xor(s, 1); s += __shfl_xor(s, 2); s += __shfl_xor(s, 4);
            if (part == 0) arr[A_QN + j] = s;
            float n0 = 0.f, n1 = 0.f;
#pragma unroll
            for (int i = 0; i < 8; ++i) { const int srow = 8 * wid + i; const unsigned kw = *reinterpret_cast<const MLAS unsigned*>(KIMG + srow * PQ + lane * 4); const float w = arr[A_WP + srow];
                n0 += w * bf2f_lo(kw); n1 += w * bf2f_hi(kw); }
            npart[wid * 128 + 2 * lane] = n0; npart[wid * 128 + 2 * lane + 1] = n1;
        }
        __syncthreads();
        if (wid >= 4) {
            f32x16 acc_n = f32x16{};
            const MLAS char* sa = SC + (32 * jb + r32) * PS + hi * 16;
            {   s16x4 l0, l1, l2, l3, h0, h1, h2, h3;
                if (tb0 == 0) { ML_TRRD(l0, trb_v, 0); ML_TRRD(h0, trb_v, 2048); ML_TRRD(l1, trb_v, 4096); ML_TRRD(h1, trb_v, 6144); ML_TRRD(l2, trb_v, 8192); ML_TRRD(h2, trb_v, 10240); ML_TRRD(l3, trb_v, 12288); ML_TRRD(h3, trb_v, 14336); }
                else { ML_TRRD(l0, trb_v, 512); ML_TRRD(h0, trb_v, 512 + 2048); ML_TRRD(l1, trb_v, 512 + 4096); ML_TRRD(h1, trb_v, 512 + 6144); ML_TRRD(l2, trb_v, 512 + 8192); ML_TRRD(h2, trb_v, 512 + 10240); ML_TRRD(l3, trb_v, 512 + 12288); ML_TRRD(h3, trb_v, 512 + 14336); }
                const bf16x8 s0 = *reinterpret_cast<const MLAS bf16x8*>(sa), s1 = *reinterpret_cast<const MLAS bf16x8*>(sa + 32), s2 = *reinterpret_cast<const MLAS bf16x8*>(sa + 64), s3 = *reinterpret_cast<const MLAS bf16x8*>(sa + 96);
                asm volatile("s_waitcnt lgkmcnt(0)" ::: "memory"); ML_SBAR();
                acc_n = __builtin_amdgcn_mfma_f32_32x32x16_bf16(ML_FR(l0, h0), s0, acc_n, 0, 0, 0);
                acc_n = __builtin_amdgcn_mfma_f32_32x32x16_bf16(ML_FR(l1, h1), s1, acc_n, 0, 0, 0);
                acc_n = __builtin_amdgcn_mfma_f32_32x32x16_bf16(ML_FR(l2, h2), s2, acc_n, 0, 0, 0);
                acc_n = __builtin_amdgcn_mfma_f32_32x32x16_bf16(ML_FR(l3, h3), s3, acc_n, 0, 0, 0); }
            const int j = 32 * jb + r32; const float inter = arr[A_INTER + j];
            const float den = arr[A_RS0 + j] + arr[A_RS1 + j] + inter * arr[A_QN + j];
            const float rden = 1.f / fmaxf(fabsf(den), arr[A_EMJ + j]);
            float ss = 0.f;
#pragma unroll
            for (int q4 = 0; q4 < 4; ++q4) { float hv[4];
#pragma unroll
                for (int i = 0; i < 4; ++i) { hv[i] = (acc_n[4 * q4 + i] + inter * acc_qc[4 * q4 + i]) * rden; ss += hv[i] * hv[i]; }
                dst_w[q4] = (u32x2){cvtpk(hv[0], hv[1]), cvtpk(hv[2], hv[3])}; }
            ss += __shfl_xor(ss, 32);
            dst_ss = ss;
        }
        {
            s16x4 al[4], ah[4], bl[4], bh[4];
#define ML_LD4(d0k, d0v) do { ML_TRRD(al[0], trb_kw, (d0k) * 512); ML_TRRD(ah[0], trb_kw, (d0k) * 512 + 2048); ML_TRRD(al[1], trb_kw, (d0k) * 512 + 4096); ML_TRRD(ah[1], trb_kw, (d0k) * 512 + 6144); \
            ML_TRRD(al[2], trb_kw, (d0k) * 512 + 8192); ML_TRRD(ah[2], trb_kw, (d0k) * 512 + 10240); ML_TRRD(al[3], trb_kw, (d0k) * 512 + 12288); ML_TRRD(ah[3], trb_kw, (d0k) * 512 + 14336); \
            ML_TRRD(bl[0], trb_v, (d0v) * 512); ML_TRRD(bh[0], trb_v, (d0v) * 512 + 2048); ML_TRRD(bl[1], trb_v, (d0v) * 512 + 4096); ML_TRRD(bh[1], trb_v, (d0v) * 512 + 6144); \
            ML_TRRD(bl[2], trb_v, (d0v) * 512 + 8192); ML_TRRD(bh[2], trb_v, (d0v) * 512 + 10240); ML_TRRD(bl[3], trb_v, (d0v) * 512 + 12288); ML_TRRD(bh[3], trb_v, (d0v) * 512 + 14336); } while (0)
            switch (wid) { case 0: ML_LD4(0, 0); break; case 1: ML_LD4(0, 1); break; case 2: ML_LD4(1, 0); break; case 3: ML_LD4(1, 1); break;
                           case 4: ML_LD4(2, 0); break; case 5: ML_LD4(2, 1); break; case 6: ML_LD4(3, 0); break; default: ML_LD4(3, 1); break; }
#undef ML_LD4
#pragma unroll
            for (int r = 0; r < 16; ++r) cst[r] *= decay;
            asm volatile("s_waitcnt lgkmcnt(0)" ::: "memory"); ML_SBAR();
#pragma unroll
            for (int ks = 0; ks < 4; ++ks) cst = __builtin_amdgcn_mfma_f32_32x32x16_bf16(ML_FR(al[ks], ah[ks]), ML_FR(bl[ks], bh[ks]), cst, 0, 0, 0);
            const int dv = 32 * dvb + r32;
#pragma unroll
            for (int q4 = 0; q4 < 4; ++q4) { const u32x2 w = {cvtpk(cst[4 * q4], cst[4 * q4 + 1]), cvtpk(cst[4 * q4 + 2], cst[4 * q4 + 3])};
                *reinterpret_cast<MLAS u32x2*>(CIMG + dv * PQ + (32 * dkb + 8 * q4 + 4 * hi) * 2) = w; }
        }
        if (tid < 128) { float s = nvec[tid] * decay;
#pragma unroll
            for (int w = 0; w < 8; ++w) s += npart[w * 128 + tid];
            nvec[tid] = s; }
        __syncthreads();
    }
    ML_STORE_OUT((NC - 1) * L);
#undef ML_STORE_OUT
#undef ML_LOAD
}
}
static_assert(ml::LDS_BYTES <= 131072, "mLSTM LDS inside the ring region");
constexpr size_t MiB = 1u << 20;
constexpr size_t WS_CTL = 0, CTL_ZERO_BYTES = 1 * MiB;
constexpr size_t WS_WQKV = 2 * MiB, WS_WAO = 8 * MiB, WS_WML = 10 * MiB  , WS_WMO = 17 * MiB, WS_W1 = 19 * MiB  , WS_W2 = 35 * MiB  ;
constexpr size_t WS_GATES = 51 * MiB;
constexpr size_t WS_SSQ = 52 * MiB;
constexpr size_t WS_GS = 56 * MiB;
constexpr size_t WS_SSQH = 58 * MiB;
constexpr size_t WS_XN = 64 * MiB;
constexpr size_t WS_U = 128 * MiB;
constexpr size_t WS_HT = 320 * MiB;
constexpr size_t WS_AO = 384 * MiB;
constexpr size_t WS_STASH = 448 * MiB;
constexpr size_t WS_END = 480 * MiB;
constexpr int CW_TMO = 0, CW_CODE = 1;
constexpr int CW_BAR = 4096;
constexpr int RING_OFF = 0, RING_BYTES = 131072;
constexpr int LDSCTL_OFF = RING_BYTES, MISC_OFF = LDSCTL_OFF + 320;
constexpr int LDS_BYTES = 147456;
static_assert(MISC_OFF + 128 <= LDS_BYTES, "LDS map");

#define GAS __attribute__((address_space(1)))
#define LAS __attribute__((address_space(3)))
typedef unsigned short bf16;
typedef unsigned v4u __attribute__((ext_vector_type(4)));
typedef float f32x4 __attribute__((ext_vector_type(4)));
typedef short bf16x8 __attribute__((ext_vector_type(8)));
typedef GAS unsigned gu32;
typedef GAS unsigned long long gu64;
#define RLX_AGENT __ATOMIC_RELAXED, __HIP_MEMORY_SCOPE_AGENT
#define LDS_WAIT() asm volatile("s_waitcnt lgkmcnt(0)" ::: "memory")
#define VM_WAIT() asm volatile("s_waitcnt vmcnt(0)" ::: "memory")
__device__ __forceinline__ unsigned long long rt() { return __builtin_amdgcn_s_memrealtime(); }
__device__ __forceinline__ unsigned f2bf(float f) { unsigned u = __builtin_bit_cast(unsigned, f); return (u + 0x7fffu + ((u >> 16) & 1u)) >> 16; }
__device__ __forceinline__ unsigned pk2(float lo, float hi) { return f2bf(lo) | (f2bf(hi) << 16); }

#define XB_TMO      128
#define XB_XCNT(j)  (256  + 64 * (j))
#define XB_XSUB(j)  (1280 + 64 * (j))
#define XB_XGEN(j)  (2304 + 64 * (j))
#define XB_TOP      3328
#define XB_TOPGEN   3392
#define XCD_BAR_WORDS 3456
#define XB_SPIN_CAP (1u << 23)

__device__ __forceinline__ unsigned xb_ld(unsigned* p)              { return __hip_atomic_load(p, __ATOMIC_RELAXED, __HIP_MEMORY_SCOPE_AGENT); }
__device__ __forceinline__ unsigned xb_add(unsigned* p, unsigned v) { return __hip_atomic_fetch_add(p, v, __ATOMIC_RELAXED, __HIP_MEMORY_SCOPE_AGENT); }
__device__ __forceinline__ unsigned xb_xcc_id() { return (unsigned)__builtin_amdgcn_s_getreg((3 << 11) | 20) & 0xFu; }
#define XB_SPIN(cond, bar) do { unsigned _sp = 0; while (cond) { __builtin_amdgcn_s_sleep(1); \
    if ((++_sp & 255u) == 0u) { if (xb_ld(&(bar)[XB_TMO])) break; if (_sp > XB_SPIN_CAP) { atomicAdd(&(bar)[XB_TMO], 1u); break; } } } } while (0)

struct XcdBarrier {
    unsigned* bar; unsigned x;
    volatile LAS unsigned* st;
};

__device__ __forceinline__ XcdBarrier xcd_barrier_post(unsigned* bar, volatile LAS unsigned* st) {
    XcdBarrier b; b.bar = bar; b.x = xb_xcc_id(); b.st = st;
    if (threadIdx.x == 0) (void)xb_add(&bar[XB_XCNT(b.x)], 1u);
    return b;
}
__device__ __forceinline__ void xcd_barrier_complete(unsigned* bar, unsigned x, unsigned& nloc, unsigned& nx) {
    const unsigned G = gridDim.x * gridDim.y * gridDim.z;
    unsigned sum, cnt, mine, sp = 0u;
    for (;;) {
        sum = 0u; cnt = 0u; mine = 0u;
#pragma unroll
        for (unsigned j = 0; j < 16; ++j) { const unsigned c = xb_ld(&bar[XB_XCNT(j)]); sum += c; cnt += (c > 0u) ? 1u : 0u; mine = (j == x) ? c : mine; }
        if (sum == G) break;
        __builtin_amdgcn_s_sleep(1);
        if ((++sp & 255u) == 0u) { if (xb_ld(&bar[XB_TMO])) break; if (sp > XB_SPIN_CAP) { atomicAdd(&bar[XB_TMO], 1u); break; } }
    }
    nloc = mine > 0u ? mine : 1u; nx = cnt > 0u ? cnt : 1u;
}

__device__ __forceinline__ void xcd_barrier(const XcdBarrier& b) {
    asm volatile("s_waitcnt vmcnt(0)" ::: "memory");
    __syncthreads();
    if (threadIdx.x == 0) {
        unsigned* bar = b.bar;
        __builtin_amdgcn_s_waitcnt(0);
        unsigned nloc = b.st[0], nx = b.st[1];
        if (nloc == 0u) { xcd_barrier_complete(bar, b.x, nloc, nx); b.st[0] = nloc; b.st[1] = nx; }
        const unsigned old = xb_add(&bar[XB_XSUB(b.x)], 1u);
        const unsigned gen = old / nloc;
        if (old + 1u == (gen + 1u) * nloc) {
            __builtin_amdgcn_fence(__ATOMIC_RELEASE, "agent");
            asm volatile("s_waitcnt vmcnt(0)" ::: "memory");
            const unsigned og = xb_add(&bar[XB_TOP], 1u);
            const unsigned tg = og / nx;
            if (og + 1u == (tg + 1u) * nx) xb_add(&bar[XB_TOPGEN], 1u);
            else XB_SPIN(xb_ld(&bar[XB_TOPGEN]) == tg, bar);
            __builtin_amdgcn_fence(__ATOMIC_ACQUIRE, "agent");
            xb_add(&bar[XB_XGEN(b.x)], 1u);
            asm volatile("s_waitcnt vmcnt(0)" ::: "memory");
        } else {
            XB_SPIN(xb_ld(&bar[XB_XGEN(b.x)]) == gen, bar);
            __builtin_amdgcn_fence(__ATOMIC_ACQUIRE, "agent");
            asm volatile("s_waitcnt vmcnt(0)" ::: "memory");
        }
    }
    __syncthreads();
}

struct Frame {
    LAS unsigned char* lds;
    volatile LAS unsigned* MISC;
    gu32* ctl;
    int tid, lane, wave;
    int vcu, G;
};
__device__ __forceinline__ float wave_sum(float v) {
#pragma unroll
    for (int o = 1; o < 64; o <<= 1) v += __shfl_xor(v, o);
    return v;
}
__device__ __forceinline__ void p0_transpose_item(const float* W, int K, int ldw, int nblk, bf16* WT, const float* gk, int gmask, float gs, LAS float* scr, int item, int lane) {
    const int kb = item / nblk, nb = item % nblk, k0 = 64 * kb, n0 = 64 * nb;
    f32x4 v[16];
#pragma unroll
    for (int i = 0; i < 16; ++i) v[i] = *(const GAS f32x4*)(W + (size_t)(k0 + 4 * i + (lane >> 4)) * ldw + n0 + (lane & 15) * 4);
#pragma unroll
    for (int i = 0; i < 16; ++i) { const int kk = 4 * i + (lane >> 4); const float g = gk ? gk[(k0 + kk) & gmask] * gs : gs; LAS float* d = scr + kk * 64; const int nn = (lane & 15) * 4 + kk;
        d[nn & 63] = v[i].x * g; d[(nn + 1) & 63] = v[i].y * g; d[(nn + 2) & 63] = v[i].z * g; d[(nn + 3) & 63] = v[i].w * g; }
    LDS_WAIT(); asm volatile("" ::: "memory");
    const int c = lane & 7;
#pragma unroll
    for (int j = 0; j < 8; ++j) { const int n = (lane >> 3) + 8 * j; const LAS float* s = scr + (8 * c) * 64; const int nn = n + 8 * c;
        v4u o; o.x = pk2(s[0 * 64 + (nn & 63)], s[1 * 64 + ((nn + 1) & 63)]); o.y = pk2(s[2 * 64 + ((nn + 2) & 63)], s[3 * 64 + ((nn + 3) & 63)]);
        o.z = pk2(s[4 * 64 + ((nn + 4) & 63)], s[5 * 64 + ((nn + 5) & 63)]); o.w = pk2(s[6 * 64 + ((nn + 6) & 63)], s[7 * 64 + ((nn + 7) & 63)]);
        *(GAS v4u*)(WT + (size_t)(n0 + n) * K + k0 + 8 * c) = o; }
    LDS_WAIT(); asm volatile("" ::: "memory");
}
__device__ __forceinline__ void rms_row_load(const float* xrow, int lane, f32x4 (&v)[4]) {
    const GAS f32x4* xr = (const GAS f32x4*)xrow + lane; float s2 = 0.f;
#pragma unroll
    for (int j = 0; j < 4; ++j) { v[j] = xr[64 * j]; s2 += (v[j].x * v[j].x + v[j].y * v[j].y) + (v[j].z * v[j].z + v[j].w * v[j].w); }
    const float rstd = 1.f / sqrtf(wave_sum(s2) * (1.f / D) + EPS);
#pragma unroll
    for (int j = 0; j < 4; ++j) v[j] = v[j] * rstd;
}
__device__ __forceinline__ void row_store_bf16(bf16* orow, int lane, const f32x4 (&v)[4]) {
    GAS unsigned long long* o8 = (GAS unsigned long long*)orow + lane;
#pragma unroll
    for (int j = 0; j < 4; ++j) o8[64 * j] = (unsigned long long)pk2(v[j].x, v[j].y) | ((unsigned long long)pk2(v[j].z, v[j].w) << 32);
}
__device__ __forceinline__ float log_sigmoid(float x) { return fminf(x, 0.f) - log1pf(expf(-fabsf(x))); }

struct Args { const float* in[22]; float* out; unsigned char* ws; int ph_lo, ph_hi, li, pad; };

__device__ __forceinline__ void p0_prologue(Frame& F, const Args& a) {
    unsigned char* ws = a.ws;
    LAS float* scr = (LAS float*)(F.lds + RING_OFF + F.wave * 16384);
    const int gw = F.vcu * NWAVES + F.wave, NGW = F.G * NWAVES;
    constexpr int I_QKV = (D / 64) * (NQKV / 64), I_O = (D / 64) * (D / 64), I_ML = (D / 64) * (NPROJ / 64), I_1 = (D / 64) * (FF / 64), I_2 = (FF / 64) * (D / 64);
    constexpr int NITEMS = I_QKV + I_O + I_ML + I_O + 2 * I_1 + 2 * I_2;
    for (int it = gw; it < NITEMS; it += NGW) {
        int r = it;
        if (r < I_QKV) { p0_transpose_item(a.in[3], D, NQKV, NQKV / 64, (bf16*)(ws + WS_WQKV), a.in[2], 0xffff, 1.f, scr, r, F.lane); continue; } r -= I_QKV;
        if (r < I_O) { p0_transpose_item(a.in[9], D, D, D / 64, (bf16*)(ws + WS_WAO), a.in[8], 127, 1.f - LAMBDA_INIT0, scr, r, F.lane); continue; } r -= I_O;
        if (r < I_ML) { p0_transpose_item(a.in[11], D, MLW, NPROJ / 64, (bf16*)(ws + WS_WML), a.in[10], 0xffff, 1.f, scr, r, F.lane); continue; } r -= I_ML;
        if (r < I_O) { p0_transpose_item(a.in[17], D, D, D / 64, (bf16*)(ws + WS_WMO), a.in[16], 0xffff, 1.f, scr, r, F.lane); continue; } r -= I_O;
        if (r < 2 * I_1) { const int l = r / I_1; p0_transpose_item(a.in[19] + (size_t)l * D * FF, D, FF, FF / 64, (bf16*)(ws + WS_W1) + (size_t)l * D * FF, a.in[18] + l * D, 0xffff, 1.f, scr, r % I_1, F.lane); continue; } r -= 2 * I_1;
        { const int l = r / I_2; p0_transpose_item(a.in[20] + (size_t)l * D * FF, FF, D, D / 64, (bf16*)(ws + WS_W2) + (size_t)l * D * FF, nullptr, 0, 1.f, scr, r % I_2, F.lane); }
    }
    { bf16* WT = (bf16*)(ws + WS_WML) + (size_t)NPROJ * D; const int gt = (F.vcu * NWAVES + F.wave) * 64 + F.lane, NGT = F.G * NWAVES * 64;
      for (int i = gt; i < 256 * D / 2; i += NGT) { const int j = (2 * i) / D, k = (2 * i) % D;
          const unsigned w = j < 8 ? pk2(a.in[10][k] * a.in[11][(size_t)k * MLW + NPROJ + j], a.in[10][k + 1] * a.in[11][(size_t)(k + 1) * MLW + NPROJ + j]) : 0u;
          ((GAS unsigned*)WT)[i] = w; } }
    bf16* XN = (bf16*)(ws + WS_XN); float* SSQH = (float*)(ws + WS_SSQH);
    for (int m = gw; m < M; m += NGW) { f32x4 v[4]; const GAS f32x4* xr = (const GAS f32x4*)(a.in[0] + (size_t)m * D) + F.lane; float s2 = 0.f;
#pragma unroll
        for (int j = 0; j < 4; ++j) { v[j] = xr[64 * j]; s2 += (v[j].x * v[j].x + v[j].y * v[j].y) + (v[j].z * v[j].z + v[j].w * v[j].w); }
        s2 = wave_sum(s2); row_store_bf16(XN + (size_t)m * D, F.lane, v);
        if (F.lane < 16) SSQH[(size_t)m * 16 + F.lane] = F.lane == 0 ? s2 : 0.f; }
}
__device__ __forceinline__ void final_norm_phase(Frame& F, const bf16* XN, const float* SSQH, const float* g, float* out) {
    const int gw = F.vcu * NWAVES + F.wave, NGW = F.G * NWAVES;
    for (int m = gw; m < M; m += NGW) {
        const float rstd = pg8::row_rstd(SSQH, m);
        const v4u h0 = *(const GAS v4u*)(XN + (size_t)m * D + F.lane * 16), h1 = *(const GAS v4u*)(XN + (size_t)m * D + F.lane * 16 + 8);
        GAS f32x4* o = (GAS f32x4*)(out + (size_t)m * D + F.lane * 16); const GAS f32x4* gg = (const GAS f32x4*)(g + F.lane * 16);
#pragma unroll
        for (int q = 0; q < 2; ++q) { const f32x4 a = gg[q];
            o[q] = (f32x4){__uint_as_float(h0[2 * q] << 16) * rstd * a.x, __uint_as_float(h0[2 * q] & 0xffff0000u) * rstd * a.y, __uint_as_float(h0[2 * q + 1] << 16) * rstd * a.z, __uint_as_float(h0[2 * q + 1] & 0xffff0000u) * rstd * a.w}; }
#pragma unroll
        for (int q = 0; q < 2; ++q) { const f32x4 a = gg[2 + q];
            o[2 + q] = (f32x4){__uint_as_float(h1[2 * q] << 16) * rstd * a.x, __uint_as_float(h1[2 * q] & 0xffff0000u) * rstd * a.y, __uint_as_float(h1[2 * q + 1] << 16) * rstd * a.z, __uint_as_float(h1[2 * q + 1] & 0xffff0000u) * rstd * a.w}; }
    }
}

__device__ __forceinline__ float bf2f(bf16 v) { return __uint_as_float((unsigned)v << 16); }
__device__ __forceinline__ int t5_bucket(int d) {
    if (d < 16) return d;
    const float v = logf((float)d / 16.f) / logf(8.f) * 16.f; int b = 16 + (int)v; return b > 31 ? 31 : b;
}
__device__ __forceinline__ void naive_attn_phase(Frame& F, const bf16* __restrict__ QKV, const float* __restrict__ rel_bias, const float* __restrict__ lq1, const float* __restrict__ lk1,
                                                  const float* __restrict__ lq2, const float* __restrict__ lk2, bf16* AO) {
    LAS float* lut = (LAS float*)(F.lds + RING_OFF);
    const int tid = F.tid, half = tid & 1;
    float s1 = 0.f, s2 = 0.f;
    for (int i = 0; i < 64; ++i) { s1 += lq1[i] * lk1[i]; s2 += lq2[i] * lk2[i]; }
    const float lam = expf(s1) - expf(s2) + LAMBDA_INIT0;
    for (int u = F.vcu; u < BATCH * NH_A * (SEQ / 256); u += F.G) {
        const int qb = u % (SEQ / 256), h = (u / (SEQ / 256)) % NH_A, b = u / (SEQ / 256) / NH_A, q0 = qb * 256, q = q0 + (tid >> 1);
        __syncthreads();
        if (tid < 128) lut[tid] = rel_bias[t5_bucket(tid) * NH_A + h] * LOG2E;
        __syncthreads();
        const size_t tok = (size_t)b * SEQ + q;
        float res[64];
        for (int m = 0; m < 2; ++m) {
            float qv[64];
            const bf16* qp = QKV + tok * NQKV + h * 128 + m * 64;
#pragma unroll
            for (int d = 0; d < 64; ++d) qv[d] = bf2f(qp[d]);
            float o[64];
#pragma unroll
            for (int d = 0; d < 64; ++d) o[d] = 0.f;
            float mrun = -1e30f, l = 0.f;
            const int kend = q0 + 256;
            for (int k = 0; k < kend; ++k) {
                const bf16* kr = QKV + ((size_t)b * SEQ + k) * NQKV + D + h * 128 + m * 64;
                const bf16* vr = QKV + ((size_t)b * SEQ + k) * NQKV + 2 * D + h * 128 + half * 64;
                float s = 0.f;
#pragma unroll
                for (int d = 0; d < 64; ++d) s += qv[d] * bf2f(kr[d]);
                const int dist = q - k;
                if (dist >= 0) {
                    s += lut[dist < 127 ? dist : 127];
                    if (s > mrun) { const float al = exp2f(mrun - s); l *= al;
#pragma unroll
                        for (int d = 0; d < 64; ++d) o[d] *= al;
                        mrun = s; }
                    const float p = exp2f(s - mrun); l += p;
#pragma unroll
                    for (int d = 0; d < 64; ++d) o[d] += p * bf2f(vr[d]);
                }
            }
            const float il = 1.f / l;
            if (m == 0) {
#pragma unroll
                for (int d = 0; d < 64; ++d) res[d] = o[d] * il;
            } else {
                float ss = 0.f;
#pragma unroll
                for (int d = 0; d < 64; ++d) { res[d] = res[d] - lam * (o[d] * il); ss += res[d] * res[d]; }
                ss += __shfl_xor(ss, 1);
                const float rstd = 1.f / sqrtf(ss * (1.f / 128.f) + EPS);
                bf16* op = AO + tok * D + h * 128 + half * 64;
#pragma unroll
                for (int d = 0; d < 64; d += 2) *(unsigned*)(op + d) = pk2(res[d] * rstd, res[d + 1] * rstd);
            }
        }
    }
    __syncthreads();
}
__device__ __forceinline__ void naive_mlstm_phase(Frame& F, const bf16* __restrict__ PROJ, const float* __restrict__ GATES, const float* __restrict__ conv_w, const float* __restrict__ conv_b, bf16* AO) {
    LAS float* q_s = (LAS float*)(F.lds + RING_OFF); LAS float* k_s = q_s + 128; LAS float* v_s = q_s + 256; LAS float* red = q_s + 512;
    const int tid = F.tid, dv = tid >> 1, half = tid & 1, lane = F.lane, wave = F.wave;
    for (int u = (int)blockIdx.x; u < BATCH * NH_M; u += F.G) {
        const int h = u & 3, b = u >> 2;
        float C[64], n[64];
#pragma unroll
        for (int j = 0; j < 64; ++j) { C[j] = 0.f; n[j] = 0.f; }
        float mst = 0.f;
        const int col = (tid < 128) ? (h * 128 + tid) : (512 + h * 128 + ((tid - 128) & 127));
        float cw0 = 0.f, cw1 = 0.f, cw2 = 0.f, cw3 = 0.f, cb = 0.f;
        if (tid < 256) { cw0 = conv_w[0 * D + col]; cw1 = conv_w[1 * D + col]; cw2 = conv_w[2 * D + col]; cw3 = conv_w[3 * D + col]; cb = conv_b[col]; }
        __syncthreads();
        for (int t = 0; t < SEQ; ++t) {
            const size_t tok = (size_t)b * SEQ + t;
            if (tid < 256) {
                float x3 = bf2f(PROJ[tok * NPROJ + col]);
                float x2 = t >= 1 ? bf2f(PROJ[(tok - 1) * NPROJ + col]) : 0.f;
                float x1 = t >= 2 ? bf2f(PROJ[(tok - 2) * NPROJ + col]) : 0.f;
                float x0 = t >= 3 ? bf2f(PROJ[(tok - 3) * NPROJ + col]) : 0.f;
                float y = cw0 * x0 + cw1 * x1 + cw2 * x2 + cw3 * x3 + cb;
                y = y / (1.f + expf(-y));
                if (tid < 128) q_s[tid] = y * MQSCALE; else k_s[tid - 128] = y;
            } else {
                v_s[tid - 256] = bf2f(PROJ[tok * NPROJ + 1024 + h * 256 + (tid - 256)]);
            }
            const float ig = GATES[tok * 8 + h], lf = GATES[tok * 8 + 4 + h];
            __syncthreads();
            const float mnew = fmaxf(lf + mst, ig), fd = expf(lf + mst - mnew), gi = expf(ig - mnew);
            mst = mnew;
            const float gv = gi * v_s[dv];
            float num = 0.f, den = 0.f;
#pragma unroll
            for (int j = 0; j < 64; ++j) { const float kk = k_s[half * 64 + j], qq = q_s[half * 64 + j];
                C[j] = fd * C[j] + gv * kk; n[j] = fd * n[j] + gi * kk; num += C[j] * qq; den += n[j] * qq; }
            num += __shfl_xor(num, 1); den += __shfl_xor(den, 1);
            const float hv = num / fmaxf(fabsf(den), expf(-mnew));
            float ss = half == 0 ? hv * hv : 0.f;
            ss = wave_sum(ss);
            if (lane == 0) red[wave] = ss;
            __syncthreads();
            float tot = 0.f;
#pragma unroll
            for (int w = 0; w < 8; ++w) tot += red[w];
            const float rstd = 1.f / sqrtf(tot * (1.f / 256.f) + EPS);
            if (half == 0) { const float op = bf2f(PROJ[tok * NPROJ + 2048 + h * 256 + dv]); const float sg = 1.f / (1.f + expf(-op));
                AO[tok * D + h * 256 + dv] = (bf16)f2bf(sg * hv * rstd); }
            __syncthreads();
        }
    }
}

__device__ __forceinline__ void attn_phase(Frame& F, const bf16* __restrict__ QKV, bf16* AO, float* stash, const float* __restrict__ rel_bias, const float* __restrict__ lq1, const float* __restrict__ lk1,
                                           const float* __restrict__ lq2, const float* __restrict__ lk2) {
    using da::f32x16; using da::f32x4;
    LAS char* lds = (LAS char*)(F.lds + RING_OFF);
    LAS float* lut = (LAS float*)(lds + da::OFF_LUT);
    const int tid = F.tid, lane = F.lane, wid = F.wave, r32 = lane & 31, hi = lane >> 5;
    float s1 = 0.f, s2 = 0.f;
    for (int i = 0; i < 64; ++i) { s1 += lq1[i] * lk1[i]; s2 += lq2[i] * lk2[i]; }
    const float lam = expf(s1) - expf(s2) + LAMBDA_INIT0;
    f32x4* st = (f32x4*)(stash + (((size_t)blockIdx.x * NWAVES + wid) * 64 + lane) * 64);
    for (int L = F.vcu; L < BATCH * NH_A * 4; L += F.G) {
        const int bh = L >> 2, x = L & 3, b = bh >> 3, h = bh & 7;
        __syncthreads();
        if (tid < 128) lut[tid] = rel_bias[t5_bucket(tid) * NH_A + h] * LOG2E;
        __syncthreads();
        const float c31 = lut[127];
        for (int s = 0; s < 4; ++s) {
            const int qb = (s >> 1) ? 7 - x : x, m = s & 1, P0 = qb * 256;
            const bf16* Qp = QKV + ((size_t)b * SEQ + P0) * NQKV + h * 128 + m * 64;
            const bf16* Kp = QKV + (size_t)b * SEQ * NQKV + D + h * 128 + m * 64;
            const bf16* Vp = QKV + (size_t)b * SEQ * NQKV + 2 * D + h * 128;
            f32x16 o[4];
            da::attn_block(Qp, Kp, Vp, P0, lds, c31, o);
            if (m == 0) {
#pragma unroll
                for (int i = 0; i < 16; ++i) st[i] = (f32x4){o[i >> 2][(i & 3) * 4 + 0], o[i >> 2][(i & 3) * 4 + 1], o[i >> 2][(i & 3) * 4 + 2], o[i >> 2][(i & 3) * 4 + 3]};
            } else {
#pragma unroll
                for (int i = 0; i < 16; ++i) { const f32x4 a = st[i];
#pragma unroll
                    for (int e = 0; e < 4; ++e) o[i >> 2][(i & 3) * 4 + e] = a[e] - lam * o[i >> 2][(i & 3) * 4 + e]; }
                bf16* Ow = AO + ((size_t)b * SEQ + P0 + wid * 32) * D + h * 128;
#pragma unroll
                for (int r = 0; r < 16; ++r) {
                    float ss = (o[0][r] * o[0][r] + o[1][r] * o[1][r]) + (o[2][r] * o[2][r] + o[3][r] * o[3][r]);
#pragma unroll
                    for (int off = 1; off < 32; off <<= 1) ss += __shfl_xor(ss, off);
                    const float rstd = 1.f / sqrtf(ss * (1.f / 128.f) + EPS);
                    const int orow = da::crow(r, hi);
#pragma unroll
                    for (int d0 = 0; d0 < 4; ++d0) { const float v = o[d0][r] * rstd; const float vn = __shfl_xor(v, 1);
                        if ((r32 & 1) == 0) *(unsigned*)(Ow + (size_t)orow * D + d0 * 32 + r32) = da::cvtpk(v, vn); }
                }
            }
        }
    }
    __syncthreads();
}

__device__ __forceinline__ void convscan_phase(Frame& F, const bf16* __restrict__ PROJ, const float* __restrict__ GATES, const float* __restrict__ conv_w, const float* __restrict__ conv_b, bf16* QKC, float* GS) {
    {   const int pc = F.tid & 127, col = pc * 8;
        float cw[4][8], cbias[8];
#pragma unroll
        for (int i = 0; i < 8; ++i) { cbias[i] = conv_b[col + i];
#pragma unroll
            for (int t = 0; t < 4; ++t) cw[t][i] = conv_w[t * 1024 + col + i]; }
        const float osc = col < 512 ? MQSCALE : 1.f;
        for (int seg = F.vcu * 4 + (F.tid >> 7); seg < M / 32; seg += F.G * 4) {
            const int tokb = seg * 32;
#pragma unroll 1
            for (int run = 0; run < 4; ++run) {
                const int t8 = tokb + run * 8; const bool first = (t8 & (SEQ - 1)) == 0;
                const bf16* p = PROJ + (size_t)t8 * NPROJ + col;
                v4u r[11];
#pragma unroll
                for (int i = 0; i < 3; ++i) r[i] = first ? (v4u){0u, 0u, 0u, 0u} : *(const GAS v4u*)(p + ((ptrdiff_t)i - 3) * NPROJ);
#pragma unroll
                for (int i = 3; i < 11; ++i) r[i] = *(const GAS v4u*)(p + (size_t)(i - 3) * NPROJ);
#pragma unroll
                for (int t = 0; t < 8; ++t) {
                    unsigned o[4];
#pragma unroll
                    for (int q = 0; q < 4; ++q) {
                        float s0 = cbias[2 * q], s1 = cbias[2 * q + 1];
#pragma unroll
                        for (int tap = 0; tap < 4; ++tap) { const unsigned w = r[t + tap][q]; s0 += cw[tap][2 * q] * __uint_as_float(w << 16); s1 += cw[tap][2 * q + 1] * __uint_as_float(w & 0xffff0000u); }
                        s0 = s0 / (1.f + __expf(-s0)) * osc; s1 = s1 / (1.f + __expf(-s1)) * osc; o[q] = pk2(s0, s1); }
                    *(GAS v4u*)(QKC + (size_t)(t8 + t) * D + col) = (v4u){o[0], o[1], o[2], o[3]};
                }
            }
        }
    }
    {   const int gw = F.vcu * NWAVES + F.wave, NGW = F.G * NWAVES, lane = F.lane;
        for (int task = gw; task < BATCH * NH_M * (SEQ / 64); task += NGW) {
            const int c = task % (SEQ / 64), h = (task / (SEQ / 64)) % NH_M, b = task / (SEQ / 64) / NH_M;
            const size_t tok = (size_t)b * SEQ + c * 64 + lane;
            const float ig = GATES[tok * 8 + h], lf = GATES[tok * 8 + 4 + h];
            float bsum = lf;
#pragma unroll
            for (int off = 1; off < 64; off <<= 1) { const float t = __shfl_up(bsum, off); if (lane >= off) bsum += t; }
            const float e = ig - bsum; float pm = e;
#pragma unroll
            for (int off = 1; off < 64; off <<= 1) { const float t = __shfl_up(pm, off); if (lane >= off) pm = fmaxf(pm, t); }
            *(GAS f32x4*)(GS + tok * 16 + h * 4) = (f32x4){bsum, e, pm, 0.f};
        }
    }
}
__device__ __forceinline__ void mlstm_phase(Frame& F, const bf16* __restrict__ PROJ, const bf16* __restrict__ QKC, const float* __restrict__ GS, bf16* HT, float* SSQ) {
    for (int u = F.vcu; u < BATCH * NH_M * 4; u += F.G) {
        __syncthreads();
        ml::mlstm_unit(u >> 4, (u >> 2) & 3, u & 3, PROJ, QKC, GS, HT, SSQ, (LAS char*)(F.lds + RING_OFF));
    }
    __syncthreads();
}
__device__ __forceinline__ void gatenorm_phase(Frame& F, const bf16* __restrict__ PROJ, const bf16* __restrict__ HT, const float* __restrict__ SSQ, bf16* AO) {
    const int gw = F.vcu * NWAVES + F.wave, NGW = F.G * NWAVES, lane = F.lane;
    for (int m = gw; m < M; m += NGW) {
        const int hd = lane >> 4;
        const f32x4 s0 = *(const GAS f32x4*)(SSQ + (size_t)m * 32 + hd * 8), s1 = *(const GAS f32x4*)(SSQ + (size_t)m * 32 + hd * 8 + 4);
        const float tot = ((s0.x + s0.y) + (s0.z + s0.w)) + ((s1.x + s1.y) + (s1.z + s1.w));
        const float rstd = 1.f / sqrtf(tot * (1.f / 256.f) + EPS);
        const v4u h0 = *(const GAS v4u*)(HT + (size_t)m * D + lane * 16), h1 = *(const GAS v4u*)(HT + (size_t)m * D + lane * 16 + 8);
        const v4u o0 = *(const GAS v4u*)(PROJ + (size_t)m * NPROJ + 2048 + lane * 16), o1 = *(const GAS v4u*)(PROJ + (size_t)m * NPROJ + 2048 + lane * 16 + 8);
        v4u r0, r1;
#pragma unroll
        for (int q = 0; q < 4; ++q) {
            { const float ha = __uint_as_float(h0[q] << 16) * rstd, hb = __uint_as_float(h0[q] & 0xffff0000u) * rstd, oa = __uint_as_float(o0[q] << 16), ob = __uint_as_float(o0[q] & 0xffff0000u);
              r0[q] = pk2(ha / (1.f + __expf(-oa)), hb / (1.f + __expf(-ob))); }
            { const float ha = __uint_as_float(h1[q] << 16) * rstd, hb = __uint_as_float(h1[q] & 0xffff0000u) * rstd, oa = __uint_as_float(o1[q] << 16), ob = __uint_as_float(o1[q] & 0xffff0000u);
              r1[q] = pk2(ha / (1.f + __expf(-oa)), hb / (1.f + __expf(-ob))); }
        }
        *(GAS v4u*)(AO + (size_t)m * D + lane * 16) = r0; *(GAS v4u*)(AO + (size_t)m * D + lane * 16 + 8) = r1;
    }
}

template <class Epi>
__device__ __forceinline__ void run_gemm(Frame& F, const bf16* A, const bf16* Bt, int N, int K, const Epi& E) {
    pg8::Gemm g{A, Bt, M, N, K}; pg8::StaticOrder S; S.init(M, N, F.G, (int)blockIdx.x);
    pg8::gemm_phase<Epi, pg8::StaticOrder, PG8_ALIGN, PG8_SP2>(F.lds + RING_OFF, g, S, E);
}
__global__ void __launch_bounds__(NWAVES * 64, 2) fwd(Args args) {
    extern __shared__ __attribute__((aligned(16))) unsigned char lds[];
    Frame F;
    F.lds = (LAS unsigned char*)lds;
    F.MISC = (volatile LAS unsigned*)(F.lds + MISC_OFF);
    F.tid = threadIdx.x; F.lane = F.tid & 63; F.wave = __builtin_amdgcn_readfirstlane(F.tid >> 6);
    F.G = gridDim.x; { const int bx = blockIdx.x; F.vcu = (F.G % 8 == 0) ? (bx % 8) * (F.G / 8) + bx / 8 : bx; }
    unsigned char* ws = args.ws;
    F.ctl = (gu32*)(ws + WS_CTL);
    for (int u = F.tid; u < (LDS_BYTES - LDSCTL_OFF) / 4; u += NWAVES * 64) ((LAS unsigned*)(F.lds + LDSCTL_OFF))[u] = 0u;
    __syncthreads();
    const int lo = args.ph_lo, hi = args.ph_hi;
    const bool use_bar = (hi - lo) > 1;
    XcdBarrier bar; bar.bar = (unsigned*)(F.ctl + CW_BAR) + args.li * XCD_BAR_WORDS; bar.x = 0; bar.st = nullptr;
    if (use_bar) bar = xcd_barrier_post((unsigned*)(F.ctl + CW_BAR) + args.li * XCD_BAR_WORDS, F.MISC + 8);
#define IN(k) (lo <= (k) && (k) < hi)
#define SEAM(k) do { if (hi > lo + 1) xcd_barrier(bar); } while (0)
#define REP(k) for (int rep_ = 0; rep_ < ((DUP_PHASE == (k)) ? 2 : 1); ++rep_)
#define DUPBAR(k) do { if (DUP_PHASE == (k) && rep_ == 0) xcd_barrier(bar); } while (0)
    bf16* const XN = (bf16*)(ws + WS_XN); bf16* const AO = (bf16*)(ws + WS_AO); bf16* const QKV = (bf16*)(ws + WS_U); bf16* const U = (bf16*)(ws + WS_U); float* const SSQH = (float*)(ws + WS_SSQH);
    float* const H = args.out;
    using pg8::EpiBf16; using pg8::EpiResNorm; (void)H;

    if (IN(0)) { REP(0) { p0_prologue(F, args); DUPBAR(0); } SEAM(0); }
    if (IN(1)) { EpiBf16<0> E{QKV, NQKV, D, QSCALE, SSQH, -1, nullptr, nullptr, nullptr}; if (DUP_PHASE == 1) { run_gemm(F, XN, (const bf16*)(ws + WS_WQKV), NQKV, D, E); xcd_barrier(bar); } run_gemm(F, XN, (const bf16*)(ws + WS_WQKV), NQKV, D, E); SEAM(1); }
    if (IN(2)) { REP(2) { attn_phase(F, QKV, AO, (float*)(ws + WS_STASH), args.in[1], args.in[4], args.in[5], args.in[6], args.in[7]); DUPBAR(2); } SEAM(2); }
    if (IN(3)) { EpiResNorm<true> E{args.in[0], nullptr, XN, SSQH, D}; if (DUP_PHASE == 3) { run_gemm(F, AO, (const bf16*)(ws + WS_WAO), D, D, E); xcd_barrier(bar); } run_gemm(F, AO, (const bf16*)(ws + WS_WAO), D, D, E); SEAM(4); }
    if (IN(5)) { EpiBf16<2> E{U, FF, 0, 1.f, SSQH, -1, nullptr, nullptr, nullptr}; if (DUP_PHASE == 5) { run_gemm(F, XN, (const bf16*)(ws + WS_W1), FF, D, E); xcd_barrier(bar); } run_gemm(F, XN, (const bf16*)(ws + WS_W1), FF, D, E); SEAM(5); }
    if (IN(6)) { EpiResNorm<false> E{nullptr, XN, XN, SSQH, D}; run_gemm(F, U, (const bf16*)(ws + WS_W2), D, FF, E); SEAM(7); }
    if (IN(8)) { EpiBf16<0> E{QKV, NPROJ, 0, 1.f, SSQH, NPROJ / 256, (float*)(ws + WS_GATES), args.in[12], args.in[13]}; if (DUP_PHASE == 8) { run_gemm(F, XN, (const bf16*)(ws + WS_WML), NPROJ + 256, D, E); xcd_barrier(bar); } run_gemm(F, XN, (const bf16*)(ws + WS_WML), NPROJ + 256, D, E); SEAM(8); }
    if (IN(9)) { REP(16) { convscan_phase(F, QKV, (const float*)(ws + WS_GATES), args.in[14], args.in[15], AO, (float*)(ws + WS_GS)); xcd_barrier(bar); }
        REP(9) { mlstm_phase(F, QKV, AO, (const float*)(ws + WS_GS), (bf16*)(ws + WS_HT), (float*)(ws + WS_SSQ)); DUPBAR(9); } SEAM(9); }
    if (IN(10)) { REP(10) { gatenorm_phase(F, QKV, (const bf16*)(ws + WS_HT), (const float*)(ws + WS_SSQ), AO); DUPBAR(10); } SEAM(10); }
    if (IN(11)) { EpiResNorm<false> E{nullptr, XN, XN, SSQH, D}; run_gemm(F, AO, (const bf16*)(ws + WS_WMO), D, D, E); SEAM(12); }
    if (IN(13)) { EpiBf16<2> E{U, FF, 0, 1.f, SSQH, -1, nullptr, nullptr, nullptr}; if (DUP_PHASE == 13) { run_gemm(F, XN, (const bf16*)(ws + WS_W1) + (size_t)D * FF, FF, D, E); xcd_barrier(bar); } run_gemm(F, XN, (const bf16*)(ws + WS_W1) + (size_t)D * FF, FF, D, E); SEAM(13); }
    if (IN(14)) { EpiResNorm<false> E{nullptr, XN, XN, SSQH, D}; run_gemm(F, U, (const bf16*)(ws + WS_W2) + (size_t)D * FF, D, FF, E); SEAM(14); }
    if (IN(15)) { final_norm_phase(F, XN, SSQH, args.in[21], args.out); }
#undef IN
#undef SEAM
}

extern "C" void kernel_launch(void* const* d_in, const int* in_sizes, int n_in, void* d_out, int out_size, void* d_ws, size_t ws_size, hipStream_t stream) {
    static int grid = 0;
    if (grid == 0) {
        if (n_in != 22 || in_sizes[0] != M * D || out_size != M * D || ws_size < WS_END) { fprintf(stderr, "kernel_launch: unexpected shapes (n_in %d, in0 %d, out %d, ws %zu); nothing launched\n", n_in, n_in > 0 ? in_sizes[0] : -1, out_size, ws_size); grid = -1; return; }
        int dev = 0, cus = 0, per_cu = 0;
        if (hipGetDevice(&dev) != hipSuccess || hipDeviceGetAttribute(&cus, hipDeviceAttributeMultiprocessorCount, dev) != hipSuccess) { grid = -1; return; }
        if (hipFuncSetAttribute((const void*)fwd, hipFuncAttributeMaxDynamicSharedMemorySize, LDS_BYTES) != hipSuccess) { fprintf(stderr, "kernel_launch: hipFuncSetAttribute failed\n"); grid = -1; return; }
        if (hipOccupancyMaxActiveBlocksPerMultiprocessor(&per_cu, (const void*)fwd, NWAVES * 64, LDS_BYTES) != hipSuccess || per_cu < 1) fprintf(stderr, "kernel_launch: occupancy query says %d\n", per_cu);
        (void)hipGetLastError();
        grid = cus;
    }
    if (grid < 0) return;
    (void)hipMemsetAsync((char*)d_ws + WS_CTL, 0, CTL_ZERO_BYTES, stream);
    Args a{};
    for (int i = 0; i < 22; ++i) a.in[i] = (const float*)d_in[i];
    a.out = (float*)d_out; a.ws = (unsigned char*)d_ws;
    int li = 0;
    auto run = [&](int lo, int hi) { a.ph_lo = lo; a.ph_hi = hi; a.li = li++; hipLaunchKernelGGL(fwd, dim3(grid), dim3(NWAVES * 64), LDS_BYTES, stream, a); };
    run(0, NPHASE);
}
```

```cpp
#include <hip/hip_runtime.h>
#include <cstdio>
#include <cstdint>
namespace pg8 {
#define PG8_LAS __attribute__((address_space(3)))
typedef unsigned short bf16_t;
typedef short bf16x8 __attribute__((ext_vector_type(8)));
typedef float f32x4 __attribute__((ext_vector_type(4)));
typedef unsigned u32x4 __attribute__((ext_vector_type(4)));
constexpr int BM = 256, BK = 64, HALF = 128, HTB = HALF * BK * 2  , STAGE_BYTES = 8 * HTB, NXCD = 8, WGM = 8;

__host__ __device__ __forceinline__ int lds_byte(int r, int c) { const int st = (r >> 4) * 2 + (c >> 5), rr = r & 15, cc = c & 31, ob = rr * 64 + cc * 2; return st * 1024 + (ob ^ (((ob >> 9) & 1) << 5)); }
__host__ __device__ __forceinline__ void stage_rc(int b, int& R, int& C) { const int st = b / 1024, sb = b % 1024, swz = sb ^ (((sb >> 9) & 1) << 5); R = (st >> 1) * 16 + swz / 64; C = (st & 1) * 32 + (swz % 64) / 2; }
__host__ __device__ __forceinline__ int perm32(int rho) { const int n = rho >> 4, i = rho & 15; return 8 * (i >> 2) + 4 * n + (i & 3); }

struct Unit { int pm, pn; };
struct Gemm { const bf16_t* A; const bf16_t* Bt; int M, N, K; };

struct StaticOrder {
    int nM, nN, nwg, G, c;
    __host__ __device__ void init(int M, int N, int G_, int c_) { nM = M / BM; nN = N / BM; nwg = nM * nN; G = G_; c = c_; }
    __host__ __device__ bool next(int i, Unit& u) const {
        const long L = (long)i * G + c; if (L >= nwg) return false;
        int wgid = (int)L; { const int q = nwg / NXCD, r = nwg % NXCD, xcd = wgid % NXCD, off = wgid / NXCD; wgid = (xcd < r ? xcd * (q + 1) : r * (q + 1) + (xcd - r) * q) + off; }
        const int nig = WGM * nN, gid = wgid / nig, fm = gid * WGM, gsz = (nM - fm) < WGM ? (nM - fm) : WGM;
        u.pm = fm + ((wgid % nig) % gsz); u.pn = (wgid % nig) / gsz; return true;
    }
    __device__ __forceinline__ void a_ready(const Unit&) const {}
    __device__ __forceinline__ void done(const Unit&) const {}
};

__device__ __forceinline__ unsigned cvt_pk_bf16(float lo, float hi) { unsigned r; asm volatile("v_cvt_pk_bf16_f32 %0, %1, %2" : "=v"(r) : "v"(lo), "v"(hi)); return r; }
__device__ __forceinline__ float row_rstd(const float* ssq, int row) {
    const f32x4 a = *(const f32x4*)(ssq + (size_t)row * 4);
    return __builtin_amdgcn_rsqf(((a[0] + a[1]) + (a[2] + a[3])) * (1.0f / 1024.0f) + 1e-6f);
}
__device__ __forceinline__ float log_sigmoid_f(float x) { return fminf(x, 0.f) - log1pf(expf(-fabsf(x))); }
template <int ACT> struct EpiBf16 {
    static constexpr bool PERM = true, AFTER_DRAIN = false;
    bf16_t* O; int ldc; int scale_cols; float scale0; const float* ssq; int gate_tile; float* gates; const float* b_i; const float* b_f;
    __device__ __forceinline__ void operator()(const f32x4 (&acc)[2][2][4][2], const Unit& u, int wr, int wc, int fr, int fq) const {
        const int row0 = u.pm * BM + wr * 64 + fr; const int colt = u.pn * BM;
        const float sc = (colt < scale_cols) ? scale0 : 1.f;
        const int col0 = colt + wc * 32 + 8 * fq;
        float rs[2][4];
#pragma unroll
        for (int ai = 0; ai < 2; ++ai)
#pragma unroll
            for (int m = 0; m < 4; ++m) rs[ai][m] = ssq ? row_rstd(ssq, row0 + ai * HALF + m * 16) * sc : sc;
        if (u.pn == gate_tile) {
            if (wc == 0 && fq == 0) { const f32x4 bi = *(const f32x4*)b_i, bf = *(const f32x4*)b_f;
#pragma unroll
                for (int ai = 0; ai < 2; ++ai)
#pragma unroll
                    for (int m = 0; m < 4; ++m) { const int row = row0 + ai * HALF + m * 16; const f32x4 gi = acc[ai][0][m][0] * rs[ai][m] + bi; f32x4 gf = acc[ai][0][m][1] * rs[ai][m] + bf;
#pragma unroll
                        for (int e = 0; e < 4; ++e) gf[e] = log_sigmoid_f(gf[e]);
                        *(f32x4*)(gates + (size_t)row * 8) = gi; *(f32x4*)(gates + (size_t)row * 8 + 4) = gf; } }
            return;
        }
#pragma unroll
        for (int ai = 0; ai < 2; ++ai)
#pragma unroll
            for (int m = 0; m < 4; ++m) { bf16_t* rowp = O + (size_t)(row0 + ai * HALF + m * 16) * ldc + col0; const float r = rs[ai][m];
#pragma unroll
                for (int bj = 0; bj < 2; ++bj) { f32x4 v0 = acc[ai][bj][m][0] * r, v1 = acc[ai][bj][m][1] * r;
                    if (ACT == 2) {
#pragma unroll
                        for (int e = 0; e < 4; ++e) { const float a = fmaxf(v0[e], 0.f), b = fmaxf(v1[e], 0.f); v0[e] = a * a; v1[e] = b * b; } }
                    u32x4 w; w.x = cvt_pk_bf16(v0[0], v0[1]); w.y = cvt_pk_bf16(v0[2], v0[3]); w.z = cvt_pk_bf16(v1[0], v1[1]); w.w = cvt_pk_bf16(v1[2], v1[3]);
                    *(u32x4*)(rowp + bj * HALF) = w; } }
    }
};
template <bool BASE_F32> struct EpiResNorm {
    static constexpr bool PERM = true, AFTER_DRAIN = false;
    const float* basef; const bf16_t* baseh; bf16_t* xn; float* ssq; int ldc; PG8_LAS float* red;
    __device__ __forceinline__ void operator()(const f32x4 (&acc)[2][2][4][2], const Unit& u, int wr, int wc, int fr, int fq) const {
        const int row0 = u.pm * BM + wr * 64 + fr; const int col0 = u.pn * BM + wc * 32 + 8 * fq;
#pragma unroll
        for (int ai = 0; ai < 2; ++ai)
#pragma unroll
            for (int m = 0; m < 4; ++m) { const int row = row0 + ai * HALF + m * 16; const size_t off = (size_t)row * ldc + col0; float s = 0.f;
#pragma unroll
                for (int bj = 0; bj < 2; ++bj) { f32x4 v0, v1;
                    if (BASE_F32) { v0 = *(const f32x4*)(basef + off + bj * HALF); v1 = *(const f32x4*)(basef + off + bj * HALF + 4); }
                    else { const u32x4 h = *(const u32x4*)(baseh + off + bj * HALF);
                        v0 = (f32x4){__uint_as_float(h.x << 16), __uint_as_float(h.x & 0xffff0000u), __uint_as_float(h.y << 16), __uint_as_float(h.y & 0xffff0000u)};
                        v1 = (f32x4){__uint_as_float(h.z << 16), __uint_as_float(h.z & 0xffff0000u), __uint_as_float(h.w << 16), __uint_as_float(h.w & 0xffff0000u)}; }
                    v0 = v0 + acc[ai][bj][m][0]; v1 = v1 + acc[ai][bj][m][1];
                    s += ((v0[0] * v0[0] + v0[1] * v0[1]) + (v0[2] * v0[2] + v0[3] * v0[3])) + ((v1[0] * v1[0] + v1[1] * v1[1]) + (v1[2] * v1[2] + v1[3] * v1[3]));
                    u32x4 w; w.x = cvt_pk_bf16(v0[0], v0[1]); w.y = cvt_pk_bf16(v0[2], v0[3]); w.z = cvt_pk_bf16(v1[0], v1[1]); w.w = cvt_pk_bf16(v1[2], v1[3]);
                    *(u32x4*)(xn + off + bj * HALF) = w; }
                s += __shfl_xor(s, 16); s += __shfl_xor(s, 32);
                if (fq == 0) red[(ai * HALF + wr * 64 + m * 16 + fr) * 4 + wc] = s; }
        asm volatile("s_waitcnt lgkmcnt(0)" ::: "memory"); __builtin_amdgcn_s_barrier(); asm volatile("" ::: "memory");
        const int t = threadIdx.x;
        if (t < BM) { const f32x4 p = *(const PG8_LAS f32x4*)(red + t * 4); ssq[(size_t)(u.pm * BM + t) * 4 + u.pn] = (p[0] + p[1]) + (p[2] + p[3]); }
    }
};

template <class Epi, class Sched, bool ALIGN_EPI = false, bool SP2 = false>
__device__ __forceinline__ void gemm_phase(PG8_LAS unsigned char* lds, const Gemm g, const Sched& S, const Epi& E) {
    const int tid = threadIdx.x, wid = __builtin_amdgcn_readfirstlane(tid >> 6), lane = tid & 63, wr = wid >> 2, wc = wid & 3, fr = lane & 15, fq = lane >> 4;
    const int K = g.K, nt = K / BK;
    unsigned voffA[2], voffB[2];
#pragma unroll
    for (int i = 0; i < 2; ++i) { int R, C; stage_rc(tid * 16 + i * 8192, R, C); const int Rb = Epi::PERM ? ((R & ~31) + perm32(R & 31)) : R;
        voffA[i] = (unsigned)(R * K + C) * 2u; voffB[i] = (unsigned)(Rb * K + C) * 2u; }
    const size_t kstep = (size_t)(BK * 2);
    const size_t hstep = (size_t)HALF * K * 2;
    const size_t tstep = 2 * hstep;
    const unsigned ldsw = (unsigned)wid * 1024u;
    const int aoff = lds_byte(wr * 64 + fr, fq * 8), boff = lds_byte(wc * 32 + fr, fq * 8);
#define PG8_SA(b, h) (((b) * 2 + (h)) * HTB)
#define PG8_SB(b, h) ((4 + (b) * 2 + (h)) * HTB)
#define PG8_STAGE(bufoff, gbase, voff) do { _Pragma("unroll") for (int _i = 0; _i < 2; ++_i) \
        __builtin_amdgcn_global_load_lds((const unsigned*)((const char*)(gbase) + (voff)[_i]), (PG8_LAS unsigned*)(lds + (bufoff) + ldsw + _i * 8192), 16, 0, 0); } while (0)
#define PG8_LDA(dst, b, h) do { _Pragma("unroll") for (int m = 0; m < 4; ++m) _Pragma("unroll") for (int k = 0; k < 2; ++k) dst[m][k] = *(const PG8_LAS bf16x8*)(lds + PG8_SA(b, h) + aoff + m * 2048 + k * 1024); } while (0)
#define PG8_LDB(dst, b, h) do { _Pragma("unroll") for (int n = 0; n < 2; ++n) _Pragma("unroll") for (int k = 0; k < 2; ++k) dst[n][k] = *(const PG8_LAS bf16x8*)(lds + PG8_SB(b, h) + boff + n * 2048 + k * 1024); } while (0)
#define PG8_MMA(ai, bj, At, Bt) do { __builtin_amdgcn_s_setprio(1); _Pragma("unroll") for (int m = 0; m < 4; ++m) _Pragma("unroll") for (int n = 0; n < 2; ++n) _Pragma("unroll") for (int k = 0; k < 2; ++k) \
        acc[ai][bj][m][n] = __builtin_amdgcn_mfma_f32_16x16x32_bf16(Bt[n][k], At[m][k], acc[ai][bj][m][n], 0, 0, 0); __builtin_amdgcn_s_setprio(0); } while (0)
#define PG8_WAIT_V(n) asm volatile("s_waitcnt vmcnt(" #n ")" ::: "memory")
#define PG8_WAIT_L(n) asm volatile("s_waitcnt lgkmcnt(" #n ")" ::: "memory")
#define PG8_BAR __builtin_amdgcn_s_barrier()
#define PG8_SCHED __builtin_amdgcn_sched_barrier(0)
    Unit cur, nxt; int ui = 0;
    if (!S.next(0, cur)) return;
    f32x4 acc[2][2][4][2];
#pragma unroll
    for (int a = 0; a < 2; ++a)
#pragma unroll
        for (int b = 0; b < 2; ++b)
#pragma unroll
            for (int m = 0; m < 4; ++m)
#pragma unroll
                for (int n = 0; n < 2; ++n) acc[a][b][m][n] = (f32x4){0.f, 0.f, 0.f, 0.f};
    bf16x8 At[4][2], B0[2][2], B1[2][2];
    const char* cA = (const char*)g.A + (size_t)cur.pm * tstep; const char* cB = (const char*)g.Bt + (size_t)cur.pn * tstep;
    S.a_ready(cur);
    if constexpr (SP2) {
        PG8_STAGE(PG8_SB(0, 0), cB, voffB); PG8_STAGE(PG8_SB(0, 1), cB + hstep, voffB); PG8_STAGE(PG8_SA(0, 0), cA, voffA); PG8_STAGE(PG8_SA(0, 1), cA + hstep, voffA);
        if (wr == 1) PG8_BAR;
        PG8_WAIT_V(2); PG8_BAR;
        PG8_STAGE(PG8_SB(1, 0), cB + kstep, voffB); PG8_STAGE(PG8_SA(1, 0), cA + kstep, voffA); PG8_STAGE(PG8_SB(1, 1), cB + hstep + kstep, voffB);
        PG8_WAIT_V(6); PG8_BAR;
    } else {
        PG8_STAGE(PG8_SB(0, 0), cB, voffB); PG8_STAGE(PG8_SA(0, 0), cA, voffA); PG8_STAGE(PG8_SB(0, 1), cB + hstep, voffB); PG8_STAGE(PG8_SA(0, 1), cA + hstep, voffA);
        if (wr == 1) PG8_BAR;
        PG8_WAIT_V(4); PG8_BAR;
        PG8_STAGE(PG8_SB(1, 0), cB + kstep, voffB); PG8_STAGE(PG8_SA(1, 0), cA + kstep, voffA); PG8_STAGE(PG8_SB(1, 1), cB + hstep + kstep, voffB);
        PG8_WAIT_V(6); PG8_BAR;
    }
    for (;;) {
        const bool has_next = S.next(ui + 1, nxt);
        const char* nA = has_next ? (const char*)g.A + (size_t)nxt.pm * tstep : cA; const char* nB = has_next ? (const char*)g.Bt + (size_t)nxt.pn * tstep : cB;
        for (int t = 0; t < nt; t += 2) {
            const bool last = (t == nt - 2);
            const char* a1 = cA + (size_t)(t + 1) * kstep;
            const char* a2 = last ? nA : cA + (size_t)(t + 2) * kstep; const char* b2 = last ? nB : cB + (size_t)(t + 2) * kstep;
            const char* a3 = a2 + kstep; const char* b3 = b2 + kstep;
            if (last && has_next) S.a_ready(nxt);
            if constexpr (SP2) {
            PG8_LDB(B0, 0, 0); PG8_LDB(B1, 0, 1); PG8_SCHED; PG8_LDA(At, 0, 0); PG8_STAGE(PG8_SA(1, 1), a1 + hstep, voffA);
            PG8_WAIT_V(8); PG8_WAIT_L(0); PG8_BAR; PG8_MMA(0, 0, At, B0); PG8_MMA(0, 1, At, B1); PG8_BAR; PG8_SCHED;
            PG8_LDA(At, 0, 1); PG8_STAGE(PG8_SB(0, 0), b2, voffB); PG8_STAGE(PG8_SB(0, 1), b2 + hstep, voffB); PG8_STAGE(PG8_SA(0, 0), a2, voffA);
            PG8_WAIT_V(8); PG8_WAIT_L(0); PG8_BAR; PG8_MMA(1, 0, At, B0); PG8_MMA(1, 1, At, B1); PG8_BAR; PG8_SCHED;
            PG8_LDB(B0, 1, 0); PG8_LDB(B1, 1, 1); PG8_SCHED; PG8_LDA(At, 1, 0); PG8_STAGE(PG8_SA(0, 1), a2 + hstep, voffA);
            PG8_WAIT_V(8); PG8_WAIT_L(0); PG8_BAR; PG8_MMA(0, 0, At, B0); PG8_MMA(0, 1, At, B1); PG8_BAR; PG8_SCHED;
            PG8_LDA(At, 1, 1); PG8_STAGE(PG8_SB(1, 0), b3, voffB); PG8_STAGE(PG8_SB(1, 1), b3 + hstep, voffB); PG8_STAGE(PG8_SA(1, 0), a3, voffA);
            PG8_WAIT_V(8); PG8_WAIT_L(0); PG8_BAR; PG8_MMA(1, 0, At, B0); PG8_MMA(1, 1, At, B1); PG8_BAR; PG8_SCHED;
            } else {
            PG8_LDB(B0, 0, 0); PG8_SCHED; PG8_LDA(At, 0, 0); PG8_STAGE(PG8_SA(1, 1), a1 + hstep, voffA);
            PG8_WAIT_L(8); PG8_BAR; PG8_WAIT_L(0); PG8_MMA(0, 0, At, B0); PG8_BAR; PG8_SCHED;
            PG8_LDB(B1, 0, 1); PG8_STAGE(PG8_SB(0, 0), b2, voffB);
            PG8_BAR; PG8_WAIT_L(0); PG8_MMA(0, 1, At, B1); PG8_BAR;
            PG8_LDA(At, 0, 1); PG8_STAGE(PG8_SA(0, 0), a2, voffA);
            PG8_BAR; PG8_WAIT_L(0); PG8_MMA(1, 0, At, B0); PG8_BAR; PG8_SCHED;
            PG8_STAGE(PG8_SB(0, 1), b2 + hstep, voffB);
            PG8_WAIT_V(6); PG8_BAR; PG8_MMA(1, 1, At, B1); PG8_BAR;
            PG8_LDB(B0, 1, 0); PG8_SCHED; PG8_LDA(At, 1, 0); PG8_STAGE(PG8_SA(0, 1), a2 + hstep, voffA);
            PG8_WAIT_L(8); PG8_BAR; PG8_WAIT_L(0); PG8_MMA(0, 0, At, B0); PG8_BAR; PG8_SCHED;
            PG8_LDB(B1, 1, 1); PG8_STAGE(PG8_SB(1, 0), b3, voffB);
            PG8_BAR; PG8_WAIT_L(0); PG8_MMA(0, 1, At, B1); PG8_BAR;
            PG8_LDA(At, 1, 1); PG8_STAGE(PG8_SA(1, 0), a3, voffA);
            PG8_BAR; PG8_WAIT_L(0); PG8_MMA(1, 0, At, B0); PG8_BAR; PG8_SCHED;
            PG8_STAGE(PG8_SB(1, 1), b3 + hstep, voffB);
            PG8_WAIT_V(6); PG8_BAR; PG8_MMA(1, 1, At, B1); PG8_BAR;
            }
        }
        if constexpr (ALIGN_EPI) { if (wr == 0) PG8_BAR; }
        if constexpr (!Epi::AFTER_DRAIN) { E(acc, cur, wr, wc, fr, fq); S.done(cur); }
        if (!has_next) break;
#pragma unroll
        for (int a = 0; a < 2; ++a)
#pragma unroll
            for (int b = 0; b < 2; ++b)
#pragma unroll
                for (int m = 0; m < 4; ++m)
#pragma unroll
                    for (int n = 0; n < 2; ++n) acc[a][b][m][n] = (f32x4){0.f, 0.f, 0.f, 0.f};
        cur = nxt; cA = nA; cB = nB; ++ui;
        if constexpr (ALIGN_EPI) { if (wr == 1) PG8_BAR; }
    }
    PG8_WAIT_V(0);
    if constexpr (!ALIGN_EPI) { if (wr == 0) PG8_BAR; }
    PG8_BAR;
    if constexpr (Epi::AFTER_DRAIN) { E.fused(acc, cur, wr, wc, fr, fq, lds, wid, lane); S.done(cur); }
#undef PG8_SA
#undef PG8_SB
#undef PG8_STAGE
#undef PG8_LDA
#undef PG8_LDB
#undef PG8_MMA
#undef PG8_WAIT_V
#undef PG8_WAIT_L
#undef PG8_BAR
#undef PG8_SCHED
}
}

#ifndef PG8_SP2
#define PG8_SP2 true
#endif
#ifndef PG8_ALIGN
#define PG8_ALIGN true
#endif
namespace da {
typedef short bf16x8 __attribute__((ext_vector_type(8)));
typedef short s16x4 __attribute__((ext_vector_type(4)));
typedef float f32x16 __attribute__((ext_vector_type(16)));
typedef float f32x4 __attribute__((ext_vector_type(4)));
typedef unsigned u32x4 __attribute__((ext_vector_type(4)));
#define DLAS __attribute__((address_space(3)))
constexpr int NW = 8, QBLK = 32, KVBLK = 64, QB = NW * QBLK, PITCH = 3072;
constexpr int SHM_V = KVBLK * 128 * 2, SHM_K = KVBLK * 64 * 2;
constexpr int OFF_V = 0, OFF_K = 2 * SHM_V, OFF_WS = OFF_K + 2 * SHM_K, OFF_LUT = OFF_WS + NW * 64 * 4, LDS_BYTES = OFF_LUT + 512;
constexpr float THR = 8.f;
#define DA_KSWZ(row, c) ((row) * 128 + ((((c) ^ (((row) >> 1) & 7))) << 4))
#define DA_SBAR() __builtin_amdgcn_sched_barrier(0)
__device__ __forceinline__ int v_st(int k, int c) { const int kk = (k & ~0xC) | ((k & 4) << 1) | ((k & 8) >> 1); return ((kk >> 3) * 4 + (c >> 5)) * 512 + ((kk & 7) * 32 + (c & 31)) * 2; }
__device__ __forceinline__ int v_rd_base(int lane) { return ((lane & 3) << 3) | (((lane >> 2) & 3) << 6) | (((lane >> 4) & 1) << 5) | (((lane >> 5) & 1) << 8); }
constexpr int v_rd_off(int d0, int ks, int half) { return d0 * 512 + ks * 4096 + half * 2048; }
__device__ __forceinline__ int crow(int r, int hi) { return (r & 3) + 8 * (r >> 2) + 4 * hi; }
__device__ __forceinline__ unsigned cvtpk(float lo, float hi) { unsigned r; asm volatile("v_cvt_pk_bf16_f32 %0, %1, %2" : "=v"(r) : "v"(lo), "v"(hi)); return r; }
__device__ __forceinline__ void mask_tile(f32x16& p0, f32x16& p1, int dq) {
    const float NEG = -__builtin_inff();
#pragma unroll
    for (int r = 0; r < 16; ++r) { const int c = (r & 3) + 8 * (r >> 2); if (dq - c < 0) p0[r] = NEG; if (dq - c - 32 < 0) p1[r] = NEG; }
}
__device__ __forceinline__ void bias_tile(f32x16& p0, f32x16& p1, int dq, const DLAS float* lut) {
#pragma unroll
    for (int g = 0; g < 4; ++g) {
#pragma unroll
        for (int rr = 0; rr < 4; ++rr) { const int r = g * 4 + rr; const int c = (r & 3) + 8 * (r >> 2);
            int i0 = dq - c; i0 = i0 < 0 ? 0 : (i0 > 127 ? 127 : i0); int i1 = dq - c - 32; i1 = i1 < 0 ? 0 : (i1 > 127 ? 127 : i1);
            p0[r] += lut[i0]; p1[r] += lut[i1]; }
        DA_SBAR();
    }
}
__device__ __forceinline__ void partialSM(f32x16& p0, f32x16& p1, float& m_reg, float& alpha, float cb) {
    float pmax = p0[0];
#pragma unroll
    for (int r = 1; r < 16; ++r) pmax = fmaxf(pmax, p0[r]);
#pragma unroll
    for (int r = 0; r < 16; ++r) pmax = fmaxf(pmax, p1[r]);
    { auto rr = __builtin_amdgcn_permlane32_swap(__float_as_uint(pmax), __float_as_uint(pmax), false, false);
      pmax = fmaxf(__uint_as_float(rr[0]), __uint_as_float(rr[1])); }
    pmax += cb;
    float mn;
    if (__builtin_expect(__all(pmax - m_reg <= THR), 1)) { mn = m_reg; alpha = 1.f; }
    else { mn = fmaxf(m_reg, pmax); alpha = __builtin_amdgcn_exp2f(m_reg - mn); m_reg = mn; }
    const float off = cb - mn;
#pragma unroll
    for (int r = 0; r < 16; ++r) p0[r] += off;
#pragma unroll
    for (int r = 0; r < 16; ++r) p1[r] += off;
#pragma unroll
    for (int r = 0; r < 16; ++r) p0[r] = __builtin_amdgcn_exp2f(p0[r]);
}
__device__ __forceinline__ void finishSM(f32x16& p0, f32x16& p1, float alpha, float& l_reg, bf16x8& pa0, bf16x8& pa1, bf16x8& pa2, bf16x8& pa3) {
#pragma unroll
    for (int r = 0; r < 16; ++r) p1[r] = __builtin_amdgcn_exp2f(p1[r]);
    float ps = 0;
#pragma unroll
    for (int r = 0; r < 16; ++r) ps += p0[r];
#pragma unroll
    for (int r = 0; r < 16; ++r) ps += p1[r];
    { auto rr = __builtin_amdgcn_permlane32_swap(__float_as_uint(ps), __float_as_uint(ps), false, false);
      ps = __uint_as_float(rr[0]) + __uint_as_float(rr[1]); }
    l_reg = l_reg * alpha + ps;
#define DA_PK4(P, B_, OUT) do { unsigned a0 = cvtpk(P[B_+0], P[B_+1]), a1 = cvtpk(P[B_+2], P[B_+3]);                          \
        unsigned b0 = cvtpk(P[B_+4], P[B_+5]), b1 = cvtpk(P[B_+6], P[B_+7]);                                             \
        auto r0 = __builtin_amdgcn_permlane32_swap(a0, b0, false, false); auto r1 = __builtin_amdgcn_permlane32_swap(a1, b1, false, false); \
        u32x4 w = {r0[0], r1[0], r0[1], r1[1]}; OUT = *reinterpret_cast<bf16x8*>(&w); } while (0)
    DA_PK4(p0, 0, pa0); DA_PK4(p0, 8, pa1); DA_PK4(p1, 0, pa2); DA_PK4(p1, 8, pa3);
#undef DA_PK4
}
template <int KB>
__device__ __forceinline__ void qkt(f32x16& p0, f32x16& p1, const DLAS char* K_lds, int r32, int hi, const bf16x8* qr) {
    p0 = f32x16{}; p1 = f32x16{};
#pragma unroll
    for (int d0 = 0; d0 < 4; ++d0) { const DLAS char* a = K_lds + KB * SHM_K + DA_KSWZ(r32, d0 * 2 + hi);
        const bf16x8 b0 = *reinterpret_cast<const DLAS bf16x8*>(a);
        const bf16x8 b1 = *reinterpret_cast<const DLAS bf16x8*>(a + 32 * 128);
        p0 = __builtin_amdgcn_mfma_f32_32x32x16_bf16(b0, qr[d0], p0, 0, 0, 0);
        p1 = __builtin_amdgcn_mfma_f32_32x32x16_bf16(b1, qr[d0], p1, 0, 0, 0); }
}
template <int VB>
__device__ __forceinline__ void pv_tile(f32x16* o, int vb0, bf16x8 pa0, bf16x8 pa1, bf16x8 pa2, bf16x8 pa3) {
#define DA_TRRD(dst, off) asm volatile("ds_read_b64_tr_b16 %0, %1 offset:%2" : "=&v"(dst) : "v"(vb0), "i"(off) : "memory")
#define DA_PV_D0(d0) do { s16x4 l0, l1, l2, l3, h0, h1, h2, h3; constexpr int b_ = VB * SHM_V + v_rd_off(d0, 0, 0); \
        DA_TRRD(l0, b_); DA_TRRD(h0, b_ + 2048); DA_TRRD(l1, b_ + 4096); DA_TRRD(h1, b_ + 6144); DA_TRRD(l2, b_ + 8192); DA_TRRD(h2, b_ + 10240); DA_TRRD(l3, b_ + 12288); DA_TRRD(h3, b_ + 14336); \
        asm volatile("s_waitcnt lgkmcnt(0)" ::: "memory"); DA_SBAR();   \
        o[d0] = __builtin_amdgcn_mfma_f32_32x32x16_bf16(pa0, (bf16x8){l0[0], l0[1], l0[2], l0[3], h0[0], h0[1], h0[2], h0[3]}, o[d0], 0, 0, 0);   \
        o[d0] = __builtin_amdgcn_mfma_f32_32x32x16_bf16(pa1, (bf16x8){l1[0], l1[1], l1[2], l1[3], h1[0], h1[1], h1[2], h1[3]}, o[d0], 0, 0, 0);   \
        o[d0] = __builtin_amdgcn_mfma_f32_32x32x16_bf16(pa2, (bf16x8){l2[0], l2[1], l2[2], l2[3], h2[0], h2[1], h2[2], h2[3]}, o[d0], 0, 0, 0);   \
        o[d0] = __builtin_amdgcn_mfma_f32_32x32x16_bf16(pa3, (bf16x8){l3[0], l3[1], l3[2], l3[3], h3[0], h3[1], h3[2], h3[3]}, o[d0], 0, 0, 0); } while (0)
    DA_PV_D0(0); DA_PV_D0(1); DA_PV_D0(2); DA_PV_D0(3);
#undef DA_PV_D0
#undef DA_TRRD
}
__device__ __forceinline__ void attn_block(const unsigned short* __restrict__ Qp, const unsigned short* __restrict__ Kp, const unsigned short* __restrict__ Vp, int P0, DLAS char* lds, float c31, f32x16 (&o)[4]) {
    const int tid = threadIdx.x, wid = __builtin_amdgcn_readfirstlane(tid >> 6), lane = tid & 63, r32 = lane & 31, hi = lane >> 5;
    const int NT = (P0 + QB) / KVBLK;
    const int qlo = P0 + wid * QBLK, qm = qlo + r32 - 4 * hi;
    DLAS char* V_lds = lds + OFF_V; DLAS char* K_lds = lds + OFF_K;
    DLAS float* wsf = (DLAS float*)(lds + OFF_WS) + wid * 64; DLAS float* li_l = wsf; DLAS float* al_l = wsf + 32;
    const DLAS float* lut = (const DLAS float*)(lds + OFF_LUT);
    float m_reg = -1e30f, l_reg = 0.f;
#pragma unroll
    for (int d = 0; d < 4; ++d) o[d] = f32x16{};
    const int sr = tid >> 4, sc = (tid & 15) * 8, vst0 = v_st(sr, sc), vst1 = v_st(32 + sr, sc);
    const int kr = tid >> 3, kc = tid & 7, kws = DA_KSWZ(kr, kc);
    const int vb0 = (int)(uintptr_t)V_lds + v_rd_base(lane);
    bf16x8 qr[4];
#pragma unroll
    for (int d0 = 0; d0 < 4; ++d0) qr[d0] = *reinterpret_cast<const bf16x8*>(Qp + (size_t)(wid * QBLK + r32) * PITCH + d0 * 16 + hi * 8);
    bf16x8 st_v0, st_v1, st_k0;
#define DA_VMW() asm volatile("s_waitcnt vmcnt(0)" ::: "memory")
#define DA_SLOAD(k0) do { st_v0 = *reinterpret_cast<const bf16x8*>(Vp + (size_t)((k0) + sr) * PITCH + sc); st_v1 = *reinterpret_cast<const bf16x8*>(Vp + (size_t)((k0) + 32 + sr) * PITCH + sc); \
                          st_k0 = *reinterpret_cast<const bf16x8*>(Kp + (size_t)((k0) + kr) * PITCH + kc * 8); } while (0)
#define DA_SWRITE(bf) do { *reinterpret_cast<DLAS bf16x8*>(V_lds + (bf) * SHM_V + vst0) = st_v0; *reinterpret_cast<DLAS bf16x8*>(V_lds + (bf) * SHM_V + vst1) = st_v1; \
                           *reinterpret_cast<DLAS bf16x8*>(K_lds + (bf) * SHM_K + kws) = st_k0; } while (0)
#define DA_RESC(a) do { if (__any((a) < 1.f)) { if (hi == 0) al_l[r32] = (a); asm volatile("s_waitcnt lgkmcnt(0)" ::: "memory");              \
                        _Pragma("unroll") for (int d_ = 0; d_ < 4; ++d_) _Pragma("unroll") for (int r = 0; r < 16; ++r) o[d_][r] *= al_l[crow(r, hi)]; } } while (0)
#define DA_BIASMASK(P0_, P1_, t, cbv) do { const int kb_ = (t) * KVBLK; if (kb_ + KVBLK - 1 + 128 > qlo) { bias_tile(P0_, P1_, qm - kb_, lut); cbv = 0.f; if (kb_ + KVBLK - 1 > qlo) mask_tile(P0_, P1_, qm - kb_); } else cbv = c31; } while (0)
    f32x16 pA0, pA1, pB0, pB1; float alA, alB, cbA, cbB; bf16x8 pa0, pa1, pa2, pa3;
    DA_SLOAD(0); DA_VMW(); DA_SWRITE(0); DA_SBAR();
    DA_SLOAD(KVBLK);
    __syncthreads();
    DA_SBAR(); qkt<0>(pA0, pA1, K_lds, r32, hi, qr);
    DA_BIASMASK(pA0, pA1, 0, cbA); partialSM(pA0, pA1, m_reg, alA, cbA);
    DA_VMW(); DA_SWRITE(1);
    __syncthreads();
#define DA_HALF_STEP(PX0, PX1, alX, cbX, PY0, PY1, alY, t, KB, VB, SB) do {                                                      \
        DA_SBAR(); qkt<KB>(PX0, PX1, K_lds, r32, hi, qr);                                             \
        finishSM(PY0, PY1, alY, l_reg, pa0, pa1, pa2, pa3); DA_SBAR();                                                           \
        DA_SLOAD(((t) + 1) * KVBLK); DA_SBAR();                                               \
        pv_tile<VB>(o, vb0, pa0, pa1, pa2, pa3); DA_BIASMASK(PX0, PX1, (t), cbX); partialSM(PX0, PX1, m_reg, alX, cbX);                                        \
        __syncthreads();                                                                                                      \
        DA_VMW(); DA_SWRITE(SB);                                                                          \
        DA_RESC(alX); __syncthreads(); } while (0)
    for (int t = 1; t + 1 < NT; t += 2) {
        DA_HALF_STEP(pB0, pB1, alB, cbB, pA0, pA1, alA, t, 1, 0, 0);
        DA_HALF_STEP(pA0, pA1, alA, cbA, pB0, pB1, alB, t + 1, 0, 1, 1);
    }
    DA_SBAR(); qkt<1>(pB0, pB1, K_lds, r32, hi, qr); DA_SBAR();
    finishSM(pA0, pA1, alA, l_reg, pa0, pa1, pa2, pa3); DA_SBAR();
    pv_tile<0>(o, vb0, pa0, pa1, pa2, pa3);
    DA_BIASMASK(pB0, pB1, NT - 1, cbB); partialSM(pB0, pB1, m_reg, alB, cbB); DA_RESC(alB);
    finishSM(pB0, pB1, alB, l_reg, pa0, pa1, pa2, pa3); DA_SBAR(); pv_tile<1>(o, vb0, pa0, pa1, pa2, pa3);
    if (hi == 0) li_l[r32] = l_reg; asm volatile("s_waitcnt lgkmcnt(0)" ::: "memory");
#pragma unroll
    for (int r = 0; r < 16; ++r) { const float rl = __builtin_amdgcn_rcpf(li_l[crow(r, hi)]);
#pragma unroll
        for (int d0 = 0; d0 < 4; ++d0) o[d0][r] *= rl; }
    __syncthreads();
#undef DA_VMW
#undef DA_SLOAD
#undef DA_SWRITE
#undef DA_RESC
#undef DA_BIASMASK
#undef DA_HALF_STEP
}
}
static_assert(da::LDS_BYTES <= 131072, "attention LDS inside the ring region");
constexpr int NWAVES = 8;
#ifndef MK_N_LAUNCHES
#define MK_N_LAUNCHES 1
#endif
constexpr int BATCH = 16, SEQ = 2048, D = 1024, FF = 4096, M = BATCH * SEQ;
constexpr int NQKV = 3072;
constexpr int MLW = 3080, NPROJ = 3072;
constexpr int NH_A = 8, NH_M = 4;
constexpr float EPS = 1e-6f, LOG2E = 1.4426950408889634f;
constexpr float QSCALE = 0.125f * LOG2E;
constexpr float LAMBDA_INIT0 = 0.2f;
constexpr float MQSCALE = 0.08838834764831845f;
constexpr int NPHASE = 16;
constexpr int DUP_PHASE = -1;

namespace ml {
typedef short bf16x8 __attribute__((ext_vector_type(8)));
typedef short s16x4 __attribute__((ext_vector_type(4)));
typedef float f32x16 __attribute__((ext_vector_type(16)));
typedef float f32x4 __attribute__((ext_vector_type(4)));
typedef unsigned u32x4 __attribute__((ext_vector_type(4)));
typedef unsigned u32x2 __attribute__((ext_vector_type(2)));
#define MLAS __attribute__((address_space(3)))
constexpr int L = 64, NC = 2048 / L, PITCH = 3072;
constexpr int PQ = 272, PS = 144;
constexpr int O_Q = 0, O_K = O_Q + 64 * PQ, O_C = O_K + 64 * PQ, O_KW = O_C + 64 * PQ, O_V = O_KW + 16384, O_SC = O_V + 16384, O_ARR = O_SC + 64 * PS, O_NP = O_ARR + 9 * 256, O_N = O_NP + 4096, LDS_BYTES = O_N + 512;
enum { A_E = 0, A_BM = 64, A_INTER = 128, A_EMJ = 192, A_WP = 256, A_RS0 = 320, A_RS1 = 384, A_QN = 448, A_SCAL = 512 };
__device__ __forceinline__ float bf2f_lo(unsigned w) { return __uint_as_float(w << 16); }
__device__ __forceinline__ float bf2f_hi(unsigned w) { return __uint_as_float(w & 0xffff0000u); }
typedef float f32x2_t __attribute__((ext_vector_type(2))); typedef __bf16 bf16x2_t __attribute__((ext_vector_type(2)));
__device__ __forceinline__ unsigned cvtpk(float lo, float hi) { f32x2_t v = {lo, hi}; bf16x2_t b = __builtin_convertvector(v, bf16x2_t); return __builtin_bit_cast(unsigned, b); }
__device__ __forceinline__ int crow(int r, int hi) { return (r & 3) + 8 * (r >> 2) + 4 * hi; }
__device__ __forceinline__ int v_st(int k, int c) { const int kk = (k & ~0xC) | ((k & 4) << 1) | ((k & 8) >> 1); return ((kk >> 3) * 4 + (c >> 5)) * 512 + ((kk & 7) * 32 + (c & 31)) * 2; }
__device__ __forceinline__ int v_rd_base(int lane) { return ((lane & 3) << 3) | (((lane >> 2) & 3) << 6) | (((lane >> 4) & 1) << 5) | (((lane >> 5) & 1) << 8); }
#define ML_TRRD(dst, base, off) asm volatile("ds_read_b64_tr_b16 %0, %1 offset:%2" : "=&v"(dst) : "v"(base), "i"(off) : "memory")
#define ML_SBAR() __builtin_amdgcn_sched_barrier(0)
#define ML_FR(lo, hi_) (bf16x8){lo[0], lo[1], lo[2], lo[3], hi_[0], hi_[1], hi_[2], hi_[3]}
struct Pre { bf16x8 q[2], k[2], v; f32x4 g; };

__device__ __forceinline__ void mlstm_unit(int b, int h, int s4, const unsigned short* __restrict__ PROJ, const unsigned short* __restrict__ QKC, const float* __restrict__ GS,
                                           unsigned short* HT, float* SSQ, MLAS char* lds) {
    const int tid = threadIdx.x, wid = __builtin_amdgcn_readfirstlane(tid >> 6), lane = tid & 63, r32 = lane & 31, hi = lane >> 5;
    MLAS char* QIMG = lds + O_Q; MLAS char* KIMG = lds + O_K; MLAS char* CIMG = lds + O_C; MLAS char* KWTR = lds + O_KW; MLAS char* VTR = lds + O_V; MLAS char* SC = lds + O_SC;
    MLAS float* arr = (MLAS float*)(lds + O_ARR); MLAS float* npart = (MLAS float*)(lds + O_NP); MLAS float* nvec = (MLAS float*)(lds + O_N);
    const int srow = tid >> 4, cg = tid & 15;
    const int vrow = tid >> 3, vcol = (tid & 7) * 8;
    const size_t tok0 = (size_t)b * 2048;
    const unsigned short* xq = QKC + tok0 * 1024 + h * 128 + cg * 8;
    const unsigned short* xk = xq + 512;
    const unsigned short* xv = PROJ + tok0 * PITCH + 1024 + h * 256 + s4 * 64 + vcol;
    const float* gs = GS + tok0 * 16 + h * 4;
    const int dkb = wid >> 1, dvb = wid & 1;
    const int tb0 = (wid & 3) >> 1, jb = wid & 1;
    f32x16 cst = f32x16{};
    float m_prev = 0.f;
    for (int i = tid; i < (64 * PQ) / 16; i += 512) ((MLAS u32x4*)CIMG)[i] = (u32x4){0u, 0u, 0u, 0u};
    if (tid < 128) nvec[tid] = 0.f;
    Pre P;
#define ML_LOAD(t0_) do { P.q[0] = *reinterpret_cast<const bf16x8*>(xq + (size_t)((t0_) + srow) * 1024); P.q[1] = *reinterpret_cast<const bf16x8*>(xq + (size_t)((t0_) + srow + 32) * 1024); \
        P.k[0] = *reinterpret_cast<const bf16x8*>(xk + (size_t)((t0_) + srow) * 1024); P.k[1] = *reinterpret_cast<const bf16x8*>(xk + (size_t)((t0_) + srow + 32) * 1024); \
        P.v = *reinterpret_cast<const bf16x8*>(xv + (size_t)((t0_) + vrow) * PITCH); P.g = *reinterpret_cast<const f32x4*>(gs + (size_t)((t0_) + lane) * 16); } while (0)
    ML_LOAD(0);
    u32x2 dst_w[4] = {}; float dst_ss = 0.f;
    const int trb_kw = (int)(uintptr_t)KWTR + v_rd_base(lane), trb_v = (int)(uintptr_t)VTR + v_rd_base(lane);
    __syncthreads();
    for (int c = 0; c < NC; ++c) {
        const int t0 = c * L;
        const float bsum = P.g[0], e = P.g[1], pm = P.g[2];
        asm volatile("" :: "v"(P.g[3]));
        const float b_last = __int_as_float(__builtin_amdgcn_readlane(__float_as_int(bsum), 63)), m_loc = b_last + __int_as_float(__builtin_amdgcn_readlane(__float_as_int(pm), 63));
        const float m_new = fmaxf(b_last + m_prev, m_loc), decay = __expf(b_last + m_prev - m_new);
        const float wp = __expf(b_last + e - m_new);
        const float m_inter = bsum + m_prev, m_j = fmaxf(m_inter, bsum + pm);
        if (wid == 0) { arr[A_E + lane] = e; arr[A_BM + lane] = bsum - m_j; arr[A_INTER + lane] = __expf(m_inter - m_j); arr[A_EMJ + lane] = __expf(-m_j); arr[A_WP + lane] = wp; }
        m_prev = m_new;
#pragma unroll
        for (int i = 0; i < 2; ++i) { const int row = srow + 32 * i; const float wrow = __shfl(wp, row);
            *reinterpret_cast<MLAS bf16x8*>(QIMG + row * PQ + cg * 16) = P.q[i];
            *reinterpret_cast<MLAS bf16x8*>(KIMG + row * PQ + cg * 16) = P.k[i];
            const u32x4 kw = __builtin_bit_cast(u32x4, P.k[i]); u32x4 ow;
#pragma unroll
            for (int q = 0; q < 4; ++q) ow[q] = cvtpk(bf2f_lo(kw[q]) * wrow, bf2f_hi(kw[q]) * wrow);
            *reinterpret_cast<MLAS u32x4*>(KWTR + v_st(row, cg * 8)) = ow; }
        *reinterpret_cast<MLAS bf16x8*>(VTR + v_st(vrow, vcol)) = P.v;
        __syncthreads();
#define ML_STORE_OUT(tt) do { if (wid >= 4) { const int j_ = 32 * jb + r32; unsigned short* hp_ = HT + (tok0 + (tt) + j_) * 1024 + h * 256 + s4 * 64 + 32 * tb0 + 4 * hi; \
            _Pragma("unroll") for (int q4 = 0; q4 < 4; ++q4) *reinterpret_cast<u32x2*>(hp_ + 8 * q4) = dst_w[q4]; \
            if (hi == 0) SSQ[(tok0 + (tt) + j_) * 32 + h * 8 + s4 * 2 + tb0] = dst_ss; } } while (0)
        if (c > 0) ML_STORE_OUT(t0 - L);
        { const int tn = (c + 1 < NC) ? t0 + L : t0; ML_LOAD(tn); }
        f32x16 acc_qc = f32x16{};
        if (wid < 4) {
            f32x16 g = f32x16{};
            if (!(tb0 == 1 && jb == 0)) {
                const MLAS char* ka = KIMG + (32 * tb0 + r32) * PQ + hi * 16; const MLAS char* qa = QIMG + (32 * jb + r32) * PQ + hi * 16;
bf16x8 fa[8], fb[8];
#pragma unroll
                for (int kk = 0; kk < 8; ++kk) { fa[kk] = *reinterpret_cast<const MLAS bf16x8*>(ka + kk * 32); fb[kk] = *reinterpret_cast<const MLAS bf16x8*>(qa + kk * 32); }
                ML_SBAR();
#pragma unroll
                for (int kk = 0; kk < 8; ++kk) g = __builtin_amdgcn_mfma_f32_32x32x16_bf16(fa[kk], fb[kk], g, 0, 0, 0);
            }
            const int j = 32 * jb + r32; const float bm = arr[A_BM + j]; float rsum = 0.f;
#pragma unroll
            for (int q4 = 0; q4 < 4; ++q4) { const f32x4 ev = *reinterpret_cast<const MLAS f32x4*>(arr + A_E + 32 * tb0 + 8 * q4 + 4 * hi);
                float sc4[4];
#pragma unroll
                for (int i = 0; i < 4; ++i) { const int s = 32 * tb0 + 8 * q4 + 4 * hi + i; const float v = (s <= j) ? g[4 * q4 + i] * __expf(bm + ev[i]) : 0.f; sc4[i] = v; rsum += v; }
                const u32x2 w = {cvtpk(sc4[0], sc4[1]), cvtpk(sc4[2], sc4[3])};
                *reinterpret_cast<MLAS u32x2*>(SC + j * PS + (32 * tb0 + 8 * q4 + 4 * hi) * 2) = w; }
            rsum += __shfl_xor(rsum, 32);
            if (hi == 0) arr[(tb0 ? A_RS1 : A_RS0) + j] = rsum;
        } else {
            const MLAS char* ca = CIMG + (32 * tb0 + r32) * PQ + hi * 16; const MLAS char* qa = QIMG + (32 * jb + r32) * PQ + hi * 16;
bf16x8 fa[8], fb[8];
#pragma unroll
            for (int kk = 0; kk < 8; ++kk) { fa[kk] = *reinterpret_cast<const MLAS bf16x8*>(ca + kk * 32); fb[kk] = *reinterpret_cast<const MLAS bf16x8*>(qa + kk * 32); }
            ML_SBAR();
#pragma unroll
            for (int kk = 0; kk < 8; ++kk) acc_qc = __builtin_amdgcn_mfma_f32_32x32x16_bf16(fa[kk], fb[kk], acc_qc, 0, 0, 0);
        }
        {
            const int j = tid >> 3, part = tid & 7;
            const u32x4 q0 = *reinterpret_cast<const MLAS u32x4*>(QIMG + j * PQ + part * 32), q1 = *reinterpret_cast<const MLAS u32x4*>(QIMG + j * PQ + part * 32 + 16);
            float s = 0.f;
#pragma unroll
            for (int q = 0; q < 4; ++q) { const f32x4 n4 = *reinterpret_cast<const MLAS f32x4*>(nvec + part * 16 + 4 * q);
                const unsigned w0 = q < 2 ? q0[2 * q] : q1[2 * q - 4], w1 = q < 2 ? q0[2 * q + 1] : q1[2 * q - 3];
                s += bf2f_lo(w0) * n4[0] + bf2f_hi(w0) * n4[1] + bf2f_lo(w1) * n4[2] + bf2f_hi(w1) * n4[3]; }
            s += __shfl_xor(s, 1); s += __shfl_xor(s, 2); s += __shfl_xor(s, 4);
            if (part == 0) arr[A_QN + j] = s;
            float n0 = 0.f, n1 = 0.f;
#pragma unroll
            for (int i = 0; i < 8; ++i) { const int srow = 8 * wid + i; const unsigned kw = *reinterpret_cast<const MLAS unsigned*>(KIMG + srow * PQ + lane * 4); const float w = arr[A_WP + srow];
                n0 += w * bf2f_lo(kw); n1 += w * bf2f_hi(kw); }
            npart[wid * 128 + 2 * lane] = n0; npart[wid * 128 + 2 * lane + 1] = n1;
        }
        __syncthreads();
        if (wid >= 4) {
            f32x16 acc_n = f32x16{};
            const MLAS char* sa = SC + (32 * jb + r32) * PS + hi * 16;
            {   s16x4 l0, l1, l2, l3, h0, h1, h2, h3;
                if (tb0 == 0) { ML_TRRD(l0, trb_v, 0); ML_TRRD(h0, trb_v, 2048); ML_TRRD(l1, trb_v, 4096); ML_TRRD(h1, trb_v, 6144); ML_TRRD(l2, trb_v, 8192); ML_TRRD(h2, trb_v, 10240); ML_TRRD(l3, trb_v, 12288); ML_TRRD(h3, trb_v, 14336); }
                else { ML_TRRD(l0, trb_v, 512); ML_TRRD(h0, trb_v, 512 + 2048); ML_TRRD(l1, trb_v, 512 + 4096); ML_TRRD(h1, trb_v, 512 + 6144); ML_TRRD(l2, trb_v, 512 + 8192); ML_TRRD(h2, trb_v, 512 + 10240); ML_TRRD(l3, trb_v, 512 + 12288); ML_TRRD(h3, trb_v, 512 + 14336); }
                const bf16x8 s0 = *reinterpret_cast<const MLAS bf16x8*>(sa), s1 = *reinterpret_cast<const MLAS bf16x8*>(sa + 32), s2 = *reinterpret_cast<const MLAS bf16x8*>(sa + 64), s3 = *reinterpret_cast<const MLAS bf16x8*>(sa + 96);
                asm volatile("s_waitcnt lgkmcnt(0)" ::: "memory"); ML_SBAR();
                acc_n = __builtin_amdgcn_mfma_f32_32x32x16_bf16(ML_FR(l0, h0), s0, acc_n, 0, 0, 0);
                acc_n = __builtin_amdgcn_mfma_f32_32x32x16_bf16(ML_FR(l1, h1), s1, acc_n, 0, 0, 0);
                acc_n = __builtin_amdgcn_mfma_f32_32x32x16_bf16(ML_FR(l2, h2), s2, acc_n, 0, 0, 0);
                acc_n = __builtin_amdgcn_mfma_f32_32x32x16_bf16(ML_FR(l3, h3), s3, acc_n, 0, 0, 0); }
            const int j = 32 * jb + r32; const float inter = arr[A_INTER + j];
            const float den = arr[A_RS0 + j] + arr[A_RS1 + j] + inter * arr[A_QN + j];
            const float rden = 1.f / fmaxf(fabsf(den), arr[A_EMJ + j]);
            float ss = 0.f;
#pragma unroll
            for (int q4 = 0; q4 < 4; ++q4) { float hv[4];
#pragma unroll
                for (int i = 0; i < 4; ++i) { hv[i] = (acc_n[4 * q4 + i] + inter * acc_qc[4 * q4 + i]) * rden; ss += hv[i] * hv[i]; }
                dst_w[q4] = (u32x2){cvtpk(hv[0], hv[1]), cvtpk(hv[2], hv[3])}; }
            ss += __shfl_xor(ss, 32);
            dst_ss = ss;
        }
        {
            s16x4 al[4], ah[4], bl[4], bh[4];
#define ML_LD4(d0k, d0v) do { ML_TRRD(al[0], trb_kw, (d0k) * 512); ML_TRRD(ah[0], trb_kw, (d0k) * 512 + 2048); ML_TRRD(al[1], trb_kw, (d0k) * 512 + 4096); ML_TRRD(ah[1], trb_kw, (d0k) * 512 + 6144); \
            ML_TRRD(al[2], trb_kw, (d0k) * 512 + 8192); ML_TRRD(ah[2], trb_kw, (d0k) * 512 + 10240); ML_TRRD(al[3], trb_kw, (d0k) * 512 + 12288); ML_TRRD(ah[3], trb_kw, (d0k) * 512 + 14336); \
            ML_TRRD(bl[0], trb_v, (d0v) * 512); ML_TRRD(bh[0], trb_v, (d0v) * 512 + 2048); ML_TRRD(bl[1], trb_v, (d0v) * 512 + 4096); ML_TRRD(bh[1], trb_v, (d0v) * 512 + 6144); \
            ML_TRRD(bl[2], trb_v, (d0v) * 512 + 8192); ML_TRRD(bh[2], trb_v, (d0v) * 512 + 10240); ML_TRRD(bl[3], trb_v, (d0v) * 512 + 12288); ML_TRRD(bh[3], trb_v, (d0v) * 512 + 14336); } while (0)
            switch (wid) { case 0: ML_LD4(0, 0); break; case 1: ML_LD4(0, 1); break; case 2: ML_LD4(1, 0); break; case 3: ML_LD4(1, 1); break;
                           case 4: ML_LD4(2, 0); break; case 5: ML_LD4(2, 1); break; case 6: ML_LD4(3, 0); break; default: ML_LD4(3, 1); break; }
#undef ML_LD4
#pragma unroll
            for (int r = 0; r < 16; ++r) cst[r] *= decay;
            asm volatile("s_waitcnt lgkmcnt(0)" ::: "memory"); ML_SBAR();
#pragma unroll
            for (int ks = 0; ks < 4; ++ks) cst = __builtin_amdgcn_mfma_f32_32x32x16_bf16(ML_FR(al[ks], ah[ks]), ML_FR(bl[ks], bh[ks]), cst, 0, 0, 0);
            const int dv = 32 * dvb + r32;
#pragma unroll
            for (int q4 = 0; q4 < 4; ++q4) { const u32x2 w = {cvtpk(cst[4 * q4], cst[4 * q4 + 1]), cvtpk(cst[4 * q4 + 2], cst[4 * q4 + 3])};
                *reinterpret_cast<MLAS u32x2*>(CIMG + dv * PQ + (32 * dkb + 8 * q4 + 4 * hi) * 2) = w; }
        }
        if (tid < 128) { float s = nvec[tid] * decay;
#pragma unroll
            for (int w = 0; w < 8; ++w) s += npart[w * 128 + tid];
            nvec[tid] = s; }
        __syncthreads();
    }
    ML_STORE_OUT((NC - 1) * L);
#undef ML_STORE_OUT
#undef ML_LOAD
}
}
static_assert(ml::LDS_BYTES <= 131072, "mLSTM LDS inside the ring region");
constexpr size_t MiB = 1u << 20;
constexpr size_t WS_CTL = 0, CTL_ZERO_BYTES = 1 * MiB;
constexpr size_t WS_WQKV = 2 * MiB, WS_WAO = 8 * MiB, WS_WML = 10 * MiB  , WS_WMO = 17 * MiB, WS_W1 = 19 * MiB  , WS_W2 = 35 * MiB  ;
constexpr size_t WS_GATES = 51 * MiB;
constexpr size_t WS_SSQ = 52 * MiB;
constexpr size_t WS_GS = 56 * MiB;
constexpr size_t WS_SSQH = 58 * MiB;
constexpr size_t WS_XN = 64 * MiB;
constexpr size_t WS_U = 128 * MiB;
constexpr size_t WS_HT = 320 * MiB;
constexpr size_t WS_AO = 384 * MiB;
constexpr size_t WS_STASH = 448 * MiB;
constexpr size_t WS_END = 480 * MiB;
constexpr int CW_TMO = 0, CW_CODE = 1;
constexpr int CW_BAR = 4096;
constexpr int RING_OFF = 0, RING_BYTES = 131072;
constexpr int LDSCTL_OFF = RING_BYTES, MISC_OFF = LDSCTL_OFF + 320;
constexpr int EPIRED_OFF = LDSCTL_OFF + 1024;
constexpr int LDS_BYTES = 147456;
static_assert(MISC_OFF + 128 <= LDS_BYTES, "LDS map");

#define GAS __attribute__((address_space(1)))
#define LAS __attribute__((address_space(3)))
typedef unsigned short bf16;
typedef unsigned v4u __attribute__((ext_vector_type(4)));
typedef float f32x4 __attribute__((ext_vector_type(4)));
typedef short bf16x8 __attribute__((ext_vector_type(8)));
typedef GAS unsigned gu32;
typedef GAS unsigned long long gu64;
#define RLX_AGENT __ATOMIC_RELAXED, __HIP_MEMORY_SCOPE_AGENT
#define LDS_WAIT() asm volatile("s_waitcnt lgkmcnt(0)" ::: "memory")
#define VM_WAIT() asm volatile("s_waitcnt vmcnt(0)" ::: "memory")
__device__ __forceinline__ unsigned long long rt() { return __builtin_amdgcn_s_memrealtime(); }
__device__ __forceinline__ unsigned f2bf(float f) { unsigned u = __builtin_bit_cast(unsigned, f); return (u + 0x7fffu + ((u >> 16) & 1u)) >> 16; }
__device__ __forceinline__ unsigned pk2(float lo, float hi) { return f2bf(lo) | (f2bf(hi) << 16); }

#define XB_TMO      128
#define XB_XCNT(j)  (256  + 64 * (j))
#define XB_XSUB(j)  (1280 + 64 * (j))
#define XB_XGEN(j)  (2304 + 64 * (j))
#define XB_TOP      3328
#define XB_TOPGEN   3392
#define XCD_BAR_WORDS 3456
#define XB_SPIN_CAP (1u << 23)

__device__ __forceinline__ unsigned xb_ld(unsigned* p)              { return __hip_atomic_load(p, __ATOMIC_RELAXED, __HIP_MEMORY_SCOPE_AGENT); }
__device__ __forceinline__ unsigned xb_add(unsigned* p, unsigned v) { return __hip_atomic_fetch_add(p, v, __ATOMIC_RELAXED, __HIP_MEMORY_SCOPE_AGENT); }
__device__ __forceinline__ unsigned xb_xcc_id() { return (unsigned)__builtin_amdgcn_s_getreg((3 << 11) | 20) & 0xFu; }
#define XB_SPIN(cond, bar) do { unsigned _sp = 0; while (cond) { __builtin_amdgcn_s_sleep(1); \
    if ((++_sp & 255u) == 0u) { if (xb_ld(&(bar)[XB_TMO])) break; if (_sp > XB_SPIN_CAP) { atomicAdd(&(bar)[XB_TMO], 1u); break; } } } } while (0)

struct XcdBarrier {
    unsigned* bar; unsigned x;
    volatile LAS unsigned* st;
};

__device__ __forceinline__ XcdBarrier xcd_barrier_post(unsigned* bar, volatile LAS unsigned* st) {
    XcdBarrier b; b.bar = bar; b.x = xb_xcc_id(); b.st = st;
    if (threadIdx.x == 0) (void)xb_add(&bar[XB_XCNT(b.x)], 1u);
    return b;
}
__device__ __forceinline__ void xcd_barrier_complete(unsigned* bar, unsigned x, unsigned& nloc, unsigned& nx) {
    const unsigned G = gridDim.x * gridDim.y * gridDim.z;
    unsigned sum, cnt, mine, sp = 0u;
    for (;;) {
        sum = 0u; cnt = 0u; mine = 0u;
#pragma unroll
        for (unsigned j = 0; j < 16; ++j) { const unsigned c = xb_ld(&bar[XB_XCNT(j)]); sum += c; cnt += (c > 0u) ? 1u : 0u; mine = (j == x) ? c : mine; }
        if (sum == G) break;
        __builtin_amdgcn_s_sleep(1);
        if ((++sp & 255u) == 0u) { if (xb_ld(&bar[XB_TMO])) break; if (sp > XB_SPIN_CAP) { atomicAdd(&bar[XB_TMO], 1u); break; } }
    }
    nloc = mine > 0u ? mine : 1u; nx = cnt > 0u ? cnt : 1u;
}

__device__ __forceinline__ void xcd_barrier(const XcdBarrier& b) {
    asm volatile("s_waitcnt vmcnt(0)" ::: "memory");
    __syncthreads();
    if (threadIdx.x == 0) {
        unsigned* bar = b.bar;
        __builtin_amdgcn_s_waitcnt(0);
        unsigned nloc = b.st[0], nx = b.st[1];
        if (nloc == 0u) { xcd_barrier_complete(bar, b.x, nloc, nx); b.st[0] = nloc; b.st[1] = nx; }
        const unsigned old = xb_add(&bar[XB_XSUB(b.x)], 1u);
        const unsigned gen = old / nloc;
        if (old + 1u == (gen + 1u) * nloc) {
            __builtin_amdgcn_fence(__ATOMIC_RELEASE, "agent");
            asm volatile("s_waitcnt vmcnt(0)" ::: "memory");
            const unsigned og = xb_add(&bar[XB_TOP], 1u);
            const unsigned tg = og / nx;
            if (og + 1u == (tg + 1u) * nx) xb_add(&bar[XB_TOPGEN], 1u);
            else XB_SPIN(xb_ld(&bar[XB_TOPGEN]) == tg, bar);
            __builtin_amdgcn_fence(__ATOMIC_ACQUIRE, "agent");
            xb_add(&bar[XB_XGEN(b.x)], 1u);
            asm volatile("s_waitcnt vmcnt(0)" ::: "memory");
        } else {
            XB_SPIN(xb_ld(&bar[XB_XGEN(b.x)]) == gen, bar);
            __builtin_amdgcn_fence(__ATOMIC_ACQUIRE, "agent");
            asm volatile("s_waitcnt vmcnt(0)" ::: "memory");
        }
    }
    __syncthreads();
}

struct Frame {
    LAS unsigned char* lds;
    volatile LAS unsigned* MISC;
    gu32* ctl;
    int tid, lane, wave;
    int vcu, G;
};
__device__ __forceinline__ float wave_sum(float v) {
#pragma unroll
    for (int o = 1; o < 64; o <<= 1) v += __shfl_xor(v, o);
    return v;
}
__device__ __forceinline__ void p0_transpose_item(const float* W, int K, int ldw, int nblk, bf16* WT, const float* gk, int gmask, float gs, LAS float* scr, int item, int lane) {
    const int kb = item / nblk, nb = item % nblk, k0 = 64 * kb, n0 = 64 * nb;
    f32x4 v[16];
#pragma unroll
    for (int i = 0; i < 16; ++i) v[i] = *(const GAS f32x4*)(W + (size_t)(k0 + 4 * i + (lane >> 4)) * ldw + n0 + (lane & 15) * 4);
#pragma unroll
    for (int i = 0; i < 16; ++i) { const int kk = 4 * i + (lane >> 4); const float g = gk ? gk[(k0 + kk) & gmask] * gs : gs; LAS float* d = scr + kk * 64; const int nn = (lane & 15) * 4 + kk;
        d[nn & 63] = v[i].x * g; d[(nn + 1) & 63] = v[i].y * g; d[(nn + 2) & 63] = v[i].z * g; d[(nn + 3) & 63] = v[i].w * g; }
    LDS_WAIT(); asm volatile("" ::: "memory");
    const int c = lane & 7;
#pragma unroll
    for (int j = 0; j < 8; ++j) { const int n = (lane >> 3) + 8 * j; const LAS float* s = scr + (8 * c) * 64; const int nn = n + 8 * c;
        v4u o; o.x = pk2(s[0 * 64 + (nn & 63)], s[1 * 64 + ((nn + 1) & 63)]); o.y = pk2(s[2 * 64 + ((nn + 2) & 63)], s[3 * 64 + ((nn + 3) & 63)]);
        o.z = pk2(s[4 * 64 + ((nn + 4) & 63)], s[5 * 64 + ((nn + 5) & 63)]); o.w = pk2(s[6 * 64 + ((nn + 6) & 63)], s[7 * 64 + ((nn + 7) & 63)]);
        *(GAS v4u*)(WT + (size_t)(n0 + n) * K + k0 + 8 * c) = o; }
    LDS_WAIT(); asm volatile("" ::: "memory");
}
__device__ __forceinline__ void rms_row_load(const float* xrow, int lane, f32x4 (&v)[4]) {
    const GAS f32x4* xr = (const GAS f32x4*)xrow + lane; float s2 = 0.f;
#pragma unroll
    for (int j = 0; j < 4; ++j) { v[j] = xr[64 * j]; s2 += (v[j].x * v[j].x + v[j].y * v[j].y) + (v[j].z * v[j].z + v[j].w * v[j].w); }
    const float rstd = 1.f / sqrtf(wave_sum(s2) * (1.f / D) + EPS);
#pragma unroll
    for (int j = 0; j < 4; ++j) v[j] = v[j] * rstd;
}
__device__ __forceinline__ void row_store_bf16(bf16* orow, int lane, const f32x4 (&v)[4]) {
    GAS unsigned long long* o8 = (GAS unsigned long long*)orow + lane;
#pragma unroll
    for (int j = 0; j < 4; ++j) o8[64 * j] = (unsigned long long)pk2(v[j].x, v[j].y) | ((unsigned long long)pk2(v[j].z, v[j].w) << 32);
}
__device__ __forceinline__ float log_sigmoid(float x) { return fminf(x, 0.f) - log1pf(expf(-fabsf(x))); }

struct Args { const float* in[22]; float* out; unsigned char* ws; int ph_lo, ph_hi, li, pad; };

__device__ __forceinline__ void p0_prologue(Frame& F, const Args& a) {
    unsigned char* ws = a.ws;
    LAS float* scr = (LAS float*)(F.lds + RING_OFF + F.wave * 16384);
    const int gw = F.vcu * NWAVES + F.wave, NGW = F.G * NWAVES;
    constexpr int I_QKV = (D / 64) * (NQKV / 64), I_O = (D / 64) * (D / 64), I_ML = (D / 64) * (NPROJ / 64), I_1 = (D / 64) * (FF / 64), I_2 = (FF / 64) * (D / 64);
    constexpr int NITEMS = I_QKV + I_O + I_ML + I_O + 2 * I_1 + 2 * I_2;
    for (int it = gw; it < NITEMS; it += NGW) {
        int r = it;
        if (r < I_QKV) { p0_transpose_item(a.in[3], D, NQKV, NQKV / 64, (bf16*)(ws + WS_WQKV), a.in[2], 0xffff, 1.f, scr, r, F.lane); continue; } r -= I_QKV;
        if (r < I_O) { p0_transpose_item(a.in[9], D, D, D / 64, (bf16*)(ws + WS_WAO), a.in[8], 127, 1.f - LAMBDA_INIT0, scr, r, F.lane); continue; } r -= I_O;
        if (r < I_ML) { p0_transpose_item(a.in[11], D, MLW, NPROJ / 64, (bf16*)(ws + WS_WML), a.in[10], 0xffff, 1.f, scr, r, F.lane); continue; } r -= I_ML;
        if (r < I_O) { p0_transpose_item(a.in[17], D, D, D / 64, (bf16*)(ws + WS_WMO), a.in[16], 0xffff, 1.f, scr, r, F.lane); continue; } r -= I_O;
        if (r < 2 * I_1) { const int l = r / I_1; p0_transpose_item(a.in[19] + (size_t)l * D * FF, D, FF, FF / 64, (bf16*)(ws + WS_W1) + (size_t)l * D * FF, a.in[18] + l * D, 0xffff, 1.f, scr, r % I_1, F.lane); continue; } r -= 2 * I_1;
        { const int l = r / I_2; p0_transpose_item(a.in[20] + (size_t)l * D * FF, FF, D, D / 64, (bf16*)(ws + WS_W2) + (size_t)l * D * FF, nullptr, 0, 1.f, scr, r % I_2, F.lane); }
    }
    { bf16* WT = (bf16*)(ws + WS_WML) + (size_t)NPROJ * D; const int gt = (F.vcu * NWAVES + F.wave) * 64 + F.lane, NGT = F.G * NWAVES * 64;
      for (int i = gt; i < 256 * D / 2; i += NGT) { const int j = (2 * i) / D, k = (2 * i) % D;
          const unsigned w = j < 8 ? pk2(a.in[10][k] * a.in[11][(size_t)k * MLW + NPROJ + j], a.in[10][k + 1] * a.in[11][(size_t)(k + 1) * MLW + NPROJ + j]) : 0u;
          ((GAS unsigned*)WT)[i] = w; } }
    bf16* XN = (bf16*)(ws + WS_XN); float* SSQH = (float*)(ws + WS_SSQH);
    for (int m = gw; m < M; m += NGW) { f32x4 v[4]; const GAS f32x4* xr = (const GAS f32x4*)(a.in[0] + (size_t)m * D) + F.lane; float s2 = 0.f;
#pragma unroll
        for (int j = 0; j < 4; ++j) { v[j] = xr[64 * j]; s2 += (v[j].x * v[j].x + v[j].y * v[j].y) + (v[j].z * v[j].z + v[j].w * v[j].w); }
        s2 = wave_sum(s2); row_store_bf16(XN + (size_t)m * D, F.lane, v);
        if (F.lane < 4) SSQH[(size_t)m * 4 + F.lane] = F.lane == 0 ? s2 : 0.f; }
}
__device__ __forceinline__ void final_norm_phase(Frame& F, const bf16* XN, const float* SSQH, const float* g, float* out) {
    const int gw = F.vcu * NWAVES + F.wave, NGW = F.G * NWAVES;
    for (int m = gw; m < M; m += NGW) {
        const float rstd = pg8::row_rstd(SSQH, m);
        const v4u h0 = *(const GAS v4u*)(XN + (size_t)m * D + F.lane * 16), h1 = *(const GAS v4u*)(XN + (size_t)m * D + F.lane * 16 + 8);
        GAS f32x4* o = (GAS f32x4*)(out + (size_t)m * D + F.lane * 16); const GAS f32x4* gg = (const GAS f32x4*)(g + F.lane * 16);
#pragma unroll
        for (int q = 0; q < 2; ++q) { const f32x4 a = gg[q];
            o[q] = (f32x4){__uint_as_float(h0[2 * q] << 16) * rstd * a.x, __uint_as_float(h0[2 * q] & 0xffff0000u) * rstd * a.y, __uint_as_float(h0[2 * q + 1] << 16) * rstd * a.z, __uint_as_float(h0[2 * q + 1] & 0xffff0000u) * rstd * a.w}; }
#pragma unroll
        for (int q = 0; q < 2; ++q) { const f32x4 a = gg[2 + q];
            o[2 + q] = (f32x4){__uint_as_float(h1[2 * q] << 16) * rstd * a.x, __uint_as_float(h1[2 * q] & 0xffff0000u) * rstd * a.y, __uint_as_float(h1[2 * q + 1] << 16) * rstd * a.z, __uint_as_float(h1[2 * q + 1] & 0xffff0000u) * rstd * a.w}; }
    }
}

__device__ __forceinline__ float bf2f(bf16 v) { return __uint_as_float((unsigned)v << 16); }
__device__ __forceinline__ int t5_bucket(int d) {
    if (d < 16) return d;
    const float v = logf((float)d / 16.f) / logf(8.f) * 16.f; int b = 16 + (int)v; return b > 31 ? 31 : b;
}
__device__ __forceinline__ void naive_attn_phase(Frame& F, const bf16* __restrict__ QKV, const float* __restrict__ rel_bias, const float* __restrict__ lq1, const float* __restrict__ lk1,
                                                  const float* __restrict__ lq2, const float* __restrict__ lk2, bf16* AO) {
    LAS float* lut = (LAS float*)(F.lds + RING_OFF);
    const int tid = F.tid, half = tid & 1;
    float s1 = 0.f, s2 = 0.f;
    for (int i = 0; i < 64; ++i) { s1 += lq1[i] * lk1[i]; s2 += lq2[i] * lk2[i]; }
    const float lam = expf(s1) - expf(s2) + LAMBDA_INIT0;
    for (int u = F.vcu; u < BATCH * NH_A * (SEQ / 256); u += F.G) {
        const int qb = u % (SEQ / 256), h = (u / (SEQ / 256)) % NH_A, b = u / (SEQ / 256) / NH_A, q0 = qb * 256, q = q0 + (tid >> 1);
        __syncthreads();
        if (tid < 128) lut[tid] = rel_bias[t5_bucket(tid) * NH_A + h] * LOG2E;
        __syncthreads();
        const size_t tok = (size_t)b * SEQ + q;
        float res[64];
        for (int m = 0; m < 2; ++m) {
            float qv[64];
            const bf16* qp = QKV + tok * NQKV + h * 128 + m * 64;
#pragma unroll
            for (int d = 0; d < 64; ++d) qv[d] = bf2f(qp[d]);
            float o[64];
#pragma unroll
            for (int d = 0; d < 64; ++d) o[d] = 0.f;
            float mrun = -1e30f, l = 0.f;
            const int kend = q0 + 256;
            for (int k = 0; k < kend; ++k) {
                const bf16* kr = QKV + ((size_t)b * SEQ + k) * NQKV + D + h * 128 + m * 64;
                const bf16* vr = QKV + ((size_t)b * SEQ + k) * NQKV + 2 * D + h * 128 + half * 64;
                float s = 0.f;
#pragma unroll
                for (int d = 0; d < 64; ++d) s += qv[d] * bf2f(kr[d]);
                const int dist = q - k;
                if (dist >= 0) {
                    s += lut[dist < 127 ? dist : 127];
                    if (s > mrun) { const float al = exp2f(mrun - s); l *= al;
#pragma unroll
                        for (int d = 0; d < 64; ++d) o[d] *= al;
                        mrun = s; }
                    const float p = exp2f(s - mrun); l += p;
#pragma unroll
                    for (int d = 0; d < 64; ++d) o[d] += p * bf2f(vr[d]);
                }
            }
            const float il = 1.f / l;
            if (m == 0) {
#pragma unroll
                for (int d = 0; d < 64; ++d) res[d] = o[d] * il;
            } else {
                float ss = 0.f;
#pragma unroll
                for (int d = 0; d < 64; ++d) { res[d] = res[d] - lam * (o[d] * il); ss += res[d] * res[d]; }
                ss += __shfl_xor(ss, 1);
                const float rstd = 1.f / sqrtf(ss * (1.f / 128.f) + EPS);
                bf16* op = AO + tok * D + h * 128 + half * 64;
#pragma unroll
                for (int d = 0; d < 64; d += 2) *(unsigned*)(op + d) = pk2(res[d] * rstd, res[d + 1] * rstd);
            }
        }
    }
    __syncthreads();
}
__device__ __forceinline__ void naive_mlstm_phase(Frame& F, const bf16* __restrict__ PROJ, const float* __restrict__ GATES, const float* __restrict__ conv_w, const float* __restrict__ conv_b, bf16* AO) {
    LAS float* q_s = (LAS float*)(F.lds + RING_OFF); LAS float* k_s = q_s + 128; LAS float* v_s = q_s + 256; LAS float* red = q_s + 512;
    const int tid = F.tid, dv = tid >> 1, half = tid & 1, lane = F.lane, wave = F.wave;
    for (int u = (int)blockIdx.x; u < BATCH * NH_M; u += F.G) {
        const int h = u & 3, b = u >> 2;
        float C[64], n[64];
#pragma unroll
        for (int j = 0; j < 64; ++j) { C[j] = 0.f; n[j] = 0.f; }
        float mst = 0.f;
        const int col = (tid < 128) ? (h * 128 + tid) : (512 + h * 128 + ((tid - 128) & 127));
        float cw0 = 0.f, cw1 = 0.f, cw2 = 0.f, cw3 = 0.f, cb = 0.f;
        if (tid < 256) { cw0 = conv_w[0 * D + col]; cw1 = conv_w[1 * D + col]; cw2 = conv_w[2 * D + col]; cw3 = conv_w[3 * D + col]; cb = conv_b[col]; }
        __syncthreads();
        for (int t = 0; t < SEQ; ++t) {
            const size_t tok = (size_t)b * SEQ + t;
            if (tid < 256) {
                float x3 = bf2f(PROJ[tok * NPROJ + col]);
                float x2 = t >= 1 ? bf2f(PROJ[(tok - 1) * NPROJ + col]) : 0.f;
                float x1 = t >= 2 ? bf2f(PROJ[(tok - 2) * NPROJ + col]) : 0.f;
                float x0 = t >= 3 ? bf2f(PROJ[(tok - 3) * NPROJ + col]) : 0.f;
                float y = cw0 * x0 + cw1 * x1 + cw2 * x2 + cw3 * x3 + cb;
                y = y / (1.f + expf(-y));
                if (tid < 128) q_s[tid] = y * MQSCALE; else k_s[tid - 128] = y;
            } else {
                v_s[tid - 256] = bf2f(PROJ[tok * NPROJ + 1024 + h * 256 + (tid - 256)]);
            }
            const float ig = GATES[tok * 8 + h], lf = GATES[tok * 8 + 4 + h];
            __syncthreads();
            const float mnew = fmaxf(lf + mst, ig), fd = expf(lf + mst - mnew), gi = expf(ig - mnew);
            mst = mnew;
            const float gv = gi * v_s[dv];
            float num = 0.f, den = 0.f;
#pragma unroll
            for (int j = 0; j < 64; ++j) { const float kk = k_s[half * 64 + j], qq = q_s[half * 64 + j];
                C[j] = fd * C[j] + gv * kk; n[j] = fd * n[j] + gi * kk; num += C[j] * qq; den += n[j] * qq; }
            num += __shfl_xor(num, 1); den += __shfl_xor(den, 1);
            const float hv = num / fmaxf(fabsf(den), expf(-mnew));
            float ss = half == 0 ? hv * hv : 0.f;
            ss = wave_sum(ss);
            if (lane == 0) red[wave] = ss;
            __syncthreads();
            float tot = 0.f;
#pragma unroll
            for (int w = 0; w < 8; ++w) tot += red[w];
            const float rstd = 1.f / sqrtf(tot * (1.f / 256.f) + EPS);
            if (half == 0) { const float op = bf2f(PROJ[tok * NPROJ + 2048 + h * 256 + dv]); const float sg = 1.f / (1.f + expf(-op));
                AO[tok * D + h * 256 + dv] = (bf16)f2bf(sg * hv * rstd); }
            __syncthreads();
        }
    }
}

__device__ __forceinline__ void attn_phase(Frame& F, const bf16* __restrict__ QKV, bf16* AO, float* stash, const float* __restrict__ rel_bias, const float* __restrict__ lq1, const float* __restrict__ lk1,
                                           const float* __restrict__ lq2, const float* __restrict__ lk2) {
    using da::f32x16; using da::f32x4;
    LAS char* lds = (LAS char*)(F.lds + RING_OFF);
    LAS float* lut = (LAS float*)(lds + da::OFF_LUT);
    const int tid = F.tid, lane = F.lane, wid = F.wave, r32 = lane & 31, hi = lane >> 5;
    float s1 = 0.f, s2 = 0.f;
    for (int i = 0; i < 64; ++i) { s1 += lq1[i] * lk1[i]; s2 += lq2[i] * lk2[i]; }
    const float lam = expf(s1) - expf(s2) + LAMBDA_INIT0;
    f32x4* st = (f32x4*)(stash + (((size_t)blockIdx.x * NWAVES + wid) * 64 + lane) * 64);
    for (int L = F.vcu; L < BATCH * NH_A * 4; L += F.G) {
        const int bh = L >> 2, x = L & 3, b = bh >> 3, h = bh & 7;
        __syncthreads();
        if (tid < 128) lut[tid] = rel_bias[t5_bucket(tid) * NH_A + h] * LOG2E;
        __syncthreads();
        const float c31 = lut[127];
        for (int s = 0; s < 4; ++s) {
            const int qb = (s >> 1) ? 7 - x : x, m = s & 1, P0 = qb * 256;
            const bf16* Qp = QKV + ((size_t)b * SEQ + P0) * NQKV + h * 128 + m * 64;
            const bf16* Kp = QKV + (size_t)b * SEQ * NQKV + D + h * 128 + m * 64;
            const bf16* Vp = QKV + (size_t)b * SEQ * NQKV + 2 * D + h * 128;
            f32x16 o[4];
            da::attn_block(Qp, Kp, Vp, P0, lds, c31, o);
            if (m == 0) {
#pragma unroll
                for (int i = 0; i < 16; ++i) st[i] = (f32x4){o[i >> 2][(i & 3) * 4 + 0], o[i >> 2][(i & 3) * 4 + 1], o[i >> 2][(i & 3) * 4 + 2], o[i >> 2][(i & 3) * 4 + 3]};
            } else {
#pragma unroll
                for (int i = 0; i < 16; ++i) { const f32x4 a = st[i];
#pragma unroll
                    for (int e = 0; e < 4; ++e) o[i >> 2][(i & 3) * 4 + e] = a[e] - lam * o[i >> 2][(i & 3) * 4 + e]; }
                bf16* Ow = AO + ((size_t)b * SEQ + P0 + wid * 32) * D + h * 128;
#pragma unroll
                for (int r = 0; r < 16; ++r) {
                    float ss = (o[0][r] * o[0][r] + o[1][r] * o[1][r]) + (o[2][r] * o[2][r] + o[3][r] * o[3][r]);
#pragma unroll
                    for (int off = 1; off < 32; off <<= 1) ss += __shfl_xor(ss, off);
                    const float rstd = 1.f / sqrtf(ss * (1.f / 128.f) + EPS);
                    const int orow = da::crow(r, hi);
#pragma unroll
                    for (int d0 = 0; d0 < 4; ++d0) { const float v = o[d0][r] * rstd; const float vn = __shfl_xor(v, 1);
                        if ((r32 & 1) == 0) *(unsigned*)(Ow + (size_t)orow * D + d0 * 32 + r32) = da::cvtpk(v, vn); }
                }
            }
        }
    }
    __syncthreads();
}

__device__ __forceinline__ void convscan_phase(Frame& F, const bf16* __restrict__ PROJ, const float* __restrict__ GATES, const float* __restrict__ conv_w, const float* __restrict__ conv_b, bf16* QKC, float* GS) {
    {   const int pc = F.tid & 127, col = pc * 8;
        float cw[4][8], cbias[8];
#pragma unroll
        for (int i = 0; i < 8; ++i) { cbias[i] = conv_b[col + i];
#pragma unroll
            for (int t = 0; t < 4; ++t) cw[t][i] = conv_w[t * 1024 + col + i]; }
        const float osc = col < 512 ? MQSCALE : 1.f;
        for (int seg = F.vcu * 4 + (F.tid >> 7); seg < M / 32; seg += F.G * 4) {
            const int tokb = seg * 32;
#pragma unroll 1
            for (int run = 0; run < 4; ++run) {
                const int t8 = tokb + run * 8; const bool first = (t8 & (SEQ - 1)) == 0;
                const bf16* p = PROJ + (size_t)t8 * NPROJ + col;
                v4u r[11];
#pragma unroll
                for (int i = 0; i < 3; ++i) r[i] = first ? (v4u){0u, 0u, 0u, 0u} : *(const GAS v4u*)(p + ((ptrdiff_t)i - 3) * NPROJ);
#pragma unroll
                for (int i = 3; i < 11; ++i) r[i] = *(const GAS v4u*)(p + (size_t)(i - 3) * NPROJ);
#pragma unroll
                for (int t = 0; t < 8; ++t) {
                    unsigned o[4];
#pragma unroll
                    for (int q = 0; q < 4; ++q) {
                        float s0 = cbias[2 * q], s1 = cbias[2 * q + 1];
#pragma unroll
                        for (int tap = 0; tap < 4; ++tap) { const unsigned w = r[t + tap][q]; s0 += cw[tap][2 * q] * __uint_as_float(w << 16); s1 += cw[tap][2 * q + 1] * __uint_as_float(w & 0xffff0000u); }
                        s0 = s0 / (1.f + __expf(-s0)) * osc; s1 = s1 / (1.f + __expf(-s1)) * osc; o[q] = pk2(s0, s1); }
                    *(GAS v4u*)(QKC + (size_t)(t8 + t) * D + col) = (v4u){o[0], o[1], o[2], o[3]};
                }
            }
        }
    }
    {   const int gw = F.vcu * NWAVES + F.wave, NGW = F.G * NWAVES, lane = F.lane;
        for (int task = gw; task < BATCH * NH_M * (SEQ / 64); task += NGW) {
            const int c = task % (SEQ / 64), h = (task / (SEQ / 64)) % NH_M, b = task / (SEQ / 64) / NH_M;
            const size_t tok = (size_t)b * SEQ + c * 64 + lane;
            const float ig = GATES[tok * 8 + h], lf = GATES[tok * 8 + 4 + h];
            float bsum = lf;
#pragma unroll
            for (int off = 1; off < 64; off <<= 1) { const float t = __shfl_up(bsum, off); if (lane >= off) bsum += t; }
            const float e = ig - bsum; float pm = e;
#pragma unroll
            for (int off = 1; off < 64; off <<= 1) { const float t = __shfl_up(pm, off); if (lane >= off) pm = fmaxf(pm, t); }
            *(GAS f32x4*)(GS + tok * 16 + h * 4) = (f32x4){bsum, e, pm, 0.f};
        }
    }
}
__device__ __forceinline__ void mlstm_phase(Frame& F, const bf16* __restrict__ PROJ, const bf16* __restrict__ QKC, const float* __restrict__ GS, bf16* HT, float* SSQ) {
    for (int u = F.vcu; u < BATCH * NH_M * 4; u += F.G) {
        __syncthreads();
        ml::mlstm_unit(u >> 4, (u >> 2) & 3, u & 3, PROJ, QKC, GS, HT, SSQ, (LAS char*)(F.lds + RING_OFF));
    }
    __syncthreads();
}
__device__ __forceinline__ void gatenorm_phase(Frame& F, const bf16* __restrict__ PROJ, const bf16* __restrict__ HT, const float* __restrict__ SSQ, bf16* AO) {
    const int gw = F.vcu * NWAVES + F.wave, NGW = F.G * NWAVES, lane = F.lane;
    for (int m = gw; m < M; m += NGW) {
        const int hd = lane >> 4;
        const f32x4 s0 = *(const GAS f32x4*)(SSQ + (size_t)m * 32 + hd * 8), s1 = *(const GAS f32x4*)(SSQ + (size_t)m * 32 + hd * 8 + 4);
        const float tot = ((s0.x + s0.y) + (s0.z + s0.w)) + ((s1.x + s1.y) + (s1.z + s1.w));
        const float rstd = 1.f / sqrtf(tot * (1.f / 256.f) + EPS);
        const v4u h0 = *(const GAS v4u*)(HT + (size_t)m * D + lane * 16), h1 = *(const GAS v4u*)(HT + (size_t)m * D + lane * 16 + 8);
        const v4u o0 = *(const GAS v4u*)(PROJ + (size_t)m * NPROJ + 2048 + lane * 16), o1 = *(const GAS v4u*)(PROJ + (size_t)m * NPROJ + 2048 + lane * 16 + 8);
        v4u r0, r1;
#pragma unroll
        for (int q = 0; q < 4; ++q) {
            { const float ha = __uint_as_float(h0[q] << 16) * rstd, hb = __uint_as_float(h0[q] & 0xffff0000u) * rstd, oa = __uint_as_float(o0[q] << 16), ob = __uint_as_float(o0[q] & 0xffff0000u);
              r0[q] = pk2(ha / (1.f + __expf(-oa)), hb / (1.f + __expf(-ob))); }
            { const float ha = __uint_as_float(h1[q] << 16) * rstd, hb = __uint_as_float(h1[q] & 0xffff0000u) * rstd, oa = __uint_as_float(o1[q] << 16), ob = __uint_as_float(o1[q] & 0xffff0000u);
              r1[q] = pk2(ha / (1.f + __expf(-oa)), hb / (1.f + __expf(-ob))); }
        }
        *(GAS v4u*)(AO + (size_t)m * D + lane * 16) = r0; *(GAS v4u*)(AO + (size_t)m * D + lane * 16 + 8) = r1;
    }
}

template <class Epi>
__device__ __forceinline__ void run_gemm(Frame& F, const bf16* A, const bf16* Bt, int N, int K, const Epi& E) {
    pg8::Gemm g{A, Bt, M, N, K}; pg8::StaticOrder S; S.init(M, N, F.G, (int)blockIdx.x);
    pg8::gemm_phase<Epi, pg8::StaticOrder, PG8_ALIGN, PG8_SP2>(F.lds + RING_OFF, g, S, E);
}
__global__ void __launch_bounds__(NWAVES * 64, 2) fwd(Args args) {
    extern __shared__ __attribute__((aligned(16))) unsigned char lds[];
    Frame F;
    F.lds = (LAS unsigned char*)lds;
    F.MISC = (volatile LAS unsigned*)(F.lds + MISC_OFF);
    F.tid = threadIdx.x; F.lane = F.tid & 63; F.wave = __builtin_amdgcn_readfirstlane(F.tid >> 6);
    F.G = gridDim.x; { const int bx = blockIdx.x; F.vcu = (F.G % 8 == 0) ? (bx % 8) * (F.G / 8) + bx / 8 : bx; }
    unsigned char* ws = args.ws;
    F.ctl = (gu32*)(ws + WS_CTL);
    for (int u = F.tid; u < (LDS_BYTES - LDSCTL_OFF) / 4; u += NWAVES * 64) ((LAS unsigned*)(F.lds + LDSCTL_OFF))[u] = 0u;
    __syncthreads();
    const int lo = args.ph_lo, hi = args.ph_hi;
    const bool use_bar = (hi - lo) > 1;
    XcdBarrier bar; bar.bar = (unsigned*)(F.ctl + CW_BAR) + args.li * XCD_BAR_WORDS; bar.x = 0; bar.st = nullptr;
    if (use_bar) bar = xcd_barrier_post((unsigned*)(F.ctl + CW_BAR) + args.li * XCD_BAR_WORDS, F.MISC + 8);
#define IN(k) (lo <= (k) && (k) < hi)
#define SEAM(k) do { if (hi > lo + 1) xcd_barrier(bar); } while (0)
#define REP(k) for (int rep_ = 0; rep_ < ((DUP_PHASE == (k)) ? 2 : 1); ++rep_)
#define DUPBAR(k) do { if (DUP_PHASE == (k) && rep_ == 0) xcd_barrier(bar); } while (0)
    bf16* const XN = (bf16*)(ws + WS_XN); bf16* const AO = (bf16*)(ws + WS_AO); bf16* const QKV = (bf16*)(ws + WS_U); bf16* const U = (bf16*)(ws + WS_U); float* const SSQH = (float*)(ws + WS_SSQH);
    float* const H = args.out;
    using pg8::EpiBf16; using pg8::EpiResNorm; (void)H;

    if (IN(0)) { REP(0) { p0_prologue(F, args); DUPBAR(0); } SEAM(0); }
    if (IN(1)) { EpiBf16<0> E{QKV, NQKV, D, QSCALE, SSQH, -1, nullptr, nullptr, nullptr}; if (DUP_PHASE == 1) { run_gemm(F, XN, (const bf16*)(ws + WS_WQKV), NQKV, D, E); xcd_barrier(bar); } run_gemm(F, XN, (const bf16*)(ws + WS_WQKV), NQKV, D, E); SEAM(1); }
    if (IN(2)) { REP(2) { attn_phase(F, QKV, AO, (float*)(ws + WS_STASH), args.in[1], args.in[4], args.in[5], args.in[6], args.in[7]); DUPBAR(2); } SEAM(2); }
    if (IN(3)) { EpiResNorm<true> E{args.in[0], nullptr, XN, SSQH, D, (LAS float*)(F.lds + EPIRED_OFF)}; if (DUP_PHASE == 3) { run_gemm(F, AO, (const bf16*)(ws + WS_WAO), D, D, E); xcd_barrier(bar); } run_gemm(F, AO, (const bf16*)(ws + WS_WAO), D, D, E); SEAM(4); }
    if (IN(5)) { EpiBf16<2> E{U, FF, 0, 1.f, SSQH, -1, nullptr, nullptr, nullptr}; if (DUP_PHASE == 5) { run_gemm(F, XN, (const bf16*)(ws + WS_W1), FF, D, E); xcd_barrier(bar); } run_gemm(F, XN, (const bf16*)(ws + WS_W1), FF, D, E); SEAM(5); }
    if (IN(6)) { EpiResNorm<false> E{nullptr, XN, XN, SSQH, D, (LAS float*)(F.lds + EPIRED_OFF)}; run_gemm(F, U, (const bf16*)(ws + WS_W2), D, FF, E); SEAM(7); }
    if (IN(8)) { EpiBf16<0> E{QKV, NPROJ, 0, 1.f, SSQH, NPROJ / 256, (float*)(ws + WS_GATES), args.in[12], args.in[13]}; if (DUP_PHASE == 8) { run_gemm(F, XN, (const bf16*)(ws + WS_WML), NPROJ + 256, D, E); xcd_barrier(bar); } run_gemm(F, XN, (const bf16*)(ws + WS_WML), NPROJ + 256, D, E); SEAM(8); }
    if (IN(9)) { REP(16) { convscan_phase(F, QKV, (const float*)(ws + WS_GATES), args.in[14], args.in[15], AO, (float*)(ws + WS_GS)); xcd_barrier(bar); }
        REP(9) { mlstm_phase(F, QKV, AO, (const float*)(ws + WS_GS), (bf16*)(ws + WS_HT), (float*)(ws + WS_SSQ)); DUPBAR(9); } SEAM(9); }
    if (IN(10)) { REP(10) { gatenorm_phase(F, QKV, (const bf16*)(ws + WS_HT), (const float*)(ws + WS_SSQ), AO); DUPBAR(10); } SEAM(10); }
    if (IN(11)) { EpiResNorm<false> E{nullptr, XN, XN, SSQH, D, (LAS float*)(F.lds + EPIRED_OFF)}; run_gemm(F, AO, (const bf16*)(ws + WS_WMO), D, D, E); SEAM(12); }
    if (IN(13)) { EpiBf16<2> E{U, FF, 0, 1.f, SSQH, -1, nullptr, nullptr, nullptr}; if (DUP_PHASE == 13) { run_gemm(F, XN, (const bf16*)(ws + WS_W1) + (size_t)D * FF, FF, D, E); xcd_barrier(bar); } run_gemm(F, XN, (const bf16*)(ws + WS_W1) + (size_t)D * FF, FF, D, E); SEAM(13); }
    if (IN(14)) { EpiResNorm<false> E{nullptr, XN, XN, SSQH, D, (LAS float*)(F.lds + EPIRED_OFF)}; run_gemm(F, U, (const bf16*)(ws + WS_W2) + (size_t)D * FF, D, FF, E); SEAM(14); }
    if (IN(15)) { final_norm_phase(F, XN, SSQH, args.in[21], args.out); }
#undef IN
#undef SEAM
}

extern "C" void kernel_launch(void* const* d_in, const int* in_sizes, int n_in, void* d_out, int out_size, void* d_ws, size_t ws_size, hipStream_t stream) {
    static int grid = 0;
    if (grid == 0) {
        if (n_in != 22 || in_sizes[0] != M * D || out_size != M * D || ws_size < WS_END) { fprintf(stderr, "kernel_launch: unexpected shapes (n_in %d, in0 %d, out %d, ws %zu); nothing launched\n", n_in, n_in > 0 ? in_sizes[0] : -1, out_size, ws_size); grid = -1; return; }
        int dev = 0, cus = 0, per_cu = 0;
        if (hipGetDevice(&dev) != hipSuccess || hipDeviceGetAttribute(&cus, hipDeviceAttributeMultiprocessorCount, dev) != hipSuccess) { grid = -1; return; }
        if (hipFuncSetAttribute((const void*)fwd, hipFuncAttributeMaxDynamicSharedMemorySize, LDS_BYTES) != hipSuccess) { fprintf(stderr, "kernel_launch: hipFuncSetAttribute failed\n"); grid = -1; return; }
        if (hipOccupancyMaxActiveBlocksPerMultiprocessor(&per_cu, (const void*)fwd, NWAVES * 64, LDS_BYTES) != hipSuccess || per_cu < 1) fprintf(stderr, "kernel_launch: occupancy query says %d\n", per_cu);
        (void)hipGetLastError();
        grid = cus;
    }
    if (grid < 0) return;
    (void)hipMemsetAsync((char*)d_ws + WS_CTL, 0, CTL_ZERO_BYTES, stream);
    Args a{};
    for (int i = 0; i < 22; ++i) a.in[i] = (const float*)d_in[i];
    a.out = (float*)d_out; a.ws = (unsigned char*)d_ws;
    int li = 0;
    auto run = [&](int lo, int hi) { a.ph_lo = lo; a.ph_hi = hi; a.li = li++; hipLaunchKernelGGL(fwd, dim3(grid), dim3(NWAVES * 64), LDS_BYTES, stream, a); };
    run(0, NPHASE);
}
```

```cpp
#include <hip/hip_runtime.h>
#include <cstdio>
#include <cstdint>
namespace pg8 {
#define PG8_LAS __attribute__((address_space(3)))
typedef unsigned short bf16_t;
typedef short bf16x8 __attribute__((ext_vector_type(8)));
typedef float f32x4 __attribute__((ext_vector_type(4)));
typedef unsigned u32x4 __attribute__((ext_vector_type(4)));
constexpr int BM = 256, BK = 64, HALF = 128, HTB = HALF * BK * 2  , STAGE_BYTES = 8 * HTB, NXCD = 8, WGM = 8;

__host__ __device__ __forceinline__ int lds_byte(int r, int c) { const int st = (r >> 4) * 2 + (c >> 5), rr = r & 15, cc = c & 31, ob = rr * 64 + cc * 2; return st * 1024 + (ob ^ (((ob >> 9) & 1) << 5)); }
__host__ __device__ __forceinline__ void stage_rc(int b, int& R, int& C) { const int st = b / 1024, sb = b % 1024, swz = sb ^ (((sb >> 9) & 1) << 5); R = (st >> 1) * 16 + swz / 64; C = (st & 1) * 32 + (swz % 64) / 2; }
__host__ __device__ __forceinline__ int perm32(int rho) { const int n = rho >> 4, i = rho & 15; return 8 * (i >> 2) + 4 * n + (i & 3); }

struct Unit { int pm, pn; };
struct Gemm { const bf16_t* A; const bf16_t* Bt; int M, N, K; };

struct StaticOrder {
    int nM, nN, nwg, G, c;
    __host__ __device__ void init(int M, int N, int G_, int c_) { nM = M / BM; nN = N / BM; nwg = nM * nN; G = G_; c = c_; }
    __host__ __device__ bool next(int i, Unit& u) const {
        const long L = (long)i * G + c; if (L >= nwg) return false;
        int wgid = (int)L; { const int q = nwg / NXCD, r = nwg % NXCD, xcd = wgid % NXCD, off = wgid / NXCD; wgid = (xcd < r ? xcd * (q + 1) : r * (q + 1) + (xcd - r) * q) + off; }
        const int nig = WGM * nN, gid = wgid / nig, fm = gid * WGM, gsz = (nM - fm) < WGM ? (nM - fm) : WGM;
        u.pm = fm + ((wgid % nig) % gsz); u.pn = (wgid % nig) / gsz; return true;
    }
    __device__ __forceinline__ void a_ready(const Unit&) const {}
    __device__ __forceinline__ void done(const Unit&) const {}
};

__device__ __forceinline__ unsigned cvt_pk_bf16(float lo, float hi) { unsigned r; asm volatile("v_cvt_pk_bf16_f32 %0, %1, %2" : "=v"(r) : "v"(lo), "v"(hi)); return r; }
__device__ __forceinline__ float row_rstd(const float* ssq, int row) {
    const f32x4 a = *(const f32x4*)(ssq + (size_t)row * 4);
    return __builtin_amdgcn_rsqf(((a[0] + a[1]) + (a[2] + a[3])) * (1.0f / 1024.0f) + 1e-6f);
}
__device__ __forceinline__ float log_sigmoid_f(float x) { return fminf(x, 0.f) - log1pf(expf(-fabsf(x))); }
template <int ACT> struct EpiBf16 {
    static constexpr bool PERM = true, AFTER_DRAIN = false;
    bf16_t* O; int ldc; int scale_cols; float scale0; const float* ssq; int gate_tile; float* gates; const float* b_i; const float* b_f;
    __device__ __forceinline__ void operator()(const f32x4 (&acc)[2][2][4][2], const Unit& u, int wr, int wc, int fr, int fq) const {
        const int row0 = u.pm * BM + wr * 64 + fr; const int colt = u.pn * BM;
        const float sc = (colt < scale_cols) ? scale0 : 1.f;
        const int col0 = colt + wc * 32 + 8 * fq;
        float rs[2][4];
#pragma unroll
        for (int ai = 0; ai < 2; ++ai)
#pragma unroll
            for (int m = 0; m < 4; ++m) rs[ai][m] = ssq ? row_rstd(ssq, row0 + ai * HALF + m * 16) * sc : sc;
        if (u.pn == gate_tile) {
            if (wc == 0 && fq == 0) { const f32x4 bi = *(const f32x4*)b_i, bf = *(const f32x4*)b_f;
#pragma unroll
                for (int ai = 0; ai < 2; ++ai)
#pragma unroll
                    for (int m = 0; m < 4; ++m) { const int row = row0 + ai * HALF + m * 16; const f32x4 gi = acc[ai][0][m][0] * rs[ai][m] + bi; f32x4 gf = acc[ai][0][m][1] * rs[ai][m] + bf;
#pragma unroll
                        for (int e = 0; e < 4; ++e) gf[e] = log_sigmoid_f(gf[e]);
                        *(f32x4*)(gates + (size_t)row * 8) = gi; *(f32x4*)(gates + (size_t)row * 8 + 4) = gf; } }
            return;
        }
#pragma unroll
        for (int ai = 0; ai < 2; ++ai)
#pragma unroll
            for (int m = 0; m < 4; ++m) { bf16_t* rowp = O + (size_t)(row0 + ai * HALF + m * 16) * ldc + col0; const float r = rs[ai][m];
#pragma unroll
                for (int bj = 0; bj < 2; ++bj) { f32x4 v0 = acc[ai][bj][m][0] * r, v1 = acc[ai][bj][m][1] * r;
                    if (ACT == 2) {
#pragma unroll
                        for (int e = 0; e < 4; ++e) { const float a = fmaxf(v0[e], 0.f), b = fmaxf(v1[e], 0.f); v0[e] = a * a; v1[e] = b * b; } }
                    u32x4 w; w.x = cvt_pk_bf16(v0[0], v0[1]); w.y = cvt_pk_bf16(v0[2], v0[3]); w.z = cvt_pk_bf16(v1[0], v1[1]); w.w = cvt_pk_bf16(v1[2], v1[3]);
                    *(u32x4*)(rowp + bj * HALF) = w; } }
    }
};
template <bool BASE_F32> struct EpiResNorm {
    static constexpr bool PERM = true, AFTER_DRAIN = false;
    const float* basef; const bf16_t* baseh; bf16_t* xn; float* ssq; int ldc; PG8_LAS float* red;
    __device__ __forceinline__ void operator()(const f32x4 (&acc)[2][2][4][2], const Unit& u, int wr, int wc, int fr, int fq) const {
        const int row0 = u.pm * BM + wr * 64 + fr; const int col0 = u.pn * BM + wc * 32 + 8 * fq;
#pragma unroll
        for (int ai = 0; ai < 2; ++ai)
#pragma unroll
            for (int m = 0; m < 4; ++m) { const int row = row0 + ai * HALF + m * 16; const size_t off = (size_t)row * ldc + col0; float s = 0.f;
#pragma unroll
                for (int bj = 0; bj < 2; ++bj) { f32x4 v0, v1;
                    if (BASE_F32) { v0 = *(const f32x4*)(basef + off + bj * HALF); v1 = *(const f32x4*)(basef + off + bj * HALF + 4); }
                    else { const u32x4 h = *(const u32x4*)(baseh + off + bj * HALF);
                        v0 = (f32x4){__uint_as_float(h.x << 16), __uint_as_float(h.x & 0xffff0000u), __uint_as_float(h.y << 16), __uint_as_float(h.y & 0xffff0000u)};
                        v1 = (f32x4){__uint_as_float(h.z << 16), __uint_as_float(h.z & 0xffff0000u), __uint_as_float(h.w << 16), __uint_as_float(h.w & 0xffff0000u)}; }
                    v0 = v0 + acc[ai][bj][m][0]; v1 = v1 + acc[ai][bj][m][1];
                    s += ((v0[0] * v0[0] + v0[1] * v0[1]) + (v0[2] * v0[2] + v0[3] * v0[3])) + ((v1[0] * v1[0] + v1[1] * v1[1]) + (v1[2] * v1[2] + v1[3] * v1[3]));
                    u32x4 w; w.x = cvt_pk_bf16(v0[0], v0[1]); w.y = cvt_pk_bf16(v0[2], v0[3]); w.z = cvt_pk_bf16(v1[0], v1[1]); w.w = cvt_pk_bf16(v1[2], v1[3]);
                    *(u32x4*)(xn + off + bj * HALF) = w; }
                s += __shfl_xor(s, 16); s += __shfl_xor(s, 32);
                if (fq == 0) red[(ai * HALF + wr * 64 + m * 16 + fr) * 4 + wc] = s; }
        asm volatile("s_waitcnt lgkmcnt(0)" ::: "memory"); __builtin_amdgcn_s_barrier(); asm volatile("" ::: "memory");
        const int t = threadIdx.x;
        if (t < BM) { const f32x4 p = *(const PG8_LAS f32x4*)(red + t * 4); ssq[(size_t)(u.pm * BM + t) * 4 + u.pn] = (p[0] + p[1]) + (p[2] + p[3]); }
    }
};

template <class Epi, class Sched, bool ALIGN_EPI = false, bool SP2 = false>
__device__ __forceinline__ void gemm_phase(PG8_LAS unsigned char* lds, const Gemm g, const Sched& S, const Epi& E) {
    const int tid = threadIdx.x, wid = __builtin_amdgcn_readfirstlane(tid >> 6), lane = tid & 63, wr = wid >> 2, wc = wid & 3, fr = lane & 15, fq = lane >> 4;
    const int K = g.K, nt = K / BK;
    unsigned voffA[2], voffB[2];
#pragma unroll
    for (int i = 0; i < 2; ++i) { int R, C; stage_rc(tid * 16 + i * 8192, R, C); const int Rb = Epi::PERM ? ((R & ~31) + perm32(R & 31)) : R;
        voffA[i] = (unsigned)(R * K + C) * 2u; voffB[i] = (unsigned)(Rb * K + C) * 2u; }
    const size_t kstep = (size_t)(BK * 2);
    const size_t hstep = (size_t)HALF * K * 2;
    const size_t tstep = 2 * hstep;
    const unsigned ldsw = (unsigned)wid * 1024u;
    const int aoff = lds_byte(wr * 64 + fr, fq * 8), boff = lds_byte(wc * 32 + fr, fq * 8);
#define PG8_SA(b, h) (((b) * 2 + (h)) * HTB)
#define PG8_SB(b, h) ((4 + (b) * 2 + (h)) * HTB)
#define PG8_STAGE(bufoff, gbase, voff) do { _Pragma("unroll") for (int _i = 0; _i < 2; ++_i) \
        __builtin_amdgcn_global_load_lds((const unsigned*)((const char*)(gbase) + (voff)[_i]), (PG8_LAS unsigned*)(lds + (bufoff) + ldsw + _i * 8192), 16, 0, 0); } while (0)
#define PG8_LDA(dst, b, h) do { _Pragma("unroll") for (int m = 0; m < 4; ++m) _Pragma("unroll") for (int k = 0; k < 2; ++k) dst[m][k] = *(const PG8_LAS bf16x8*)(lds + PG8_SA(b, h) + aoff + m * 2048 + k * 1024); } while (0)
#define PG8_LDB(dst, b, h) do { _Pragma("unroll") for (int n = 0; n < 2; ++n) _Pragma("unroll") for (int k = 0; k < 2; ++k) dst[n][k] = *(const PG8_LAS bf16x8*)(lds + PG8_SB(b, h) + boff + n * 2048 + k * 1024); } while (0)
#define PG8_MMA(ai, bj, At, Bt) do { __builtin_amdgcn_s_setprio(1); _Pragma("unroll") for (int m = 0; m < 4; ++m) _Pragma("unroll") for (int n = 0; n < 2; ++n) _Pragma("unroll") for (int k = 0; k < 2; ++k) \
        acc[ai][bj][m][n] = __builtin_amdgcn_mfma_f32_16x16x32_bf16(Bt[n][k], At[m][k], acc[ai][bj][m][n], 0, 0, 0); __builtin_amdgcn_s_setprio(0); } while (0)
#define PG8_WAIT_V(n) asm volatile("s_waitcnt vmcnt(" #n ")" ::: "memory")
#define PG8_WAIT_L(n) asm volatile("s_waitcnt lgkmcnt(" #n ")" ::: "memory")
#define PG8_BAR __builtin_amdgcn_s_barrier()
#define PG8_SCHED __builtin_amdgcn_sched_barrier(0)
    Unit cur, nxt; int ui = 0;
    if (!S.next(0, cur)) return;
    f32x4 acc[2][2][4][2];
#pragma unroll
    for (int a = 0; a < 2; ++a)
#pragma unroll
        for (int b = 0; b < 2; ++b)
#pragma unroll
            for (int m = 0; m < 4; ++m)
#pragma unroll
                for (int n = 0; n < 2; ++n) acc[a][b][m][n] = (f32x4){0.f, 0.f, 0.f, 0.f};
    bf16x8 At[4][2], B0[2][2], B1[2][2];
    const char* cA = (const char*)g.A + (size_t)cur.pm * tstep; const char* cB = (const char*)g.Bt + (size_t)cur.pn * tstep;
    S.a_ready(cur);
    if constexpr (SP2) {
        PG8_STAGE(PG8_SB(0, 0), cB, voffB); PG8_STAGE(PG8_SB(0, 1), cB + hstep, voffB); PG8_STAGE(PG8_SA(0, 0), cA, voffA); PG8_STAGE(PG8_SA(0, 1), cA + hstep, voffA);
        if (wr == 1) PG8_BAR;
        PG8_WAIT_V(2); PG8_BAR;
        PG8_STAGE(PG8_SB(1, 0), cB + kstep, voffB); PG8_STAGE(PG8_SA(1, 0), cA + kstep, voffA); PG8_STAGE(PG8_SB(1, 1), cB + hstep + kstep, voffB);
        PG8_WAIT_V(6); PG8_BAR;
    } else {
        PG8_STAGE(PG8_SB(0, 0), cB, voffB); PG8_STAGE(PG8_SA(0, 0), cA, voffA); PG8_STAGE(PG8_SB(0, 1), cB + hstep, voffB); PG8_STAGE(PG8_SA(0, 1), cA + hstep, voffA);
        if (wr == 1) PG8_BAR;
        PG8_WAIT_V(4); PG8_BAR;
        PG8_STAGE(PG8_SB(1, 0), cB + kstep, voffB); PG8_STAGE(PG8_SA(1, 0), cA + kstep, voffA); PG8_STAGE(PG8_SB(1, 1), cB + hstep + kstep, voffB);
        PG8_WAIT_V(6); PG8_BAR;
    }
    for (;;) {
        const bool has_next = S.next(ui + 1, nxt);
        const char* nA = has_next ? (const char*)g.A + (size_t)nxt.pm * tstep : cA; const char* nB = has_next ? (const char*)g.Bt + (size_t)nxt.pn * tstep : cB;
        for (int t = 0; t < nt; t += 2) {
            const bool last = (t == nt - 2);
            const char* a1 = cA + (size_t)(t + 1) * kstep;
            const char* a2 = last ? nA : cA + (size_t)(t + 2) * kstep; const char* b2 = last ? nB : cB + (size_t)(t + 2) * kstep;
            const char* a3 = a2 + kstep; const char* b3 = b2 + kstep;
            if (last && has_next) S.a_ready(nxt);
            if constexpr (SP2) {
            PG8_LDB(B0, 0, 0); PG8_LDB(B1, 0, 1); PG8_SCHED; PG8_LDA(At, 0, 0); PG8_STAGE(PG8_SA(1, 1), a1 + hstep, voffA);
            PG8_WAIT_V(8); PG8_WAIT_L(0); PG8_BAR; PG8_MMA(0, 0, At, B0); PG8_MMA(0, 1, At, B1); PG8_BAR; PG8_SCHED;
            PG8_LDA(At, 0, 1); PG8_STAGE(PG8_SB(0, 0), b2, voffB); PG8_STAGE(PG8_SB(0, 1), b2 + hstep, voffB); PG8_STAGE(PG8_SA(0, 0), a2, voffA);
            PG8_WAIT_V(8); PG8_WAIT_L(0); PG8_BAR; PG8_MMA(1, 0, At, B0); PG8_MMA(1, 1, At, B1); PG8_BAR; PG8_SCHED;
            PG8_LDB(B0, 1, 0); PG8_LDB(B1, 1, 1); PG8_SCHED; PG8_LDA(At, 1, 0); PG8_STAGE(PG8_SA(0, 1), a2 + hstep, voffA);
            PG8_WAIT_V(8); PG8_WAIT_L(0); PG8_BAR; PG8_MMA(0, 0, At, B0); PG8_MMA(0, 1, At, B1); PG8_BAR; PG8_SCHED;
            PG8_LDA(At, 1, 1); PG8_STAGE(PG8_SB(1, 0), b3, voffB); PG8_STAGE(PG8_SB(1, 1), b3 + hstep, voffB); PG8_STAGE(PG8_SA(1, 0), a3, voffA);
            PG8_WAIT_V(8); PG8_WAIT_L(0); PG8_BAR; PG8_MMA(1, 0, At, B0); PG8_MMA(1, 1, At, B1); PG8_BAR; PG8_SCHED;
            } else {
            PG8_LDB(B0, 0, 0); PG8_SCHED; PG8_LDA(At, 0, 0); PG8_STAGE(PG8_SA(1, 1), a1 + hstep, voffA);
            PG8_WAIT_L(8); PG8_BAR; PG8_WAIT_L(0); PG8_MMA(0, 0, At, B0); PG8_BAR; PG8_SCHED;
            PG8_LDB(B1, 0, 1); PG8_STAGE(PG8_SB(0, 0), b2, voffB);
            PG8_BAR; PG8_WAIT_L(0); PG8_MMA(0, 1, At, B1); PG8_BAR;
            PG8_LDA(At, 0, 1); PG8_STAGE(PG8_SA(0, 0), a2, voffA);
            PG8_BAR; PG8_WAIT_L(0); PG8_MMA(1, 0, At, B0); PG8_BAR; PG8_SCHED;
            PG8_STAGE(PG8_SB(0, 1), b2 + hstep, voffB);
            PG8_WAIT_V(6); PG8_BAR; PG8_MMA(1, 1, At, B1); PG8_BAR;
            PG8_LDB(B0, 1, 0); PG8_SCHED; PG8_LDA(At, 1, 0); PG8_STAGE(PG8_SA(0, 1), a2 + hstep, voffA);
            PG8_WAIT_L(8); PG8_BAR; PG8_WAIT_L(0); PG8_MMA(0, 0, At, B0); PG8_BAR; PG8_SCHED;
            PG8_LDB(B1, 1, 1); PG8_STAGE(PG8_SB(1, 0), b3, voffB);
            PG8_BAR; PG8_WAIT_L(0); PG8_MMA(0, 1, At, B1); PG8_BAR;
            PG8_LDA(At, 1, 1); PG8_STAGE(PG8_SA(1, 0), a3, voffA);
            PG8_BAR; PG8_WAIT_L(0); PG8_MMA(1, 0, At, B0); PG8_BAR; PG8_SCHED;
            PG8_STAGE(PG8_SB(1, 1), b3 + hstep, voffB);
            PG8_WAIT_V(6); PG8_BAR; PG8_MMA(1, 1, At, B1); PG8_BAR;
            }
        }
        if constexpr (ALIGN_EPI) { if (wr == 0) PG8_BAR; }
        if constexpr (!Epi::AFTER_DRAIN) { E(acc, cur, wr, wc, fr, fq); S.done(cur); }
        if (!has_next) break;
#pragma unroll
        for (int a = 0; a < 2; ++a)
#pragma unroll
            for (int b = 0; b < 2; ++b)
#pragma unroll
                for (int m = 0; m < 4; ++m)
#pragma unroll
                    for (int n = 0; n < 2; ++n) acc[a][b][m][n] = (f32x4){0.f, 0.f, 0.f, 0.f};
        cur = nxt; cA = nA; cB = nB; ++ui;
        if constexpr (ALIGN_EPI) { if (wr == 1) PG8_BAR; }
    }
    PG8_WAIT_V(0);
    if constexpr (!ALIGN_EPI) { if (wr == 0) PG8_BAR; }
    PG8_BAR;
    if constexpr (Epi::AFTER_DRAIN) { E.fused(acc, cur, wr, wc, fr, fq, lds, wid, lane); S.done(cur); }
#undef PG8_SA
#undef PG8_SB
#undef PG8_STAGE
#undef PG8_LDA
#undef PG8_LDB
#undef PG8_MMA
#undef PG8_WAIT_V
#undef PG8_WAIT_L
#undef PG8_BAR
#undef PG8_SCHED
}
}

#ifndef PG8_SP2
#define PG8_SP2 true
#endif
#ifndef PG8_ALIGN
#define PG8_ALIGN true
#endif
namespace da {
typedef short bf16x8 __attribute__((ext_vector_type(8)));
typedef short s16x4 __attribute__((ext_vector_type(4)));
typedef float f32x16 __attribute__((ext_vector_type(16)));
typedef float f32x4 __attribute__((ext_vector_type(4)));
typedef unsigned u32x4 __attribute__((ext_vector_type(4)));
#define DLAS __attribute__((address_space(3)))
constexpr int NW = 8, QBLK = 32, KVBLK = 64, QB = NW * QBLK, PITCH = 3072;
constexpr int SHM_V = KVBLK * 128 * 2, SHM_K = KVBLK * 64 * 2;
constexpr int OFF_V = 0, OFF_K = 2 * SHM_V, OFF_WS = OFF_K + 2 * SHM_K, OFF_LUT = OFF_WS + NW * 64 * 4, LDS_BYTES = OFF_LUT + 512;
constexpr float THR = 8.f;
#define DA_KSWZ(row, c) ((row) * 128 + ((((c) ^ (((row) >> 1) & 7))) << 4))
#define DA_SBAR() __builtin_amdgcn_sched_barrier(0)
__device__ __forceinline__ int v_st(int k, int c) { const int kk = (k & ~0xC) | ((k & 4) << 1) | ((k & 8) >> 1); return ((kk >> 3) * 4 + (c >> 5)) * 512 + ((kk & 7) * 32 + (c & 31)) * 2; }
__device__ __forceinline__ int v_rd_base(int lane) { return ((lane & 3) << 3) | (((lane >> 2) & 3) << 6) | (((lane >> 4) & 1) << 5) | (((lane >> 5) & 1) << 8); }
constexpr int v_rd_off(int d0, int ks, int half) { return d0 * 512 + ks * 4096 + half * 2048; }
__device__ __forceinline__ int crow(int r, int hi) { return (r & 3) + 8 * (r >> 2) + 4 * hi; }
__device__ __forceinline__ unsigned cvtpk(float lo, float hi) { unsigned r; asm volatile("v_cvt_pk_bf16_f32 %0, %1, %2" : "=v"(r) : "v"(lo), "v"(hi)); return r; }
__device__ __forceinline__ void mask_tile(f32x16& p0, f32x16& p1, int dq) {
    const float NEG = -__builtin_inff();
#pragma unroll
    for (int r = 0; r < 16; ++r) { const int c = (r & 3) + 8 * (r >> 2); if (dq - c < 0) p0[r] = NEG; if (dq - c - 32 < 0) p1[r] = NEG; }
}
__device__ __forceinline__ void bias_tile(f32x16& p0, f32x16& p1, int dq, const DLAS float* lut) {
#pragma unroll
    for (int g = 0; g < 4; ++g) {
#pragma unroll
        for (int rr = 0; rr < 4; ++rr) { const int r = g * 4 + rr; const int c = (r & 3) + 8 * (r >> 2);
            int i0 = dq - c; i0 = i0 < 0 ? 0 : (i0 > 127 ? 127 : i0); int i1 = dq - c - 32; i1 = i1 < 0 ? 0 : (i1 > 127 ? 127 : i1);
            p0[r] += lut[i0]; p1[r] += lut[i1]; }
        DA_SBAR();
    }
}
__device__ __forceinline__ void partialSM(f32x16& p0, f32x16& p1, float& m_reg, float& alpha, float cb) {
    float pmax = p0[0];
#pragma unroll
    for (int r = 1; r < 16; ++r) pmax = fmaxf(pmax, p0[r]);
#pragma unroll
    for (int r = 0; r < 16; ++r) pmax = fmaxf(pmax, p1[r]);
    { auto rr = __builtin_amdgcn_permlane32_swap(__float_as_uint(pmax), __float_as_uint(pmax), false, false);
      pmax = fmaxf(__uint_as_float(rr[0]), __uint_as_float(rr[1])); }
    pmax += cb;
    float mn;
    if (__builtin_expect(__all(pmax - m_reg <= THR), 1)) { mn = m_reg; alpha = 1.f; }
    else { mn = fmaxf(m_reg, pmax); alpha = __builtin_amdgcn_exp2f(m_reg - mn); m_reg = mn; }
    const float off = cb - mn;
#pragma unroll
    for (int r = 0; r < 16; ++r) p0[r] += off;
#pragma unroll
    for (int r = 0; r < 16; ++r) p1[r] += off;
#pragma unroll
    for (int r = 0; r < 16; ++r) p0[r] = __builtin_amdgcn_exp2f(p0[r]);
}
__device__ __forceinline__ void finishSM(f32x16& p0, f32x16& p1, float alpha, float& l_reg, bf16x8& pa0, bf16x8& pa1, bf16x8& pa2, bf16x8& pa3) {
#pragma unroll
    for (int r = 0; r < 16; ++r) p1[r] = __builtin_amdgcn_exp2f(p1[r]);
    float ps = 0;
#pragma unroll
    for (int r = 0; r < 16; ++r) ps += p0[r];
#pragma unroll
    for (int r = 0; r < 16; ++r) ps += p1[r];
    { auto rr = __builtin_amdgcn_permlane32_swap(__float_as_uint(ps), __float_as_uint(ps), false, false);
      ps = __uint_as_float(rr[0]) + __uint_as_float(rr[1]); }
    l_reg = l_reg * alpha + ps;
#define DA_PK4(P, B_, OUT) do { unsigned a0 = cvtpk(P[B_+0], P[B_+1]), a1 = cvtpk(P[B_+2], P[B_+3]);                          \
        unsigned b0 = cvtpk(P[B_+4], P[B_+5]), b1 = cvtpk(P[B_+6], P[B_+7]);                                             \
        auto r0 = __builtin_amdgcn_permlane32_swap(a0, b0, false, false); auto r1 = __builtin_amdgcn_permlane32_swap(a1, b1, false, false); \
        u32x4 w = {r0[0], r1[0], r0[1], r1[1]}; OUT = *reinterpret_cast<bf16x8*>(&w); } while (0)
    DA_PK4(p0, 0, pa0); DA_PK4(p0, 8, pa1); DA_PK4(p1, 0, pa2); DA_PK4(p1, 8, pa3);
#undef DA_PK4
}
template <int KB>
__device__ __forceinline__ void qkt(f32x16& p0, f32x16& p1, const DLAS char* K_lds, int r32, int hi, const bf16x8* qr) {
    p0 = f32x16{}; p1 = f32x16{};
#pragma unroll
    for (int d0 = 0; d0 < 4; ++d0) { const DLAS char* a = K_lds + KB * SHM_K + DA_KSWZ(r32, d0 * 2 + hi);
        const bf16x8 b0 = *reinterpret_cast<const DLAS bf16x8*>(a);
        const bf16x8 b1 = *reinterpret_cast<const DLAS bf16x8*>(a + 32 * 128);
        p0 = __builtin_amdgcn_mfma_f32_32x32x16_bf16(b0, qr[d0], p0, 0, 0, 0);
        p1 = __builtin_amdgcn_mfma_f32_32x32x16_bf16(b1, qr[d0], p1, 0, 0, 0); }
}
template <int VB>
__device__ __forceinline__ void pv_tile(f32x16* o, int vb0, bf16x8 pa0, bf16x8 pa1, bf16x8 pa2, bf16x8 pa3) {
#define DA_TRRD(dst, off) asm volatile("ds_read_b64_tr_b16 %0, %1 offset:%2" : "=&v"(dst) : "v"(vb0), "i"(off) : "memory")
#define DA_PV_D0(d0) do { s16x4 l0, l1, l2, l3, h0, h1, h2, h3; constexpr int b_ = VB * SHM_V + v_rd_off(d0, 0, 0); \
        DA_TRRD(l0, b_); DA_TRRD(h0, b_ + 2048); DA_TRRD(l1, b_ + 4096); DA_TRRD(h1, b_ + 6144); DA_TRRD(l2, b_ + 8192); DA_TRRD(h2, b_ + 10240); DA_TRRD(l3, b_ + 12288); DA_TRRD(h3, b_ + 14336); \
        asm volatile("s_waitcnt lgkmcnt(0)" ::: "memory"); DA_SBAR();   \
        o[d0] = __builtin_amdgcn_mfma_f32_32x32x16_bf16(pa0, (bf16x8){l0[0], l0[1], l0[2], l0[3], h0[0], h0[1], h0[2], h0[3]}, o[d0], 0, 0, 0);   \
        o[d0] = __builtin_amdgcn_mfma_f32_32x32x16_bf16(pa1, (bf16x8){l1[0], l1[1], l1[2], l1[3], h1[0], h1[1], h1[2], h1[3]}, o[d0], 0, 0, 0);   \
        o[d0] = __builtin_amdgcn_mfma_f32_32x32x16_bf16(pa2, (bf16x8){l2[0], l2[1], l2[2], l2[3], h2[0], h2[1], h2[2], h2[3]}, o[d0], 0, 0, 0);   \
        o[d0] = __builtin_amdgcn_mfma_f32_32x32x16_bf16(pa3, (bf16x8){l3[0], l3[1], l3[2], l3[3], h3[0], h3[1], h3[2], h3[3]}, o[d0], 0, 0, 0); } while (0)
    DA_PV_D0(0); DA_PV_D0(1); DA_PV_D0(2); DA_PV_D0(3);
#undef DA_PV_D0
#undef DA_TRRD
}
template <bool ORDER_B>
__device__ __forceinline__ void attn_block(const unsigned short* __restrict__ Qp, const unsigned short* __restrict__ Kp, const unsigned short* __restrict__ Vp, int P0, DLAS char* lds, float c31, f32x16 (&o)[4]) {
    const int tid = threadIdx.x, wid = __builtin_amdgcn_readfirstlane(tid >> 6), lane = tid & 63, r32 = lane & 31, hi = lane >> 5;
    const int NT = (P0 + QB) / KVBLK;
    const int qlo = P0 + wid * QBLK, qm = qlo + r32 - 4 * hi;
    DLAS char* V_lds = lds + OFF_V; DLAS char* K_lds = lds + OFF_K;
    DLAS float* wsf = (DLAS float*)(lds + OFF_WS) + wid * 64; DLAS float* li_l = wsf; DLAS float* al_l = wsf + 32;
    const DLAS float* lut = (const DLAS float*)(lds + OFF_LUT);
    float m_reg = -1e30f, l_reg = 0.f;
#pragma unroll
    for (int d = 0; d < 4; ++d) o[d] = f32x16{};
    const int sr = tid >> 4, sc = (tid & 15) * 8, vst0 = v_st(sr, sc), vst1 = v_st(32 + sr, sc);
    const int kr = tid >> 3, kc = tid & 7, kws = DA_KSWZ(kr, kc);
    const int vb0 = (int)(uintptr_t)V_lds + v_rd_base(lane);
    bf16x8 qr[4];
#pragma unroll
    for (int d0 = 0; d0 < 4; ++d0) qr[d0] = *reinterpret_cast<const bf16x8*>(Qp + (size_t)(wid * QBLK + r32) * PITCH + d0 * 16 + hi * 8);
    bf16x8 st_v0, st_v1, st_k0;
#define DA_VMW() asm volatile("s_waitcnt vmcnt(0)" ::: "memory")
#define DA_SLOAD(k0) do { st_v0 = *reinterpret_cast<const bf16x8*>(Vp + (size_t)((k0) + sr) * PITCH + sc); st_v1 = *reinterpret_cast<const bf16x8*>(Vp + (size_t)((k0) + 32 + sr) * PITCH + sc); \
                          st_k0 = *reinterpret_cast<const bf16x8*>(Kp + (size_t)((k0) + kr) * PITCH + kc * 8); } while (0)
#define DA_SWRITE(bf) do { *reinterpret_cast<DLAS bf16x8*>(V_lds + (bf) * SHM_V + vst0) = st_v0; *reinterpret_cast<DLAS bf16x8*>(V_lds + (bf) * SHM_V + vst1) = st_v1; \
                           *reinterpret_cast<DLAS bf16x8*>(K_lds + (bf) * SHM_K + kws) = st_k0; } while (0)
#define DA_RESC(a) do { if (__any((a) < 1.f)) { if (hi == 0) al_l[r32] = (a); asm volatile("s_waitcnt lgkmcnt(0)" ::: "memory");              \
                        _Pragma("unroll") for (int d_ = 0; d_ < 4; ++d_) _Pragma("unroll") for (int r = 0; r < 16; ++r) o[d_][r] *= al_l[crow(r, hi)]; } } while (0)
#define DA_BIASMASK(P0_, P1_, t, cbv) do { const int kb_ = (t) * KVBLK; if (kb_ + KVBLK - 1 + 128 > qlo) { bias_tile(P0_, P1_, qm - kb_, lut); cbv = 0.f; if (kb_ + KVBLK - 1 > qlo) mask_tile(P0_, P1_, qm - kb_); } else cbv = c31; } while (0)
    f32x16 pA0, pA1, pB0, pB1; float alA, alB, cbA, cbB; bf16x8 pa0, pa1, pa2, pa3;
    DA_SLOAD(0); DA_VMW(); DA_SWRITE(0); DA_SBAR();
    DA_SLOAD(KVBLK);
    __syncthreads();
    DA_SBAR(); qkt<0>(pA0, pA1, K_lds, r32, hi, qr);
    DA_BIASMASK(pA0, pA1, 0, cbA); partialSM(pA0, pA1, m_reg, alA, cbA);
    DA_VMW(); DA_SWRITE(1);
    __syncthreads();
#define DA_HALF_STEP(PX0, PX1, alX, cbX, PY0, PY1, alY, t, KB, VB, SB) do {                                                      \
        DA_SBAR(); DA_SLOAD(((t) + 1) * KVBLK); DA_SBAR();              \
        if constexpr (!ORDER_B) {                                                                                               \
            qkt<KB>(PX0, PX1, K_lds, r32, hi, qr);                                                                     \
            finishSM(PY0, PY1, alY, l_reg, pa0, pa1, pa2, pa3); DA_SBAR();                                                       \
            pv_tile<VB>(o, vb0, pa0, pa1, pa2, pa3); DA_BIASMASK(PX0, PX1, (t), cbX); partialSM(PX0, PX1, m_reg, alX, cbX);      \
        } else {                                                                                                                \
            finishSM(PY0, PY1, alY, l_reg, pa0, pa1, pa2, pa3); DA_SBAR();                                            \
            pv_tile<VB>(o, vb0, pa0, pa1, pa2, pa3); DA_SBAR();                                                                   \
            qkt<KB>(PX0, PX1, K_lds, r32, hi, qr); DA_BIASMASK(PX0, PX1, (t), cbX); partialSM(PX0, PX1, m_reg, alX, cbX);        \
        }                                                                                                                       \
        __syncthreads();                                                                                                      \
        DA_VMW(); DA_SWRITE(SB);                                                                          \
        DA_RESC(alX); __syncthreads(); } while (0)
    for (int t = 1; t + 1 < NT; t += 2) {
        DA_HALF_STEP(pB0, pB1, alB, cbB, pA0, pA1, alA, t, 1, 0, 0);
        DA_HALF_STEP(pA0, pA1, alA, cbA, pB0, pB1, alB, t + 1, 0, 1, 1);
    }
    DA_SBAR(); qkt<1>(pB0, pB1, K_lds, r32, hi, qr); DA_SBAR();
    finishSM(pA0, pA1, alA, l_reg, pa0, pa1, pa2, pa3); DA_SBAR();
    pv_tile<0>(o, vb0, pa0, pa1, pa2, pa3);
    DA_BIASMASK(pB0, pB1, NT - 1, cbB); partialSM(pB0, pB1, m_reg, alB, cbB); DA_RESC(alB);
    finishSM(pB0, pB1, alB, l_reg, pa0, pa1, pa2, pa3); DA_SBAR(); pv_tile<1>(o, vb0, pa0, pa1, pa2, pa3);
    if (hi == 0) li_l[r32] = l_reg; asm volatile("s_waitcnt lgkmcnt(0)" ::: "memory");
#pragma unroll
    for (int r = 0; r < 16; ++r) { const float rl = __builtin_amdgcn_rcpf(li_l[crow(r, hi)]);
#pragma unroll
        for (int d0 = 0; d0 < 4; ++d0) o[d0][r] *= rl; }
    __syncthreads();
#undef DA_VMW
#undef DA_SLOAD
#undef DA_SWRITE
#undef DA_RESC
#undef DA_BIASMASK
#undef DA_HALF_STEP
}
}
static_assert(da::LDS_BYTES <= 131072, "attention LDS inside the ring region");
namespace da2 {
typedef short bf16x8 __attribute__((ext_vector_type(8)));
typedef short s16x4 __attribute__((ext_vector_type(4)));
typedef float f32x16 __attribute__((ext_vector_type(16)));
typedef float f32x4 __attribute__((ext_vector_type(4)));
typedef unsigned u32x4 __attribute__((ext_vector_type(4)));
#define D2LAS __attribute__((address_space(3)))
constexpr int NW = 8, QBLK = 32, KVBLK = 64, QB = NW * QBLK, PITCH = 3072;
constexpr int KSLOT = 8192, VSLOT = 16384, NKS = 3, NVS = 4;
constexpr int OFF_K = 0, OFF_V = NKS * KSLOT, OFF_WS = OFF_V + NVS * VSLOT, OFF_LUT = OFF_WS + NW * 64 * 4, LDS_BYTES = OFF_LUT + 4 * 2048;
constexpr int STG_PITCH = 272, STG_WAVE = 32 * STG_PITCH;
constexpr float THR = 8.f;
#define D2_SBAR() __builtin_amdgcn_sched_barrier(0)
__device__ __forceinline__ int crow(int r, int hi) { return (r & 3) + 8 * (r >> 2) + 4 * hi; }
typedef float f32x2_t __attribute__((ext_vector_type(2))); typedef __bf16 bf16x2_t __attribute__((ext_vector_type(2)));
__device__ __forceinline__ unsigned cvtpk(float lo, float hi) { f32x2_t v = {lo, hi}; bf16x2_t b = __builtin_convertvector(v, bf16x2_t); return __builtin_bit_cast(unsigned, b); }
__device__ __forceinline__ void glds16(const void* gsrc, unsigned lds_dst) { unsigned keep;
    asm volatile("s_mov_b32 %0, m0\n\ts_mov_b32 m0, %2\n\ts_nop 0\n\tglobal_load_lds_dwordx4 %1, off\n\ts_mov_b32 m0, %0" : "=&s"(keep) : "v"(gsrc), "s"(lds_dst) : "memory"); }
#define D2_WAIT_BAR(N) asm volatile("s_waitcnt vmcnt(" #N ") lgkmcnt(0)\n\ts_barrier" ::: "memory")
constexpr int TBL_X0 = 224, TBL_N = 512, TBL_COPY_BYTES = TBL_N * 4;
__device__ __forceinline__ void bias_mask_tile(f32x16& p0, f32x16& p1, int dq, const D2LAS char* tbl_lane  ) {
    const D2LAS char* a = tbl_lane - 4 * dq;
#pragma unroll
    for (int g = 0; g < 4; ++g) { const f32x4 t0 = *reinterpret_cast<const D2LAS f32x4*>(a + 32 * g), t1 = *reinterpret_cast<const D2LAS f32x4*>(a + 32 * g + 128);
#pragma unroll
        for (int i = 0; i < 4; ++i) { p0[4 * g + i] += t0[i]; p1[4 * g + i] += t1[i]; } }
}
__device__ __forceinline__ float rowmax(const f32x16& p0, const f32x16& p1) {
    float a = fmaxf(fmaxf(p0[0], p0[1]), p1[0]), b = fmaxf(fmaxf(p0[2], p0[3]), p1[1]); a = fmaxf(fmaxf(a, p1[2]), p1[3]);
#pragma unroll
    for (int r = 4; r < 16; r += 4) { a = fmaxf(fmaxf(a, p0[r]), p0[r + 1]); b = fmaxf(fmaxf(b, p0[r + 2]), p0[r + 3]); a = fmaxf(fmaxf(a, p1[r]), p1[r + 1]); b = fmaxf(fmaxf(b, p1[r + 2]), p1[r + 3]); }
    float m = fmaxf(a, b);
    auto rr = __builtin_amdgcn_permlane32_swap(__float_as_uint(m), __float_as_uint(m), false, false);
    return fmaxf(__uint_as_float(rr[0]), __uint_as_float(rr[1]));
}
__device__ __forceinline__ void qkt(f32x16& p0, f32x16& p1, const D2LAS char* Kslot, int r32, int hi, const bf16x8* qr, const f32x16& cinit) {
    const D2LAS char* kb = Kslot + hi * 1024 + r32 * 16;
#pragma unroll
    for (int d0 = 0; d0 < 4; ++d0) {
        const bf16x8 b0 = *reinterpret_cast<const D2LAS bf16x8*>(kb + d0 * 2048), b1 = *reinterpret_cast<const D2LAS bf16x8*>(kb + d0 * 2048 + 512);
        if (d0 == 0) { p0 = __builtin_amdgcn_mfma_f32_32x32x16_bf16(b0, qr[0], cinit, 0, 0, 0); p1 = __builtin_amdgcn_mfma_f32_32x32x16_bf16(b1, qr[0], cinit, 0, 0, 0); }
        else { p0 = __builtin_amdgcn_mfma_f32_32x32x16_bf16(b0, qr[d0], p0, 0, 0, 0); p1 = __builtin_amdgcn_mfma_f32_32x32x16_bf16(b1, qr[d0], p1, 0, 0, 0); } }
}
__device__ __forceinline__ void pv_tile(f32x16* o, int vb, bf16x8 pa0, bf16x8 pa1, bf16x8 pa2, bf16x8 pa3) {
#define D2_TRRD(dst, off) asm volatile("ds_read_b64_tr_b16 %0, %1 offset:%2" : "=&v"(dst) : "v"(vb), "i"(off) : "memory")
#define D2_PV(dq) do { s16x4 l0, l1, l2, l3, h0, h1, h2, h3; constexpr int b_ = (dq) * 4096; \
        D2_TRRD(l0, b_); D2_TRRD(h0, b_ + 512); D2_TRRD(l1, b_ + 1024); D2_TRRD(h1, b_ + 1536); D2_TRRD(l2, b_ + 2048); D2_TRRD(h2, b_ + 2560); D2_TRRD(l3, b_ + 3072); D2_TRRD(h3, b_ + 3584); \
        asm volatile("s_waitcnt lgkmcnt(0)" ::: "memory"); D2_SBAR();   \
        o[dq] = __builtin_amdgcn_mfma_f32_32x32x16_bf16(pa0, (bf16x8){l0[0], l0[1], l0[2], l0[3], h0[0], h0[1], h0[2], h0[3]}, o[dq], 0, 0, 0);   \
        o[dq] = __builtin_amdgcn_mfma_f32_32x32x16_bf16(pa1, (bf16x8){l1[0], l1[1], l1[2], l1[3], h1[0], h1[1], h1[2], h1[3]}, o[dq], 0, 0, 0);   \
        o[dq] = __builtin_amdgcn_mfma_f32_32x32x16_bf16(pa2, (bf16x8){l2[0], l2[1], l2[2], l2[3], h2[0], h2[1], h2[2], h2[3]}, o[dq], 0, 0, 0);   \
        o[dq] = __builtin_amdgcn_mfma_f32_32x32x16_bf16(pa3, (bf16x8){l3[0], l3[1], l3[2], l3[3], h3[0], h3[1], h3[2], h3[3]}, o[dq], 0, 0, 0); } while (0)
    D2_PV(0); D2_PV(1); D2_PV(2); D2_PV(3);
#undef D2_PV
#undef D2_TRRD
}
__device__ __forceinline__ void attn_block(const unsigned short* __restrict__ Qp, const unsigned short* __restrict__ Kp, const unsigned short* __restrict__ Vp, int P0, D2LAS char* lds, float c31, f32x16 (&o)[4]) {
    const int tid = threadIdx.x, wid = __builtin_amdgcn_readfirstlane(tid >> 6), lane = tid & 63, r32 = lane & 31, hi = lane >> 5;
    const int NT = (P0 + QB) / KVBLK;
    const int qlo = P0 + wid * QBLK, qm = qlo + r32 - 4 * hi;
    const unsigned lds0 = (unsigned)(uintptr_t)lds;
    D2LAS float* wsf = (D2LAS float*)(lds + OFF_WS) + wid * 64;
    const D2LAS char* tbl_lane = lds + OFF_LUT + ((-r32) & 3) * TBL_COPY_BYTES + 4 * (TBL_X0 - ((-r32) & 3));
    const unsigned short* ksrc = Kp + (size_t)lane * PITCH + wid * 8;
    const unsigned short* vsrc = Vp + (size_t)(16 * (wid & 3) + (lane >> 2)) * PITCH + (wid >> 2) * 32 + (lane & 3) * 8;
    const unsigned kdst = lds0 + OFF_K + wid * 1024, vdst = lds0 + OFF_V + wid * 1024;
    int ks_i = 0, vs_i = 0;
    int jt = 0;
#define D2_DMA() do { glds16(ksrc + (size_t)jt * (KVBLK * PITCH), (unsigned)__builtin_amdgcn_readfirstlane(kdst + ks_i * KSLOT)); \
        glds16(vsrc + (size_t)jt * (KVBLK * PITCH), (unsigned)__builtin_amdgcn_readfirstlane(vdst + vs_i * VSLOT)); \
        glds16(vsrc + (size_t)jt * (KVBLK * PITCH) + 64, (unsigned)__builtin_amdgcn_readfirstlane(vdst + vs_i * VSLOT + 8192)); \
        ++jt; ks_i = ks_i == NKS - 1 ? 0 : ks_i + 1; vs_i = vs_i == NVS - 1 ? 0 : vs_i + 1; } while (0)
    bf16x8 qr[4];
#pragma unroll
    for (int d0 = 0; d0 < 4; ++d0) qr[d0] = *reinterpret_cast<const bf16x8*>(Qp + (size_t)(wid * QBLK + r32) * PITCH + d0 * 16 + hi * 8);
    D2_DMA(); D2_DMA(); D2_DMA();
    const D2LAS char* Kl = lds + OFF_K;
    const int vb0 = (int)(lds0 + OFF_V) + ((lane >> 4) & 1) * 32 + (lane & 3) * 8 + (4 * hi + ((lane & 15) >> 2)) * 64;
    float M = 0.f, l_reg = 0.f;
#pragma unroll
    for (int d = 0; d < 4; ++d) o[d] = f32x16{};
    f32x16 negb;
#pragma unroll
    for (int r = 0; r < 16; ++r) negb[r] = c31;
    f32x16 pA0, pA1, pB0, pB1; bf16x8 pa0, pa1, pa2, pa3;
    int kc = 0, vp = 0;
#define D2_BIASMASK(P0_, P1_, t) do { const int kb_ = (t) * KVBLK; if (kb_ + KVBLK - 1 + 128 > qlo) bias_mask_tile(P0_, P1_, qm - kb_, tbl_lane); } while (0)
#define D2_DECIDE(PX0, PX1, first) do { const float rm = rowmax(PX0, PX1); resc = false; \
        if ((first) || __builtin_expect(__any(rm > THR), 0)) { const float dl = (first) ? rm : fmaxf(rm, 0.f); M += dl; \
            _Pragma("unroll") for (int r = 0; r < 16; ++r) { PX0[r] -= dl; PX1[r] -= dl; } \
            _Pragma("unroll") for (int r = 0; r < 16; ++r) negb[r] = c31 - M; \
            const float f = __builtin_amdgcn_exp2f(-dl); l_reg *= f; if (hi == 0) wsf[r32] = f; resc = !(first); } \
        _Pragma("unroll") for (int r = 0; r < 16; ++r) { PX0[r] = __builtin_amdgcn_exp2f(PX0[r]); PX1[r] = __builtin_amdgcn_exp2f(PX1[r]); } } while (0)
#define D2_RESC() do { if (resc) { asm volatile("s_waitcnt lgkmcnt(0)" ::: "memory"); \
        _Pragma("unroll") for (int d_ = 0; d_ < 4; ++d_) _Pragma("unroll") for (int r = 0; r < 16; ++r) o[d_][r] *= wsf[crow(r, hi)]; } } while (0)
#define D2_FINISH(PY0, PY1) do { float s_ = 0.f; _Pragma("unroll") for (int r = 0; r < 16; ++r) s_ += PY0[r] + PY1[r]; l_reg += s_; \
        { u32x4 w_ = {cvtpk(PY0[0], PY0[1]), cvtpk(PY0[2], PY0[3]), cvtpk(PY0[4], PY0[5]), cvtpk(PY0[6], PY0[7])}; pa0 = __builtin_bit_cast(bf16x8, w_); } \
        { u32x4 w_ = {cvtpk(PY0[8], PY0[9]), cvtpk(PY0[10], PY0[11]), cvtpk(PY0[12], PY0[13]), cvtpk(PY0[14], PY0[15])}; pa1 = __builtin_bit_cast(bf16x8, w_); } \
        { u32x4 w_ = {cvtpk(PY1[0], PY1[1]), cvtpk(PY1[2], PY1[3]), cvtpk(PY1[4], PY1[5]), cvtpk(PY1[6], PY1[7])}; pa2 = __builtin_bit_cast(bf16x8, w_); } \
        { u32x4 w_ = {cvtpk(PY1[8], PY1[9]), cvtpk(PY1[10], PY1[11]), cvtpk(PY1[12], PY1[13]), cvtpk(PY1[14], PY1[15])}; pa3 = __builtin_bit_cast(bf16x8, w_); } } while (0)
#define D2_ENDW(t) do { if ((t) + 2 < NT) { D2_WAIT_BAR(5); } else if ((t) + 1 < NT) { D2_WAIT_BAR(2); } else { D2_WAIT_BAR(0); } } while (0)
    bool resc = false;
    D2_WAIT_BAR(8);
    qkt(pA0, pA1, Kl, r32, hi, qr, negb); D2_BIASMASK(pA0, pA1, 0); D2_DECIDE(pA0, pA1, true);
    D2_WAIT_BAR(5);
    kc = 1; vp = 0;
#define D2_HALF_STEP(PX0, PX1, PY0, PY1, t) do { \
        if ((t) + 2 < NT) D2_DMA(); \
        qkt(PX0, PX1, Kl + kc * KSLOT, r32, hi, qr, negb); \
        D2_FINISH(PY0, PY1); D2_SBAR(); \
        pv_tile(o, vb0 + vp * VSLOT, pa0, pa1, pa2, pa3); \
        D2_BIASMASK(PX0, PX1, (t)); D2_DECIDE(PX0, PX1, false); D2_RESC(); \
        D2_ENDW(t); kc = kc == NKS - 1 ? 0 : kc + 1; vp = vp == NVS - 1 ? 0 : vp + 1; } while (0)
    for (int t = 1; t + 1 < NT; t += 2) {
        D2_HALF_STEP(pB0, pB1, pA0, pA1, t);
        D2_HALF_STEP(pA0, pA1, pB0, pB1, t + 1);
    }
    D2_HALF_STEP(pB0, pB1, pA0, pA1, NT - 1);
    D2_FINISH(pB0, pB1); D2_SBAR(); pv_tile(o, vb0 + vp * VSLOT, pa0, pa1, pa2, pa3);
    { auto rr = __builtin_amdgcn_permlane32_swap(__float_as_uint(l_reg), __float_as_uint(l_reg), false, false); l_reg = __uint_as_float(rr[0]) + __uint_as_float(rr[1]); }
    if (hi == 0) wsf[32 + r32] = l_reg; asm volatile("s_waitcnt lgkmcnt(0)" ::: "memory");
#pragma unroll
    for (int r = 0; r < 16; ++r) { const float rl = __builtin_amdgcn_rcpf(wsf[32 + crow(r, hi)]);
#pragma unroll
        for (int d0 = 0; d0 < 4; ++d0) o[d0][r] *= rl; }
    asm volatile("s_waitcnt lgkmcnt(0)\n\ts_barrier" ::: "memory");
#undef D2_DMA
#undef D2_BIASMASK
#undef D2_DECIDE
#undef D2_RESC
#undef D2_FINISH
#undef D2_ENDW
#undef D2_HALF_STEP
}
}
static_assert(da2::LDS_BYTES <= 131072, "attention v2 LDS inside the ring region");
constexpr int NWAVES = 8;
#ifndef MK_N_LAUNCHES
#define MK_N_LAUNCHES 1
#endif
constexpr int BATCH = 16, SEQ = 2048, D = 1024, FF = 4096, M = BATCH * SEQ;
constexpr int NQKV = 3072;
constexpr int MLW = 3080, NPROJ = 3072;
constexpr int NH_A = 8, NH_M = 4;
constexpr float EPS = 1e-6f, LOG2E = 1.4426950408889634f;
constexpr float QSCALE = 0.125f * LOG2E;
constexpr float LAMBDA_INIT0 = 0.2f;
constexpr float MQSCALE = 0.08838834764831845f;
constexpr int NPHASE = 16;
constexpr int DUP_PHASE = -1;

namespace ml {
typedef short bf16x8 __attribute__((ext_vector_type(8)));
typedef short s16x4 __attribute__((ext_vector_type(4)));
typedef float f32x16 __attribute__((ext_vector_type(16)));
typedef float f32x4 __attribute__((ext_vector_type(4)));
typedef unsigned u32x4 __attribute__((ext_vector_type(4)));
typedef unsigned u32x2 __attribute__((ext_vector_type(2)));
#define MLAS __attribute__((address_space(3)))
constexpr int L = 64, NC = 2048 / L, PITCH = 3072;
constexpr int PQ = 272, PS = 144;
constexpr int O_Q = 0, O_K = O_Q + 64 * PQ, O_C = O_K + 64 * PQ, O_KW = O_C + 64 * PQ, O_V = O_KW + 16384, O_SC = O_V + 16384, O_ARR = O_SC + 64 * PS, O_NP = O_ARR + 9 * 256, O_N = O_NP + 4096, LDS_BYTES = O_N + 512;
enum { A_E = 0, A_BM = 64, A_INTER = 128, A_EMJ = 192, A_WP = 256, A_RS0 = 320, A_RS1 = 384, A_QN = 448, A_SCAL = 512 };
__device__ __forceinline__ float bf2f_lo(unsigned w) { return __uint_as_float(w << 16); }
__device__ __forceinline__ float bf2f_hi(unsigned w) { return __uint_as_float(w & 0xffff0000u); }
typedef float f32x2_t __attribute__((ext_vector_type(2))); typedef __bf16 bf16x2_t __attribute__((ext_vector_type(2)));
__device__ __forceinline__ unsigned cvtpk(float lo, float hi) { f32x2_t v = {lo, hi}; bf16x2_t b = __builtin_convertvector(v, bf16x2_t); return __builtin_bit_cast(unsigned, b); }
__device__ __forceinline__ int crow(int r, int hi) { return (r & 3) + 8 * (r >> 2) + 4 * hi; }
__device__ __forceinline__ int v_st(int k, int c) { const int kk = (k & ~0xC) | ((k & 4) << 1) | ((k & 8) >> 1); return ((kk >> 3) * 4 + (c >> 5)) * 512 + ((kk & 7) * 32 + (c & 31)) * 2; }
__device__ __forceinline__ int v_rd_base(int lane) { return ((lane & 3) << 3) | (((lane >> 2) & 3) << 6) | (((lane >> 4) & 1) << 5) | (((lane >> 5) & 1) << 8); }
#define ML_TRRD(dst, base, off) asm volatile("ds_read_b64_tr_b16 %0, %1 offset:%2" : "=&v"(dst) : "v"(base), "i"(off) : "memory")
#define ML_SBAR() __builtin_amdgcn_sched_barrier(0)
#define ML_FR(lo, hi_) (bf16x8){lo[0], lo[1], lo[2], lo[3], hi_[0], hi_[1], hi_[2], hi_[3]}
struct Pre { bf16x8 q[2], k[2], v; f32x4 g; };

__device__ __forceinline__ void mlstm_unit(int b, int h, int s4, const unsigned short* __restrict__ PROJ, const unsigned short* __restrict__ QKC, const float* __restrict__ GS,
                                           unsigned short* HT, float* SSQ, MLAS char* lds) {
    const int tid = threadIdx.x, wid = __builtin_amdgcn_readfirstlane(tid >> 6), lane = tid & 63, r32 = lane & 31, hi = lane >> 5;
    MLAS char* QIMG = lds + O_Q; MLAS char* KIMG = lds + O_K; MLAS char* CIMG = lds + O_C; MLAS char* KWTR = lds + O_KW; MLAS char* VTR = lds + O_V; MLAS char* SC = lds + O_SC;
    MLAS float* arr = (MLAS float*)(lds + O_ARR); MLAS float* npart = (MLAS float*)(lds + O_NP); MLAS float* nvec = (MLAS float*)(lds + O_N);
    const int srow = tid >> 4, cg = tid & 15;
    const int vrow = tid >> 3, vcol = (tid & 7) * 8;
    const size_t tok0 = (size_t)b * 2048;
    const unsigned short* xq = QKC + tok0 * 1024 + h * 128 + cg * 8;
    const unsigned short* xk = xq + 512;
    const unsigned short* xv = PROJ + tok0 * PITCH + 1024 + h * 256 + s4 * 64 + vcol;
    const float* gs = GS + tok0 * 16 + h * 4;
    const int dkb = wid >> 1, dvb = wid & 1;
    const int tb0 = (wid & 3) >> 1, jb = wid & 1;
    f32x16 cst = f32x16{};
    float m_prev = 0.f;
    for (int i = tid; i < (64 * PQ) / 16; i += 512) ((MLAS u32x4*)CIMG)[i] = (u32x4){0u, 0u, 0u, 0u};
    if (tid < 128) nvec[tid] = 0.f;
    Pre P;
#define ML_LOAD(t0_) do { P.q[0] = *reinterpret_cast<const bf16x8*>(xq + (size_t)((t0_) + srow) * 1024); P.q[1] = *reinterpret_cast<const bf16x8*>(xq + (size_t)((t0_) + srow + 32) * 1024); \
        P.k[0] = *reinterpret_cast<const bf16x8*>(xk + (size_t)((t0_) + srow) * 1024); P.k[1] = *reinterpret_cast<const bf16x8*>(xk + (size_t)((t0_) + srow + 32) * 1024); \
        P.v = *reinterpret_cast<const bf16x8*>(xv + (size_t)((t0_) + vrow) * PITCH); P.g = *reinterpret_cast<const f32x4*>(gs + (size_t)((t0_) + lane) * 16); } while (0)
    ML_LOAD(0);
    u32x2 dst_w[4] = {}; float dst_ss = 0.f;
    const int trb_kw = (int)(uintptr_t)KWTR + v_rd_base(lane), trb_v = (int)(uintptr_t)VTR + v_rd_base(lane);
    __syncthreads();
    for (int c = 0; c < NC; ++c) {
        const int t0 = c * L;
        const float bsum = P.g[0], e = P.g[1], pm = P.g[2];
        asm volatile("" :: "v"(P.g[3]));
        const float b_last = __int_as_float(__builtin_amdgcn_readlane(__float_as_int(bsum), 63)), m_loc = b_last + __int_as_float(__builtin_amdgcn_readlane(__float_as_int(pm), 63));
        const float m_new = fmaxf(b_last + m_prev, m_loc), decay = __expf(b_last + m_prev - m_new);
        const float wp = __expf(b_last + e - m_new);
        const float m_inter = bsum + m_prev, m_j = fmaxf(m_inter, bsum + pm);
        if (wid == 0) { arr[A_E + lane] = e; arr[A_BM + lane] = bsum - m_j; arr[A_INTER + lane] = __expf(m_inter - m_j); arr[A_EMJ + lane] = __expf(-m_j); arr[A_WP + lane] = wp; }
        m_prev = m_new;
#pragma unroll
        for (int i = 0; i < 2; ++i) { const int row = srow + 32 * i; const float wrow = __shfl(wp, row);
            *reinterpret_cast<MLAS bf16x8*>(QIMG + row * PQ + cg * 16) = P.q[i];
            *reinterpret_cast<MLAS bf16x8*>(KIMG + row * PQ + cg * 16) = P.k[i];
            const u32x4 kw = __builtin_bit_cast(u32x4, P.k[i]); u32x4 ow;
#pragma unroll
            for (int q = 0; q < 4; ++q) ow[q] = cvtpk(bf2f_lo(kw[q]) * wrow, bf2f_hi(kw[q]) * wrow);
            *reinterpret_cast<MLAS u32x4*>(KWTR + v_st(row, cg * 8)) = ow; }
        *reinterpret_cast<MLAS bf16x8*>(VTR + v_st(vrow, vcol)) = P.v;
        __syncthreads();
#define ML_STORE_OUT(tt) do { if (wid >= 4) { const int j_ = 32 * jb + r32; unsigned short* hp_ = HT + (tok0 + (tt) + j_) * 1024 + h * 256 + s4 * 64 + 32 * tb0 + 4 * hi; \
            _Pragma("unroll") for (int q4 = 0; q4 < 4; ++q4) *reinterpret_cast<u32x2*>(hp_ + 8 * q4) = dst_w[q4]; \
            if (hi == 0) SSQ[(tok0 + (tt) + j_) * 32 + h * 8 + s4 * 2 + tb0] = dst_ss; } } while (0)
        if (c > 0) ML_STORE_OUT(t0 - L);
        { const int tn = (c + 1 < NC) ? t0 + L : t0; ML_LOAD(tn); }
        f32x16 acc_qc = f32x16{};
        if (wid < 4) {
            f32x16 g = f32x16{};
            if (!(tb0 == 1 && jb == 0)) {
                const MLAS char* ka = KIMG + (32 * tb0 + r32) * PQ + hi * 16; const MLAS char* qa = QIMG + (32 * jb + r32) * PQ + hi * 16;
bf16x8 fa[8], fb[8];
#pragma unroll
                for (int kk = 0; kk < 8; ++kk) { fa[kk] = *reinterpret_cast<const MLAS bf16x8*>(ka + kk * 32); fb[kk] = *reinterpret_cast<const MLAS bf16x8*>(qa + kk * 32); }
                ML_SBAR();
#pragma unroll
                for (int kk = 0; kk < 8; ++kk) g = __builtin_amdgcn_mfma_f32_32x32x16_bf16(fa[kk], fb[kk], g, 0, 0, 0);
            }
            const int j = 32 * jb + r32; const float bm = arr[A_BM + j]; float rsum = 0.f;
#pragma unroll
            for (int q4 = 0; q4 < 4; ++q4) { const f32x4 ev = *reinterpret_cast<const MLAS f32x4*>(arr + A_E + 32 * tb0 + 8 * q4 + 4 * hi);
                float sc4[4];
#pragma unroll
                for (int i = 0; i < 4; ++i) { const int s = 32 * tb0 + 8 * q4 + 4 * hi + i; const float v = (s <= j) ? g[4 * q4 + i] * __expf(bm + ev[i]) : 0.f; sc4[i] = v; rsum += v; }
                const u32x2 w = {cvtpk(sc4[0], sc4[1]), cvtpk(sc4[2], sc4[3])};
                *reinterpret_cast<MLAS u32x2*>(SC + j * PS + (32 * tb0 + 8 * q4 + 4 * hi) * 2) = w; }
            rsum += __shfl_xor(rsum, 32);
            if (hi == 0) arr[(tb0 ? A_RS1 : A_RS0) + j] = rsum;
        } else {
            const MLAS char* ca = CIMG + (32 * tb0 + r32) * PQ + hi * 16; const MLAS char* qa = QIMG + (32 * jb + r32) * PQ + hi * 16;
bf16x8 fa[8], fb[8];
#pragma unroll
            for (int kk = 0; kk < 8; ++kk) { fa[kk] = *reinterpret_cast<const MLAS bf16x8*>(ca + kk * 32); fb[kk] = *reinterpret_cast<const MLAS bf16x8*>(qa + kk * 32); }
            ML_SBAR();
#pragma unroll
            for (int kk = 0; kk < 8; ++kk) acc_qc = __builtin_amdgcn_mfma_f32_32x32x16_bf16(fa[kk], fb[kk], acc_qc, 0, 0, 0);
        }
        {
            const int j = tid >> 3, part = tid & 7;
            const u32x4 q0 = *reinterpret_cast<const MLAS u32x4*>(QIMG + j * PQ + part * 32), q1 = *reinterpret_cast<const MLAS u32x4*>(QIMG + j * PQ + part * 32 + 16);
            float s = 0.f;
#pragma unroll
            for (int q = 0; q < 4; ++q) { const f32x4 n4 = *reinterpret_cast<const MLAS f32x4*>(nvec + part * 16 + 4 * q);
                const unsigned w0 = q < 2 ? q0[2 * q] : q1[2 * q - 4], w1 = q < 2 ? q0[2 * q + 1] : q1[2 * q - 3];
                s += bf2f_lo(w0) * n4[0] + bf2f_hi(w0) * n4[1] + bf2f_lo(w1) * n4[2] + bf2f_hi(w1) * n4[3]; }
            s += __shfl_xor(s, 1); s += __shfl_xor(s, 2); s += __shfl_xor(s, 4);
            if (part == 0) arr[A_QN + j] = s;
            float n0 = 0.f, n1 = 0.f;
#pragma unroll
            for (int i = 0; i < 8; ++i) { const int srow = 8 * wid + i; const unsigned kw = *reinterpret_cast<const MLAS unsigned*>(KIMG + srow * PQ + lane * 4); const float w = arr[A_WP + srow];
                n0 += w * bf2f_lo(kw); n1 += w * bf2f_hi(kw); }
            npart[wid * 128 + 2 * lane] = n0; npart[wid * 128 + 2 * lane + 1] = n1;
        }
        __syncthreads();
        if (wid >= 4) {
            f32x16 acc_n = f32x16{};
            const MLAS char* sa = SC + (32 * jb + r32) * PS + hi * 16;
            {   s16x4 l0, l1, l2, l3, h0, h1, h2, h3;
                if (tb0 == 0) { ML_TRRD(l0, trb_v, 0); ML_TRRD(h0, trb_v, 2048); ML_TRRD(l1, trb_v, 4096); ML_TRRD(h1, trb_v, 6144); ML_TRRD(l2, trb_v, 8192); ML_TRRD(h2, trb_v, 10240); ML_TRRD(l3, trb_v, 12288); ML_TRRD(h3, trb_v, 14336); }
                else { ML_TRRD(l0, trb_v, 512); ML_TRRD(h0, trb_v, 512 + 2048); ML_TRRD(l1, trb_v, 512 + 4096); ML_TRRD(h1, trb_v, 512 + 6144); ML_TRRD(l2, trb_v, 512 + 8192); ML_TRRD(h2, trb_v, 512 + 10240); ML_TRRD(l3, trb_v, 512 + 12288); ML_TRRD(h3, trb_v, 512 + 14336); }
                const bf16x8 s0 = *reinterpret_cast<const MLAS bf16x8*>(sa), s1 = *reinterpret_cast<const MLAS bf16x8*>(sa + 32), s2 = *reinterpret_cast<const MLAS bf16x8*>(sa + 64), s3 = *reinterpret_cast<const MLAS bf16x8*>(sa + 96);
                asm volatile("s_waitcnt lgkmcnt(0)" ::: "memory"); ML_SBAR();
                acc_n = __builtin_amdgcn_mfma_f32_32x32x16_bf16(ML_FR(l0, h0), s0, acc_n, 0, 0, 0);
                acc_n = __builtin_amdgcn_mfma_f32_32x32x16_bf16(ML_FR(l1, h1), s1, acc_n, 0, 0, 0);
                acc_n = __builtin_amdgcn_mfma_f32_32x32x16_bf16(ML_FR(l2, h2), s2, acc_n, 0, 0, 0);
                acc_n = __builtin_amdgcn_mfma_f32_32x32x16_bf16(ML_FR(l3, h3), s3, acc_n, 0, 0, 0); }
            const int j = 32 * jb + r32; const float inter = arr[A_INTER + j];
            const float den = arr[A_RS0 + j] + arr[A_RS1 + j] + inter * arr[A_QN + j];
            const float rden = 1.f / fmaxf(fabsf(den), arr[A_EMJ + j]);
            float ss = 0.f;
#pragma unroll
            for (int q4 = 0; q4 < 4; ++q4) { float hv[4];
#pragma unroll
                for (int i = 0; i < 4; ++i) { hv[i] = (acc_n[4 * q4 + i] + inter * acc_qc[4 * q4 + i]) * rden; ss += hv[i] * hv[i]; }
                dst_w[q4] = (u32x2){cvtpk(hv[0], hv[1]), cvtpk(hv[2], hv[3])}; }
            ss += __shfl_xor(ss, 32);
            dst_ss = ss;
        }
        {
            s16x4 al[4], ah[4], bl[4], bh[4];
#define ML_LD4(d0k, d0v) do { ML_TRRD(al[0], trb_kw, (d0k) * 512); ML_TRRD(ah[0], trb_kw, (d0k) * 512 + 2048); ML_TRRD(al[1], trb_kw, (d0k) * 512 + 4096); ML_TRRD(ah[1], trb_kw, (d0k) * 512 + 6144); \
            ML_TRRD(al[2], trb_kw, (d0k) * 512 + 8192); ML_TRRD(ah[2], trb_kw, (d0k) * 512 + 10240); ML_TRRD(al[3], trb_kw, (d0k) * 512 + 12288); ML_TRRD(ah[3], trb_kw, (d0k) * 512 + 14336); \
            ML_TRRD(bl[0], trb_v, (d0v) * 512); ML_TRRD(bh[0], trb_v, (d0v) * 512 + 2048); ML_TRRD(bl[1], trb_v, (d0v) * 512 + 4096); ML_TRRD(bh[1], trb_v, (d0v) * 512 + 6144); \
            ML_TRRD(bl[2], trb_v, (d0v) * 512 + 8192); ML_TRRD(bh[2], trb_v, (d0v) * 512 + 10240); ML_TRRD(bl[3], trb_v, (d0v) * 512 + 12288); ML_TRRD(bh[3], trb_v, (d0v) * 512 + 14336); } while (0)
            switch (wid) { case 0: ML_LD4(0, 0); break; case 1: ML_LD4(0, 1); break; case 2: ML_LD4(1, 0); break; case 3: ML_LD4(1, 1); break;
                           case 4: ML_LD4(2, 0); break; case 5: ML_LD4(2, 1); break; case 6: ML_LD4(3, 0); break; default: ML_LD4(3, 1); break; }
#undef ML_LD4
#pragma unroll
            for (int r = 0; r < 16; ++r) cst[r] *= decay;
            asm volatile("s_waitcnt lgkmcnt(0)" ::: "memory"); ML_SBAR();
#pragma unroll
            for (int ks = 0; ks < 4; ++ks) cst = __builtin_amdgcn_mfma_f32_32x32x16_bf16(ML_FR(al[ks], ah[ks]), ML_FR(bl[ks], bh[ks]), cst, 0, 0, 0);
            const int dv = 32 * dvb + r32;
#pragma unroll
            for (int q4 = 0; q4 < 4; ++q4) { const u32x2 w = {cvtpk(cst[4 * q4], cst[4 * q4 + 1]), cvtpk(cst[4 * q4 + 2], cst[4 * q4 + 3])};
                *reinterpret_cast<MLAS u32x2*>(CIMG + dv * PQ + (32 * dkb + 8 * q4 + 4 * hi) * 2) = w; }
        }
        if (tid < 128) { float s = nvec[tid] * decay;
#pragma unroll
            for (int w = 0; w < 8; ++w) s += npart[w * 128 + tid];
            nvec[tid] = s; }
        __syncthreads();
    }
    ML_STORE_OUT((NC - 1) * L);
#undef ML_STORE_OUT
#undef ML_LOAD
}
}
static_assert(ml::LDS_BYTES <= 131072, "mLSTM LDS inside the ring region");
constexpr size_t MiB = 1u << 20;
constexpr size_t WS_CTL = 0, CTL_ZERO_BYTES = 1 * MiB;
constexpr size_t WS_WQKV = 2 * MiB, WS_WAO = 8 * MiB, WS_WML = 10 * MiB  , WS_WMO = 17 * MiB, WS_W1 = 19 * MiB  , WS_W2 = 35 * MiB  ;
constexpr size_t WS_GATES = 51 * MiB;
constexpr size_t WS_SSQ = 52 * MiB;
constexpr size_t WS_GS = 56 * MiB;
constexpr size_t WS_SSQH = 58 * MiB;
constexpr size_t WS_XN = 64 * MiB;
constexpr size_t WS_U = 128 * MiB;
constexpr size_t WS_HT = 320 * MiB;
constexpr size_t WS_AO = 384 * MiB;
constexpr size_t WS_STASH = 448 * MiB;
constexpr size_t WS_END = 480 * MiB;
constexpr int CW_TMO = 0, CW_CODE = 1;
constexpr int CW_BAR = 4096;
constexpr int RING_OFF = 0, RING_BYTES = 131072;
constexpr int LDSCTL_OFF = RING_BYTES, MISC_OFF = LDSCTL_OFF + 320;
constexpr int EPIRED_OFF = LDSCTL_OFF + 1024;
constexpr int LDS_BYTES = 147456;
static_assert(MISC_OFF + 128 <= LDS_BYTES, "LDS map");

#define GAS __attribute__((address_space(1)))
#define LAS __attribute__((address_space(3)))
typedef unsigned short bf16;
typedef unsigned v4u __attribute__((ext_vector_type(4)));
typedef float f32x4 __attribute__((ext_vector_type(4)));
typedef short bf16x8 __attribute__((ext_vector_type(8)));
typedef GAS unsigned gu32;
typedef GAS unsigned long long gu64;
#define RLX_AGENT __ATOMIC_RELAXED, __HIP_MEMORY_SCOPE_AGENT
#define LDS_WAIT() asm volatile("s_waitcnt lgkmcnt(0)" ::: "memory")
#define VM_WAIT() asm volatile("s_waitcnt vmcnt(0)" ::: "memory")
__device__ __forceinline__ unsigned long long rt() { return __builtin_amdgcn_s_memrealtime(); }
__device__ __forceinline__ unsigned f2bf(float f) { unsigned u = __builtin_bit_cast(unsigned, f); return (u + 0x7fffu + ((u >> 16) & 1u)) >> 16; }
__device__ __forceinline__ unsigned pk2(float lo, float hi) { return f2bf(lo) | (f2bf(hi) << 16); }

#define XB_TMO      128
#define XB_XCNT(j)  (256  + 64 * (j))
#define XB_XSUB(j)  (1280 + 64 * (j))
#define XB_XGEN(j)  (2304 + 64 * (j))
#define XB_TOP      3328
#define XB_TOPGEN   3392
#define XCD_BAR_WORDS 3456
#define XB_SPIN_CAP (1u << 23)

__device__ __forceinline__ unsigned xb_ld(unsigned* p)              { return __hip_atomic_load(p, __ATOMIC_RELAXED, __HIP_MEMORY_SCOPE_AGENT); }
__device__ __forceinline__ unsigned xb_add(unsigned* p, unsigned v) { return __hip_atomic_fetch_add(p, v, __ATOMIC_RELAXED, __HIP_MEMORY_SCOPE_AGENT); }
__device__ __forceinline__ unsigned xb_xcc_id() { return (unsigned)__builtin_amdgcn_s_getreg((3 << 11) | 20) & 0xFu; }
#define XB_SPIN(cond, bar) do { unsigned _sp = 0; while (cond) { __builtin_amdgcn_s_sleep(1); \
    if ((++_sp & 255u) == 0u) { if (xb_ld(&(bar)[XB_TMO])) break; if (_sp > XB_SPIN_CAP) { atomicAdd(&(bar)[XB_TMO], 1u); break; } } } } while (0)

struct XcdBarrier {
    unsigned* bar; unsigned x;
    volatile LAS unsigned* st;
};

__device__ __forceinline__ XcdBarrier xcd_barrier_post(unsigned* bar, volatile LAS unsigned* st) {
    XcdBarrier b; b.bar = bar; b.x = xb_xcc_id(); b.st = st;
    if (threadIdx.x == 0) (void)xb_add(&bar[XB_XCNT(b.x)], 1u);
    return b;
}
__device__ __forceinline__ void xcd_barrier_complete(unsigned* bar, unsigned x, unsigned& nloc, unsigned& nx) {
    const unsigned G = gridDim.x * gridDim.y * gridDim.z;
    unsigned sum, cnt, mine, sp = 0u;
    for (;;) {
        sum = 0u; cnt = 0u; mine = 0u;
#pragma unroll
        for (unsigned j = 0; j < 16; ++j) { const unsigned c = xb_ld(&bar[XB_XCNT(j)]); sum += c; cnt += (c > 0u) ? 1u : 0u; mine = (j == x) ? c : mine; }
        if (sum == G) break;
        __builtin_amdgcn_s_sleep(1);
        if ((++sp & 255u) == 0u) { if (xb_ld(&bar[XB_TMO])) break; if (sp > XB_SPIN_CAP) { atomicAdd(&bar[XB_TMO], 1u); break; } }
    }
    nloc = mine > 0u ? mine : 1u; nx = cnt > 0u ? cnt : 1u;
}

__device__ __forceinline__ void xcd_barrier(const XcdBarrier& b) {
    asm volatile("s_waitcnt vmcnt(0)" ::: "memory");
    __syncthreads();
    if (threadIdx.x == 0) {
        unsigned* bar = b.bar;
        __builtin_amdgcn_s_waitcnt(0);
        unsigned nloc = b.st[0], nx = b.st[1];
        if (nloc == 0u) { xcd_barrier_complete(bar, b.x, nloc, nx); b.st[0] = nloc; b.st[1] = nx; }
        const unsigned old = xb_add(&bar[XB_XSUB(b.x)], 1u);
        const unsigned gen = old / nloc;
        if (old + 1u == (gen + 1u) * nloc) {
            __builtin_amdgcn_fence(__ATOMIC_RELEASE, "agent");
            asm volatile("s_waitcnt vmcnt(0)" ::: "memory");
            const unsigned og = xb_add(&bar[XB_TOP], 1u);
            const unsigned tg = og / nx;
            if (og + 1u == (tg + 1u) * nx) xb_add(&bar[XB_TOPGEN], 1u);
            else XB_SPIN(xb_ld(&bar[XB_TOPGEN]) == tg, bar);
            __builtin_amdgcn_fence(__ATOMIC_ACQUIRE, "agent");
            xb_add(&bar[XB_XGEN(b.x)], 1u);
            asm volatile("s_waitcnt vmcnt(0)" ::: "memory");
        } else {
            XB_SPIN(xb_ld(&bar[XB_XGEN(b.x)]) == gen, bar);
            __builtin_amdgcn_fence(__ATOMIC_ACQUIRE, "agent");
            asm volatile("s_waitcnt vmcnt(0)" ::: "memory");
        }
    }
    __syncthreads();
}

struct Frame {
    LAS unsigned char* lds;
    volatile LAS unsigned* MISC;
    gu32* ctl;
    int tid, lane, wave;
    int vcu, G;
};
__device__ __forceinline__ float wave_sum(float v) {
#pragma unroll
    for (int o = 1; o < 64; o <<= 1) v += __shfl_xor(v, o);
    return v;
}
__device__ __forceinline__ void p0_transpose_item(const float* W, int K, int ldw, int nblk, bf16* WT, const float* gk, int gmask, float gs, LAS float* scr, int item, int lane) {
    const int kb = item / nblk, nb = item % nblk, k0 = 64 * kb, n0 = 64 * nb;
    f32x4 v[16];
#pragma unroll
    for (int i = 0; i < 16; ++i) v[i] = *(const GAS f32x4*)(W + (size_t)(k0 + 4 * i + (lane >> 4)) * ldw + n0 + (lane & 15) * 4);
#pragma unroll
    for (int i = 0; i < 16; ++i) { const int kk = 4 * i + (lane >> 4); const float g = gk ? gk[(k0 + kk) & gmask] * gs : gs; LAS float* d = scr + kk * 64; const int nn = (lane & 15) * 4 + kk;
        d[nn & 63] = v[i].x * g; d[(nn + 1) & 63] = v[i].y * g; d[(nn + 2) & 63] = v[i].z * g; d[(nn + 3) & 63] = v[i].w * g; }
    LDS_WAIT(); asm volatile("" ::: "memory");
    const int c = lane & 7;
#pragma unroll
    for (int j = 0; j < 8; ++j) { const int n = (lane >> 3) + 8 * j; const LAS float* s = scr + (8 * c) * 64; const int nn = n + 8 * c;
        v4u o; o.x = pk2(s[0 * 64 + (nn & 63)], s[1 * 64 + ((nn + 1) & 63)]); o.y = pk2(s[2 * 64 + ((nn + 2) & 63)], s[3 * 64 + ((nn + 3) & 63)]);
        o.z = pk2(s[4 * 64 + ((nn + 4) & 63)], s[5 * 64 + ((nn + 5) & 63)]); o.w = pk2(s[6 * 64 + ((nn + 6) & 63)], s[7 * 64 + ((nn + 7) & 63)]);
        *(GAS v4u*)(WT + (size_t)(n0 + n) * K + k0 + 8 * c) = o; }
    LDS_WAIT(); asm volatile("" ::: "memory");
}
__device__ __forceinline__ void rms_row_load(const float* xrow, int lane, f32x4 (&v)[4]) {
    const GAS f32x4* xr = (const GAS f32x4*)xrow + lane; float s2 = 0.f;
#pragma unroll
    for (int j = 0; j < 4; ++j) { v[j] = xr[64 * j]; s2 += (v[j].x * v[j].x + v[j].y * v[j].y) + (v[j].z * v[j].z + v[j].w * v[j].w); }
    const float rstd = 1.f / sqrtf(wave_sum(s2) * (1.f / D) + EPS);
#pragma unroll
    for (int j = 0; j < 4; ++j) v[j] = v[j] * rstd;
}
__device__ __forceinline__ void row_store_bf16(bf16* orow, int lane, const f32x4 (&v)[4]) {
    GAS unsigned long long* o8 = (GAS unsigned long long*)orow + lane;
#pragma unroll
    for (int j = 0; j < 4; ++j) o8[64 * j] = (unsigned long long)pk2(v[j].x, v[j].y) | ((unsigned long long)pk2(v[j].z, v[j].w) << 32);
}
__device__ __forceinline__ float log_sigmoid(float x) { return fminf(x, 0.f) - log1pf(expf(-fabsf(x))); }

struct Args { const float* in[22]; float* out; unsigned char* ws; int ph_lo, ph_hi, li, pad; };

__device__ __forceinline__ void p0_prologue(Frame& F, const Args& a) {
    unsigned char* ws = a.ws;
    LAS float* scr = (LAS float*)(F.lds + RING_OFF + F.wave * 16384);
    const int gw = F.vcu * NWAVES + F.wave, NGW = F.G * NWAVES;
    constexpr int I_QKV = (D / 64) * (NQKV / 64), I_O = (D / 64) * (D / 64), I_ML = (D / 64) * (NPROJ / 64), I_1 = (D / 64) * (FF / 64), I_2 = (FF / 64) * (D / 64);
    constexpr int NITEMS = I_QKV + I_O + I_ML + I_O + 2 * I_1 + 2 * I_2;
    for (int it = gw; it < NITEMS; it += NGW) {
        int r = it;
        if (r < I_QKV) { p0_transpose_item(a.in[3], D, NQKV, NQKV / 64, (bf16*)(ws + WS_WQKV), a.in[2], 0xffff, 1.f, scr, r, F.lane); continue; } r -= I_QKV;
        if (r < I_O) { p0_transpose_item(a.in[9], D, D, D / 64, (bf16*)(ws + WS_WAO), a.in[8], 127, 1.f - LAMBDA_INIT0, scr, r, F.lane); continue; } r -= I_O;
        if (r < I_ML) { p0_transpose_item(a.in[11], D, MLW, NPROJ / 64, (bf16*)(ws + WS_WML), a.in[10], 0xffff, 1.f, scr, r, F.lane); continue; } r -= I_ML;
        if (r < I_O) { p0_transpose_item(a.in[17], D, D, D / 64, (bf16*)(ws + WS_WMO), a.in[16], 0xffff, 1.f, scr, r, F.lane); continue; } r -= I_O;
        if (r < 2 * I_1) { const int l = r / I_1; p0_transpose_item(a.in[19] + (size_t)l * D * FF, D, FF, FF / 64, (bf16*)(ws + WS_W1) + (size_t)l * D * FF, a.in[18] + l * D, 0xffff, 1.f, scr, r % I_1, F.lane); continue; } r -= 2 * I_1;
        { const int l = r / I_2; p0_transpose_item(a.in[20] + (size_t)l * D * FF, FF, D, D / 64, (bf16*)(ws + WS_W2) + (size_t)l * D * FF, nullptr, 0, 1.f, scr, r % I_2, F.lane); }
    }
    { bf16* WT = (bf16*)(ws + WS_WML) + (size_t)NPROJ * D; const int gt = (F.vcu * NWAVES + F.wave) * 64 + F.lane, NGT = F.G * NWAVES * 64;
      for (int i = gt; i < 256 * D / 2; i += NGT) { const int j = (2 * i) / D, k = (2 * i) % D;
          const unsigned w = j < 8 ? pk2(a.in[10][k] * a.in[11][(size_t)k * MLW + NPROJ + j], a.in[10][k + 1] * a.in[11][(size_t)(k + 1) * MLW + NPROJ + j]) : 0u;
          ((GAS unsigned*)WT)[i] = w; } }
    bf16* XN = (bf16*)(ws + WS_XN); float* SSQH = (float*)(ws + WS_SSQH);
    for (int m = gw; m < M; m += NGW) { f32x4 v[4]; const GAS f32x4* xr = (const GAS f32x4*)(a.in[0] + (size_t)m * D) + F.lane; float s2 = 0.f;
#pragma unroll
        for (int j = 0; j < 4; ++j) { v[j] = xr[64 * j]; s2 += (v[j].x * v[j].x + v[j].y * v[j].y) + (v[j].z * v[j].z + v[j].w * v[j].w); }
        s2 = wave_sum(s2); row_store_bf16(XN + (size_t)m * D, F.lane, v);
        if (F.lane < 4) SSQH[(size_t)m * 4 + F.lane] = F.lane == 0 ? s2 : 0.f; }
}
__device__ __forceinline__ void final_norm_phase(Frame& F, const bf16* XN, const float* SSQH, const float* g, float* out) {
    const int gw = F.vcu * NWAVES + F.wave, NGW = F.G * NWAVES;
    for (int m = gw; m < M; m += NGW) {
        const float rstd = pg8::row_rstd(SSQH, m);
        const v4u h0 = *(const GAS v4u*)(XN + (size_t)m * D + F.lane * 16), h1 = *(const GAS v4u*)(XN + (size_t)m * D + F.lane * 16 + 8);
        GAS f32x4* o = (GAS f32x4*)(out + (size_t)m * D + F.lane * 16); const GAS f32x4* gg = (const GAS f32x4*)(g + F.lane * 16);
#pragma unroll
        for (int q = 0; q < 2; ++q) { const f32x4 a = gg[q];
            o[q] = (f32x4){__uint_as_float(h0[2 * q] << 16) * rstd * a.x, __uint_as_float(h0[2 * q] & 0xffff0000u) * rstd * a.y, __uint_as_float(h0[2 * q + 1] << 16) * rstd * a.z, __uint_as_float(h0[2 * q + 1] & 0xffff0000u) * rstd * a.w}; }
#pragma unroll
        for (int q = 0; q < 2; ++q) { const f32x4 a = gg[2 + q];
            o[2 + q] = (f32x4){__uint_as_float(h1[2 * q] << 16) * rstd * a.x, __uint_as_float(h1[2 * q] & 0xffff0000u) * rstd * a.y, __uint_as_float(h1[2 * q + 1] << 16) * rstd * a.z, __uint_as_float(h1[2 * q + 1] & 0xffff0000u) * rstd * a.w}; }
    }
}

__device__ __forceinline__ float bf2f(bf16 v) { return __uint_as_float((unsigned)v << 16); }
__device__ __forceinline__ int t5_bucket(int d) {
    if (d < 16) return d;
    const float v = logf((float)d / 16.f) / logf(8.f) * 16.f; int b = 16 + (int)v; return b > 31 ? 31 : b;
}
__device__ __forceinline__ void naive_attn_phase(Frame& F, const bf16* __restrict__ QKV, const float* __restrict__ rel_bias, const float* __restrict__ lq1, const float* __restrict__ lk1,
                                                  const float* __restrict__ lq2, const float* __restrict__ lk2, bf16* AO) {
    LAS float* lut = (LAS float*)(F.lds + RING_OFF);
    const int tid = F.tid, half = tid & 1;
    float s1 = 0.f, s2 = 0.f;
    for (int i = 0; i < 64; ++i) { s1 += lq1[i] * lk1[i]; s2 += lq2[i] * lk2[i]; }
    const float lam = expf(s1) - expf(s2) + LAMBDA_INIT0;
    for (int u = F.vcu; u < BATCH * NH_A * (SEQ / 256); u += F.G) {
        const int qb = u % (SEQ / 256), h = (u / (SEQ / 256)) % NH_A, b = u / (SEQ / 256) / NH_A, q0 = qb * 256, q = q0 + (tid >> 1);
        __syncthreads();
        if (tid < 128) lut[tid] = rel_bias[t5_bucket(tid) * NH_A + h] * LOG2E;
        __syncthreads();
        const size_t tok = (size_t)b * SEQ + q;
        float res[64];
        for (int m = 0; m < 2; ++m) {
            float qv[64];
            const bf16* qp = QKV + tok * NQKV + h * 128 + m * 64;
#pragma unroll
            for (int d = 0; d < 64; ++d) qv[d] = bf2f(qp[d]);
            float o[64];
#pragma unroll
            for (int d = 0; d < 64; ++d) o[d] = 0.f;
            float mrun = -1e30f, l = 0.f;
            const int kend = q0 + 256;
            for (int k = 0; k < kend; ++k) {
                const bf16* kr = QKV + ((size_t)b * SEQ + k) * NQKV + D + h * 128 + m * 64;
                const bf16* vr = QKV + ((size_t)b * SEQ + k) * NQKV + 2 * D + h * 128 + half * 64;
                float s = 0.f;
#pragma unroll
                for (int d = 0; d < 64; ++d) s += qv[d] * bf2f(kr[d]);
                const int dist = q - k;
                if (dist >= 0) {
                    s += lut[dist < 127 ? dist : 127];
                    if (s > mrun) { const float al = exp2f(mrun - s); l *= al;
#pragma unroll
                        for (int d = 0; d < 64; ++d) o[d] *= al;
                        mrun = s; }
                    const float p = exp2f(s - mrun); l += p;
#pragma unroll
                    for (int d = 0; d < 64; ++d) o[d] += p * bf2f(vr[d]);
                }
            }
            const float il = 1.f / l;
            if (m == 0) {
#pragma unroll
                for (int d = 0; d < 64; ++d) res[d] = o[d] * il;
            } else {
                float ss = 0.f;
#pragma unroll
                for (int d = 0; d < 64; ++d) { res[d] = res[d] - lam * (o[d] * il); ss += res[d] * res[d]; }
                ss += __shfl_xor(ss, 1);
                const float rstd = 1.f / sqrtf(ss * (1.f / 128.f) + EPS);
                bf16* op = AO + tok * D + h * 128 + half * 64;
#pragma unroll
                for (int d = 0; d < 64; d += 2) *(unsigned*)(op + d) = pk2(res[d] * rstd, res[d + 1] * rstd);
            }
        }
    }
    __syncthreads();
}
__device__ __forceinline__ void naive_mlstm_phase(Frame& F, const bf16* __restrict__ PROJ, const float* __restrict__ GATES, const float* __restrict__ conv_w, const float* __restrict__ conv_b, bf16* AO) {
    LAS float* q_s = (LAS float*)(F.lds + RING_OFF); LAS float* k_s = q_s + 128; LAS float* v_s = q_s + 256; LAS float* red = q_s + 512;
    const int tid = F.tid, dv = tid >> 1, half = tid & 1, lane = F.lane, wave = F.wave;
    for (int u = (int)blockIdx.x; u < BATCH * NH_M; u += F.G) {
        const int h = u & 3, b = u >> 2;
        float C[64], n[64];
#pragma unroll
        for (int j = 0; j < 64; ++j) { C[j] = 0.f; n[j] = 0.f; }
        float mst = 0.f;
        const int col = (tid < 128) ? (h * 128 + tid) : (512 + h * 128 + ((tid - 128) & 127));
        float cw0 = 0.f, cw1 = 0.f, cw2 = 0.f, cw3 = 0.f, cb = 0.f;
        if (tid < 256) { cw0 = conv_w[0 * D + col]; cw1 = conv_w[1 * D + col]; cw2 = conv_w[2 * D + col]; cw3 = conv_w[3 * D + col]; cb = conv_b[col]; }
        __syncthreads();
        for (int t = 0; t < SEQ; ++t) {
            const size_t tok = (size_t)b * SEQ + t;
            if (tid < 256) {
                float x3 = bf2f(PROJ[tok * NPROJ + col]);
                float x2 = t >= 1 ? bf2f(PROJ[(tok - 1) * NPROJ + col]) : 0.f;
                float x1 = t >= 2 ? bf2f(PROJ[(tok - 2) * NPROJ + col]) : 0.f;
                float x0 = t >= 3 ? bf2f(PROJ[(tok - 3) * NPROJ + col]) : 0.f;
                float y = cw0 * x0 + cw1 * x1 + cw2 * x2 + cw3 * x3 + cb;
                y = y / (1.f + expf(-y));
                if (tid < 128) q_s[tid] = y * MQSCALE; else k_s[tid - 128] = y;
            } else {
                v_s[tid - 256] = bf2f(PROJ[tok * NPROJ + 1024 + h * 256 + (tid - 256)]);
            }
            const float ig = GATES[tok * 8 + h], lf = GATES[tok * 8 + 4 + h];
            __syncthreads();
            const float mnew = fmaxf(lf + mst, ig), fd = expf(lf + mst - mnew), gi = expf(ig - mnew);
            mst = mnew;
            const float gv = gi * v_s[dv];
            float num = 0.f, den = 0.f;
#pragma unroll
            for (int j = 0; j < 64; ++j) { const float kk = k_s[half * 64 + j], qq = q_s[half * 64 + j];
                C[j] = fd * C[j] + gv * kk; n[j] = fd * n[j] + gi * kk; num += C[j] * qq; den += n[j] * qq; }
            num += __shfl_xor(num, 1); den += __shfl_xor(den, 1);
            const float hv = num / fmaxf(fabsf(den), expf(-mnew));
            float ss = half == 0 ? hv * hv : 0.f;
            ss = wave_sum(ss);
            if (lane == 0) red[wave] = ss;
            __syncthreads();
            float tot = 0.f;
#pragma unroll
            for (int w = 0; w < 8; ++w) tot += red[w];
            const float rstd = 1.f / sqrtf(tot * (1.f / 256.f) + EPS);
            if (half == 0) { const float op = bf2f(PROJ[tok * NPROJ + 2048 + h * 256 + dv]); const float sg = 1.f / (1.f + expf(-op));
                AO[tok * D + h * 256 + dv] = (bf16)f2bf(sg * hv * rstd); }
            __syncthreads();
        }
    }
}

__device__ __forceinline__ void attn_phase(Frame& F, const bf16* __restrict__ QKV, bf16* AO, float* stash, const float* __restrict__ rel_bias, const float* __restrict__ lq1, const float* __restrict__ lk1,
                                           const float* __restrict__ lq2, const float* __restrict__ lk2) {
    using da2::f32x16; using da2::f32x4;
    LAS char* lds = (LAS char*)(F.lds + RING_OFF);
    LAS float* tbl = (LAS float*)(lds + da2::OFF_LUT);
    const int tid = F.tid, lane = F.lane, wid = F.wave, r32 = lane & 31, hi = lane >> 5;
    float s1 = 0.f, s2 = 0.f;
    for (int i = 0; i < 64; ++i) { s1 += lq1[i] * lk1[i]; s2 += lq2[i] * lk2[i]; }
    const float lam = expf(s1) - expf(s2) + LAMBDA_INIT0;
    f32x4* stp = (f32x4*)(stash + (((size_t)blockIdx.x * NWAVES + wid) * 64 + lane) * 64);
    LAS char* stg = lds + wid * da2::STG_WAVE;
    for (int L = F.vcu; L < BATCH * NH_A * 4; L += F.G) {
        const int bh = L >> 2, x = L & 3, b = bh >> 3, h = bh & 7;
        __syncthreads();
        const float c31 = rel_bias[31 * NH_A + h] * LOG2E;
        for (int i = tid; i < 4 * da2::TBL_N; i += NWAVES * 64) { const int c = i >> 9, y = i & 511, d = da2::TBL_X0 - (y + c);
            tbl[i] = d < 0 ? -__builtin_inff() : (d > 127 ? 0.f : rel_bias[t5_bucket(d) * NH_A + h] * LOG2E - c31); }
        __syncthreads();
        for (int s = 0; s < 4; ++s) {
            const int qb = (s >> 1) ? 7 - x : x, m = s & 1, P0 = qb * 256;
            const bf16* Qp = QKV + ((size_t)b * SEQ + P0) * NQKV + h * 128 + m * 64;
            const bf16* Kp = QKV + (size_t)b * SEQ * NQKV + D + h * 128 + m * 64;
            const bf16* Vp = QKV + (size_t)b * SEQ * NQKV + 2 * D + h * 128;
            f32x16 o[4];
            da2::attn_block(Qp, Kp, Vp, P0, lds, c31, o);
            if (m == 0) {
#pragma unroll
                for (int i = 0; i < 16; ++i) stp[i] = (f32x4){o[i >> 2][(i & 3) * 4 + 0], o[i >> 2][(i & 3) * 4 + 1], o[i >> 2][(i & 3) * 4 + 2], o[i >> 2][(i & 3) * 4 + 3]};
            } else {
#pragma unroll
                for (int i = 0; i < 16; ++i) { const f32x4 sti = stp[i];
#pragma unroll
                    for (int e = 0; e < 4; ++e) { const int dq = i >> 2, r = (i & 3) * 4 + e; const float v = sti[e] - lam * o[dq][r];
                        *(LAS unsigned short*)(stg + da2::crow(r, hi) * da2::STG_PITCH + (dq * 32 + r32) * 2) = (unsigned short)f2bf(v); } }
                asm volatile("s_waitcnt lgkmcnt(0)" ::: "memory");
                const int row = lane >> 1, half = lane & 1;
                v4u w[8]; float ss = 0.f;
#pragma unroll
                for (int i = 0; i < 8; ++i) { w[i] = *(const LAS v4u*)(stg + row * da2::STG_PITCH + half * 128 + i * 16);
#pragma unroll
                    for (int q = 0; q < 4; ++q) { const float a0 = __uint_as_float(w[i][q] << 16), a1 = __uint_as_float(w[i][q] & 0xffff0000u); ss += a0 * a0 + a1 * a1; } }
                ss += __shfl_xor(ss, 1);
                const float rstd = __builtin_amdgcn_rsqf(ss * (1.f / 128.f) + EPS);
                bf16* Ow = AO + ((size_t)b * SEQ + P0 + wid * 32 + row) * D + h * 128 + half * 64;
#pragma unroll
                for (int i = 0; i < 8; ++i) { v4u ov;
#pragma unroll
                    for (int q = 0; q < 4; ++q) ov[q] = pk2(__uint_as_float(w[i][q] << 16) * rstd, __uint_as_float(w[i][q] & 0xffff0000u) * rstd);
                    *(GAS v4u*)(Ow + i * 8) = ov; }
                asm volatile("s_waitcnt lgkmcnt(0)\n\ts_barrier" ::: "memory");
            }
        }
    }
    __syncthreads();
}
__device__ __forceinline__ void convscan_phase(Frame& F, const bf16* __restrict__ PROJ, const float* __restrict__ GATES, const float* __restrict__ conv_w, const float* __restrict__ conv_b, bf16* QKC, float* GS) {
    {   const int pc = F.tid & 127, col = pc * 8;
        float cw[4][8], cbias[8];
#pragma unroll
        for (int i = 0; i < 8; ++i) { cbias[i] = conv_b[col + i];
#pragma unroll
            for (int t = 0; t < 4; ++t) cw[t][i] = conv_w[t * 1024 + col + i]; }
        const float osc = col < 512 ? MQSCALE : 1.f;
        for (int seg = F.vcu * 4 + (F.tid >> 7); seg < M / 32; seg += F.G * 4) {
            const int tokb = seg * 32;
#pragma unroll 1
            for (int run = 0; run < 4; ++run) {
                const int t8 = tokb + run * 8; const bool first = (t8 & (SEQ - 1)) == 0;
                const bf16* p = PROJ + (size_t)t8 * NPROJ + col;
                v4u r[11];
#pragma unroll
                for (int i = 0; i < 3; ++i) r[i] = first ? (v4u){0u, 0u, 0u, 0u} : *(const GAS v4u*)(p + ((ptrdiff_t)i - 3) * NPROJ);
#pragma unroll
                for (int i = 3; i < 11; ++i) r[i] = *(const GAS v4u*)(p + (size_t)(i - 3) * NPROJ);
#pragma unroll
                for (int t = 0; t < 8; ++t) {
                    unsigned o[4];
#pragma unroll
                    for (int q = 0; q < 4; ++q) {
                        float s0 = cbias[2 * q], s1 = cbias[2 * q + 1];
#pragma unroll
                        for (int tap = 0; tap < 4; ++tap) { const unsigned w = r[t + tap][q]; s0 += cw[tap][2 * q] * __uint_as_float(w << 16); s1 += cw[tap][2 * q + 1] * __uint_as_float(w & 0xffff0000u); }
                        s0 = s0 / (1.f + __expf(-s0)) * osc; s1 = s1 / (1.f + __expf(-s1)) * osc; o[q] = pk2(s0, s1); }
                    *(GAS v4u*)(QKC + (size_t)(t8 + t) * D + col) = (v4u){o[0], o[1], o[2], o[3]};
                }
            }
        }
    }
    {   const int gw = F.vcu * NWAVES + F.wave, NGW = F.G * NWAVES, lane = F.lane;
        for (int task = gw; task < BATCH * NH_M * (SEQ / 64); task += NGW) {
            const int c = task % (SEQ / 64), h = (task / (SEQ / 64)) % NH_M, b = task / (SEQ / 64) / NH_M;
            const size_t tok = (size_t)b * SEQ + c * 64 + lane;
            const float ig = GATES[tok * 8 + h], lf = GATES[tok * 8 + 4 + h];
            float bsum = lf;
#pragma unroll
            for (int off = 1; off < 64; off <<= 1) { const float t = __shfl_up(bsum, off); if (lane >= off) bsum += t; }
            const float e = ig - bsum; float pm = e;
#pragma unroll
            for (int off = 1; off < 64; off <<= 1) { const float t = __shfl_up(pm, off); if (lane >= off) pm = fmaxf(pm, t); }
            *(GAS f32x4*)(GS + tok * 16 + h * 4) = (f32x4){bsum, e, pm, 0.f};
        }
    }
}
__device__ __forceinline__ void mlstm_phase(Frame& F, const bf16* __restrict__ PROJ, const bf16* __restrict__ QKC, const float* __restrict__ GS, bf16* HT, float* SSQ) {
    for (int u = F.vcu; u < BATCH * NH_M * 4; u += F.G) {
        __syncthreads();
        ml::mlstm_unit(u >> 4, (u >> 2) & 3, u & 3, PROJ, QKC, GS, HT, SSQ, (LAS char*)(F.lds + RING_OFF));
    }
    __syncthreads();
}
__device__ __forceinline__ void gatenorm_phase(Frame& F, const bf16* __restrict__ PROJ, const bf16* __restrict__ HT, const float* __restrict__ SSQ, bf16* AO) {
    const int gw = F.vcu * NWAVES + F.wave, NGW = F.G * NWAVES, lane = F.lane;
    for (int m = gw; m < M; m += NGW) {
        const int hd = lane >> 4;
        const f32x4 s0 = *(const GAS f32x4*)(SSQ + (size_t)m * 32 + hd * 8), s1 = *(const GAS f32x4*)(SSQ + (size_t)m * 32 + hd * 8 + 4);
        const float tot = ((s0.x + s0.y) + (s0.z + s0.w)) + ((s1.x + s1.y) + (s1.z + s1.w));
        const float rstd = 1.f / sqrtf(tot * (1.f / 256.f) + EPS);
        const v4u h0 = *(const GAS v4u*)(HT + (size_t)m * D + lane * 16), h1 = *(const GAS v4u*)(HT + (size_t)m * D + lane * 16 + 8);
        const v4u o0 = *(const GAS v4u*)(PROJ + (size_t)m * NPROJ + 2048 + lane * 16), o1 = *(const GAS v4u*)(PROJ + (size_t)m * NPROJ + 2048 + lane * 16 + 8);
        v4u r0, r1;
#pragma unroll
        for (int q = 0; q < 4; ++q) {
            { const float ha = __uint_as_float(h0[q] << 16) * rstd, hb = __uint_as_float(h0[q] & 0xffff0000u) * rstd, oa = __uint_as_float(o0[q] << 16), ob = __uint_as_float(o0[q] & 0xffff0000u);
              r0[q] = pk2(ha / (1.f + __expf(-oa)), hb / (1.f + __expf(-ob))); }
            { const float ha = __uint_as_float(h1[q] << 16) * rstd, hb = __uint_as_float(h1[q] & 0xffff0000u) * rstd, oa = __uint_as_float(o1[q] << 16), ob = __uint_as_float(o1[q] & 0xffff0000u);
              r1[q] = pk2(ha / (1.f + __expf(-oa)), hb / (1.f + __expf(-ob))); }
        }
        *(GAS v4u*)(AO + (size_t)m * D + lane * 16) = r0; *(GAS v4u*)(AO + (size_t)m * D + lane * 16 + 8) = r1;
    }
}

template <class Epi>
__device__ __forceinline__ void run_gemm(Frame& F, const bf16* A, const bf16* Bt, int N, int K, const Epi& E) {
    pg8::Gemm g{A, Bt, M, N, K}; pg8::StaticOrder S; S.init(M, N, F.G, (int)blockIdx.x);
    pg8::gemm_phase<Epi, pg8::StaticOrder, PG8_ALIGN, PG8_SP2>(F.lds + RING_OFF, g, S, E);
}
__global__ void __launch_bounds__(NWAVES * 64, 2) fwd(Args args) {
    extern __shared__ __attribute__((aligned(16))) unsigned char lds[];
    Frame F;
    F.lds = (LAS unsigned char*)lds;
    F.MISC = (volatile LAS unsigned*)(F.lds + MISC_OFF);
    F.tid = threadIdx.x; F.lane = F.tid & 63; F.wave = __builtin_amdgcn_readfirstlane(F.tid >> 6);
    F.G = gridDim.x; { const int bx = blockIdx.x; F.vcu = (F.G % 8 == 0) ? (bx % 8) * (F.G / 8) + bx / 8 : bx; }
    unsigned char* ws = args.ws;
    F.ctl = (gu32*)(ws + WS_CTL);
    for (int u = F.tid; u < (LDS_BYTES - LDSCTL_OFF) / 4; u += NWAVES * 64) ((LAS unsigned*)(F.lds + LDSCTL_OFF))[u] = 0u;
    __syncthreads();
    const int lo = args.ph_lo, hi = args.ph_hi;
    const bool use_bar = (hi - lo) > 1;
    XcdBarrier bar; bar.bar = (unsigned*)(F.ctl + CW_BAR) + args.li * XCD_BAR_WORDS; bar.x = 0; bar.st = nullptr;
    if (use_bar) bar = xcd_barrier_post((unsigned*)(F.ctl + CW_BAR) + args.li * XCD_BAR_WORDS, F.MISC + 8);
#define IN(k) (lo <= (k) && (k) < hi)
#define SEAM(k) do { if (hi > lo + 1) xcd_barrier(bar); } while (0)
#define REP(k) for (int rep_ = 0; rep_ < ((DUP_PHASE == (k)) ? 2 : 1); ++rep_)
#define DUPBAR(k) do { if (DUP_PHASE == (k) && rep_ == 0) xcd_barrier(bar); } while (0)
    bf16* const XN = (bf16*)(ws + WS_XN); bf16* const AO = (bf16*)(ws + WS_AO); bf16* const QKV = (bf16*)(ws + WS_U); bf16* const U = (bf16*)(ws + WS_U); float* const SSQH = (float*)(ws + WS_SSQH);
    float* const H = args.out;
    using pg8::EpiBf16; using pg8::EpiResNorm; (void)H;

    if (IN(0)) { REP(0) { p0_prologue(F, args); DUPBAR(0); } SEAM(0); }
    if (IN(1)) { EpiBf16<0> E{QKV, NQKV, D, QSCALE, SSQH, -1, nullptr, nullptr, nullptr}; if (DUP_PHASE == 1) { run_gemm(F, XN, (const bf16*)(ws + WS_WQKV), NQKV, D, E); xcd_barrier(bar); } run_gemm(F, XN, (const bf16*)(ws + WS_WQKV), NQKV, D, E); SEAM(1); }
    if (IN(2)) { REP(2) { attn_phase(F, QKV, AO, (float*)(ws + WS_STASH), args.in[1], args.in[4], args.in[5], args.in[6], args.in[7]); DUPBAR(2); } SEAM(2); }
    if (IN(3)) { EpiResNorm<true> E{args.in[0], nullptr, XN, SSQH, D, (LAS float*)(F.lds + EPIRED_OFF)}; if (DUP_PHASE == 3) { run_gemm(F, AO, (const bf16*)(ws + WS_WAO), D, D, E); xcd_barrier(bar); } run_gemm(F, AO, (const bf16*)(ws + WS_WAO), D, D, E); SEAM(4); }
    if (IN(5)) { EpiBf16<2> E{U, FF, 0, 1.f, SSQH, -1, nullptr, nullptr, nullptr}; if (DUP_PHASE == 5) { run_gemm(F, XN, (const bf16*)(ws + WS_W1), FF, D, E); xcd_barrier(bar); } run_gemm(F, XN, (const bf16*)(ws + WS_W1), FF, D, E); SEAM(5); }
    if (IN(6)) { EpiResNorm<false> E{nullptr, XN, XN, SSQH, D, (LAS float*)(F.lds + EPIRED_OFF)}; run_gemm(F, U, (const bf16*)(ws + WS_W2), D, FF, E); SEAM(7); }
    if (IN(8)) { EpiBf16<0> E{QKV, NPROJ, 0, 1.f, SSQH, NPROJ / 256, (float*)(ws + WS_GATES), args.in[12], args.in[13]}; if (DUP_PHASE == 8) { run_gemm(F, XN, (const bf16*)(ws + WS_WML), NPROJ + 256, D, E); xcd_barrier(bar); } run_gemm(F, XN, (const bf16*)(ws + WS_WML), NPROJ + 256, D, E); SEAM(8); }
    if (IN(9)) { REP(16) { convscan_phase(F, QKV, (const float*)(ws + WS_GATES), args.in[14], args.in[15], AO, (float*)(ws + WS_GS)); xcd_barrier(bar); }
        REP(9) { mlstm_phase(F, QKV, AO, (const float*)(ws + WS_GS), (bf16*)(ws + WS_HT), (float*)(ws + WS_SSQ)); DUPBAR(9); } SEAM(9); }
    if (IN(10)) { REP(10) { gatenorm_phase(F, QKV, (const bf16*)(ws + WS_HT), (const float*)(ws + WS_SSQ), AO); DUPBAR(10); } SEAM(10); }
    if (IN(11)) { EpiResNorm<false> E{nullptr, XN, XN, SSQH, D, (LAS float*)(F.lds + EPIRED_OFF)}; run_gemm(F, AO, (const bf16*)(ws + WS_WMO), D, D, E); SEAM(12); }
    if (IN(13)) { EpiBf16<2> E{U, FF, 0, 1.f, SSQH, -1, nullptr, nullptr, nullptr}; if (DUP_PHASE == 13) { run_gemm(F, XN, (const bf16*)(ws + WS_W1) + (size_t)D * FF, FF, D, E); xcd_barrier(bar); } run_gemm(F, XN, (const bf16*)(ws + WS_W1) + (size_t)D * FF, FF, D, E); SEAM(13); }
    if (IN(14)) { EpiResNorm<false> E{nullptr, XN, XN, SSQH, D, (LAS float*)(F.lds + EPIRED_OFF)}; run_gemm(F, U, (const bf16*)(ws + WS_W2) + (size_t)D * FF, D, FF, E); SEAM(14); }
    if (IN(15)) { final_norm_phase(F, XN, SSQH, args.in[21], args.out); }
#undef IN
#undef SEAM
}

extern "C" void kernel_launch(void* const* d_in, const int* in_sizes, int n_in, void* d_out, int out_size, void* d_ws, size_t ws_size, hipStream_t stream) {
    static int grid = 0;
    if (grid == 0) {
        if (n_in != 22 || in_sizes[0] != M * D || out_size != M * D || ws_size < WS_END) { fprintf(stderr, "kernel_launch: unexpected shapes (n_in %d, in0 %d, out %d, ws %zu); nothing launched\n", n_in, n_in > 0 ? in_sizes[0] : -1, out_size, ws_size); grid = -1; return; }
        int dev = 0, cus = 0, per_cu = 0;
        if (hipGetDevice(&dev) != hipSuccess || hipDeviceGetAttribute(&cus, hipDeviceAttributeMultiprocessorCount, dev) != hipSuccess) { grid = -1; return; }
        if (hipFuncSetAttribute((const void*)fwd, hipFuncAttributeMaxDynamicSharedMemorySize, LDS_BYTES) != hipSuccess) { fprintf(stderr, "kernel_launch: hipFuncSetAttribute failed\n"); grid = -1; return; }
        if (hipOccupancyMaxActiveBlocksPerMultiprocessor(&per_cu, (const void*)fwd, NWAVES * 64, LDS_BYTES) != hipSuccess || per_cu < 1) fprintf(stderr, "kernel_launch: occupancy query says %d\n", per_cu);
        (void)hipGetLastError();
        grid = cus;
    }
    if (grid < 0) return;
    (void)hipMemsetAsync((char*)d_ws + WS_CTL, 0, CTL_ZERO_BYTES, stream);
    Args a{};
    for (int i = 0; i < 22; ++i) a.in[i] = (const float*)d_in[i];
    a.out = (float*)d_out; a.ws = (unsigned char*)d_ws;
    int li = 0;
    auto run = [&](int lo, int hi) { a.ph_lo = lo; a.ph_hi = hi; a.li = li++; hipLaunchKernelGGL(fwd, dim3(grid), dim3(NWAVES * 64), LDS_BYTES, stream, a); };
    run(0, NPHASE);
}
```

```cpp
#include <hip/hip_runtime.h>
#include <cstdio>
#include <cstdint>
namespace pg8 {
#define PG8_LAS __attribute__((address_space(3)))
typedef unsigned short bf16_t;
typedef short bf16x8 __attribute__((ext_vector_type(8)));
typedef float f32x4 __attribute__((ext_vector_type(4)));
typedef unsigned u32x4 __attribute__((ext_vector_type(4)));
constexpr int BM = 256, BK = 64, HALF = 128, HTB = HALF * BK * 2  , STAGE_BYTES = 8 * HTB, NXCD = 8, WGM = 8;

__host__ __device__ __forceinline__ int lds_byte(int r, int c) { const int st = (r >> 4) * 2 + (c >> 5), rr = r & 15, cc = c & 31, ob = rr * 64 + cc * 2; return st * 1024 + (ob ^ (((ob >> 9) & 1) << 5)); }
__host__ __device__ __forceinline__ void stage_rc(int b, int& R, int& C) { const int st = b / 1024, sb = b % 1024, swz = sb ^ (((sb >> 9) & 1) << 5); R = (st >> 1) * 16 + swz / 64; C = (st & 1) * 32 + (swz % 64) / 2; }
__host__ __device__ __forceinline__ int perm32(int rho) { const int n = rho >> 4, i = rho & 15; return 8 * (i >> 2) + 4 * n + (i & 3); }

struct Unit { int pm, pn; };
struct Gemm { const bf16_t* A; const bf16_t* Bt; int M, N, K; };

struct StaticOrder {
    int nM, nN, nwg, G, c;
    __host__ __device__ void init(int M, int N, int G_, int c_) { nM = M / BM; nN = N / BM; nwg = nM * nN; G = G_; c = c_; }
    __host__ __device__ bool next(int i, Unit& u) const {
        const long L = (long)i * G + c; if (L >= nwg) return false;
        int wgid = (int)L; { const int q = nwg / NXCD, r = nwg % NXCD, xcd = wgid % NXCD, off = wgid / NXCD; wgid = (xcd < r ? xcd * (q + 1) : r * (q + 1) + (xcd - r) * q) + off; }
        const int nig = WGM * nN, gid = wgid / nig, fm = gid * WGM, gsz = (nM - fm) < WGM ? (nM - fm) : WGM;
        u.pm = fm + ((wgid % nig) % gsz); u.pn = (wgid % nig) / gsz; return true;
    }
    __device__ __forceinline__ void a_ready(const Unit&) const {}
    __device__ __forceinline__ void done(const Unit&) const {}
};

__device__ __forceinline__ unsigned cvt_pk_bf16(float lo, float hi) { unsigned r; asm volatile("v_cvt_pk_bf16_f32 %0, %1, %2" : "=v"(r) : "v"(lo), "v"(hi)); return r; }
__device__ __forceinline__ float row_rstd(const float* ssq, int row) {
    const f32x4 a = *(const f32x4*)(ssq + (size_t)row * 4);
    return __builtin_amdgcn_rsqf(((a[0] + a[1]) + (a[2] + a[3])) * (1.0f / 1024.0f) + 1e-6f);
}
__device__ __forceinline__ float log_sigmoid_f(float x) { return fminf(x, 0.f) - log1pf(expf(-fabsf(x))); }
template <int ACT> struct EpiBf16 {
    static constexpr bool PERM = true, AFTER_DRAIN = false;
    bf16_t* O; int ldc; int scale_cols; float scale0; const float* ssq; int gate_tile; float* gates; const float* b_i; const float* b_f;
    __device__ __forceinline__ void operator()(const f32x4 (&acc)[2][2][4][2], const Unit& u, int wr, int wc, int fr, int fq) const {
        const int row0 = u.pm * BM + wr * 64 + fr; const int colt = u.pn * BM;
        const float sc = (colt < scale_cols) ? scale0 : 1.f;
        const int col0 = colt + wc * 32 + 8 * fq;
        float rs[2][4];
#pragma unroll
        for (int ai = 0; ai < 2; ++ai)
#pragma unroll
            for (int m = 0; m < 4; ++m) rs[ai][m] = ssq ? row_rstd(ssq, row0 + ai * HALF + m * 16) * sc : sc;
        if (u.pn == gate_tile) {
            if (wc == 0 && fq == 0) { const f32x4 bi = *(const f32x4*)b_i, bf = *(const f32x4*)b_f;
#pragma unroll
                for (int ai = 0; ai < 2; ++ai)
#pragma unroll
                    for (int m = 0; m < 4; ++m) { const int row = row0 + ai * HALF + m * 16; const f32x4 gi = acc[ai][0][m][0] * rs[ai][m] + bi; f32x4 gf = acc[ai][0][m][1] * rs[ai][m] + bf;
#pragma unroll
                        for (int e = 0; e < 4; ++e) gf[e] = log_sigmoid_f(gf[e]);
                        *(f32x4*)(gates + (size_t)row * 8) = gi; *(f32x4*)(gates + (size_t)row * 8 + 4) = gf; } }
            return;
        }
#pragma unroll
        for (int ai = 0; ai < 2; ++ai)
#pragma unroll
            for (int m = 0; m < 4; ++m) { bf16_t* rowp = O + (size_t)(row0 + ai * HALF + m * 16) * ldc + col0; const float r = rs[ai][m];
#pragma unroll
                for (int bj = 0; bj < 2; ++bj) { f32x4 v0 = acc[ai][bj][m][0] * r, v1 = acc[ai][bj][m][1] * r;
                    if (ACT == 2) {
#pragma unroll
                        for (int e = 0; e < 4; ++e) { const float a = fmaxf(v0[e], 0.f), b = fmaxf(v1[e], 0.f); v0[e] = a * a; v1[e] = b * b; } }
                    u32x4 w; w.x = cvt_pk_bf16(v0[0], v0[1]); w.y = cvt_pk_bf16(v0[2], v0[3]); w.z = cvt_pk_bf16(v1[0], v1[1]); w.w = cvt_pk_bf16(v1[2], v1[3]);
                    *(u32x4*)(rowp + bj * HALF) = w; } }
    }
};
template <bool BASE_F32> struct EpiResNorm {
    static constexpr bool PERM = true, AFTER_DRAIN = false;
    const float* basef; const bf16_t* baseh; bf16_t* xn; float* ssq; int ldc; PG8_LAS float* red;
    __device__ __forceinline__ void operator()(const f32x4 (&acc)[2][2][4][2], const Unit& u, int wr, int wc, int fr, int fq) const {
        const int row0 = u.pm * BM + wr * 64 + fr; const int col0 = u.pn * BM + wc * 32 + 8 * fq;
#pragma unroll
        for (int ai = 0; ai < 2; ++ai)
#pragma unroll
            for (int m = 0; m < 4; ++m) { const int row = row0 + ai * HALF + m * 16; const size_t off = (size_t)row * ldc + col0; float s = 0.f;
#pragma unroll
                for (int bj = 0; bj < 2; ++bj) { f32x4 v0, v1;
                    if (BASE_F32) { v0 = *(const f32x4*)(basef + off + bj * HALF); v1 = *(const f32x4*)(basef + off + bj * HALF + 4); }
                    else { const u32x4 h = *(const u32x4*)(baseh + off + bj * HALF);
                        v0 = (f32x4){__uint_as_float(h.x << 16), __uint_as_float(h.x & 0xffff0000u), __uint_as_float(h.y << 16), __uint_as_float(h.y & 0xffff0000u)};
                        v1 = (f32x4){__uint_as_float(h.z << 16), __uint_as_float(h.z & 0xffff0000u), __uint_as_float(h.w << 16), __uint_as_float(h.w & 0xffff0000u)}; }
                    v0 = v0 + acc[ai][bj][m][0]; v1 = v1 + acc[ai][bj][m][1];
                    s += ((v0[0] * v0[0] + v0[1] * v0[1]) + (v0[2] * v0[2] + v0[3] * v0[3])) + ((v1[0] * v1[0] + v1[1] * v1[1]) + (v1[2] * v1[2] + v1[3] * v1[3]));
                    u32x4 w; w.x = cvt_pk_bf16(v0[0], v0[1]); w.y = cvt_pk_bf16(v0[2], v0[3]); w.z = cvt_pk_bf16(v1[0], v1[1]); w.w = cvt_pk_bf16(v1[2], v1[3]);
                    *(u32x4*)(xn + off + bj * HALF) = w; }
                s += __shfl_xor(s, 16); s += __shfl_xor(s, 32);
                if (fq == 0) red[(ai * HALF + wr * 64 + m * 16 + fr) * 4 + wc] = s; }
        asm volatile("s_waitcnt lgkmcnt(0)" ::: "memory"); __builtin_amdgcn_s_barrier(); asm volatile("" ::: "memory");
        const int t = threadIdx.x;
        if (t < BM) { const f32x4 p = *(const PG8_LAS f32x4*)(red + t * 4); ssq[(size_t)(u.pm * BM + t) * 4 + u.pn] = (p[0] + p[1]) + (p[2] + p[3]); }
    }
};

template <class Epi, class Sched, bool ALIGN_EPI = false, bool SP2 = false>
__device__ __forceinline__ void gemm_phase(PG8_LAS unsigned char* lds, const Gemm g, const Sched& S, const Epi& E) {
    const int tid = threadIdx.x, wid = __builtin_amdgcn_readfirstlane(tid >> 6), lane = tid & 63, wr = wid >> 2, wc = wid & 3, fr = lane & 15, fq = lane >> 4;
    const int K = g.K, nt = K / BK;
    unsigned voffA[2], voffB[2];
#pragma unroll
    for (int i = 0; i < 2; ++i) { int R, C; stage_rc(tid * 16 + i * 8192, R, C); const int Rb = Epi::PERM ? ((R & ~31) + perm32(R & 31)) : R;
        voffA[i] = (unsigned)(R * K + C) * 2u; voffB[i] = (unsigned)(Rb * K + C) * 2u; }
    const size_t kstep = (size_t)(BK * 2);
    const size_t hstep = (size_t)HALF * K * 2;
    const size_t tstep = 2 * hstep;
    const unsigned ldsw = (unsigned)wid * 1024u;
    const int aoff = lds_byte(wr * 64 + fr, fq * 8), boff = lds_byte(wc * 32 + fr, fq * 8);
#define PG8_SA(b, h) (((b) * 2 + (h)) * HTB)
#define PG8_SB(b, h) ((4 + (b) * 2 + (h)) * HTB)
#define PG8_STAGE(bufoff, gbase, voff) do { _Pragma("unroll") for (int _i = 0; _i < 2; ++_i) \
        __builtin_amdgcn_global_load_lds((const unsigned*)((const char*)(gbase) + (voff)[_i]), (PG8_LAS unsigned*)(lds + (bufoff) + ldsw + _i * 8192), 16, 0, 0); } while (0)
#define PG8_LDA(dst, b, h) do { _Pragma("unroll") for (int m = 0; m < 4; ++m) _Pragma("unroll") for (int k = 0; k < 2; ++k) dst[m][k] = *(const PG8_LAS bf16x8*)(lds + PG8_SA(b, h) + aoff + m * 2048 + k * 1024); } while (0)
#define PG8_LDB(dst, b, h) do { _Pragma("unroll") for (int n = 0; n < 2; ++n) _Pragma("unroll") for (int k = 0; k < 2; ++k) dst[n][k] = *(const PG8_LAS bf16x8*)(lds + PG8_SB(b, h) + boff + n * 2048 + k * 1024); } while (0)
#define PG8_MMA(ai, bj, At, Bt) do { __builtin_amdgcn_s_setprio(1); _Pragma("unroll") for (int m = 0; m < 4; ++m) _Pragma("unroll") for (int n = 0; n < 2; ++n) _Pragma("unroll") for (int k = 0; k < 2; ++k) \
        acc[ai][bj][m][n] = __builtin_amdgcn_mfma_f32_16x16x32_bf16(Bt[n][k], At[m][k], acc[ai][bj][m][n], 0, 0, 0); __builtin_amdgcn_s_setprio(0); } while (0)
#define PG8_WAIT_V(n) asm volatile("s_waitcnt vmcnt(" #n ")" ::: "memory")
#define PG8_WAIT_L(n) asm volatile("s_waitcnt lgkmcnt(" #n ")" ::: "memory")
#define PG8_BAR __builtin_amdgcn_s_barrier()
#define PG8_SCHED __builtin_amdgcn_sched_barrier(0)
    Unit cur, nxt; int ui = 0;
    if (!S.next(0, cur)) return;
    f32x4 acc[2][2][4][2];
#pragma unroll
    for (int a = 0; a < 2; ++a)
#pragma unroll
        for (int b = 0; b < 2; ++b)
#pragma unroll
            for (int m = 0; m < 4; ++m)
#pragma unroll
                for (int n = 0; n < 2; ++n) acc[a][b][m][n] = (f32x4){0.f, 0.f, 0.f, 0.f};
    bf16x8 At[4][2], B0[2][2], B1[2][2];
    const char* cA = (const char*)g.A + (size_t)cur.pm * tstep; const char* cB = (const char*)g.Bt + (size_t)cur.pn * tstep;
    S.a_ready(cur);
    if constexpr (SP2) {
        PG8_STAGE(PG8_SB(0, 0), cB, voffB); PG8_STAGE(PG8_SB(0, 1), cB + hstep, voffB); PG8_STAGE(PG8_SA(0, 0), cA, voffA); PG8_STAGE(PG8_SA(0, 1), cA + hstep, voffA);
        if (wr == 1) PG8_BAR;
        PG8_WAIT_V(2); PG8_BAR;
        PG8_STAGE(PG8_SB(1, 0), cB + kstep, voffB); PG8_STAGE(PG8_SA(1, 0), cA + kstep, voffA); PG8_STAGE(PG8_SB(1, 1), cB + hstep + kstep, voffB);
        PG8_WAIT_V(6); PG8_BAR;
    } else {
        PG8_STAGE(PG8_SB(0, 0), cB, voffB); PG8_STAGE(PG8_SA(0, 0), cA, voffA); PG8_STAGE(PG8_SB(0, 1), cB + hstep, voffB); PG8_STAGE(PG8_SA(0, 1), cA + hstep, voffA);
        if (wr == 1) PG8_BAR;
        PG8_WAIT_V(4); PG8_BAR;
        PG8_STAGE(PG8_SB(1, 0), cB + kstep, voffB); PG8_STAGE(PG8_SA(1, 0), cA + kstep, voffA); PG8_STAGE(PG8_SB(1, 1), cB + hstep + kstep, voffB);
        PG8_WAIT_V(6); PG8_BAR;
    }
    for (;;) {
        const bool has_next = S.next(ui + 1, nxt);
        const char* nA = has_next ? (const char*)g.A + (size_t)nxt.pm * tstep : cA; const char* nB = has_next ? (const char*)g.Bt + (size_t)nxt.pn * tstep : cB;
        for (int t = 0; t < nt; t += 2) {
            const bool last = (t == nt - 2);
            const char* a1 = cA + (size_t)(t + 1) * kstep;
            const char* a2 = last ? nA : cA + (size_t)(t + 2) * kstep; const char* b2 = last ? nB : cB + (size_t)(t + 2) * kstep;
            const char* a3 = a2 + kstep; const char* b3 = b2 + kstep;
            if (last && has_next) S.a_ready(nxt);
            if constexpr (SP2) {
            PG8_LDB(B0, 0, 0); PG8_LDB(B1, 0, 1); PG8_SCHED; PG8_LDA(At, 0, 0); PG8_STAGE(PG8_SA(1, 1), a1 + hstep, voffA);
            PG8_WAIT_V(8); PG8_WAIT_L(0); PG8_BAR; PG8_MMA(0, 0, At, B0); PG8_MMA(0, 1, At, B1); PG8_BAR; PG8_SCHED;
            PG8_LDA(At, 0, 1); PG8_STAGE(PG8_SB(0, 0), b2, voffB); PG8_STAGE(PG8_SB(0, 1), b2 + hstep, voffB); PG8_STAGE(PG8_SA(0, 0), a2, voffA);
            PG8_WAIT_V(8); PG8_WAIT_L(0); PG8_BAR; PG8_MMA(1, 0, At, B0); PG8_MMA(1, 1, At, B1); PG8_BAR; PG8_SCHED;
            PG8_LDB(B0, 1, 0); PG8_LDB(B1, 1, 1); PG8_SCHED; PG8_LDA(At, 1, 0); PG8_STAGE(PG8_SA(0, 1), a2 + hstep, voffA);
            PG8_WAIT_V(8); PG8_WAIT_L(0); PG8_BAR; PG8_MMA(0, 0, At, B0); PG8_MMA(0, 1, At, B1); PG8_BAR; PG8_SCHED;
            PG8_LDA(At, 1, 1); PG8_STAGE(PG8_SB(1, 0), b3, voffB); PG8_STAGE(PG8_SB(1, 1), b3 + hstep, voffB); PG8_STAGE(PG8_SA(1, 0), a3, voffA);
            PG8_WAIT_V(8); PG8_WAIT_L(0); PG8_BAR; PG8_MMA(1, 0, At, B0); PG8_MMA(1, 1, At, B1); PG8_BAR; PG8_SCHED;
            } else {
            PG8_LDB(B0, 0, 0); PG8_SCHED; PG8_LDA(At, 0, 0); PG8_STAGE(PG8_SA(1, 1), a1 + hstep, voffA);
            PG8_WAIT_L(8); PG8_BAR; PG8_WAIT_L(0); PG8_MMA(0, 0, At, B0); PG8_BAR; PG8_SCHED;
            PG8_LDB(B1, 0, 1); PG8_STAGE(PG8_SB(0, 0), b2, voffB);
            PG8_BAR; PG8_WAIT_L(0); PG8_MMA(0, 1, At, B1); PG8_BAR;
            PG8_LDA(At, 0, 1); PG8_STAGE(PG8_SA(0, 0), a2, voffA);
            PG8_BAR; PG8_WAIT_L(0); PG8_MMA(1, 0, At, B0); PG8_BAR; PG8_SCHED;
            PG8_STAGE(PG8_SB(0, 1), b2 + hstep, voffB);
            PG8_WAIT_V(6); PG8_BAR; PG8_MMA(1, 1, At, B1); PG8_BAR;
            PG8_LDB(B0, 1, 0); PG8_SCHED; PG8_LDA(At, 1, 0); PG8_STAGE(PG8_SA(0, 1), a2 + hstep, voffA);
            PG8_WAIT_L(8); PG8_BAR; PG8_WAIT_L(0); PG8_MMA(0, 0, At, B0); PG8_BAR; PG8_SCHED;
            PG8_LDB(B1, 1, 1); PG8_STAGE(PG8_SB(1, 0), b3, voffB);
            PG8_BAR; PG8_WAIT_L(0); PG8_MMA(0, 1, At, B1); PG8_BAR;
            PG8_LDA(At, 1, 1); PG8_STAGE(PG8_SA(1, 0), a3, voffA);
            PG8_BAR; PG8_WAIT_L(0); PG8_MMA(1, 0, At, B0); PG8_BAR; PG8_SCHED;
            PG8_STAGE(PG8_SB(1, 1), b3 + hstep, voffB);
            PG8_WAIT_V(6); PG8_BAR; PG8_MMA(1, 1, At, B1); PG8_BAR;
            }
        }
        if constexpr (ALIGN_EPI) { if (wr == 0) PG8_BAR; }
        if constexpr (!Epi::AFTER_DRAIN) { E(acc, cur, wr, wc, fr, fq); S.done(cur); }
        if (!has_next) break;
#pragma unroll
        for (int a = 0; a < 2; ++a)
#pragma unroll
            for (int b = 0; b < 2; ++b)
#pragma unroll
                for (int m = 0; m < 4; ++m)
#pragma unroll
                    for (int n = 0; n < 2; ++n) acc[a][b][m][n] = (f32x4){0.f, 0.f, 0.f, 0.f};
        cur = nxt; cA = nA; cB = nB; ++ui;
        if constexpr (ALIGN_EPI) { if (wr == 1) PG8_BAR; }
    }
    PG8_WAIT_V(0);
    if constexpr (!ALIGN_EPI) { if (wr == 0) PG8_BAR; }
    PG8_BAR;
    if constexpr (Epi::AFTER_DRAIN) { E.fused(acc, cur, wr, wc, fr, fq, lds, wid, lane); S.done(cur); }
#undef PG8_SA
#undef PG8_SB
#undef PG8_STAGE
#undef PG8_LDA
#undef PG8_LDB
#undef PG8_MMA
#undef PG8_WAIT_V
#undef PG8_WAIT_L
#undef PG8_BAR
#undef PG8_SCHED
}
}

#ifndef PG8_SP2
#define PG8_SP2 true
#endif
#ifndef PG8_ALIGN
#define PG8_ALIGN true
#endif
namespace da {
typedef short bf16x8 __attribute__((ext_vector_type(8)));
typedef short s16x4 __attribute__((ext_vector_type(4)));
typedef float f32x16 __attribute__((ext_vector_type(16)));
typedef float f32x4 __attribute__((ext_vector_type(4)));
typedef unsigned u32x4 __attribute__((ext_vector_type(4)));
#define DLAS __attribute__((address_space(3)))
constexpr int NW = 8, QBLK = 32, KVBLK = 64, QB = NW * QBLK, PITCH = 3072;
constexpr int SHM_V = KVBLK * 128 * 2, SHM_K = KVBLK * 64 * 2;
constexpr int OFF_V = 0, OFF_K = 2 * SHM_V, OFF_WS = OFF_K + 2 * SHM_K, OFF_LUT = OFF_WS + NW * 64 * 4, LDS_BYTES = OFF_LUT + 512;
constexpr float THR = 8.f;
#define DA_KSWZ(row, c) ((row) * 128 + ((((c) ^ (((row) >> 1) & 7))) << 4))
#define DA_SBAR() __builtin_amdgcn_sched_barrier(0)
__device__ __forceinline__ int v_st(int k, int c) { const int kk = (k & ~0xC) | ((k & 4) << 1) | ((k & 8) >> 1); return ((kk >> 3) * 4 + (c >> 5)) * 512 + ((kk & 7) * 32 + (c & 31)) * 2; }
__device__ __forceinline__ int v_rd_base(int lane) { return ((lane & 3) << 3) | (((lane >> 2) & 3) << 6) | (((lane >> 4) & 1) << 5) | (((lane >> 5) & 1) << 8); }
constexpr int v_rd_off(int d0, int ks, int half) { return d0 * 512 + ks * 4096 + half * 2048; }
__device__ __forceinline__ int crow(int r, int hi) { return (r & 3) + 8 * (r >> 2) + 4 * hi; }
__device__ __forceinline__ unsigned cvtpk(float lo, float hi) { unsigned r; asm volatile("v_cvt_pk_bf16_f32 %0, %1, %2" : "=v"(r) : "v"(lo), "v"(hi)); return r; }
__device__ __forceinline__ void mask_tile(f32x16& p0, f32x16& p1, int dq) {
    const float NEG = -__builtin_inff();
#pragma unroll
    for (int r = 0; r < 16; ++r) { const int c = (r & 3) + 8 * (r >> 2); if (dq - c < 0) p0[r] = NEG; if (dq - c - 32 < 0) p1[r] = NEG; }
}
__device__ __forceinline__ void bias_tile(f32x16& p0, f32x16& p1, int dq, const DLAS float* lut) {
#pragma unroll
    for (int g = 0; g < 4; ++g) {
#pragma unroll
        for (int rr = 0; rr < 4; ++rr) { const int r = g * 4 + rr; const int c = (r & 3) + 8 * (r >> 2);
            int i0 = dq - c; i0 = i0 < 0 ? 0 : (i0 > 127 ? 127 : i0); int i1 = dq - c - 32; i1 = i1 < 0 ? 0 : (i1 > 127 ? 127 : i1);
            p0[r] += lut[i0]; p1[r] += lut[i1]; }
        DA_SBAR();
    }
}
__device__ __forceinline__ void partialSM(f32x16& p0, f32x16& p1, float& m_reg, float& alpha, float cb) {
    float pmax = p0[0];
#pragma unroll
    for (int r = 1; r < 16; ++r) pmax = fmaxf(pmax, p0[r]);
#pragma unroll
    for (int r = 0; r < 16; ++r) pmax = fmaxf(pmax, p1[r]);
    { auto rr = __builtin_amdgcn_permlane32_swap(__float_as_uint(pmax), __float_as_uint(pmax), false, false);
      pmax = fmaxf(__uint_as_float(rr[0]), __uint_as_float(rr[1])); }
    pmax += cb;
    float mn;
    if (__builtin_expect(__all(pmax - m_reg <= THR), 1)) { mn = m_reg; alpha = 1.f; }
    else { mn = fmaxf(m_reg, pmax); alpha = __builtin_amdgcn_exp2f(m_reg - mn); m_reg = mn; }
    const float off = cb - mn;
#pragma unroll
    for (int r = 0; r < 16; ++r) p0[r] += off;
#pragma unroll
    for (int r = 0; r < 16; ++r) p1[r] += off;
#pragma unroll
    for (int r = 0; r < 16; ++r) p0[r] = __builtin_amdgcn_exp2f(p0[r]);
}
__device__ __forceinline__ void finishSM(f32x16& p0, f32x16& p1, float alpha, float& l_reg, bf16x8& pa0, bf16x8& pa1, bf16x8& pa2, bf16x8& pa3) {
#pragma unroll
    for (int r = 0; r < 16; ++r) p1[r] = __builtin_amdgcn_exp2f(p1[r]);
    float ps = 0;
#pragma unroll
    for (int r = 0; r < 16; ++r) ps += p0[r];
#pragma unroll
    for (int r = 0; r < 16; ++r) ps += p1[r];
    { auto rr = __builtin_amdgcn_permlane32_swap(__float_as_uint(ps), __float_as_uint(ps), false, false);
      ps = __uint_as_float(rr[0]) + __uint_as_float(rr[1]); }
    l_reg = l_reg * alpha + ps;
#define DA_PK4(P, B_, OUT) do { unsigned a0 = cvtpk(P[B_+0], P[B_+1]), a1 = cvtpk(P[B_+2], P[B_+3]);                          \
        unsigned b0 = cvtpk(P[B_+4], P[B_+5]), b1 = cvtpk(P[B_+6], P[B_+7]);                                             \
        auto r0 = __builtin_amdgcn_permlane32_swap(a0, b0, false, false); auto r1 = __builtin_amdgcn_permlane32_swap(a1, b1, false, false); \
        u32x4 w = {r0[0], r1[0], r0[1], r1[1]}; OUT = *reinterpret_cast<bf16x8*>(&w); } while (0)
    DA_PK4(p0, 0, pa0); DA_PK4(p0, 8, pa1); DA_PK4(p1, 0, pa2); DA_PK4(p1, 8, pa3);
#undef DA_PK4
}
template <int KB>
__device__ __forceinline__ void qkt(f32x16& p0, f32x16& p1, const DLAS char* K_lds, int r32, int hi, const bf16x8* qr) {
    p0 = f32x16{}; p1 = f32x16{};
#pragma unroll
    for (int d0 = 0; d0 < 4; ++d0) { const DLAS char* a = K_lds + KB * SHM_K + DA_KSWZ(r32, d0 * 2 + hi);
        const bf16x8 b0 = *reinterpret_cast<const DLAS bf16x8*>(a);
        const bf16x8 b1 = *reinterpret_cast<const DLAS bf16x8*>(a + 32 * 128);
        p0 = __builtin_amdgcn_mfma_f32_32x32x16_bf16(b0, qr[d0], p0, 0, 0, 0);
        p1 = __builtin_amdgcn_mfma_f32_32x32x16_bf16(b1, qr[d0], p1, 0, 0, 0); }
}
template <int VB>
__device__ __forceinline__ void pv_tile(f32x16* o, int vb0, bf16x8 pa0, bf16x8 pa1, bf16x8 pa2, bf16x8 pa3) {
#define DA_TRRD(dst, off) asm volatile("ds_read_b64_tr_b16 %0, %1 offset:%2" : "=&v"(dst) : "v"(vb0), "i"(off) : "memory")
#define DA_PV_D0(d0) do { s16x4 l0, l1, l2, l3, h0, h1, h2, h3; constexpr int b_ = VB * SHM_V + v_rd_off(d0, 0, 0); \
        DA_TRRD(l0, b_); DA_TRRD(h0, b_ + 2048); DA_TRRD(l1, b_ + 4096); DA_TRRD(h1, b_ + 6144); DA_TRRD(l2, b_ + 8192); DA_TRRD(h2, b_ + 10240); DA_TRRD(l3, b_ + 12288); DA_TRRD(h3, b_ + 14336); \
        asm volatile("s_waitcnt lgkmcnt(0)" ::: "memory"); DA_SBAR();   \
        o[d0] = __builtin_amdgcn_mfma_f32_32x32x16_bf16(pa0, (bf16x8){l0[0], l0[1], l0[2], l0[3], h0[0], h0[1], h0[2], h0[3]}, o[d0], 0, 0, 0);   \
        o[d0] = __builtin_amdgcn_mfma_f32_32x32x16_bf16(pa1, (bf16x8){l1[0], l1[1], l1[2], l1[3], h1[0], h1[1], h1[2], h1[3]}, o[d0], 0, 0, 0);   \
        o[d0] = __builtin_amdgcn_mfma_f32_32x32x16_bf16(pa2, (bf16x8){l2[0], l2[1], l2[2], l2[3], h2[0], h2[1], h2[2], h2[3]}, o[d0], 0, 0, 0);   \
        o[d0] = __builtin_amdgcn_mfma_f32_32x32x16_bf16(pa3, (bf16x8){l3[0], l3[1], l3[2], l3[3], h3[0], h3[1], h3[2], h3[3]}, o[d0], 0, 0, 0); } while (0)
    DA_PV_D0(0); DA_PV_D0(1); DA_PV_D0(2); DA_PV_D0(3);
#undef DA_PV_D0
#undef DA_TRRD
}
template <bool ORDER_B>
__device__ __forceinline__ void attn_block(const unsigned short* __restrict__ Qp, const unsigned short* __restrict__ Kp, const unsigned short* __restrict__ Vp, int P0, DLAS char* lds, float c31, f32x16 (&o)[4]) {
    const int tid = threadIdx.x, wid = __builtin_amdgcn_readfirstlane(tid >> 6), lane = tid & 63, r32 = lane & 31, hi = lane >> 5;
    const int NT = (P0 + QB) / KVBLK;
    const int qlo = P0 + wid * QBLK, qm = qlo + r32 - 4 * hi;
    DLAS char* V_lds = lds + OFF_V; DLAS char* K_lds = lds + OFF_K;
    DLAS float* wsf = (DLAS float*)(lds + OFF_WS) + wid * 64; DLAS float* li_l = wsf; DLAS float* al_l = wsf + 32;
    const DLAS float* lut = (const DLAS float*)(lds + OFF_LUT);
    float m_reg = -1e30f, l_reg = 0.f;
#pragma unroll
    for (int d = 0; d < 4; ++d) o[d] = f32x16{};
    const int sr = tid >> 4, sc = (tid & 15) * 8, vst0 = v_st(sr, sc), vst1 = v_st(32 + sr, sc);
    const int kr = tid >> 3, kc = tid & 7, kws = DA_KSWZ(kr, kc);
    const int vb0 = (int)(uintptr_t)V_lds + v_rd_base(lane);
    bf16x8 qr[4];
#pragma unroll
    for (int d0 = 0; d0 < 4; ++d0) qr[d0] = *reinterpret_cast<const bf16x8*>(Qp + (size_t)(wid * QBLK + r32) * PITCH + d0 * 16 + hi * 8);
    bf16x8 st_v0, st_v1, st_k0;
#define DA_VMW() asm volatile("s_waitcnt vmcnt(0)" ::: "memory")
#define DA_SLOAD(k0) do { st_v0 = *reinterpret_cast<const bf16x8*>(Vp + (size_t)((k0) + sr) * PITCH + sc); st_v1 = *reinterpret_cast<const bf16x8*>(Vp + (size_t)((k0) + 32 + sr) * PITCH + sc); \
                          st_k0 = *reinterpret_cast<const bf16x8*>(Kp + (size_t)((k0) + kr) * PITCH + kc * 8); } while (0)
#define DA_SWRITE(bf) do { *reinterpret_cast<DLAS bf16x8*>(V_lds + (bf) * SHM_V + vst0) = st_v0; *reinterpret_cast<DLAS bf16x8*>(V_lds + (bf) * SHM_V + vst1) = st_v1; \
                           *reinterpret_cast<DLAS bf16x8*>(K_lds + (bf) * SHM_K + kws) = st_k0; } while (0)
#define DA_RESC(a) do { if (__any((a) < 1.f)) { if (hi == 0) al_l[r32] = (a); asm volatile("s_waitcnt lgkmcnt(0)" ::: "memory");              \
                        _Pragma("unroll") for (int d_ = 0; d_ < 4; ++d_) _Pragma("unroll") for (int r = 0; r < 16; ++r) o[d_][r] *= al_l[crow(r, hi)]; } } while (0)
#define DA_BIASMASK(P0_, P1_, t, cbv) do { const int kb_ = (t) * KVBLK; if (kb_ + KVBLK - 1 + 128 > qlo) { bias_tile(P0_, P1_, qm - kb_, lut); cbv = 0.f; if (kb_ + KVBLK - 1 > qlo) mask_tile(P0_, P1_, qm - kb_); } else cbv = c31; } while (0)
    f32x16 pA0, pA1, pB0, pB1; float alA, alB, cbA, cbB; bf16x8 pa0, pa1, pa2, pa3;
    DA_SLOAD(0); DA_VMW(); DA_SWRITE(0); DA_SBAR();
    DA_SLOAD(KVBLK);
    __syncthreads();
    DA_SBAR(); qkt<0>(pA0, pA1, K_lds, r32, hi, qr);
    DA_BIASMASK(pA0, pA1, 0, cbA); partialSM(pA0, pA1, m_reg, alA, cbA);
    DA_VMW(); DA_SWRITE(1);
    __syncthreads();
#define DA_HALF_STEP(PX0, PX1, alX, cbX, PY0, PY1, alY, t, KB, VB, SB) do {                                                      \
        DA_SBAR(); DA_SLOAD(((t) + 1) * KVBLK); DA_SBAR();              \
        if constexpr (!ORDER_B) {                                                                                               \
            qkt<KB>(PX0, PX1, K_lds, r32, hi, qr);                                                                     \
            finishSM(PY0, PY1, alY, l_reg, pa0, pa1, pa2, pa3); DA_SBAR();                                                       \
            pv_tile<VB>(o, vb0, pa0, pa1, pa2, pa3); DA_BIASMASK(PX0, PX1, (t), cbX); partialSM(PX0, PX1, m_reg, alX, cbX);      \
        } else {                                                                                                                \
            finishSM(PY0, PY1, alY, l_reg, pa0, pa1, pa2, pa3); DA_SBAR();                                            \
            pv_tile<VB>(o, vb0, pa0, pa1, pa2, pa3); DA_SBAR();                                                                   \
            qkt<KB>(PX0, PX1, K_lds, r32, hi, qr); DA_BIASMASK(PX0, PX1, (t), cbX); partialSM(PX0, PX1, m_reg, alX, cbX);        \
        }                                                                                                                       \
        __syncthreads();                                                                                                      \
        DA_VMW(); DA_SWRITE(SB);                                                                          \
        DA_RESC(alX); __syncthreads(); } while (0)
    for (int t = 1; t + 1 < NT; t += 2) {
        DA_HALF_STEP(pB0, pB1, alB, cbB, pA0, pA1, alA, t, 1, 0, 0);
        DA_HALF_STEP(pA0, pA1, alA, cbA, pB0, pB1, alB, t + 1, 0, 1, 1);
    }
    DA_SBAR(); qkt<1>(pB0, pB1, K_lds, r32, hi, qr); DA_SBAR();
    finishSM(pA0, pA1, alA, l_reg, pa0, pa1, pa2, pa3); DA_SBAR();
    pv_tile<0>(o, vb0, pa0, pa1, pa2, pa3);
    DA_BIASMASK(pB0, pB1, NT - 1, cbB); partialSM(pB0, pB1, m_reg, alB, cbB); DA_RESC(alB);
    finishSM(pB0, pB1, alB, l_reg, pa0, pa1, pa2, pa3); DA_SBAR(); pv_tile<1>(o, vb0, pa0, pa1, pa2, pa3);
    if (hi == 0) li_l[r32] = l_reg; asm volatile("s_waitcnt lgkmcnt(0)" ::: "memory");
#pragma unroll
    for (int r = 0; r < 16; ++r) { const float rl = __builtin_amdgcn_rcpf(li_l[crow(r, hi)]);
#pragma unroll
        for (int d0 = 0; d0 < 4; ++d0) o[d0][r] *= rl; }
    __syncthreads();
#undef DA_VMW
#undef DA_SLOAD
#undef DA_SWRITE
#undef DA_RESC
#undef DA_BIASMASK
#undef DA_HALF_STEP
}
}
static_assert(da::LDS_BYTES <= 131072, "attention LDS inside the ring region");
namespace da2 {
typedef short bf16x8 __attribute__((ext_vector_type(8)));
typedef short s16x4 __attribute__((ext_vector_type(4)));
typedef float f32x16 __attribute__((ext_vector_type(16)));
typedef float f32x4 __attribute__((ext_vector_type(4)));
typedef unsigned u32x4 __attribute__((ext_vector_type(4)));
#define D2LAS __attribute__((address_space(3)))
constexpr int NW = 8, QBLK = 32, KVBLK = 64, QB = NW * QBLK, PITCH = 3072;
constexpr int KSLOT = 8192, VSLOT = 16384, NKS = 3, NVS = 4;
constexpr int OFF_K = 0, OFF_V = NKS * KSLOT, OFF_WS = OFF_V + NVS * VSLOT, OFF_LUT = OFF_WS + NW * 64 * 4, LDS_BYTES = OFF_LUT + 4 * 2048;
constexpr int STG_PITCH = 272, STG_WAVE = 32 * STG_PITCH;
constexpr float THR = 8.f;
#define D2_SBAR() __builtin_amdgcn_sched_barrier(0)
__device__ __forceinline__ int crow(int r, int hi) { return (r & 3) + 8 * (r >> 2) + 4 * hi; }
typedef float f32x2_t __attribute__((ext_vector_type(2))); typedef __bf16 bf16x2_t __attribute__((ext_vector_type(2)));
__device__ __forceinline__ unsigned cvtpk(float lo, float hi) { f32x2_t v = {lo, hi}; bf16x2_t b = __builtin_convertvector(v, bf16x2_t); return __builtin_bit_cast(unsigned, b); }
__device__ __forceinline__ void glds16(const void* gsrc, unsigned lds_dst) { unsigned keep;
    asm volatile("s_mov_b32 %0, m0\n\ts_mov_b32 m0, %2\n\ts_nop 0\n\tglobal_load_lds_dwordx4 %1, off\n\ts_mov_b32 m0, %0" : "=&s"(keep) : "v"(gsrc), "s"(lds_dst) : "memory"); }
#define D2_WAIT_BAR(N) asm volatile("s_waitcnt vmcnt(" #N ") lgkmcnt(0)\n\ts_barrier" ::: "memory")
constexpr int TBL_X0 = 224, TBL_N = 512, TBL_COPY_BYTES = TBL_N * 4;
__device__ __forceinline__ void bias_mask_tile(f32x16& p0, f32x16& p1, int dq, const D2LAS char* tbl_lane  ) {
    const D2LAS char* a = tbl_lane - 4 * dq;
#pragma unroll
    for (int g = 0; g < 4; ++g) { const f32x4 t0 = *reinterpret_cast<const D2LAS f32x4*>(a + 32 * g), t1 = *reinterpret_cast<const D2LAS f32x4*>(a + 32 * g + 128);
#pragma unroll
        for (int i = 0; i < 4; ++i) { p0[4 * g + i] += t0[i]; p1[4 * g + i] += t1[i]; } }
}
__device__ __forceinline__ float rowmax(const f32x16& p0, const f32x16& p1) {
    float a = fmaxf(fmaxf(p0[0], p0[1]), p1[0]), b = fmaxf(fmaxf(p0[2], p0[3]), p1[1]); a = fmaxf(fmaxf(a, p1[2]), p1[3]);
#pragma unroll
    for (int r = 4; r < 16; r += 4) { a = fmaxf(fmaxf(a, p0[r]), p0[r + 1]); b = fmaxf(fmaxf(b, p0[r + 2]), p0[r + 3]); a = fmaxf(fmaxf(a, p1[r]), p1[r + 1]); b = fmaxf(fmaxf(b, p1[r + 2]), p1[r + 3]); }
    float m = fmaxf(a, b);
    auto rr = __builtin_amdgcn_permlane32_swap(__float_as_uint(m), __float_as_uint(m), false, false);
    return fmaxf(__uint_as_float(rr[0]), __uint_as_float(rr[1]));
}
__device__ __forceinline__ void qkt(f32x16& p0, f32x16& p1, const D2LAS char* Kslot, int r32, int hi, const bf16x8* qr, const f32x16& cinit) {
    const int sw = (r32 >> 1) & 7;
#pragma unroll
    for (int d0 = 0; d0 < 4; ++d0) { const D2LAS char* a = Kslot + r32 * 128 + (((d0 * 2 + hi) ^ sw) << 4);
        const bf16x8 b0 = *reinterpret_cast<const D2LAS bf16x8*>(a), b1 = *reinterpret_cast<const D2LAS bf16x8*>(a + 32 * 128);
        if (d0 == 0) { p0 = __builtin_amdgcn_mfma_f32_32x32x16_bf16(b0, qr[0], cinit, 0, 0, 0); p1 = __builtin_amdgcn_mfma_f32_32x32x16_bf16(b1, qr[0], cinit, 0, 0, 0); }
        else { p0 = __builtin_amdgcn_mfma_f32_32x32x16_bf16(b0, qr[d0], p0, 0, 0, 0); p1 = __builtin_amdgcn_mfma_f32_32x32x16_bf16(b1, qr[d0], p1, 0, 0, 0); } }
}
__device__ __forceinline__ void pv_tile(f32x16* o, int vb, bf16x8 pa0, bf16x8 pa1, bf16x8 pa2, bf16x8 pa3) {
#define D2_TRRD(dst, off) asm volatile("ds_read_b64_tr_b16 %0, %1 offset:%2" : "=&v"(dst) : "v"(vb), "i"(off) : "memory")
#define D2_PV(dq) do { s16x4 l0, l1, l2, l3, h0, h1, h2, h3; constexpr int b_ = (dq) * 4096; \
        D2_TRRD(l0, b_); D2_TRRD(h0, b_ + 512); D2_TRRD(l1, b_ + 1024); D2_TRRD(h1, b_ + 1536); D2_TRRD(l2, b_ + 2048); D2_TRRD(h2, b_ + 2560); D2_TRRD(l3, b_ + 3072); D2_TRRD(h3, b_ + 3584); \
        asm volatile("s_waitcnt lgkmcnt(0)" ::: "memory"); D2_SBAR();   \
        o[dq] = __builtin_amdgcn_mfma_f32_32x32x16_bf16(pa0, (bf16x8){l0[0], l0[1], l0[2], l0[3], h0[0], h0[1], h0[2], h0[3]}, o[dq], 0, 0, 0);   \
        o[dq] = __builtin_amdgcn_mfma_f32_32x32x16_bf16(pa1, (bf16x8){l1[0], l1[1], l1[2], l1[3], h1[0], h1[1], h1[2], h1[3]}, o[dq], 0, 0, 0);   \
        o[dq] = __builtin_amdgcn_mfma_f32_32x32x16_bf16(pa2, (bf16x8){l2[0], l2[1], l2[2], l2[3], h2[0], h2[1], h2[2], h2[3]}, o[dq], 0, 0, 0);   \
        o[dq] = __builtin_amdgcn_mfma_f32_32x32x16_bf16(pa3, (bf16x8){l3[0], l3[1], l3[2], l3[3], h3[0], h3[1], h3[2], h3[3]}, o[dq], 0, 0, 0); } while (0)
    D2_PV(0); D2_PV(1); D2_PV(2); D2_PV(3);
#undef D2_PV
#undef D2_TRRD
}
__device__ __forceinline__ void attn_block(const unsigned short* __restrict__ Qp, const unsigned short* __restrict__ Kp, const unsigned short* __restrict__ Vp, int P0, D2LAS char* lds, float c31, f32x16 (&o)[4]) {
    const int tid = threadIdx.x, wid = __builtin_amdgcn_readfirstlane(tid >> 6), lane = tid & 63, r32 = lane & 31, hi = lane >> 5;
    const int NT = (P0 + QB) / KVBLK;
    const int qlo = P0 + wid * QBLK, qm = qlo + r32 - 4 * hi;
    const unsigned lds0 = (unsigned)(uintptr_t)lds;
    D2LAS float* wsf = (D2LAS float*)(lds + OFF_WS) + wid * 64;
    const D2LAS char* tbl_lane = lds + OFF_LUT + ((-r32) & 3) * TBL_COPY_BYTES + 4 * (TBL_X0 - ((-r32) & 3));
    const int krow = wid * 8 + (lane >> 3);
    const unsigned short* ksrc = Kp + (size_t)krow * PITCH + (((lane & 7) ^ ((krow >> 1) & 7)) * 8);
    const unsigned short* vsrc = Vp + (size_t)(16 * (wid & 3) + (lane >> 2)) * PITCH + (wid >> 2) * 32 + (lane & 3) * 8;
    const unsigned kdst = lds0 + OFF_K + wid * 1024, vdst = lds0 + OFF_V + wid * 1024;
    int ks_i = 0, vs_i = 0;
    int jt = 0;
#define D2_DMA() do { glds16(ksrc + (size_t)jt * (KVBLK * PITCH), (unsigned)__builtin_amdgcn_readfirstlane(kdst + ks_i * KSLOT)); \
        glds16(vsrc + (size_t)jt * (KVBLK * PITCH), (unsigned)__builtin_amdgcn_readfirstlane(vdst + vs_i * VSLOT)); \
        glds16(vsrc + (size_t)jt * (KVBLK * PITCH) + 64, (unsigned)__builtin_amdgcn_readfirstlane(vdst + vs_i * VSLOT + 8192)); \
        ++jt; ks_i = ks_i == NKS - 1 ? 0 : ks_i + 1; vs_i = vs_i == NVS - 1 ? 0 : vs_i + 1; } while (0)
    bf16x8 qr[4];
#pragma unroll
    for (int d0 = 0; d0 < 4; ++d0) qr[d0] = *reinterpret_cast<const bf16x8*>(Qp + (size_t)(wid * QBLK + r32) * PITCH + d0 * 16 + hi * 8);
    D2_DMA(); D2_DMA(); D2_DMA();
    const D2LAS char* Kl = lds + OFF_K;
    const int vb0 = (int)(lds0 + OFF_V) + ((lane >> 4) & 1) * 32 + (lane & 3) * 8 + (4 * hi + ((lane & 15) >> 2)) * 64;
    float M = 0.f, l_reg = 0.f;
#pragma unroll
    for (int d = 0; d < 4; ++d) o[d] = f32x16{};
    f32x16 negb;
#pragma unroll
    for (int r = 0; r < 16; ++r) negb[r] = c31;
    f32x16 pA0, pA1, pB0, pB1; bf16x8 pa0, pa1, pa2, pa3;
    int kc = 0, vp = 0;
#define D2_BIASMASK(P0_, P1_, t) do { const int kb_ = (t) * KVBLK; if (kb_ + KVBLK - 1 + 128 > qlo) bias_mask_tile(P0_, P1_, qm - kb_, tbl_lane); } while (0)
#define D2_DECIDE(PX0, PX1, first) do { const float rm = rowmax(PX0, PX1); resc = false; \
        if ((first) || __builtin_expect(__any(rm > THR), 0)) { const float dl = (first) ? rm : fmaxf(rm, 0.f); M += dl; \
            _Pragma("unroll") for (int r = 0; r < 16; ++r) { PX0[r] -= dl; PX1[r] -= dl; } \
            _Pragma("unroll") for (int r = 0; r < 16; ++r) negb[r] = c31 - M; \
            const float f = __builtin_amdgcn_exp2f(-dl); l_reg *= f; if (hi == 0) wsf[r32] = f; resc = !(first); } \
        _Pragma("unroll") for (int r = 0; r < 16; ++r) { PX0[r] = __builtin_amdgcn_exp2f(PX0[r]); PX1[r] = __builtin_amdgcn_exp2f(PX1[r]); } } while (0)
#define D2_RESC() do { if (resc) { asm volatile("s_waitcnt lgkmcnt(0)" ::: "memory"); \
        _Pragma("unroll") for (int d_ = 0; d_ < 4; ++d_) _Pragma("unroll") for (int r = 0; r < 16; ++r) o[d_][r] *= wsf[crow(r, hi)]; } } while (0)
#define D2_FINISH(PY0, PY1) do { float s_ = 0.f; _Pragma("unroll") for (int r = 0; r < 16; ++r) s_ += PY0[r] + PY1[r]; l_reg += s_; \
        { u32x4 w_ = {cvtpk(PY0[0], PY0[1]), cvtpk(PY0[2], PY0[3]), cvtpk(PY0[4], PY0[5]), cvtpk(PY0[6], PY0[7])}; pa0 = __builtin_bit_cast(bf16x8, w_); } \
        { u32x4 w_ = {cvtpk(PY0[8], PY0[9]), cvtpk(PY0[10], PY0[11]), cvtpk(PY0[12], PY0[13]), cvtpk(PY0[14], PY0[15])}; pa1 = __builtin_bit_cast(bf16x8, w_); } \
        { u32x4 w_ = {cvtpk(PY1[0], PY1[1]), cvtpk(PY1[2], PY1[3]), cvtpk(PY1[4], PY1[5]), cvtpk(PY1[6], PY1[7])}; pa2 = __builtin_bit_cast(bf16x8, w_); } \
        { u32x4 w_ = {cvtpk(PY1[8], PY1[9]), cvtpk(PY1[10], PY1[11]), cvtpk(PY1[12], PY1[13]), cvtpk(PY1[14], PY1[15])}; pa3 = __builtin_bit_cast(bf16x8, w_); } } while (0)
#define D2_ENDW(t) do { if ((t) + 2 < NT) { D2_WAIT_BAR(5); } else if ((t) + 1 < NT) { D2_WAIT_BAR(2); } else { D2_WAIT_BAR(0); } } while (0)
    bool resc = false;
    D2_WAIT_BAR(8);
    qkt(pA0, pA1, Kl, r32, hi, qr, negb); D2_BIASMASK(pA0, pA1, 0); D2_DECIDE(pA0, pA1, true);
    D2_WAIT_BAR(5);
    kc = 1; vp = 0;
#define D2_HALF_STEP(PX0, PX1, PY0, PY1, t) do { \
        if ((t) + 2 < NT) D2_DMA(); \
        qkt(PX0, PX1, Kl + kc * KSLOT, r32, hi, qr, negb); \
        D2_FINISH(PY0, PY1); D2_SBAR(); \
        pv_tile(o, vb0 + vp * VSLOT, pa0, pa1, pa2, pa3); \
        D2_BIASMASK(PX0, PX1, (t)); D2_DECIDE(PX0, PX1, false); D2_RESC(); \
        D2_ENDW(t); kc = kc == NKS - 1 ? 0 : kc + 1; vp = vp == NVS - 1 ? 0 : vp + 1; } while (0)
    for (int t = 1; t + 1 < NT; t += 2) {
        D2_HALF_STEP(pB0, pB1, pA0, pA1, t);
        D2_HALF_STEP(pA0, pA1, pB0, pB1, t + 1);
    }
    D2_HALF_STEP(pB0, pB1, pA0, pA1, NT - 1);
    D2_FINISH(pB0, pB1); D2_SBAR(); pv_tile(o, vb0 + vp * VSLOT, pa0, pa1, pa2, pa3);
    { auto rr = __builtin_amdgcn_permlane32_swap(__float_as_uint(l_reg), __float_as_uint(l_reg), false, false); l_reg = __uint_as_float(rr[0]) + __uint_as_float(rr[1]); }
    if (hi == 0) wsf[32 + r32] = l_reg; asm volatile("s_waitcnt lgkmcnt(0)" ::: "memory");
#pragma unroll
    for (int r = 0; r < 16; ++r) { const float rl = __builtin_amdgcn_rcpf(wsf[32 + crow(r, hi)]);
#pragma unroll
        for (int d0 = 0; d0 < 4; ++d0) o[d0][r] *= rl; }
    asm volatile("s_waitcnt lgkmcnt(0)\n\ts_barrier" ::: "memory");
#undef D2_DMA
#undef D2_BIASMASK
#undef D2_DECIDE
#undef D2_RESC
#undef D2_FINISH
#undef D2_ENDW
#undef D2_HALF_STEP
}
}
static_assert(da2::LDS_BYTES <= 131072, "attention v2 LDS inside the ring region");
constexpr int NWAVES = 8;
#ifndef MK_N_LAUNCHES
#define MK_N_LAUNCHES 1
#endif
constexpr int BATCH = 16, SEQ = 2048, D = 1024, FF = 4096, M = BATCH * SEQ;
constexpr int NQKV = 3072;
constexpr int MLW = 3080, NPROJ = 3072;
constexpr int NH_A = 8, NH_M = 4;
constexpr float EPS = 1e-6f, LOG2E = 1.4426950408889634f;
constexpr float QSCALE = 0.125f * LOG2E;
constexpr float LAMBDA_INIT0 = 0.2f;
constexpr float MQSCALE = 0.08838834764831845f;
constexpr int NPHASE = 16;
constexpr int DUP_PHASE = -1;

namespace ml {
typedef short bf16x8 __attribute__((ext_vector_type(8)));
typedef short s16x4 __attribute__((ext_vector_type(4)));
typedef float f32x16 __attribute__((ext_vector_type(16)));
typedef float f32x4 __attribute__((ext_vector_type(4)));
typedef unsigned u32x4 __attribute__((ext_vector_type(4)));
typedef unsigned u32x2 __attribute__((ext_vector_type(2)));
#define MLAS __attribute__((address_space(3)))
constexpr int L = 64, NC = 2048 / L, PITCH = 3072;
constexpr int PQ = 272, PS = 144;
constexpr int O_Q = 0, O_K = O_Q + 64 * PQ, O_C = O_K + 64 * PQ, O_KW = O_C + 64 * PQ, O_V = O_KW + 16384, O_SC = O_V + 16384, O_ARR = O_SC + 64 * PS, O_NP = O_ARR + 9 * 256, O_N = O_NP + 4096, LDS_BYTES = O_N + 512;
enum { A_E = 0, A_BM = 64, A_INTER = 128, A_EMJ = 192, A_WP = 256, A_RS0 = 320, A_RS1 = 384, A_QN = 448, A_SCAL = 512 };
__device__ __forceinline__ float bf2f_lo(unsigned w) { return __uint_as_float(w << 16); }
__device__ __forceinline__ float bf2f_hi(unsigned w) { return __uint_as_float(w & 0xffff0000u); }
typedef float f32x2_t __attribute__((ext_vector_type(2))); typedef __bf16 bf16x2_t __attribute__((ext_vector_type(2)));
__device__ __forceinline__ unsigned cvtpk(float lo, float hi) { f32x2_t v = {lo, hi}; bf16x2_t b = __builtin_convertvector(v, bf16x2_t); return __builtin_bit_cast(unsigned, b); }
__device__ __forceinline__ int crow(int r, int hi) { return (r & 3) + 8 * (r >> 2) + 4 * hi; }
__device__ __forceinline__ int v_st(int k, int c) { const int kk = (k & ~0xC) | ((k & 4) << 1) | ((k & 8) >> 1); return ((kk >> 3) * 4 + (c >> 5)) * 512 + ((kk & 7) * 32 + (c & 31)) * 2; }
__device__ __forceinline__ int v_rd_base(int lane) { return ((lane & 3) << 3) | (((lane >> 2) & 3) << 6) | (((lane >> 4) & 1) << 5) | (((lane >> 5) & 1) << 8); }
#define ML_TRRD(dst, base, off) asm volatile("ds_read_b64_tr_b16 %0, %1 offset:%2" : "=&v"(dst) : "v"(base), "i"(off) : "memory")
#define ML_SBAR() __builtin_amdgcn_sched_barrier(0)
#define ML_FR(lo, hi_) (bf16x8){lo[0], lo[1], lo[2], lo[3], hi_[0], hi_[1], hi_[2], hi_[3]}
struct Pre { bf16x8 q[2], k[2], v; f32x4 g; };

__device__ __forceinline__ void mlstm_unit(int b, int h, int s4, const unsigned short* __restrict__ PROJ, const unsigned short* __restrict__ QKC, const float* __restrict__ GS,
                                           unsigned short* HT, float* SSQ, MLAS char* lds) {
    const int tid = threadIdx.x, wid = __builtin_amdgcn_readfirstlane(tid >> 6), lane = tid & 63, r32 = lane & 31, hi = lane >> 5;
    MLAS char* QIMG = lds + O_Q; MLAS char* KIMG = lds + O_K; MLAS char* CIMG = lds + O_C; MLAS char* KWTR = lds + O_KW; MLAS char* VTR = lds + O_V; MLAS char* SC = lds + O_SC;
    MLAS float* arr = (MLAS float*)(lds + O_ARR); MLAS float* npart = (MLAS float*)(lds + O_NP); MLAS float* nvec = (MLAS float*)(lds + O_N);
    const int srow = tid >> 4, cg = tid & 15;
    const int vrow = tid >> 3, vcol = (tid & 7) * 8;
    const size_t tok0 = (size_t)b * 2048;
    const unsigned short* xq = QKC + tok0 * 1024 + h * 128 + cg * 8;
    const unsigned short* xk = xq + 512;
    const unsigned short* xv = PROJ + tok0 * PITCH + 1024 + h * 256 + s4 * 64 + vcol;
    const float* gs = GS + tok0 * 16 + h * 4;
    const int dkb = wid >> 1, dvb = wid & 1;
    const int tb0 = (wid & 3) >> 1, jb = wid & 1;
    f32x16 cst = f32x16{};
    float m_prev = 0.f;
    for (int i = tid; i < (64 * PQ) / 16; i += 512) ((MLAS u32x4*)CIMG)[i] = (u32x4){0u, 0u, 0u, 0u};
    if (tid < 128) nvec[tid] = 0.f;
    Pre P;
#define ML_LOAD(t0_) do { P.q[0] = *reinterpret_cast<const bf16x8*>(xq + (size_t)((t0_) + srow) * 1024); P.q[1] = *reinterpret_cast<const bf16x8*>(xq + (size_t)((t0_) + srow + 32) * 1024); \
        P.k[0] = *reinterpret_cast<const bf16x8*>(xk + (size_t)((t0_) + srow) * 1024); P.k[1] = *reinterpret_cast<const bf16x8*>(xk + (size_t)((t0_) + srow + 32) * 1024); \
        P.v = *reinterpret_cast<const bf16x8*>(xv + (size_t)((t0_) + vrow) * PITCH); P.g = *reinterpret_cast<const f32x4*>(gs + (size_t)((t0_) + lane) * 16); } while (0)
    ML_LOAD(0);
    u32x2 dst_w[4] = {}; float dst_ss = 0.f;
    const int trb_kw = (int)(uintptr_t)KWTR + v_rd_base(lane), trb_v = (int)(uintptr_t)VTR + v_rd_base(lane);
    __syncthreads();
    for (int c = 0; c < NC; ++c) {
        const int t0 = c * L;
        const float bsum = P.g[0], e = P.g[1], pm = P.g[2];
        asm volatile("" :: "v"(P.g[3]));
        const float b_last = __int_as_float(__builtin_amdgcn_readlane(__float_as_int(bsum), 63)), m_loc = b_last + __int_as_float(__builtin_amdgcn_readlane(__float_as_int(pm), 63));
        const float m_new = fmaxf(b_last + m_prev, m_loc), decay = __expf(b_last + m_prev - m_new);
        const float wp = __expf(b_last + e - m_new);
        const float m_inter = bsum + m_prev, m_j = fmaxf(m_inter, bsum + pm);
        if (wid == 0) { arr[A_E + lane] = e; arr[A_BM + lane] = bsum - m_j; arr[A_INTER + lane] = __expf(m_inter - m_j); arr[A_EMJ + lane] = __expf(-m_j); arr[A_WP + lane] = wp; }
        m_prev = m_new;
#pragma unroll
        for (int i = 0; i < 2; ++i) { const int row = srow + 32 * i; const float wrow = __shfl(wp, row);
            *reinterpret_cast<MLAS bf16x8*>(QIMG + row * PQ + cg * 16) = P.q[i];
            *reinterpret_cast<MLAS bf16x8*>(KIMG + row * PQ + cg * 16) = P.k[i];
            const u32x4 kw = __builtin_bit_cast(u32x4, P.k[i]); u32x4 ow;
#pragma unroll
            for (int q = 0; q < 4; ++q) ow[q] = cvtpk(bf2f_lo(kw[q]) * wrow, bf2f_hi(kw[q]) * wrow);
            *reinterpret_cast<MLAS u32x4*>(KWTR + v_st(row, cg * 8)) = ow; }
        *reinterpret_cast<MLAS bf16x8*>(VTR + v_st(vrow, vcol)) = P.v;
        __syncthreads();
#define ML_STORE_OUT(tt) do { if (wid >= 4) { const int j_ = 32 * jb + r32; unsigned short* hp_ = HT + (tok0 + (tt) + j_) * 1024 + h * 256 + s4 * 64 + 32 * tb0 + 4 * hi; \
            _Pragma("unroll") for (int q4 = 0; q4 < 4; ++q4) *reinterpret_cast<u32x2*>(hp_ + 8 * q4) = dst_w[q4]; \
            if (hi == 0) SSQ[(tok0 + (tt) + j_) * 32 + h * 8 + s4 * 2 + tb0] = dst_ss; } } while (0)
        if (c > 0) ML_STORE_OUT(t0 - L);
        { const int tn = (c + 1 < NC) ? t0 + L : t0; ML_LOAD(tn); }
        f32x16 acc_qc = f32x16{};
        if (wid < 4) {
            f32x16 g = f32x16{};
            if (!(tb0 == 1 && jb == 0)) {
                const MLAS char* ka = KIMG + (32 * tb0 + r32) * PQ + hi * 16; const MLAS char* qa = QIMG + (32 * jb + r32) * PQ + hi * 16;
bf16x8 fa[8], fb[8];
#pragma unroll
                for (int kk = 0; kk < 8; ++kk) { fa[kk] = *reinterpret_cast<const MLAS bf16x8*>(ka + kk * 32); fb[kk] = *reinterpret_cast<const MLAS bf16x8*>(qa + kk * 32); }
                ML_SBAR();
#pragma unroll
                for (int kk = 0; kk < 8; ++kk) g = __builtin_amdgcn_mfma_f32_32x32x16_bf16(fa[kk], fb[kk], g, 0, 0, 0);
            }
            const int j = 32 * jb + r32; const float bm = arr[A_BM + j]; float rsum = 0.f;
#pragma unroll
            for (int q4 = 0; q4 < 4; ++q4) { const f32x4 ev = *reinterpret_cast<const MLAS f32x4*>(arr + A_E + 32 * tb0 + 8 * q4 + 4 * hi);
                float sc4[4];
#pragma unroll
                for (int i = 0; i < 4; ++i) { const int s = 32 * tb0 + 8 * q4 + 4 * hi + i; const float v = (s <= j) ? g[4 * q4 + i] * __expf(bm + ev[i]) : 0.f; sc4[i] = v; rsum += v; }
                const u32x2 w = {cvtpk(sc4[0], sc4[1]), cvtpk(sc4[2], sc4[3])};
                *reinterpret_cast<MLAS u32x2*>(SC + j * PS + (32 * tb0 + 8 * q4 + 4 * hi) * 2) = w; }
            rsum += __shfl_xor(rsum, 32);
            if (hi == 0) arr[(tb0 ? A_RS1 : A_RS0) + j] = rsum;
        } else {
            const MLAS char* ca = CIMG + (32 * tb0 + r32) * PQ + hi * 16; const MLAS char* qa = QIMG + (32 * jb + r32) * PQ + hi * 16;
bf16x8 fa[8], fb[8];
#pragma unroll
            for (int kk = 0; kk < 8; ++kk) { fa[kk] = *reinterpret_cast<const MLAS bf16x8*>(ca + kk * 32); fb[kk] = *reinterpret_cast<const MLAS bf16x8*>(qa + kk * 32); }
            ML_SBAR();
#pragma unroll
            for (int kk = 0; kk < 8; ++kk) acc_qc = __builtin_amdgcn_mfma_f32_32x32x16_bf16(fa[kk], fb[kk], acc_qc, 0, 0, 0);
        }
        {
            const int j = tid >> 3, part = tid & 7;
            const u32x4 q0 = *reinterpret_cast<const MLAS u32x4*>(QIMG + j * PQ + part * 32), q1 = *reinterpret_cast<const MLAS u32x4*>(QIMG + j * PQ + part * 32 + 16);
            float s = 0.f;
#pragma unroll
            for (int q = 0; q < 4; ++q) { const f32x4 n4 = *reinterpret_cast<const MLAS f32x4*>(nvec + part * 16 + 4 * q);
                const unsigned w0 = q < 2 ? q0[2 * q] : q1[2 * q - 4], w1 = q < 2 ? q0[2 * q + 1] : q1[2 * q - 3];
                s += bf2f_lo(w0) * n4[0] + bf2f_hi(w0) * n4[1] + bf2f_lo(w1) * n4[2] + bf2f_hi(w1) * n4[3]; }
            s += __shfl_xor(s, 1); s += __shfl_xor(s, 2); s += __shfl_xor(s, 4);
            if (part == 0) arr[A_QN + j] = s;
            float n0 = 0.f, n1 = 0.f;
#pragma unroll
            for (int i = 0; i < 8; ++i) { const int srow = 8 * wid + i; const unsigned kw = *reinterpret_cast<const MLAS unsigned*>(KIMG + srow * PQ + lane * 4); const float w = arr[A_WP + srow];
                n0 += w * bf2f_lo(kw); n1 += w * bf2f_hi(kw); }
            npart[wid * 128 + 2 * lane] = n0; npart[wid * 128 + 2 * lane + 1] = n1;
        }
        __syncthreads();
        if (wid >= 4) {
            f32x16 acc_n = f32x16{};
            const MLAS char* sa = SC + (32 * jb + r32) * PS + hi * 16;
            {   s16x4 l0, l1, l2, l3, h0, h1, h2, h3;
                if (tb0 == 0) { ML_TRRD(l0, trb_v, 0); ML_TRRD(h0, trb_v, 2048); ML_TRRD(l1, trb_v, 4096); ML_TRRD(h1, trb_v, 6144); ML_TRRD(l2, trb_v, 8192); ML_TRRD(h2, trb_v, 10240); ML_TRRD(l3, trb_v, 12288); ML_TRRD(h3, trb_v, 14336); }
                else { ML_TRRD(l0, trb_v, 512); ML_TRRD(h0, trb_v, 512 + 2048); ML_TRRD(l1, trb_v, 512 + 4096); ML_TRRD(h1, trb_v, 512 + 6144); ML_TRRD(l2, trb_v, 512 + 8192); ML_TRRD(h2, trb_v, 512 + 10240); ML_TRRD(l3, trb_v, 512 + 12288); ML_TRRD(h3, trb_v, 512 + 14336); }
                const bf16x8 s0 = *reinterpret_cast<const MLAS bf16x8*>(sa), s1 = *reinterpret_cast<const MLAS bf16x8*>(sa + 32), s2 = *reinterpret_cast<const MLAS bf16x8*>(sa + 64), s3 = *reinterpret_cast<const MLAS bf16x8*>(sa + 96);
                asm volatile("s_waitcnt lgkmcnt(0)" ::: "memory"); ML_SBAR();
                acc_n = __builtin_amdgcn_mfma_f32_32x32x16_bf16(ML_FR(l0, h0), s0, acc_n, 0, 0, 0);
                acc_n = __builtin_amdgcn_mfma_f32_32x32x16_bf16(ML_FR(l1, h1), s1, acc_n, 0, 0, 0);
                acc_n = __builtin_amdgcn_mfma_f32_32x32x16_bf16(ML_FR(l2, h2), s2, acc_n, 0, 0, 0);
                acc_n = __builtin_amdgcn_mfma_f32_32x32x16_bf16(ML_FR(l3, h3), s3, acc_n, 0, 0, 0); }
            const int j = 32 * jb + r32; const float inter = arr[A_INTER + j];
            const float den = arr[A_RS0 + j] + arr[A_RS1 + j] + inter * arr[A_QN + j];
            const float rden = 1.f / fmaxf(fabsf(den), arr[A_EMJ + j]);
            float ss = 0.f;
#pragma unroll
            for (int q4 = 0; q4 < 4; ++q4) { float hv[4];
#pragma unroll
                for (int i = 0; i < 4; ++i) { hv[i] = (acc_n[4 * q4 + i] + inter * acc_qc[4 * q4 + i]) * rden; ss += hv[i] * hv[i]; }
                dst_w[q4] = (u32x2){cvtpk(hv[0], hv[1]), cvtpk(hv[2], hv[3])}; }
            ss += __shfl_xor(ss, 32);
            dst_ss = ss;
        }
        {
            s16x4 al[4], ah[4], bl[4], bh[4];
#define ML_LD4(d0k, d0v) do { ML_TRRD(al[0], trb_kw, (d0k) * 512); ML_TRRD(ah[0], trb_kw, (d0k) * 512 + 2048); ML_TRRD(al[1], trb_kw, (d0k) * 512 + 4096); ML_TRRD(ah[1], trb_kw, (d0k) * 512 + 6144); \
            ML_TRRD(al[2], trb_kw, (d0k) * 512 + 8192); ML_TRRD(ah[2], trb_kw, (d0k) * 512 + 10240); ML_TRRD(al[3], trb_kw, (d0k) * 512 + 12288); ML_TRRD(ah[3], trb_kw, (d0k) * 512 + 14336); \
            ML_TRRD(bl[0], trb_v, (d0v) * 512); ML_TRRD(bh[0], trb_v, (d0v) * 512 + 2048); ML_TRRD(bl[1], trb_v, (d0v) * 512 + 4096); ML_TRRD(bh[1], trb_v, (d0v) * 512 + 6144); \
            ML_TRRD(bl[2], trb_v, (d0v) * 512 + 8192); ML_TRRD(bh[2], trb_v, (d0v) * 512 + 10240); ML_TRRD(bl[3], trb_v, (d0v) * 512 + 12288); ML_TRRD(bh[3], trb_v, (d0v) * 512 + 14336); } while (0)
            switch (wid) { case 0: ML_LD4(0, 0); break; case 1: ML_LD4(0, 1); break; case 2: ML_LD4(1, 0); break; case 3: ML_LD4(1, 1); break;
                           case 4: ML_LD4(2, 0); break; case 5: ML_LD4(2, 1); break; case 6: ML_LD4(3, 0); break; default: ML_LD4(3, 1); break; }
#undef ML_LD4
#pragma unroll
            for (int r = 0; r < 16; ++r) cst[r] *= decay;
            asm volatile("s_waitcnt lgkmcnt(0)" ::: "memory"); ML_SBAR();
#pragma unroll
            for (int ks = 0; ks < 4; ++ks) cst = __builtin_amdgcn_mfma_f32_32x32x16_bf16(ML_FR(al[ks], ah[ks]), ML_FR(bl[ks], bh[ks]), cst, 0, 0, 0);
            const int dv = 32 * dvb + r32;
#pragma unroll
            for (int q4 = 0; q4 < 4; ++q4) { const u32x2 w = {cvtpk(cst[4 * q4], cst[4 * q4 + 1]), cvtpk(cst[4 * q4 + 2], cst[4 * q4 + 3])};
                *reinterpret_cast<MLAS u32x2*>(CIMG + dv * PQ + (32 * dkb + 8 * q4 + 4 * hi) * 2) = w; }
        }
        if (tid < 128) { float s = nvec[tid] * decay;
#pragma unroll
            for (int w = 0; w < 8; ++w) s += npart[w * 128 + tid];
            nvec[tid] = s; }
        __syncthreads();
    }
    ML_STORE_OUT((NC - 1) * L);
#undef ML_STORE_OUT
#undef ML_LOAD
}
}
static_assert(ml::LDS_BYTES <= 131072, "mLSTM LDS inside the ring region");
constexpr size_t MiB = 1u << 20;
constexpr size_t WS_CTL = 0, CTL_ZERO_BYTES = 1 * MiB;
constexpr size_t WS_WQKV = 2 * MiB, WS_WAO = 8 * MiB, WS_WML = 10 * MiB  , WS_WMO = 17 * MiB, WS_W1 = 19 * MiB  , WS_W2 = 35 * MiB  ;
constexpr size_t WS_GATES = 51 * MiB;
constexpr size_t WS_SSQ = 52 * MiB;
constexpr size_t WS_GS = 56 * MiB;
constexpr size_t WS_SSQH = 58 * MiB;
constexpr size_t WS_XN = 64 * MiB;
constexpr size_t WS_U = 128 * MiB;
constexpr size_t WS_HT = 320 * MiB;
constexpr size_t WS_AO = 384 * MiB;
constexpr size_t WS_STASH = 448 * MiB;
constexpr size_t WS_END = 480 * MiB;
constexpr int CW_TMO = 0, CW_CODE = 1;
constexpr int CW_BAR = 4096;
constexpr int RING_OFF = 0, RING_BYTES = 131072;
constexpr int LDSCTL_OFF = RING_BYTES, MISC_OFF = LDSCTL_OFF + 320;
constexpr int EPIRED_OFF = LDSCTL_OFF + 1024;
constexpr int LDS_BYTES = 147456;
static_assert(MISC_OFF + 128 <= LDS_BYTES, "LDS map");

#define GAS __attribute__((address_space(1)))
#define LAS __attribute__((address_space(3)))
typedef unsigned short bf16;
typedef unsigned v4u __attribute__((ext_vector_type(4)));
typedef float f32x4 __attribute__((ext_vector_type(4)));
typedef short bf16x8 __attribute__((ext_vector_type(8)));
typedef GAS unsigned gu32;
typedef GAS unsigned long long gu64;
#define RLX_AGENT __ATOMIC_RELAXED, __HIP_MEMORY_SCOPE_AGENT
#define LDS_WAIT() asm volatile("s_waitcnt lgkmcnt(0)" ::: "memory")
#define VM_WAIT() asm volatile("s_waitcnt vmcnt(0)" ::: "memory")
__device__ __forceinline__ unsigned long long rt() { return __builtin_amdgcn_s_memrealtime(); }
__device__ __forceinline__ unsigned f2bf(float f) { unsigned u = __builtin_bit_cast(unsigned, f); return (u + 0x7fffu + ((u >> 16) & 1u)) >> 16; }
__device__ __forceinline__ unsigned pk2(float lo, float hi) { return f2bf(lo) | (f2bf(hi) << 16); }

#define XB_TMO      128
#define XB_XCNT(j)  (256  + 64 * (j))
#define XB_XSUB(j)  (1280 + 64 * (j))
#define XB_XGEN(j)  (2304 + 64 * (j))
#define XB_TOP      3328
#define XB_TOPGEN   3392
#define XCD_BAR_WORDS 3456
#define XB_SPIN_CAP (1u << 23)

__device__ __forceinline__ unsigned xb_ld(unsigned* p)              { return __hip_atomic_load(p, __ATOMIC_RELAXED, __HIP_MEMORY_SCOPE_AGENT); }
__device__ __forceinline__ unsigned xb_add(unsigned* p, unsigned v) { return __hip_atomic_fetch_add(p, v, __ATOMIC_RELAXED, __HIP_MEMORY_SCOPE_AGENT); }
__device__ __forceinline__ unsigned xb_xcc_id() { return (unsigned)__builtin_amdgcn_s_getreg((3 << 11) | 20) & 0xFu; }
#define XB_SPIN(cond, bar) do { unsigned _sp = 0; while (cond) { __builtin_amdgcn_s_sleep(1); \
    if ((++_sp & 255u) == 0u) { if (xb_ld(&(bar)[XB_TMO])) break; if (_sp > XB_SPIN_CAP) { atomicAdd(&(bar)[XB_TMO], 1u); break; } } } } while (0)

struct XcdBarrier {
    unsigned* bar; unsigned x;
    volatile LAS unsigned* st;
};

__device__ __forceinline__ XcdBarrier xcd_barrier_post(unsigned* bar, volatile LAS unsigned* st) {
    XcdBarrier b; b.bar = bar; b.x = xb_xcc_id(); b.st = st;
    if (threadIdx.x == 0) (void)xb_add(&bar[XB_XCNT(b.x)], 1u);
    return b;
}
__device__ __forceinline__ void xcd_barrier_complete(unsigned* bar, unsigned x, unsigned& nloc, unsigned& nx) {
    const unsigned G = gridDim.x * gridDim.y * gridDim.z;
    unsigned sum, cnt, mine, sp = 0u;
    for (;;) {
        sum = 0u; cnt = 0u; mine = 0u;
#pragma unroll
        for (unsigned j = 0; j < 16; ++j) { const unsigned c = xb_ld(&bar[XB_XCNT(j)]); sum += c; cnt += (c > 0u) ? 1u : 0u; mine = (j == x) ? c : mine; }
        if (sum == G) break;
        __builtin_amdgcn_s_sleep(1);
        if ((++sp & 255u) == 0u) { if (xb_ld(&bar[XB_TMO])) break; if (sp > XB_SPIN_CAP) { atomicAdd(&bar[XB_TMO], 1u); break; } }
    }
    nloc = mine > 0u ? mine : 1u; nx = cnt > 0u ? cnt : 1u;
}

__device__ __forceinline__ void xcd_barrier(const XcdBarrier& b) {
    asm volatile("s_waitcnt vmcnt(0)" ::: "memory");
    __syncthreads();
    if (threadIdx.x == 0) {
        unsigned* bar = b.bar;
        __builtin_amdgcn_s_waitcnt(0);
        unsigned nloc = b.st[0], nx = b.st[1];
        if (nloc == 0u) { xcd_barrier_complete(bar, b.x, nloc, nx); b.st[0] = nloc; b.st[1] = nx; }
        const unsigned old = xb_add(&bar[XB_XSUB(b.x)], 1u);
        const unsigned gen = old / nloc;
        if (old + 1u == (gen + 1u) * nloc) {
            __builtin_amdgcn_fence(__ATOMIC_RELEASE, "agent");
            asm volatile("s_waitcnt vmcnt(0)" ::: "memory");
            const unsigned og = xb_add(&bar[XB_TOP], 1u);
            const unsigned tg = og / nx;
            if (og + 1u == (tg + 1u) * nx) xb_add(&bar[XB_TOPGEN], 1u);
            else XB_SPIN(xb_ld(&bar[XB_TOPGEN]) == tg, bar);
            __builtin_amdgcn_fence(__ATOMIC_ACQUIRE, "agent");
            xb_add(&bar[XB_XGEN(b.x)], 1u);
            asm volatile("s_waitcnt vmcnt(0)" ::: "memory");
        } else {
            XB_SPIN(xb_ld(&bar[XB_XGEN(b.x)]) == gen, bar);
            __builtin_amdgcn_fence(__ATOMIC_ACQUIRE, "agent");
            asm volatile("s_waitcnt vmcnt(0)" ::: "memory");
        }
    }
    __syncthreads();
}

struct Frame {
    LAS unsigned char* lds;
    volatile LAS unsigned* MISC;
    gu32* ctl;
    int tid, lane, wave;
    int vcu, G;
};
__device__ __forceinline__ float wave_sum(float v) {
#pragma unroll
    for (int o = 1; o < 64; o <<= 1) v += __shfl_xor(v, o);
    return v;
}
__device__ __forceinline__ void p0_transpose_item(const float* W, int K, int ldw, int nblk, bf16* WT, const float* gk, int gmask, float gs, LAS float* scr, int item, int lane) {
    const int kb = item / nblk, nb = item % nblk, k0 = 64 * kb, n0 = 64 * nb;
    f32x4 v[16];
#pragma unroll
    for (int i = 0; i < 16; ++i) v[i] = *(const GAS f32x4*)(W + (size_t)(k0 + 4 * i + (lane >> 4)) * ldw + n0 + (lane & 15) * 4);
#pragma unroll
    for (int i = 0; i < 16; ++i) { const int kk = 4 * i + (lane >> 4); const float g = gk ? gk[(k0 + kk) & gmask] * gs : gs; LAS float* d = scr + kk * 64; const int nn = (lane & 15) * 4 + kk;
        d[nn & 63] = v[i].x * g; d[(nn + 1) & 63] = v[i].y * g; d[(nn + 2) & 63] = v[i].z * g; d[(nn + 3) & 63] = v[i].w * g; }
    LDS_WAIT(); asm volatile("" ::: "memory");
    const int c = lane & 7;
#pragma unroll
    for (int j = 0; j < 8; ++j) { const int n = (lane >> 3) + 8 * j; const LAS float* s = scr + (8 * c) * 64; const int nn = n + 8 * c;
        v4u o; o.x = pk2(s[0 * 64 + (nn & 63)], s[1 * 64 + ((nn + 1) & 63)]); o.y = pk2(s[2 * 64 + ((nn + 2) & 63)], s[3 * 64 + ((nn + 3) & 63)]);
        o.z = pk2(s[4 * 64 + ((nn + 4) & 63)], s[5 * 64 + ((nn + 5) & 63)]); o.w = pk2(s[6 * 64 + ((nn + 6) & 63)], s[7 * 64 + ((nn + 7) & 63)]);
        *(GAS v4u*)(WT + (size_t)(n0 + n) * K + k0 + 8 * c) = o; }
    LDS_WAIT(); asm volatile("" ::: "memory");
}
__device__ __forceinline__ void rms_row_load(const float* xrow, int lane, f32x4 (&v)[4]) {
    const GAS f32x4* xr = (const GAS f32x4*)xrow + lane; float s2 = 0.f;
#pragma unroll
    for (int j = 0; j < 4; ++j) { v[j] = xr[64 * j]; s2 += (v[j].x * v[j].x + v[j].y * v[j].y) + (v[j].z * v[j].z + v[j].w * v[j].w); }
    const float rstd = 1.f / sqrtf(wave_sum(s2) * (1.f / D) + EPS);
#pragma unroll
    for (int j = 0; j < 4; ++j) v[j] = v[j] * rstd;
}
__device__ __forceinline__ void row_store_bf16(bf16* orow, int lane, const f32x4 (&v)[4]) {
    GAS unsigned long long* o8 = (GAS unsigned long long*)orow + lane;
#pragma unroll
    for (int j = 0; j < 4; ++j) o8[64 * j] = (unsigned long long)pk2(v[j].x, v[j].y) | ((unsigned long long)pk2(v[j].z, v[j].w) << 32);
}
__device__ __forceinline__ float log_sigmoid(float x) { return fminf(x, 0.f) - log1pf(expf(-fabsf(x))); }

struct Args { const float* in[22]; float* out; unsigned char* ws; int ph_lo, ph_hi, li, pad; };

__device__ __forceinline__ void p0_prologue(Frame& F, const Args& a) {
    unsigned char* ws = a.ws;
    LAS float* scr = (LAS float*)(F.lds + RING_OFF + F.wave * 16384);
    const int gw = F.vcu * NWAVES + F.wave, NGW = F.G * NWAVES;
    constexpr int I_QKV = (D / 64) * (NQKV / 64), I_O = (D / 64) * (D / 64), I_ML = (D / 64) * (NPROJ / 64), I_1 = (D / 64) * (FF / 64), I_2 = (FF / 64) * (D / 64);
    constexpr int NITEMS = I_QKV + I_O + I_ML + I_O + 2 * I_1 + 2 * I_2;
    for (int it = gw; it < NITEMS; it += NGW) {
        int r = it;
        if (r < I_QKV) { p0_transpose_item(a.in[3], D, NQKV, NQKV / 64, (bf16*)(ws + WS_WQKV), a.in[2], 0xffff, 1.f, scr, r, F.lane); continue; } r -= I_QKV;
        if (r < I_O) { p0_transpose_item(a.in[9], D, D, D / 64, (bf16*)(ws + WS_WAO), a.in[8], 127, 1.f - LAMBDA_INIT0, scr, r, F.lane); continue; } r -= I_O;
        if (r < I_ML) { p0_transpose_item(a.in[11], D, MLW, NPROJ / 64, (bf16*)(ws + WS_WML), a.in[10], 0xffff, 1.f, scr, r, F.lane); continue; } r -= I_ML;
        if (r < I_O) { p0_transpose_item(a.in[17], D, D, D / 64, (bf16*)(ws + WS_WMO), a.in[16], 0xffff, 1.f, scr, r, F.lane); continue; } r -= I_O;
        if (r < 2 * I_1) { const int l = r / I_1; p0_transpose_item(a.in[19] + (size_t)l * D * FF, D, FF, FF / 64, (bf16*)(ws + WS_W1) + (size_t)l * D * FF, a.in[18] + l * D, 0xffff, 1.f, scr, r % I_1, F.lane); continue; } r -= 2 * I_1;
        { const int l = r / I_2; p0_transpose_item(a.in[20] + (size_t)l * D * FF, FF, D, D / 64, (bf16*)(ws + WS_W2) + (size_t)l * D * FF, nullptr, 0, 1.f, scr, r % I_2, F.lane); }
    }
    { bf16* WT = (bf16*)(ws + WS_WML) + (size_t)NPROJ * D; const int gt = (F.vcu * NWAVES + F.wave) * 64 + F.lane, NGT = F.G * NWAVES * 64;
      for (int i = gt; i < 256 * D / 2; i += NGT) { const int j = (2 * i) / D, k = (2 * i) % D;
          const unsigned w = j < 8 ? pk2(a.in[10][k] * a.in[11][(size_t)k * MLW + NPROJ + j], a.in[10][k + 1] * a.in[11][(size_t)(k + 1) * MLW + NPROJ + j]) : 0u;
          ((GAS unsigned*)WT)[i] = w; } }
    bf16* XN = (bf16*)(ws + WS_XN); float* SSQH = (float*)(ws + WS_SSQH);
    for (int m = gw; m < M; m += NGW) { f32x4 v[4]; const GAS f32x4* xr = (const GAS f32x4*)(a.in[0] + (size_t)m * D) + F.lane; float s2 = 0.f;
#pragma unroll
        for (int j = 0; j < 4; ++j) { v[j] = xr[64 * j]; s2 += (v[j].x * v[j].x + v[j].y * v[j].y) + (v[j].z * v[j].z + v[j].w * v[j].w); }
        s2 = wave_sum(s2); row_store_bf16(XN + (size_t)m * D, F.lane, v);
        if (F.lane < 4) SSQH[(size_t)m * 4 + F.lane] = F.lane == 0 ? s2 : 0.f; }
}
__device__ __forceinline__ void final_norm_phase(Frame& F, const bf16* XN, const float* SSQH, const float* g, float* out) {
    const int gw = F.vcu * NWAVES + F.wave, NGW = F.G * NWAVES;
    for (int m = gw; m < M; m += NGW) {
        const float rstd = pg8::row_rstd(SSQH, m);
        const v4u h0 = *(const GAS v4u*)(XN + (size_t)m * D + F.lane * 16), h1 = *(const GAS v4u*)(XN + (size_t)m * D + F.lane * 16 + 8);
        GAS f32x4* o = (GAS f32x4*)(out + (size_t)m * D + F.lane * 16); const GAS f32x4* gg = (const GAS f32x4*)(g + F.lane * 16);
#pragma unroll
        for (int q = 0; q < 2; ++q) { const f32x4 a = gg[q];
            o[q] = (f32x4){__uint_as_float(h0[2 * q] << 16) * rstd * a.x, __uint_as_float(h0[2 * q] & 0xffff0000u) * rstd * a.y, __uint_as_float(h0[2 * q + 1] << 16) * rstd * a.z, __uint_as_float(h0[2 * q + 1] & 0xffff0000u) * rstd * a.w}; }
#pragma unroll
        for (int q = 0; q < 2; ++q) { const f32x4 a = gg[2 + q];
            o[2 + q] = (f32x4){__uint_as_float(h1[2 * q] << 16) * rstd * a.x, __uint_as_float(h1[2 * q] & 0xffff0000u) * rstd * a.y, __uint_as_float(h1[2 * q + 1] << 16) * rstd * a.z, __uint_as_float(h1[2 * q + 1] & 0xffff0000u) * rstd * a.w}; }
    }
}

__device__ __forceinline__ float bf2f(bf16 v) { return __uint_as_float((unsigned)v << 16); }
__device__ __forceinline__ int t5_bucket(int d) {
    if (d < 16) return d;
    const float v = logf((float)d / 16.f) / logf(8.f) * 16.f; int b = 16 + (int)v; return b > 31 ? 31 : b;
}
__device__ __forceinline__ void naive_attn_phase(Frame& F, const bf16* __restrict__ QKV, const float* __restrict__ rel_bias, const float* __restrict__ lq1, const float* __restrict__ lk1,
                                                  const float* __restrict__ lq2, const float* __restrict__ lk2, bf16* AO) {
    LAS float* lut = (LAS float*)(F.lds + RING_OFF);
    const int tid = F.tid, half = tid & 1;
    float s1 = 0.f, s2 = 0.f;
    for (int i = 0; i < 64; ++i) { s1 += lq1[i] * lk1[i]; s2 += lq2[i] * lk2[i]; }
    const float lam = expf(s1) - expf(s2) + LAMBDA_INIT0;
    for (int u = F.vcu; u < BATCH * NH_A * (SEQ / 256); u += F.G) {
        const int qb = u % (SEQ / 256), h = (u / (SEQ / 256)) % NH_A, b = u / (SEQ / 256) / NH_A, q0 = qb * 256, q = q0 + (tid >> 1);
        __syncthreads();
        if (tid < 128) lut[tid] = rel_bias[t5_bucket(tid) * NH_A + h] * LOG2E;
        __syncthreads();
        const size_t tok = (size_t)b * SEQ + q;
        float res[64];
        for (int m = 0; m < 2; ++m) {
            float qv[64];
            const bf16* qp = QKV + tok * NQKV + h * 128 + m * 64;
#pragma unroll
            for (int d = 0; d < 64; ++d) qv[d] = bf2f(qp[d]);
            float o[64];
#pragma unroll
            for (int d = 0; d < 64; ++d) o[d] = 0.f;
            float mrun = -1e30f, l = 0.f;
            const int kend = q0 + 256;
            for (int k = 0; k < kend; ++k) {
                const bf16* kr = QKV + ((size_t)b * SEQ + k) * NQKV + D + h * 128 + m * 64;
                const bf16* vr = QKV + ((size_t)b * SEQ + k) * NQKV + 2 * D + h * 128 + half * 64;
                float s = 0.f;
#pragma unroll
                for (int d = 0; d < 64; ++d) s += qv[d] * bf2f(kr[d]);
                const int dist = q - k;
                if (dist >= 0) {
                    s += lut[dist < 127 ? dist : 127];
                    if (s > mrun) { const float al = exp2f(mrun - s); l *= al;
#pragma unroll
                        for (int d = 0; d < 64; ++d) o[d] *= al;
                        mrun = s; }
                    const float p = exp2f(s - mrun); l += p;
#pragma unroll
                    for (int d = 0; d < 64; ++d) o[d] += p * bf2f(vr[d]);
                }
            }
            const float il = 1.f / l;
            if (m == 0) {
#pragma unroll
                for (int d = 0; d < 64; ++d) res[d] = o[d] * il;
            } else {
                float ss = 0.f;
#pragma unroll
                for (int d = 0; d < 64; ++d) { res[d] = res[d] - lam * (o[d] * il); ss += res[d] * res[d]; }
                ss += __shfl_xor(ss, 1);
                const float rstd = 1.f / sqrtf(ss * (1.f / 128.f) + EPS);
                bf16* op = AO + tok * D + h * 128 + half * 64;
#pragma unroll
                for (int d = 0; d < 64; d += 2) *(unsigned*)(op + d) = pk2(res[d] * rstd, res[d + 1] * rstd);
            }
        }
    }
    __syncthreads();
}
__device__ __forceinline__ void naive_mlstm_phase(Frame& F, const bf16* __restrict__ PROJ, const float* __restrict__ GATES, const float* __restrict__ conv_w, const float* __restrict__ conv_b, bf16* AO) {
    LAS float* q_s = (LAS float*)(F.lds + RING_OFF); LAS float* k_s = q_s + 128; LAS float* v_s = q_s + 256; LAS float* red = q_s + 512;
    const int tid = F.tid, dv = tid >> 1, half = tid & 1, lane = F.lane, wave = F.wave;
    for (int u = (int)blockIdx.x; u < BATCH * NH_M; u += F.G) {
        const int h = u & 3, b = u >> 2;
        float C[64], n[64];
#pragma unroll
        for (int j = 0; j < 64; ++j) { C[j] = 0.f; n[j] = 0.f; }
        float mst = 0.f;
        const int col = (tid < 128) ? (h * 128 + tid) : (512 + h * 128 + ((tid - 128) & 127));
        float cw0 = 0.f, cw1 = 0.f, cw2 = 0.f, cw3 = 0.f, cb = 0.f;
        if (tid < 256) { cw0 = conv_w[0 * D + col]; cw1 = conv_w[1 * D + col]; cw2 = conv_w[2 * D + col]; cw3 = conv_w[3 * D + col]; cb = conv_b[col]; }
        __syncthreads();
        for (int t = 0; t < SEQ; ++t) {
            const size_t tok = (size_t)b * SEQ + t;
            if (tid < 256) {
                float x3 = bf2f(PROJ[tok * NPROJ + col]);
                float x2 = t >= 1 ? bf2f(PROJ[(tok - 1) * NPROJ + col]) : 0.f;
                float x1 = t >= 2 ? bf2f(PROJ[(tok - 2) * NPROJ + col]) : 0.f;
                float x0 = t >= 3 ? bf2f(PROJ[(tok - 3) * NPROJ + col]) : 0.f;
                float y = cw0 * x0 + cw1 * x1 + cw2 * x2 + cw3 * x3 + cb;
                y = y / (1.f + expf(-y));
                if (tid < 128) q_s[tid] = y * MQSCALE; else k_s[tid - 128] = y;
            } else {
                v_s[tid - 256] = bf2f(PROJ[tok * NPROJ + 1024 + h * 256 + (tid - 256)]);
            }
            const float ig = GATES[tok * 8 + h], lf = GATES[tok * 8 + 4 + h];
            __syncthreads();
            const float mnew = fmaxf(lf + mst, ig), fd = expf(lf + mst - mnew), gi = expf(ig - mnew);
            mst = mnew;
            const float gv = gi * v_s[dv];
            float num = 0.f, den = 0.f;
#pragma unroll
            for (int j = 0; j < 64; ++j) { const float kk = k_s[half * 64 + j], qq = q_s[half * 64 + j];
                C[j] = fd * C[j] + gv * kk; n[j] = fd * n[j] + gi * kk; num += C[j] * qq; den += n[j] * qq; }
            num += __shfl_xor(num, 1); den += __shfl_xor(den, 1);
            const float hv = num / fmaxf(fabsf(den), expf(-mnew));
            float ss = half == 0 ? hv * hv : 0.f;
            ss = wave_sum(ss);
            if (lane == 0) red[wave] = ss;
            __syncthreads();
            float tot = 0.f;
#pragma unroll
            for (int w = 0; w < 8; ++w) tot += red[w];
            const float rstd = 1.f / sqrtf(tot * (1.f / 256.f) + EPS);
            if (half == 0) { const float op = bf2f(PROJ[tok * NPROJ + 2048 + h * 256 + dv]); const float sg = 1.f / (1.f + expf(-op));
                AO[tok * D + h * 256 + dv] = (bf16)f2bf(sg * hv * rstd); }
            __syncthreads();
        }
    }
}

__device__ __forceinline__ void attn_phase(Frame& F, const bf16* __restrict__ QKV, bf16* AO, float* stash, const float* __restrict__ rel_bias, const float* __restrict__ lq1, const float* __restrict__ lk1,
                                           const float* __restrict__ lq2, const float* __restrict__ lk2) {
    using da2::f32x16; using da2::f32x4;
    LAS char* lds = (LAS char*)(F.lds + RING_OFF);
    LAS float* tbl = (LAS float*)(lds + da2::OFF_LUT);
    const int tid = F.tid, lane = F.lane, wid = F.wave, r32 = lane & 31, hi = lane >> 5;
    float s1 = 0.f, s2 = 0.f;
    for (int i = 0; i < 64; ++i) { s1 += lq1[i] * lk1[i]; s2 += lq2[i] * lk2[i]; }
    const float lam = expf(s1) - expf(s2) + LAMBDA_INIT0;
    const __amdgpu_buffer_rsrc_t strs = __builtin_amdgcn_make_buffer_rsrc(stash + ((size_t)blockIdx.x * NWAVES + wid) * 4096, 0, 16384, 0x00020000);
    const int stvo = lane * 16;
    LAS char* stg = lds + wid * da2::STG_WAVE;
    for (int L = F.vcu; L < BATCH * NH_A * 4; L += F.G) {
        const int bh = L >> 2, x = L & 3, b = bh >> 3, h = bh & 7;
        __syncthreads();
        const float c31 = rel_bias[31 * NH_A + h] * LOG2E;
        for (int i = tid; i < 4 * da2::TBL_N; i += NWAVES * 64) { const int c = i >> 9, y = i & 511, d = da2::TBL_X0 - (y + c);
            tbl[i] = d < 0 ? -__builtin_inff() : (d > 127 ? 0.f : rel_bias[t5_bucket(d) * NH_A + h] * LOG2E - c31); }
        __syncthreads();
        for (int s = 0; s < 4; ++s) {
            const int qb = (s >> 1) ? 7 - x : x, m = s & 1, P0 = qb * 256;
            const bf16* Qp = QKV + ((size_t)b * SEQ + P0) * NQKV + h * 128 + m * 64;
            const bf16* Kp = QKV + (size_t)b * SEQ * NQKV + D + h * 128 + m * 64;
            const bf16* Vp = QKV + (size_t)b * SEQ * NQKV + 2 * D + h * 128;
            f32x16 o[4];
            da2::attn_block(Qp, Kp, Vp, P0, lds, c31, o);
            if (m == 0) {
#pragma unroll
                for (int i = 0; i < 16; ++i) { const f32x4 v = {o[i >> 2][(i & 3) * 4 + 0], o[i >> 2][(i & 3) * 4 + 1], o[i >> 2][(i & 3) * 4 + 2], o[i >> 2][(i & 3) * 4 + 3]};
                    __builtin_amdgcn_raw_buffer_store_b128(__builtin_bit_cast(v4u, v), strs, stvo, i * 1024, 0); }
            } else {
#pragma unroll
                for (int i = 0; i < 16; ++i) { const f32x4 sti = __builtin_bit_cast(f32x4, __builtin_amdgcn_raw_buffer_load_b128(strs, stvo, i * 1024, 0));
#pragma unroll
                    for (int e = 0; e < 4; ++e) { const int dq = i >> 2, r = (i & 3) * 4 + e; const float v = sti[e] - lam * o[dq][r];
                        *(LAS unsigned short*)(stg + da2::crow(r, hi) * da2::STG_PITCH + (dq * 32 + r32) * 2) = (unsigned short)f2bf(v); } }
                asm volatile("s_waitcnt lgkmcnt(0)" ::: "memory");
                const int row = lane >> 1, half = lane & 1;
                v4u w[8]; float ss = 0.f;
#pragma unroll
                for (int i = 0; i < 8; ++i) { w[i] = *(const LAS v4u*)(stg + row * da2::STG_PITCH + half * 128 + i * 16);
#pragma unroll
                    for (int q = 0; q < 4; ++q) { const float a0 = __uint_as_float(w[i][q] << 16), a1 = __uint_as_float(w[i][q] & 0xffff0000u); ss += a0 * a0 + a1 * a1; } }
                ss += __shfl_xor(ss, 1);
                const float rstd = __builtin_amdgcn_rsqf(ss * (1.f / 128.f) + EPS);
                bf16* Ow = AO + ((size_t)b * SEQ + P0 + wid * 32 + row) * D + h * 128 + half * 64;
#pragma unroll
                for (int i = 0; i < 8; ++i) { v4u ov;
#pragma unroll
                    for (int q = 0; q < 4; ++q) ov[q] = pk2(__uint_as_float(w[i][q] << 16) * rstd, __uint_as_float(w[i][q] & 0xffff0000u) * rstd);
                    *(GAS v4u*)(Ow + i * 8) = ov; }
                asm volatile("s_waitcnt lgkmcnt(0)\n\ts_barrier" ::: "memory");
            }
        }
    }
    __syncthreads();
}
__device__ __forceinline__ void convscan_phase(Frame& F, const bf16* __restrict__ PROJ, const float* __restrict__ GATES, const float* __restrict__ conv_w, const float* __restrict__ conv_b, bf16* QKC, float* GS) {
    {   const int pc = F.tid & 127, col = pc * 8;
        float cw[4][8], cbias[8];
#pragma unroll
        for (int i = 0; i < 8; ++i) { cbias[i] = conv_b[col + i];
#pragma unroll
            for (int t = 0; t < 4; ++t) cw[t][i] = conv_w[t * 1024 + col + i]; }
        const float osc = col < 512 ? MQSCALE : 1.f;
        for (int seg = F.vcu * 4 + (F.tid >> 7); seg < M / 32; seg += F.G * 4) {
            const int tokb = seg * 32;
#pragma unroll 1
            for (int run = 0; run < 4; ++run) {
                const int t8 = tokb + run * 8; const bool first = (t8 & (SEQ - 1)) == 0;
                const bf16* p = PROJ + (size_t)t8 * NPROJ + col;
                v4u r[11];
#pragma unroll
                for (int i = 0; i < 3; ++i) r[i] = first ? (v4u){0u, 0u, 0u, 0u} : *(const GAS v4u*)(p + ((ptrdiff_t)i - 3) * NPROJ);
#pragma unroll
                for (int i = 3; i < 11; ++i) r[i] = *(const GAS v4u*)(p + (size_t)(i - 3) * NPROJ);
#pragma unroll
                for (int t = 0; t < 8; ++t) {
                    unsigned o[4];
#pragma unroll
                    for (int q = 0; q < 4; ++q) {
                        float s0 = cbias[2 * q], s1 = cbias[2 * q + 1];
#pragma unroll
                        for (int tap = 0; tap < 4; ++tap) { const unsigned w = r[t + tap][q]; s0 += cw[tap][2 * q] * __uint_as_float(w << 16); s1 += cw[tap][2 * q + 1] * __uint_as_float(w & 0xffff0000u); }
                        s0 = s0 / (1.f + __expf(-s0)) * osc; s1 = s1 / (1.f + __expf(-s1)) * osc; o[q] = pk2(s0, s1); }
                    *(GAS v4u*)(QKC + (size_t)(t8 + t) * D + col) = (v4u){o[0], o[1], o[2], o[3]};
                }
            }
        }
    }
    {   const int gw = F.vcu * NWAVES + F.wave, NGW = F.G * NWAVES, lane = F.lane;
        for (int task = gw; task < BATCH * NH_M * (SEQ / 64); task += NGW) {
            const int c = task % (SEQ / 64), h = (task / (SEQ / 64)) % NH_M, b = task / (SEQ / 64) / NH_M;
            const size_t tok = (size_t)b * SEQ + c * 64 + lane;
            const float ig = GATES[tok * 8 + h], lf = GATES[tok * 8 + 4 + h];
            float bsum = lf;
#pragma unroll
            for (int off = 1; off < 64; off <<= 1) { const float t = __shfl_up(bsum, off); if (lane >= off) bsum += t; }
            const float e = ig - bsum; float pm = e;
#pragma unroll
            for (int off = 1; off < 64; off <<= 1) { const float t = __shfl_up(pm, off); if (lane >= off) pm = fmaxf(pm, t); }
            *(GAS f32x4*)(GS + tok * 16 + h * 4) = (f32x4){bsum, e, pm, 0.f};
        }
    }
}
__device__ __forceinline__ void mlstm_phase(Frame& F, const bf16* __restrict__ PROJ, const bf16* __restrict__ QKC, const float* __restrict__ GS, bf16* HT, float* SSQ) {
    for (int u = F.vcu; u < BATCH * NH_M * 4; u += F.G) {
        __syncthreads();
        ml::mlstm_unit(u >> 4, (u >> 2) & 3, u & 3, PROJ, QKC, GS, HT, SSQ, (LAS char*)(F.lds + RING_OFF));
    }
    __syncthreads();
}
__device__ __forceinline__ void gatenorm_phase(Frame& F, const bf16* __restrict__ PROJ, const bf16* __restrict__ HT, const float* __restrict__ SSQ, bf16* AO) {
    const int gw = F.vcu * NWAVES + F.wave, NGW = F.G * NWAVES, lane = F.lane;
    for (int m = gw; m < M; m += NGW) {
        const int hd = lane >> 4;
        const f32x4 s0 = *(const GAS f32x4*)(SSQ + (size_t)m * 32 + hd * 8), s1 = *(const GAS f32x4*)(SSQ + (size_t)m * 32 + hd * 8 + 4);
        const float tot = ((s0.x + s0.y) + (s0.z + s0.w)) + ((s1.x + s1.y) + (s1.z + s1.w));
        const float rstd = 1.f / sqrtf(tot * (1.f / 256.f) + EPS);
        const v4u h0 = *(const GAS v4u*)(HT + (size_t)m * D + lane * 16), h1 = *(const GAS v4u*)(HT + (size_t)m * D + lane * 16 + 8);
        const v4u o0 = *(const GAS v4u*)(PROJ + (size_t)m * NPROJ + 2048 + lane * 16), o1 = *(const GAS v4u*)(PROJ + (size_t)m * NPROJ + 2048 + lane * 16 + 8);
        v4u r0, r1;
#pragma unroll
        for (int q = 0; q < 4; ++q) {
            { const float ha = __uint_as_float(h0[q] << 16) * rstd, hb = __uint_as_float(h0[q] & 0xffff0000u) * rstd, oa = __uint_as_float(o0[q] << 16), ob = __uint_as_float(o0[q] & 0xffff0000u);
              r0[q] = pk2(ha / (1.f + __expf(-oa)), hb / (1.f + __expf(-ob))); }
            { const float ha = __uint_as_float(h1[q] << 16) * rstd, hb = __uint_as_float(h1[q] & 0xffff0000u) * rstd, oa = __uint_as_float(o1[q] << 16), ob = __uint_as_float(o1[q] & 0xffff0000u);
              r1[q] = pk2(ha / (1.f + __expf(-oa)), hb / (1.f + __expf(-ob))); }
        }
        *(GAS v4u*)(AO + (size_t)m * D + lane * 16) = r0; *(GAS v4u*)(AO + (size_t)m * D + lane * 16 + 8) = r1;
    }
}

template <class Epi>
__device__ __forceinline__ void run_gemm(Frame& F, const bf16* A, const bf16* Bt, int N, int K, const Epi& E) {
    pg8::Gemm g{A, Bt, M, N, K}; pg8::StaticOrder S; S.init(M, N, F.G, (int)blockIdx.x);
    pg8::gemm_phase<Epi, pg8::StaticOrder, PG8_ALIGN, PG8_SP2>(F.lds + RING_OFF, g, S, E);
}
__global__ void __launch_bounds__(NWAVES * 64, 2) fwd(Args args) {
    extern __shared__ __attribute__((aligned(16))) unsigned char lds[];
    Frame F;
    F.lds = (LAS unsigned char*)lds;
    F.MISC = (volatile LAS unsigned*)(F.lds + MISC_OFF);
    F.tid = threadIdx.x; F.lane = F.tid & 63; F.wave = __builtin_amdgcn_readfirstlane(F.tid >> 6);
    F.G = gridDim.x; { const int bx = blockIdx.x; F.vcu = (F.G % 8 == 0) ? (bx % 8) * (F.G / 8) + bx / 8 : bx; }
    unsigned char* ws = args.ws;
    F.ctl = (gu32*)(ws + WS_CTL);
    for (int u = F.tid; u < (LDS_BYTES - LDSCTL_OFF) / 4; u += NWAVES * 64) ((LAS unsigned*)(F.lds + LDSCTL_OFF))[u] = 0u;
    __syncthreads();
    const int lo = args.ph_lo, hi = args.ph_hi;
    const bool use_bar = (hi - lo) > 1;
    XcdBarrier bar; bar.bar = (unsigned*)(F.ctl + CW_BAR) + args.li * XCD_BAR_WORDS; bar.x = 0; bar.st = nullptr;
    if (use_bar) bar = xcd_barrier_post((unsigned*)(F.ctl + CW_BAR) + args.li * XCD_BAR_WORDS, F.MISC + 8);
#define IN(k) (lo <= (k) && (k) < hi)
#define SEAM(k) do { if (hi > lo + 1) xcd_barrier(bar); } while (0)
#define REP(k) for (int rep_ = 0; rep_ < ((DUP_PHASE == (k)) ? 2 : 1); ++rep_)
#define DUPBAR(k) do { if (DUP_PHASE == (k) && rep_ == 0) xcd_barrier(bar); } while (0)
    bf16* const XN = (bf16*)(ws + WS_XN); bf16* const AO = (bf16*)(ws + WS_AO); bf16* const QKV = (bf16*)(ws + WS_U); bf16* const U = (bf16*)(ws + WS_U); float* const SSQH = (float*)(ws + WS_SSQH);
    float* const H = args.out;
    using pg8::EpiBf16; using pg8::EpiResNorm; (void)H;

    if (IN(0)) { REP(0) { p0_prologue(F, args); DUPBAR(0); } SEAM(0); }
    if (IN(1)) { EpiBf16<0> E{QKV, NQKV, D, QSCALE, SSQH, -1, nullptr, nullptr, nullptr}; if (DUP_PHASE == 1) { run_gemm(F, XN, (const bf16*)(ws + WS_WQKV), NQKV, D, E); xcd_barrier(bar); } run_gemm(F, XN, (const bf16*)(ws + WS_WQKV), NQKV, D, E); SEAM(1); }
    if (IN(2)) { REP(2) { attn_phase(F, QKV, AO, (float*)(ws + WS_STASH), args.in[1], args.in[4], args.in[5], args.in[6], args.in[7]); DUPBAR(2); } SEAM(2); }
    if (IN(3)) { EpiResNorm<true> E{args.in[0], nullptr, XN, SSQH, D, (LAS float*)(F.lds + EPIRED_OFF)}; if (DUP_PHASE == 3) { run_gemm(F, AO, (const bf16*)(ws + WS_WAO), D, D, E); xcd_barrier(bar); } run_gemm(F, AO, (const bf16*)(ws + WS_WAO), D, D, E); SEAM(4); }
    if (IN(5)) { EpiBf16<2> E{U, FF, 0, 1.f, SSQH, -1, nullptr, nullptr, nullptr}; if (DUP_PHASE == 5) { run_gemm(F, XN, (const bf16*)(ws + WS_W1), FF, D, E); xcd_barrier(bar); } run_gemm(F, XN, (const bf16*)(ws + WS_W1), FF, D, E); SEAM(5); }
    if (IN(6)) { EpiResNorm<false> E{nullptr, XN, XN, SSQH, D, (LAS float*)(F.lds + EPIRED_OFF)}; run_gemm(F, U, (const bf16*)(ws + WS_W2), D, FF, E); SEAM(7); }
    if (IN(8)) { EpiBf16<0> E{QKV, NPROJ, 0, 1.f, SSQH, NPROJ / 256, (float*)(ws + WS_GATES), args.in[12], args.in[13]}; if (DUP_PHASE == 8) { run_gemm(F, XN, (const bf16*)(ws + WS_WML), NPROJ + 256, D, E); xcd_barrier(bar); } run_gemm(F, XN, (const bf16*)(ws + WS_WML), NPROJ + 256, D, E); SEAM(8); }
    if (IN(9)) { REP(16) { convscan_phase(F, QKV, (const float*)(ws + WS_GATES), args.in[14], args.in[15], AO, (float*)(ws + WS_GS)); xcd_barrier(bar); }
        REP(9) { mlstm_phase(F, QKV, AO, (const float*)(ws + WS_GS), (bf16*)(ws + WS_HT), (float*)(ws + WS_SSQ)); DUPBAR(9); } SEAM(9); }
    if (IN(10)) { REP(10) { gatenorm_phase(F, QKV, (const bf16*)(ws + WS_HT), (const float*)(ws + WS_SSQ), AO); DUPBAR(10); } SEAM(10); }
    if (IN(11)) { EpiResNorm<false> E{nullptr, XN, XN, SSQH, D, (LAS float*)(F.lds + EPIRED_OFF)}; run_gemm(F, AO, (const bf16*)(ws + WS_WMO), D, D, E); SEAM(12); }
    if (IN(13)) { EpiBf16<2> E{U, FF, 0, 1.f, SSQH, -1, nullptr, nullptr, nullptr}; if (DUP_PHASE == 13) { run_gemm(F, XN, (const bf16*)(ws + WS_W1) + (size_t)D * FF, FF, D, E); xcd_barrier(bar); } run_gemm(F, XN, (const bf16*)(ws + WS_W1) + (size_t)D * FF, FF, D, E); SEAM(13); }
    if (IN(14)) { EpiResNorm<false> E{nullptr, XN, XN, SSQH, D, (LAS float*)(F.lds + EPIRED_OFF)}; run_gemm(F, U, (const bf16*)(ws + WS_W2) + (size_t)D * FF, D, FF, E); SEAM(14); }
    if (IN(15)) { final_norm_phase(F, XN, SSQH, args.in[21], args.out); }
#undef IN
#undef SEAM
}

extern "C" void kernel_launch(void* const* d_in, const int* in_sizes, int n_in, void* d_out, int out_size, void* d_ws, size_t ws_size, hipStream_t stream) {
    static int grid = 0;
    if (grid == 0) {
        if (n_in != 22 || in_sizes[0] != M * D || out_size != M * D || ws_size < WS_END) { fprintf(stderr, "kernel_launch: unexpected shapes (n_in %d, in0 %d, out %d, ws %zu); nothing launched\n", n_in, n_in > 0 ? in_sizes[0] : -1, out_size, ws_size); grid = -1; return; }
        int dev = 0, cus = 0, per_cu = 0;
        if (hipGetDevice(&dev) != hipSuccess || hipDeviceGetAttribute(&cus, hipDeviceAttributeMultiprocessorCount, dev) != hipSuccess) { grid = -1; return; }
        if (hipFuncSetAttribute((const void*)fwd, hipFuncAttributeMaxDynamicSharedMemorySize, LDS_BYTES) != hipSuccess) { fprintf(stderr, "kernel_launch: hipFuncSetAttribute failed\n"); grid = -1; return; }
        if (hipOccupancyMaxActiveBlocksPerMultiprocessor(&per_cu, (const void*)fwd, NWAVES * 64, LDS_BYTES) != hipSuccess || per_cu < 1) fprintf(stderr, "kernel_launch: occupancy query says %d\n", per_cu);
        (void)hipGetLastError();
        grid = cus;
    }
    if (grid < 0) return;
    (void)hipMemsetAsync((char*)d_ws + WS_CTL, 0, CTL_ZERO_BYTES, stream);
    Args a{};
    for (int i = 0; i < 22; ++i) a.in[i] = (const float*)d_in[i];
    a.out = (float*)d_out; a.ws = (unsigned char*)d_ws;
    int li = 0;
    auto run = [&](int lo, int hi) { a.ph_lo = lo; a.ph_hi = hi; a.li = li++; hipLaunchKernelGGL(fwd, dim3(grid), dim3(NWAVES * 64), LDS_BYTES, stream, a); };
    run(0, NPHASE);
}
```

```cpp
#include <hip/hip_runtime.h>
#include <cstdio>
#include <cstdint>
namespace pg8 {
#define PG8_LAS __attribute__((address_space(3)))
typedef unsigned short bf16_t;
typedef short bf16x8 __attribute__((ext_vector_type(8)));
typedef float f32x4 __attribute__((ext_vector_type(4)));
typedef unsigned u32x4 __attribute__((ext_vector_type(4)));
constexpr int BM = 256, BK = 64, HALF = 128, HTB = HALF * BK * 2  , STAGE_BYTES = 8 * HTB, NXCD = 8, WGM = 8;

__host__ __device__ __forceinline__ int lds_byte(int r, int c) { const int st = (r >> 4) * 2 + (c >> 5), rr = r & 15, cc = c & 31, ob = rr * 64 + cc * 2; return st * 1024 + (ob ^ (((ob >> 9) & 1) << 5)); }
__host__ __device__ __forceinline__ void stage_rc(int b, int& R, int& C) { const int st = b / 1024, sb = b % 1024, swz = sb ^ (((sb >> 9) & 1) << 5); R = (st >> 1) * 16 + swz / 64; C = (st & 1) * 32 + (swz % 64) / 2; }
__host__ __device__ __forceinline__ int perm32(int rho) { const int n = rho >> 4, i = rho & 15; return 8 * (i >> 2) + 4 * n + (i & 3); }

struct Unit { int pm, pn; };
struct Gemm { const bf16_t* A; const bf16_t* Bt; int M, N, K; };

struct StaticOrder {
    int nM, nN, nwg, G, c;
    __host__ __device__ void init(int M, int N, int G_, int c_) { nM = M / BM; nN = N / BM; nwg = nM * nN; G = G_; c = c_; }
    __host__ __device__ bool next(int i, Unit& u) const {
        const long L = (long)i * G + c; if (L >= nwg) return false;
        int wgid = (int)L; { const int q = nwg / NXCD, r = nwg % NXCD, xcd = wgid % NXCD, off = wgid / NXCD; wgid = (xcd < r ? xcd * (q + 1) : r * (q + 1) + (xcd - r) * q) + off; }
        const int nig = WGM * nN, gid = wgid / nig, fm = gid * WGM, gsz = (nM - fm) < WGM ? (nM - fm) : WGM;
        u.pm = fm + ((wgid % nig) % gsz); u.pn = (wgid % nig) / gsz; return true;
    }
    __device__ __forceinline__ void a_ready(const Unit&) const {}
    __device__ __forceinline__ void done(const Unit&) const {}
};

__device__ __forceinline__ unsigned cvt_pk_bf16(float lo, float hi) { unsigned r; asm volatile("v_cvt_pk_bf16_f32 %0, %1, %2" : "=v"(r) : "v"(lo), "v"(hi)); return r; }
__device__ __forceinline__ float row_rstd(const float* ssq, int row) {
    const f32x4 a = *(const f32x4*)(ssq + (size_t)row * 4);
    return __builtin_amdgcn_rsqf(((a[0] + a[1]) + (a[2] + a[3])) * (1.0f / 1024.0f) + 1e-6f);
}
__device__ __forceinline__ float log_sigmoid_f(float x) { return fminf(x, 0.f) - log1pf(expf(-fabsf(x))); }
template <int ACT> struct EpiBf16 {
    static constexpr bool PERM = true, AFTER_DRAIN = false;
    bf16_t* O; int ldc; int scale_cols; float scale0; const PG8_LAS float* rstd_tbl  ; int gate_tile; float* gates; const float* b_i; const float* b_f;
    __device__ __forceinline__ void operator()(const f32x4 (&acc)[2][2][4][2], const Unit& u, int wr, int wc, int fr, int fq, int ui) const {
        const int row0 = u.pm * BM + wr * 64 + fr; const int colt = u.pn * BM;
        const float sc = (colt < scale_cols) ? scale0 : 1.f;
        const int col0 = colt + wc * 32 + 8 * fq;
        float rs[2][4];
#pragma unroll
        for (int ai = 0; ai < 2; ++ai)
#pragma unroll
            for (int m = 0; m < 4; ++m) rs[ai][m] = rstd_tbl ? rstd_tbl[ui * BM + ai * HALF + wr * 64 + m * 16 + fr] * sc : sc;
        if (u.pn == gate_tile) {
            if (wc == 0 && fq == 0) { const f32x4 bi = *(const f32x4*)b_i, bf = *(const f32x4*)b_f;
#pragma unroll
                for (int ai = 0; ai < 2; ++ai)
#pragma unroll
                    for (int m = 0; m < 4; ++m) { const int row = row0 + ai * HALF + m * 16; const f32x4 gi = acc[ai][0][m][0] * rs[ai][m] + bi; f32x4 gf = acc[ai][0][m][1] * rs[ai][m] + bf;
#pragma unroll
                        for (int e = 0; e < 4; ++e) gf[e] = log_sigmoid_f(gf[e]);
                        *(f32x4*)(gates + (size_t)row * 8) = gi; *(f32x4*)(gates + (size_t)row * 8 + 4) = gf; } }
            return;
        }
#pragma unroll
        for (int ai = 0; ai < 2; ++ai)
#pragma unroll
            for (int m = 0; m < 4; ++m) { bf16_t* rowp = O + (size_t)(row0 + ai * HALF + m * 16) * ldc + col0; const float r = rs[ai][m];
#pragma unroll
                for (int bj = 0; bj < 2; ++bj) { f32x4 v0 = acc[ai][bj][m][0] * r, v1 = acc[ai][bj][m][1] * r;
                    if (ACT == 2) {
#pragma unroll
                        for (int e = 0; e < 4; ++e) { const float a = fmaxf(v0[e], 0.f), b = fmaxf(v1[e], 0.f); v0[e] = a * a; v1[e] = b * b; } }
                    u32x4 w; w.x = cvt_pk_bf16(v0[0], v0[1]); w.y = cvt_pk_bf16(v0[2], v0[3]); w.z = cvt_pk_bf16(v1[0], v1[1]); w.w = cvt_pk_bf16(v1[2], v1[3]);
                    *(u32x4*)(rowp + bj * HALF) = w; } }
    }
};
template <class Sched>
__device__ __forceinline__ void fill_rstd_table(const Sched& S, const float* ssq, PG8_LAS float* tbl) {
    Unit u;
    for (int i = 0; i < 8 && S.next(i, u); ++i)
        for (int r = threadIdx.x; r < BM; r += 512) tbl[i * BM + r] = row_rstd(ssq, u.pm * BM + r);
    asm volatile("s_waitcnt lgkmcnt(0)" ::: "memory");
}
template <bool BASE_F32> struct EpiResNorm {
    static constexpr bool PERM = true, AFTER_DRAIN = false;
    const float* basef; const bf16_t* baseh; bf16_t* xn; float* ssq; int ldc; PG8_LAS float* red;
    __device__ __forceinline__ void operator()(const f32x4 (&acc)[2][2][4][2], const Unit& u, int wr, int wc, int fr, int fq, int) const {
        const int row0 = u.pm * BM + wr * 64 + fr; const int col0 = u.pn * BM + wc * 32 + 8 * fq;
#pragma unroll
        for (int ai = 0; ai < 2; ++ai)
#pragma unroll
            for (int m = 0; m < 4; ++m) { const int row = row0 + ai * HALF + m * 16; const size_t off = (size_t)row * ldc + col0; float s = 0.f;
#pragma unroll
                for (int bj = 0; bj < 2; ++bj) { f32x4 v0, v1;
                    if (BASE_F32) { v0 = *(const f32x4*)(basef + off + bj * HALF); v1 = *(const f32x4*)(basef + off + bj * HALF + 4); }
                    else { const u32x4 h = *(const u32x4*)(baseh + off + bj * HALF);
                        v0 = (f32x4){__uint_as_float(h.x << 16), __uint_as_float(h.x & 0xffff0000u), __uint_as_float(h.y << 16), __uint_as_float(h.y & 0xffff0000u)};
                        v1 = (f32x4){__uint_as_float(h.z << 16), __uint_as_float(h.z & 0xffff0000u), __uint_as_float(h.w << 16), __uint_as_float(h.w & 0xffff0000u)}; }
                    v0 = v0 + acc[ai][bj][m][0]; v1 = v1 + acc[ai][bj][m][1];
                    s += ((v0[0] * v0[0] + v0[1] * v0[1]) + (v0[2] * v0[2] + v0[3] * v0[3])) + ((v1[0] * v1[0] + v1[1] * v1[1]) + (v1[2] * v1[2] + v1[3] * v1[3]));
                    u32x4 w; w.x = cvt_pk_bf16(v0[0], v0[1]); w.y = cvt_pk_bf16(v0[2], v0[3]); w.z = cvt_pk_bf16(v1[0], v1[1]); w.w = cvt_pk_bf16(v1[2], v1[3]);
                    *(u32x4*)(xn + off + bj * HALF) = w; }
                s += __shfl_xor(s, 16); s += __shfl_xor(s, 32);
                if (fq == 0) red[(ai * HALF + wr * 64 + m * 16 + fr) * 4 + wc] = s; }
        asm volatile("s_waitcnt lgkmcnt(0)" ::: "memory"); __builtin_amdgcn_s_barrier(); asm volatile("" ::: "memory");
        const int t = threadIdx.x;
        if (t < BM) { const f32x4 p = *(const PG8_LAS f32x4*)(red + t * 4); ssq[(size_t)(u.pm * BM + t) * 4 + u.pn] = (p[0] + p[1]) + (p[2] + p[3]); }
    }
};

template <class Epi, class Sched, bool ALIGN_EPI = false, bool SP2 = false>
__device__ __forceinline__ void gemm_phase(PG8_LAS unsigned char* lds, const Gemm g, const Sched& S, const Epi& E) {
    const int tid = threadIdx.x, wid = __builtin_amdgcn_readfirstlane(tid >> 6), lane = tid & 63, wr = wid >> 2, wc = wid & 3, fr = lane & 15, fq = lane >> 4;
    const int K = g.K, nt = K / BK;
    unsigned voffA[2], voffB[2];
#pragma unroll
    for (int i = 0; i < 2; ++i) { int R, C; stage_rc(tid * 16 + i * 8192, R, C); const int Rb = Epi::PERM ? ((R & ~31) + perm32(R & 31)) : R;
        voffA[i] = (unsigned)(R * K + C) * 2u; voffB[i] = (unsigned)(Rb * K + C) * 2u; }
    const size_t kstep = (size_t)(BK * 2);
    const size_t hstep = (size_t)HALF * K * 2;
    const size_t tstep = 2 * hstep;
    const unsigned ldsw = (unsigned)wid * 1024u;
    const int aoff = lds_byte(wr * 64 + fr, fq * 8), boff = lds_byte(wc * 32 + fr, fq * 8);
#define PG8_SA(b, h) (((b) * 2 + (h)) * HTB)
#define PG8_SB(b, h) ((4 + (b) * 2 + (h)) * HTB)
#define PG8_STAGE(bufoff, gbase, voff) do { _Pragma("unroll") for (int _i = 0; _i < 2; ++_i) \
        __builtin_amdgcn_global_load_lds((const unsigned*)((const char*)(gbase) + (voff)[_i]), (PG8_LAS unsigned*)(lds + (bufoff) + ldsw + _i * 8192), 16, 0, 0); } while (0)
#define PG8_LDA(dst, b, h) do { _Pragma("unroll") for (int m = 0; m < 4; ++m) _Pragma("unroll") for (int k = 0; k < 2; ++k) dst[m][k] = *(const PG8_LAS bf16x8*)(lds + PG8_SA(b, h) + aoff + m * 2048 + k * 1024); } while (0)
#define PG8_LDB(dst, b, h) do { _Pragma("unroll") for (int n = 0; n < 2; ++n) _Pragma("unroll") for (int k = 0; k < 2; ++k) dst[n][k] = *(const PG8_LAS bf16x8*)(lds + PG8_SB(b, h) + boff + n * 2048 + k * 1024); } while (0)
#define PG8_MMA(ai, bj, At, Bt) do { __builtin_amdgcn_s_setprio(1); _Pragma("unroll") for (int m = 0; m < 4; ++m) _Pragma("unroll") for (int n = 0; n < 2; ++n) _Pragma("unroll") for (int k = 0; k < 2; ++k) \
        acc[ai][bj][m][n] = __builtin_amdgcn_mfma_f32_16x16x32_bf16(Bt[n][k], At[m][k], acc[ai][bj][m][n], 0, 0, 0); __builtin_amdgcn_s_setprio(0); } while (0)
#define PG8_WAIT_V(n) asm volatile("s_waitcnt vmcnt(" #n ")" ::: "memory")
#define PG8_WAIT_L(n) asm volatile("s_waitcnt lgkmcnt(" #n ")" ::: "memory")
#define PG8_BAR __builtin_amdgcn_s_barrier()
#define PG8_SCHED __builtin_amdgcn_sched_barrier(0)
    Unit cur, nxt; int ui = 0;
    if (!S.next(0, cur)) return;
    f32x4 acc[2][2][4][2];
#pragma unroll
    for (int a = 0; a < 2; ++a)
#pragma unroll
        for (int b = 0; b < 2; ++b)
#pragma unroll
            for (int m = 0; m < 4; ++m)
#pragma unroll
                for (int n = 0; n < 2; ++n) acc[a][b][m][n] = (f32x4){0.f, 0.f, 0.f, 0.f};
    bf16x8 At[4][2], B0[2][2], B1[2][2];
    const char* cA = (const char*)g.A + (size_t)cur.pm * tstep; const char* cB = (const char*)g.Bt + (size_t)cur.pn * tstep;
    S.a_ready(cur);
    if constexpr (SP2) {
        PG8_STAGE(PG8_SB(0, 0), cB, voffB); PG8_STAGE(PG8_SB(0, 1), cB + hstep, voffB); PG8_STAGE(PG8_SA(0, 0), cA, voffA); PG8_STAGE(PG8_SA(0, 1), cA + hstep, voffA);
        if (wr == 1) PG8_BAR;
        PG8_WAIT_V(2); PG8_BAR;
        PG8_STAGE(PG8_SB(1, 0), cB + kstep, voffB); PG8_STAGE(PG8_SA(1, 0), cA + kstep, voffA); PG8_STAGE(PG8_SB(1, 1), cB + hstep + kstep, voffB);
        PG8_WAIT_V(6); PG8_BAR;
    } else {
        PG8_STAGE(PG8_SB(0, 0), cB, voffB); PG8_STAGE(PG8_SA(0, 0), cA, voffA); PG8_STAGE(PG8_SB(0, 1), cB + hstep, voffB); PG8_STAGE(PG8_SA(0, 1), cA + hstep, voffA);
        if (wr == 1) PG8_BAR;
        PG8_WAIT_V(4); PG8_BAR;
        PG8_STAGE(PG8_SB(1, 0), cB + kstep, voffB); PG8_STAGE(PG8_SA(1, 0), cA + kstep, voffA); PG8_STAGE(PG8_SB(1, 1), cB + hstep + kstep, voffB);
        PG8_WAIT_V(6); PG8_BAR;
    }
    for (;;) {
        const bool has_next = S.next(ui + 1, nxt);
        const char* nA = has_next ? (const char*)g.A + (size_t)nxt.pm * tstep : cA; const char* nB = has_next ? (const char*)g.Bt + (size_t)nxt.pn * tstep : cB;
        for (int t = 0; t < nt; t += 2) {
            const bool last = (t == nt - 2);
            const char* a1 = cA + (size_t)(t + 1) * kstep;
            const char* a2 = last ? nA : cA + (size_t)(t + 2) * kstep; const char* b2 = last ? nB : cB + (size_t)(t + 2) * kstep;
            const char* a3 = a2 + kstep; const char* b3 = b2 + kstep;
            if (last && has_next) S.a_ready(nxt);
            if constexpr (SP2) {
            PG8_LDB(B0, 0, 0); PG8_LDB(B1, 0, 1); PG8_SCHED; PG8_LDA(At, 0, 0); PG8_STAGE(PG8_SA(1, 1), a1 + hstep, voffA);
            PG8_WAIT_V(8); PG8_WAIT_L(0); PG8_BAR; PG8_MMA(0, 0, At, B0); PG8_MMA(0, 1, At, B1); PG8_BAR; PG8_SCHED;
            PG8_LDA(At, 0, 1); PG8_STAGE(PG8_SB(0, 0), b2, voffB); PG8_STAGE(PG8_SB(0, 1), b2 + hstep, voffB); PG8_STAGE(PG8_SA(0, 0), a2, voffA);
            PG8_WAIT_V(8); PG8_WAIT_L(0); PG8_BAR; PG8_MMA(1, 0, At, B0); PG8_MMA(1, 1, At, B1); PG8_BAR; PG8_SCHED;
            PG8_LDB(B0, 1, 0); PG8_LDB(B1, 1, 1); PG8_SCHED; PG8_LDA(At, 1, 0); PG8_STAGE(PG8_SA(0, 1), a2 + hstep, voffA);
            PG8_WAIT_V(8); PG8_WAIT_L(0); PG8_BAR; PG8_MMA(0, 0, At, B0); PG8_MMA(0, 1, At, B1); PG8_BAR; PG8_SCHED;
            PG8_LDA(At, 1, 1); PG8_STAGE(PG8_SB(1, 0), b3, voffB); PG8_STAGE(PG8_SB(1, 1), b3 + hstep, voffB); PG8_STAGE(PG8_SA(1, 0), a3, voffA);
            PG8_WAIT_V(8); PG8_WAIT_L(0); PG8_BAR; PG8_MMA(1, 0, At, B0); PG8_MMA(1, 1, At, B1); PG8_BAR; PG8_SCHED;
            } else {
            PG8_LDB(B0, 0, 0); PG8_SCHED; PG8_LDA(At, 0, 0); PG8_STAGE(PG8_SA(1, 1), a1 + hstep, voffA);
            PG8_WAIT_L(8); PG8_BAR; PG8_WAIT_L(0); PG8_MMA(0, 0, At, B0); PG8_BAR; PG8_SCHED;
            PG8_LDB(B1, 0, 1); PG8_STAGE(PG8_SB(0, 0), b2, voffB);
            PG8_BAR; PG8_WAIT_L(0); PG8_MMA(0, 1, At, B1); PG8_BAR;
            PG8_LDA(At, 0, 1); PG8_STAGE(PG8_SA(0, 0), a2, voffA);
            PG8_BAR; PG8_WAIT_L(0); PG8_MMA(1, 0, At, B0); PG8_BAR; PG8_SCHED;
            PG8_STAGE(PG8_SB(0, 1), b2 + hstep, voffB);
            PG8_WAIT_V(6); PG8_BAR; PG8_MMA(1, 1, At, B1); PG8_BAR;
            PG8_LDB(B0, 1, 0); PG8_SCHED; PG8_LDA(At, 1, 0); PG8_STAGE(PG8_SA(0, 1), a2 + hstep, voffA);
            PG8_WAIT_L(8); PG8_BAR; PG8_WAIT_L(0); PG8_MMA(0, 0, At, B0); PG8_BAR; PG8_SCHED;
            PG8_LDB(B1, 1, 1); PG8_STAGE(PG8_SB(1, 0), b3, voffB);
            PG8_BAR; PG8_WAIT_L(0); PG8_MMA(0, 1, At, B1); PG8_BAR;
            PG8_LDA(At, 1, 1); PG8_STAGE(PG8_SA(1, 0), a3, voffA);
            PG8_BAR; PG8_WAIT_L(0); PG8_MMA(1, 0, At, B0); PG8_BAR; PG8_SCHED;
            PG8_STAGE(PG8_SB(1, 1), b3 + hstep, voffB);
            PG8_WAIT_V(6); PG8_BAR; PG8_MMA(1, 1, At, B1); PG8_BAR;
            }
        }
        if constexpr (ALIGN_EPI) { if (wr == 0) PG8_BAR; }
        if constexpr (!Epi::AFTER_DRAIN) { E(acc, cur, wr, wc, fr, fq, ui); S.done(cur); }
        if (!has_next) break;
#pragma unroll
        for (int a = 0; a < 2; ++a)
#pragma unroll
            for (int b = 0; b < 2; ++b)
#pragma unroll
                for (int m = 0; m < 4; ++m)
#pragma unroll
                    for (int n = 0; n < 2; ++n) acc[a][b][m][n] = (f32x4){0.f, 0.f, 0.f, 0.f};
        cur = nxt; cA = nA; cB = nB; ++ui;
        if constexpr (ALIGN_EPI) { if (wr == 1) PG8_BAR; }
    }
    PG8_WAIT_V(0);
    if constexpr (!ALIGN_EPI) { if (wr == 0) PG8_BAR; }
    PG8_BAR;
    if constexpr (Epi::AFTER_DRAIN) { E.fused(acc, cur, wr, wc, fr, fq, lds, wid, lane); S.done(cur); }
#undef PG8_SA
#undef PG8_SB
#undef PG8_STAGE
#undef PG8_LDA
#undef PG8_LDB
#undef PG8_MMA
#undef PG8_WAIT_V
#undef PG8_WAIT_L
#undef PG8_BAR
#undef PG8_SCHED
}
}

#ifndef PG8_SP2
#define PG8_SP2 true
#endif
#ifndef PG8_ALIGN
#define PG8_ALIGN true
#endif
namespace da {
typedef short bf16x8 __attribute__((ext_vector_type(8)));
typedef short s16x4 __attribute__((ext_vector_type(4)));
typedef float f32x16 __attribute__((ext_vector_type(16)));
typedef float f32x4 __attribute__((ext_vector_type(4)));
typedef unsigned u32x4 __attribute__((ext_vector_type(4)));
#define DLAS __attribute__((address_space(3)))
constexpr int NW = 8, QBLK = 32, KVBLK = 64, QB = NW * QBLK, PITCH = 3072;
constexpr int SHM_V = KVBLK * 128 * 2, SHM_K = KVBLK * 64 * 2;
constexpr int OFF_V = 0, OFF_K = 2 * SHM_V, OFF_WS = OFF_K + 2 * SHM_K, OFF_LUT = OFF_WS + NW * 64 * 4, LDS_BYTES = OFF_LUT + 512;
constexpr float THR = 8.f;
#define DA_KSWZ(row, c) ((row) * 128 + ((((c) ^ (((row) >> 1) & 7))) << 4))
#define DA_SBAR() __builtin_amdgcn_sched_barrier(0)
__device__ __forceinline__ int v_st(int k, int c) { const int kk = (k & ~0xC) | ((k & 4) << 1) | ((k & 8) >> 1); return ((kk >> 3) * 4 + (c >> 5)) * 512 + ((kk & 7) * 32 + (c & 31)) * 2; }
__device__ __forceinline__ int v_rd_base(int lane) { return ((lane & 3) << 3) | (((lane >> 2) & 3) << 6) | (((lane >> 4) & 1) << 5) | (((lane >> 5) & 1) << 8); }
constexpr int v_rd_off(int d0, int ks, int half) { return d0 * 512 + ks * 4096 + half * 2048; }
__device__ __forceinline__ int crow(int r, int hi) { return (r & 3) + 8 * (r >> 2) + 4 * hi; }
__device__ __forceinline__ unsigned cvtpk(float lo, float hi) { unsigned r; asm volatile("v_cvt_pk_bf16_f32 %0, %1, %2" : "=v"(r) : "v"(lo), "v"(hi)); return r; }
__device__ __forceinline__ void mask_tile(f32x16& p0, f32x16& p1, int dq) {
    const float NEG = -__builtin_inff();
#pragma unroll
    for (int r = 0; r < 16; ++r) { const int c = (r & 3) + 8 * (r >> 2); if (dq - c < 0) p0[r] = NEG; if (dq - c - 32 < 0) p1[r] = NEG; }
}
__device__ __forceinline__ void bias_tile(f32x16& p0, f32x16& p1, int dq, const DLAS float* lut) {
#pragma unroll
    for (int g = 0; g < 4; ++g) {
#pragma unroll
        for (int rr = 0; rr < 4; ++rr) { const int r = g * 4 + rr; const int c = (r & 3) + 8 * (r >> 2);
            int i0 = dq - c; i0 = i0 < 0 ? 0 : (i0 > 127 ? 127 : i0); int i1 = dq - c - 32; i1 = i1 < 0 ? 0 : (i1 > 127 ? 127 : i1);
            p0[r] += lut[i0]; p1[r] += lut[i1]; }
        DA_SBAR();
    }
}
__device__ __forceinline__ void partialSM(f32x16& p0, f32x16& p1, float& m_reg, float& alpha, float cb) {
    float pmax = p0[0];
#pragma unroll
    for (int r = 1; r < 16; ++r) pmax = fmaxf(pmax, p0[r]);
#pragma unroll
    for (int r = 0; r < 16; ++r) pmax = fmaxf(pmax, p1[r]);
    { auto rr = __builtin_amdgcn_permlane32_swap(__float_as_uint(pmax), __float_as_uint(pmax), false, false);
      pmax = fmaxf(__uint_as_float(rr[0]), __uint_as_float(rr[1])); }
    pmax += cb;
    float mn;
    if (__builtin_expect(__all(pmax - m_reg <= THR), 1)) { mn = m_reg; alpha = 1.f; }
    else { mn = fmaxf(m_reg, pmax); alpha = __builtin_amdgcn_exp2f(m_reg - mn); m_reg = mn; }
    const float off = cb - mn;
#pragma unroll
    for (int r = 0; r < 16; ++r) p0[r] += off;
#pragma unroll
    for (int r = 0; r < 16; ++r) p1[r] += off;
#pragma unroll
    for (int r = 0; r < 16; ++r) p0[r] = __builtin_amdgcn_exp2f(p0[r]);
}
__device__ __forceinline__ void finishSM(f32x16& p0, f32x16& p1, float alpha, float& l_reg, bf16x8& pa0, bf16x8& pa1, bf16x8& pa2, bf16x8& pa3) {
#pragma unroll
    for (int r = 0; r < 16; ++r) p1[r] = __builtin_amdgcn_exp2f(p1[r]);
    float ps = 0;
#pragma unroll
    for (int r = 0; r < 16; ++r) ps += p0[r];
#pragma unroll
    for (int r = 0; r < 16; ++r) ps += p1[r];
    { auto rr = __builtin_amdgcn_permlane32_swap(__float_as_uint(ps), __float_as_uint(ps), false, false);
      ps = __uint_as_float(rr[0]) + __uint_as_float(rr[1]); }
    l_reg = l_reg * alpha + ps;
#define DA_PK4(P, B_, OUT) do { unsigned a0 = cvtpk(P[B_+0], P[B_+1]), a1 = cvtpk(P[B_+2], P[B_+3]);                          \
        unsigned b0 = cvtpk(P[B_+4], P[B_+5]), b1 = cvtpk(P[B_+6], P[B_+7]);                                             \
        auto r0 = __builtin_amdgcn_permlane32_swap(a0, b0, false, false); auto r1 = __builtin_amdgcn_permlane32_swap(a1, b1, false, false); \
        u32x4 w = {r0[0], r1[0], r0[1], r1[1]}; OUT = *reinterpret_cast<bf16x8*>(&w); } while (0)
    DA_PK4(p0, 0, pa0); DA_PK4(p0, 8, pa1); DA_PK4(p1, 0, pa2); DA_PK4(p1, 8, pa3);
#undef DA_PK4
}
template <int KB>
__device__ __forceinline__ void qkt(f32x16& p0, f32x16& p1, const DLAS char* K_lds, int r32, int hi, const bf16x8* qr) {
    p0 = f32x16{}; p1 = f32x16{};
#pragma unroll
    for (int d0 = 0; d0 < 4; ++d0) { const DLAS char* a = K_lds + KB * SHM_K + DA_KSWZ(r32, d0 * 2 + hi);
        const bf16x8 b0 = *reinterpret_cast<const DLAS bf16x8*>(a);
        const bf16x8 b1 = *reinterpret_cast<const DLAS bf16x8*>(a + 32 * 128);
        p0 = __builtin_amdgcn_mfma_f32_32x32x16_bf16(b0, qr[d0], p0, 0, 0, 0);
        p1 = __builtin_amdgcn_mfma_f32_32x32x16_bf16(b1, qr[d0], p1, 0, 0, 0); }
}
template <int VB>
__device__ __forceinline__ void pv_tile(f32x16* o, int vb0, bf16x8 pa0, bf16x8 pa1, bf16x8 pa2, bf16x8 pa3) {
#define DA_TRRD(dst, off) asm volatile("ds_read_b64_tr_b16 %0, %1 offset:%2" : "=&v"(dst) : "v"(vb0), "i"(off) : "memory")
#define DA_PV_D0(d0) do { s16x4 l0, l1, l2, l3, h0, h1, h2, h3; constexpr int b_ = VB * SHM_V + v_rd_off(d0, 0, 0); \
        DA_TRRD(l0, b_); DA_TRRD(h0, b_ + 2048); DA_TRRD(l1, b_ + 4096); DA_TRRD(h1, b_ + 6144); DA_TRRD(l2, b_ + 8192); DA_TRRD(h2, b_ + 10240); DA_TRRD(l3, b_ + 12288); DA_TRRD(h3, b_ + 14336); \
        asm volatile("s_waitcnt lgkmcnt(0)" ::: "memory"); DA_SBAR();   \
        o[d0] = __builtin_amdgcn_mfma_f32_32x32x16_bf16(pa0, (bf16x8){l0[0], l0[1], l0[2], l0[3], h0[0], h0[1], h0[2], h0[3]}, o[d0], 0, 0, 0);   \
        o[d0] = __builtin_amdgcn_mfma_f32_32x32x16_bf16(pa1, (bf16x8){l1[0], l1[1], l1[2], l1[3], h1[0], h1[1], h1[2], h1[3]}, o[d0], 0, 0, 0);   \
        o[d0] = __builtin_amdgcn_mfma_f32_32x32x16_bf16(pa2, (bf16x8){l2[0], l2[1], l2[2], l2[3], h2[0], h2[1], h2[2], h2[3]}, o[d0], 0, 0, 0);   \
        o[d0] = __builtin_amdgcn_mfma_f32_32x32x16_bf16(pa3, (bf16x8){l3[0], l3[1], l3[2], l3[3], h3[0], h3[1], h3[2], h3[3]}, o[d0], 0, 0, 0); } while (0)
    DA_PV_D0(0); DA_PV_D0(1); DA_PV_D0(2); DA_PV_D0(3);
#undef DA_PV_D0
#undef DA_TRRD
}
template <bool ORDER_B>
__device__ __forceinline__ void attn_block(const unsigned short* __restrict__ Qp, const unsigned short* __restrict__ Kp, const unsigned short* __restrict__ Vp, int P0, DLAS char* lds, float c31, f32x16 (&o)[4]) {
    const int tid = threadIdx.x, wid = __builtin_amdgcn_readfirstlane(tid >> 6), lane = tid & 63, r32 = lane & 31, hi = lane >> 5;
    const int NT = (P0 + QB) / KVBLK;
    const int qlo = P0 + wid * QBLK, qm = qlo + r32 - 4 * hi;
    DLAS char* V_lds = lds + OFF_V; DLAS char* K_lds = lds + OFF_K;
    DLAS float* wsf = (DLAS float*)(lds + OFF_WS) + wid * 64; DLAS float* li_l = wsf; DLAS float* al_l = wsf + 32;
    const DLAS float* lut = (const DLAS float*)(lds + OFF_LUT);
    float m_reg = -1e30f, l_reg = 0.f;
#pragma unroll
    for (int d = 0; d < 4; ++d) o[d] = f32x16{};
    const int sr = tid >> 4, sc = (tid & 15) * 8, vst0 = v_st(sr, sc), vst1 = v_st(32 + sr, sc);
    const int kr = tid >> 3, kc = tid & 7, kws = DA_KSWZ(kr, kc);
    const int vb0 = (int)(uintptr_t)V_lds + v_rd_base(lane);
    bf16x8 qr[4];
#pragma unroll
    for (int d0 = 0; d0 < 4; ++d0) qr[d0] = *reinterpret_cast<const bf16x8*>(Qp + (size_t)(wid * QBLK + r32) * PITCH + d0 * 16 + hi * 8);
    bf16x8 st_v0, st_v1, st_k0;
#define DA_VMW() asm volatile("s_waitcnt vmcnt(0)" ::: "memory")
#define DA_SLOAD(k0) do { st_v0 = *reinterpret_cast<const bf16x8*>(Vp + (size_t)((k0) + sr) * PITCH + sc); st_v1 = *reinterpret_cast<const bf16x8*>(Vp + (size_t)((k0) + 32 + sr) * PITCH + sc); \
                          st_k0 = *reinterpret_cast<const bf16x8*>(Kp + (size_t)((k0) + kr) * PITCH + kc * 8); } while (0)
#define DA_SWRITE(bf) do { *reinterpret_cast<DLAS bf16x8*>(V_lds + (bf) * SHM_V + vst0) = st_v0; *reinterpret_cast<DLAS bf16x8*>(V_lds + (bf) * SHM_V + vst1) = st_v1; \
                           *reinterpret_cast<DLAS bf16x8*>(K_lds + (bf) * SHM_K + kws) = st_k0; } while (0)
#define DA_RESC(a) do { if (__any((a) < 1.f)) { if (hi == 0) al_l[r32] = (a); asm volatile("s_waitcnt lgkmcnt(0)" ::: "memory");              \
                        _Pragma("unroll") for (int d_ = 0; d_ < 4; ++d_) _Pragma("unroll") for (int r = 0; r < 16; ++r) o[d_][r] *= al_l[crow(r, hi)]; } } while (0)
#define DA_BIASMASK(P0_, P1_, t, cbv) do { const int kb_ = (t) * KVBLK; if (kb_ + KVBLK - 1 + 128 > qlo) { bias_tile(P0_, P1_, qm - kb_, lut); cbv = 0.f; if (kb_ + KVBLK - 1 > qlo) mask_tile(P0_, P1_, qm - kb_); } else cbv = c31; } while (0)
    f32x16 pA0, pA1, pB0, pB1; float alA, alB, cbA, cbB; bf16x8 pa0, pa1, pa2, pa3;
    DA_SLOAD(0); DA_VMW(); DA_SWRITE(0); DA_SBAR();
    DA_SLOAD(KVBLK);
    __syncthreads();
    DA_SBAR(); qkt<0>(pA0, pA1, K_lds, r32, hi, qr);
    DA_BIASMASK(pA0, pA1, 0, cbA); partialSM(pA0, pA1, m_reg, alA, cbA);
    DA_VMW(); DA_SWRITE(1);
    __syncthreads();
#define DA_HALF_STEP(PX0, PX1, alX, cbX, PY0, PY1, alY, t, KB, VB, SB) do {                                                      \
        DA_SBAR(); DA_SLOAD(((t) + 1) * KVBLK); DA_SBAR();              \
        if constexpr (!ORDER_B) {                                                                                               \
            qkt<KB>(PX0, PX1, K_lds, r32, hi, qr);                                                                     \
            finishSM(PY0, PY1, alY, l_reg, pa0, pa1, pa2, pa3); DA_SBAR();                                                       \
            pv_tile<VB>(o, vb0, pa0, pa1, pa2, pa3); DA_BIASMASK(PX0, PX1, (t), cbX); partialSM(PX0, PX1, m_reg, alX, cbX);      \
        } else {                                                                                                                \
            finishSM(PY0, PY1, alY, l_reg, pa0, pa1, pa2, pa3); DA_SBAR();                                            \
            pv_tile<VB>(o, vb0, pa0, pa1, pa2, pa3); DA_SBAR();                                                                   \
            qkt<KB>(PX0, PX1, K_lds, r32, hi, qr); DA_BIASMASK(PX0, PX1, (t), cbX); partialSM(PX0, PX1, m_reg, alX, cbX);        \
        }                                                                                                                       \
        __syncthreads();                                                                                                      \
        DA_VMW(); DA_SWRITE(SB);                                                                          \
        DA_RESC(alX); __syncthreads(); } while (0)
    for (int t = 1; t + 1 < NT; t += 2) {
        DA_HALF_STEP(pB0, pB1, alB, cbB, pA0, pA1, alA, t, 1, 0, 0);
        DA_HALF_STEP(pA0, pA1, alA, cbA, pB0, pB1, alB, t + 1, 0, 1, 1);
    }
    DA_SBAR(); qkt<1>(pB0, pB1, K_lds, r32, hi, qr); DA_SBAR();
    finishSM(pA0, pA1, alA, l_reg, pa0, pa1, pa2, pa3); DA_SBAR();
    pv_tile<0>(o, vb0, pa0, pa1, pa2, pa3);
    DA_BIASMASK(pB0, pB1, NT - 1, cbB); partialSM(pB0, pB1, m_reg, alB, cbB); DA_RESC(alB);
    finishSM(pB0, pB1, alB, l_reg, pa0, pa1, pa2, pa3); DA_SBAR(); pv_tile<1>(o, vb0, pa0, pa1, pa2, pa3);
    if (hi == 0) li_l[r32] = l_reg; asm volatile("s_waitcnt lgkmcnt(0)" ::: "memory");
#pragma unroll
    for (int r = 0; r < 16; ++r) { const float rl = __builtin_amdgcn_rcpf(li_l[crow(r, hi)]);
#pragma unroll
        for (int d0 = 0; d0 < 4; ++d0) o[d0][r] *= rl; }
    __syncthreads();
#undef DA_VMW
#undef DA_SLOAD
#undef DA_SWRITE
#undef DA_RESC
#undef DA_BIASMASK
#undef DA_HALF_STEP
}
}
static_assert(da::LDS_BYTES <= 131072, "attention LDS inside the ring region");
namespace da2 {
typedef short bf16x8 __attribute__((ext_vector_type(8)));
typedef short s16x4 __attribute__((ext_vector_type(4)));
typedef float f32x16 __attribute__((ext_vector_type(16)));
typedef float f32x4 __attribute__((ext_vector_type(4)));
typedef unsigned u32x4 __attribute__((ext_vector_type(4)));
#define D2LAS __attribute__((address_space(3)))
constexpr int NW = 8, QBLK = 32, KVBLK = 64, QB = NW * QBLK, PITCH = 3072;
constexpr int KSLOT = 8192, VSLOT = 16384, NKS = 3, NVS = 4;
constexpr int OFF_K = 0, OFF_V = NKS * KSLOT, OFF_WS = OFF_V + NVS * VSLOT, OFF_LUT = OFF_WS + NW * 64 * 4, LDS_BYTES = OFF_LUT + 4 * 2048;
constexpr int STG_PITCH = 272, STG_WAVE = 32 * STG_PITCH;
constexpr float THR = 8.f;
#define D2_SBAR() __builtin_amdgcn_sched_barrier(0)
__device__ __forceinline__ int crow(int r, int hi) { return (r & 3) + 8 * (r >> 2) + 4 * hi; }
typedef float f32x2_t __attribute__((ext_vector_type(2))); typedef __bf16 bf16x2_t __attribute__((ext_vector_type(2)));
__device__ __forceinline__ unsigned cvtpk(float lo, float hi) { f32x2_t v = {lo, hi}; bf16x2_t b = __builtin_convertvector(v, bf16x2_t); return __builtin_bit_cast(unsigned, b); }
__device__ __forceinline__ void glds16(const void* gsrc, unsigned lds_dst) { unsigned keep;
    asm volatile("s_mov_b32 %0, m0\n\ts_mov_b32 m0, %2\n\ts_nop 0\n\tglobal_load_lds_dwordx4 %1, off\n\ts_mov_b32 m0, %0" : "=&s"(keep) : "v"(gsrc), "s"(lds_dst) : "memory"); }
#define D2_WAIT_BAR(N) asm volatile("s_waitcnt vmcnt(" #N ") lgkmcnt(0)\n\ts_barrier" ::: "memory")
constexpr int TBL_X0 = 224, TBL_N = 512, TBL_COPY_BYTES = TBL_N * 4;
__device__ __forceinline__ void bias_mask_tile(f32x16& p0, f32x16& p1, int dq, const D2LAS char* tbl_lane  ) {
    const D2LAS char* a = tbl_lane - 4 * dq;
#pragma unroll
    for (int g = 0; g < 4; ++g) { const f32x4 t0 = *reinterpret_cast<const D2LAS f32x4*>(a + 32 * g), t1 = *reinterpret_cast<const D2LAS f32x4*>(a + 32 * g + 128);
#pragma unroll
        for (int i = 0; i < 4; ++i) { p0[4 * g + i] += t0[i]; p1[4 * g + i] += t1[i]; } }
}
__device__ __forceinline__ float rowmax(const f32x16& p0, const f32x16& p1) {
    float a = fmaxf(fmaxf(p0[0], p0[1]), p1[0]), b = fmaxf(fmaxf(p0[2], p0[3]), p1[1]); a = fmaxf(fmaxf(a, p1[2]), p1[3]);
#pragma unroll
    for (int r = 4; r < 16; r += 4) { a = fmaxf(fmaxf(a, p0[r]), p0[r + 1]); b = fmaxf(fmaxf(b, p0[r + 2]), p0[r + 3]); a = fmaxf(fmaxf(a, p1[r]), p1[r + 1]); b = fmaxf(fmaxf(b, p1[r + 2]), p1[r + 3]); }
    float m = fmaxf(a, b);
    auto rr = __builtin_amdgcn_permlane32_swap(__float_as_uint(m), __float_as_uint(m), false, false);
    return fmaxf(__uint_as_float(rr[0]), __uint_as_float(rr[1]));
}
__device__ __forceinline__ void qkt(f32x16& p0, f32x16& p1, const D2LAS char* Kslot, int r32, int hi, const bf16x8* qr, const f32x16& cinit) {
    const int sw = (r32 >> 1) & 7;
#pragma unroll
    for (int d0 = 0; d0 < 4; ++d0) { const D2LAS char* a = Kslot + r32 * 128 + (((d0 * 2 + hi) ^ sw) << 4);
        const bf16x8 b0 = *reinterpret_cast<const D2LAS bf16x8*>(a), b1 = *reinterpret_cast<const D2LAS bf16x8*>(a + 32 * 128);
        if (d0 == 0) { p0 = __builtin_amdgcn_mfma_f32_32x32x16_bf16(b0, qr[0], cinit, 0, 0, 0); p1 = __builtin_amdgcn_mfma_f32_32x32x16_bf16(b1, qr[0], cinit, 0, 0, 0); }
        else { p0 = __builtin_amdgcn_mfma_f32_32x32x16_bf16(b0, qr[d0], p0, 0, 0, 0); p1 = __builtin_amdgcn_mfma_f32_32x32x16_bf16(b1, qr[d0], p1, 0, 0, 0); } }
}
__device__ __forceinline__ void pv_tile(f32x16* o, int vb, bf16x8 pa0, bf16x8 pa1, bf16x8 pa2, bf16x8 pa3) {
#define D2_TRRD(dst, off) asm volatile("ds_read_b64_tr_b16 %0, %1 offset:%2" : "=&v"(dst) : "v"(vb), "i"(off) : "memory")
#define D2_PV(dq) do { s16x4 l0, l1, l2, l3, h0, h1, h2, h3; constexpr int b_ = (dq) * 4096; \
        D2_TRRD(l0, b_); D2_TRRD(h0, b_ + 512); D2_TRRD(l1, b_ + 1024); D2_TRRD(h1, b_ + 1536); D2_TRRD(l2, b_ + 2048); D2_TRRD(h2, b_ + 2560); D2_TRRD(l3, b_ + 3072); D2_TRRD(h3, b_ + 3584); \
        asm volatile("s_waitcnt lgkmcnt(0)" ::: "memory"); D2_SBAR();   \
        o[dq] = __builtin_amdgcn_mfma_f32_32x32x16_bf16(pa0, (bf16x8){l0[0], l0[1], l0[2], l0[3], h0[0], h0[1], h0[2], h0[3]}, o[dq], 0, 0, 0);   \
        o[dq] = __builtin_amdgcn_mfma_f32_32x32x16_bf16(pa1, (bf16x8){l1[0], l1[1], l1[2], l1[3], h1[0], h1[1], h1[2], h1[3]}, o[dq], 0, 0, 0);   \
        o[dq] = __builtin_amdgcn_mfma_f32_32x32x16_bf16(pa2, (bf16x8){l2[0], l2[1], l2[2], l2[3], h2[0], h2[1], h2[2], h2[3]}, o[dq], 0, 0, 0);   \
        o[dq] = __builtin_amdgcn_mfma_f32_32x32x16_bf16(pa3, (bf16x8){l3[0], l3[1], l3[2], l3[3], h3[0], h3[1], h3[2], h3[3]}, o[dq], 0, 0, 0); } while (0)
    D2_PV(0); D2_PV(1); D2_PV(2); D2_PV(3);
#undef D2_PV
#undef D2_TRRD
}
__device__ __forceinline__ void attn_block(const unsigned short* __restrict__ Qp, const unsigned short* __restrict__ Kp, const unsigned short* __restrict__ Vp, int P0, D2LAS char* lds, float c31, f32x16 (&o)[4]) {
    const int tid = threadIdx.x, wid = __builtin_amdgcn_readfirstlane(tid >> 6), lane = tid & 63, r32 = lane & 31, hi = lane >> 5;
    const int NT = (P0 + QB) / KVBLK;
    const int qlo = P0 + wid * QBLK, qm = qlo + r32 - 4 * hi;
    const unsigned lds0 = (unsigned)(uintptr_t)lds;
    D2LAS float* wsf = (D2LAS float*)(lds + OFF_WS) + wid * 64;
    const D2LAS char* tbl_lane = lds + OFF_LUT + ((-r32) & 3) * TBL_COPY_BYTES + 4 * (TBL_X0 - ((-r32) & 3));
    const int krow = wid * 8 + (lane >> 3);
    const unsigned short* ksrc = Kp + (size_t)krow * PITCH + (((lane & 7) ^ ((krow >> 1) & 7)) * 8);
    const unsigned short* vsrc = Vp + (size_t)(16 * (wid & 3) + (lane >> 2)) * PITCH + (wid >> 2) * 32 + (lane & 3) * 8;
    const unsigned kdst = lds0 + OFF_K + wid * 1024, vdst = lds0 + OFF_V + wid * 1024;
    int ks_i = 0, vs_i = 0;
    int jt = 0;
#define D2_DMA() do { glds16(ksrc + (size_t)jt * (KVBLK * PITCH), (unsigned)__builtin_amdgcn_readfirstlane(kdst + ks_i * KSLOT)); \
        glds16(vsrc + (size_t)jt * (KVBLK * PITCH), (unsigned)__builtin_amdgcn_readfirstlane(vdst + vs_i * VSLOT)); \
        glds16(vsrc + (size_t)jt * (KVBLK * PITCH) + 64, (unsigned)__builtin_amdgcn_readfirstlane(vdst + vs_i * VSLOT + 8192)); \
        ++jt; ks_i = ks_i == NKS - 1 ? 0 : ks_i + 1; vs_i = vs_i == NVS - 1 ? 0 : vs_i + 1; } while (0)
    bf16x8 qr[4];
#pragma unroll
    for (int d0 = 0; d0 < 4; ++d0) qr[d0] = *reinterpret_cast<const bf16x8*>(Qp + (size_t)(wid * QBLK + r32) * PITCH + d0 * 16 + hi * 8);
    D2_DMA(); D2_DMA(); D2_DMA();
    const D2LAS char* Kl = lds + OFF_K;
    const int vb0 = (int)(lds0 + OFF_V) + ((lane >> 4) & 1) * 32 + (lane & 3) * 8 + (4 * hi + ((lane & 15) >> 2)) * 64;
    float M = 0.f, l_reg = 0.f;
#pragma unroll
    for (int d = 0; d < 4; ++d) o[d] = f32x16{};
    f32x16 negb;
#pragma unroll
    for (int r = 0; r < 16; ++r) negb[r] = c31;
    f32x16 pA0, pA1, pB0, pB1; bf16x8 pa0, pa1, pa2, pa3;
    int kc = 0, vp = 0;
#define D2_BIASMASK(P0_, P1_, t) do { const int kb_ = (t) * KVBLK; if (kb_ + KVBLK - 1 + 128 > qlo) bias_mask_tile(P0_, P1_, qm - kb_, tbl_lane); } while (0)
#define D2_DECIDE(PX0, PX1, first) do { const float rm = rowmax(PX0, PX1); resc = false; \
        if ((first) || __builtin_expect(__any(rm > THR), 0)) { const float dl = (first) ? rm : fmaxf(rm, 0.f); M += dl; \
            _Pragma("unroll") for (int r = 0; r < 16; ++r) { PX0[r] -= dl; PX1[r] -= dl; } \
            _Pragma("unroll") for (int r = 0; r < 16; ++r) negb[r] = c31 - M; \
            const float f = __builtin_amdgcn_exp2f(-dl); l_reg *= f; if (hi == 0) wsf[r32] = f; resc = !(first); } \
        _Pragma("unroll") for (int r = 0; r < 16; ++r) { PX0[r] = __builtin_amdgcn_exp2f(PX0[r]); PX1[r] = __builtin_amdgcn_exp2f(PX1[r]); } } while (0)
#define D2_RESC() do { if (resc) { asm volatile("s_waitcnt lgkmcnt(0)" ::: "memory"); \
        _Pragma("unroll") for (int d_ = 0; d_ < 4; ++d_) _Pragma("unroll") for (int r = 0; r < 16; ++r) o[d_][r] *= wsf[crow(r, hi)]; } } while (0)
#define D2_FINISH(PY0, PY1) do { float s_ = 0.f; _Pragma("unroll") for (int r = 0; r < 16; ++r) s_ += PY0[r] + PY1[r]; l_reg += s_; \
        { u32x4 w_ = {cvtpk(PY0[0], PY0[1]), cvtpk(PY0[2], PY0[3]), cvtpk(PY0[4], PY0[5]), cvtpk(PY0[6], PY0[7])}; pa0 = __builtin_bit_cast(bf16x8, w_); } \
        { u32x4 w_ = {cvtpk(PY0[8], PY0[9]), cvtpk(PY0[10], PY0[11]), cvtpk(PY0[12], PY0[13]), cvtpk(PY0[14], PY0[15])}; pa1 = __builtin_bit_cast(bf16x8, w_); } \
        { u32x4 w_ = {cvtpk(PY1[0], PY1[1]), cvtpk(PY1[2], PY1[3]), cvtpk(PY1[4], PY1[5]), cvtpk(PY1[6], PY1[7])}; pa2 = __builtin_bit_cast(bf16x8, w_); } \
        { u32x4 w_ = {cvtpk(PY1[8], PY1[9]), cvtpk(PY1[10], PY1[11]), cvtpk(PY1[12], PY1[13]), cvtpk(PY1[14], PY1[15])}; pa3 = __builtin_bit_cast(bf16x8, w_); } } while (0)
#define D2_ENDW(t) do { if ((t) + 2 < NT) { D2_WAIT_BAR(5); } else if ((t) + 1 < NT) { D2_WAIT_BAR(2); } else { D2_WAIT_BAR(0); } } while (0)
    bool resc = false;
    D2_WAIT_BAR(8);
    qkt(pA0, pA1, Kl, r32, hi, qr, negb); D2_BIASMASK(pA0, pA1, 0); D2_DECIDE(pA0, pA1, true);
    D2_WAIT_BAR(5);
    kc = 1; vp = 0;
#define D2_HALF_STEP(PX0, PX1, PY0, PY1, t) do { \
        if ((t) + 2 < NT) D2_DMA(); \
        qkt(PX0, PX1, Kl + kc * KSLOT, r32, hi, qr, negb); \
        D2_FINISH(PY0, PY1); D2_SBAR(); \
        pv_tile(o, vb0 + vp * VSLOT, pa0, pa1, pa2, pa3); \
        D2_BIASMASK(PX0, PX1, (t)); D2_DECIDE(PX0, PX1, false); D2_RESC(); \
        D2_ENDW(t); kc = kc == NKS - 1 ? 0 : kc + 1; vp = vp == NVS - 1 ? 0 : vp + 1; } while (0)
    for (int t = 1; t + 1 < NT; t += 2) {
        D2_HALF_STEP(pB0, pB1, pA0, pA1, t);
        D2_HALF_STEP(pA0, pA1, pB0, pB1, t + 1);
    }
    D2_HALF_STEP(pB0, pB1, pA0, pA1, NT - 1);
    D2_FINISH(pB0, pB1); D2_SBAR(); pv_tile(o, vb0 + vp * VSLOT, pa0, pa1, pa2, pa3);
    { auto rr = __builtin_amdgcn_permlane32_swap(__float_as_uint(l_reg), __float_as_uint(l_reg), false, false); l_reg = __uint_as_float(rr[0]) + __uint_as_float(rr[1]); }
    if (hi == 0) wsf[32 + r32] = l_reg; asm volatile("s_waitcnt lgkmcnt(0)" ::: "memory");
#pragma unroll
    for (int r = 0; r < 16; ++r) { const float rl = __builtin_amdgcn_rcpf(wsf[32 + crow(r, hi)]);
#pragma unroll
        for (int d0 = 0; d0 < 4; ++d0) o[d0][r] *= rl; }
    asm volatile("s_waitcnt lgkmcnt(0)\n\ts_barrier" ::: "memory");
#undef D2_DMA
#undef D2_BIASMASK
#undef D2_DECIDE
#undef D2_RESC
#undef D2_FINISH
#undef D2_ENDW
#undef D2_HALF_STEP
}
}
static_assert(da2::LDS_BYTES <= 131072, "attention v2 LDS inside the ring region");
constexpr int NWAVES = 8;
#ifndef MK_N_LAUNCHES
#define MK_N_LAUNCHES 1
#endif
constexpr int BATCH = 16, SEQ = 2048, D = 1024, FF = 4096, M = BATCH * SEQ;
constexpr int NQKV = 3072;
constexpr int MLW = 3080, NPROJ = 3072;
constexpr int NH_A = 8, NH_M = 4;
constexpr float EPS = 1e-6f, LOG2E = 1.4426950408889634f;
constexpr float QSCALE = 0.125f * LOG2E;
constexpr float LAMBDA_INIT0 = 0.2f;
constexpr float MQSCALE = 0.08838834764831845f;
constexpr int NPHASE = 16;
constexpr int DUP_PHASE = -1;

namespace ml {
typedef short bf16x8 __attribute__((ext_vector_type(8)));
typedef short s16x4 __attribute__((ext_vector_type(4)));
typedef float f32x16 __attribute__((ext_vector_type(16)));
typedef float f32x4 __attribute__((ext_vector_type(4)));
typedef unsigned u32x4 __attribute__((ext_vector_type(4)));
typedef unsigned u32x2 __attribute__((ext_vector_type(2)));
#define MLAS __attribute__((address_space(3)))
constexpr int L = 64, NC = 2048 / L, PITCH = 3072;
constexpr int PQ = 272, PS = 144;
constexpr int O_Q = 0, O_K = O_Q + 64 * PQ, O_C = O_K + 64 * PQ, O_KW = O_C + 64 * PQ, O_V = O_KW + 16384, O_SC = O_V + 16384, O_ARR = O_SC + 64 * PS, O_NP = O_ARR + 9 * 256, O_N = O_NP + 4096, LDS_BYTES = O_N + 512;
enum { A_E = 0, A_BM = 64, A_INTER = 128, A_EMJ = 192, A_WP = 256, A_RS0 = 320, A_RS1 = 384, A_QN = 448, A_SCAL = 512 };
__device__ __forceinline__ float bf2f_lo(unsigned w) { return __uint_as_float(w << 16); }
__device__ __forceinline__ float bf2f_hi(unsigned w) { return __uint_as_float(w & 0xffff0000u); }
typedef float f32x2_t __attribute__((ext_vector_type(2))); typedef __bf16 bf16x2_t __attribute__((ext_vector_type(2)));
__device__ __forceinline__ unsigned cvtpk(float lo, float hi) { f32x2_t v = {lo, hi}; bf16x2_t b = __builtin_convertvector(v, bf16x2_t); return __builtin_bit_cast(unsigned, b); }
__device__ __forceinline__ int crow(int r, int hi) { return (r & 3) + 8 * (r >> 2) + 4 * hi; }
__device__ __forceinline__ int v_st(int k, int c) { const int kk = (k & ~0xC) | ((k & 4) << 1) | ((k & 8) >> 1); return ((kk >> 3) * 4 + (c >> 5)) * 512 + ((kk & 7) * 32 + (c & 31)) * 2; }
__device__ __forceinline__ int v_rd_base(int lane) { return ((lane & 3) << 3) | (((lane >> 2) & 3) << 6) | (((lane >> 4) & 1) << 5) | (((lane >> 5) & 1) << 8); }
#define ML_TRRD(dst, base, off) asm volatile("ds_read_b64_tr_b16 %0, %1 offset:%2" : "=&v"(dst) : "v"(base), "i"(off) : "memory")
#define ML_SBAR() __builtin_amdgcn_sched_barrier(0)
#define ML_FR(lo, hi_) (bf16x8){lo[0], lo[1], lo[2], lo[3], hi_[0], hi_[1], hi_[2], hi_[3]}
struct Pre { bf16x8 q[2], k[2], v; f32x4 g; };

__device__ __forceinline__ void mlstm_unit(int b, int h, int s4, const unsigned short* __restrict__ PROJ, const unsigned short* __restrict__ QKC, const float* __restrict__ GS,
                                           unsigned short* HT, float* SSQ, MLAS char* lds) {
    const int tid = threadIdx.x, wid = __builtin_amdgcn_readfirstlane(tid >> 6), lane = tid & 63, r32 = lane & 31, hi = lane >> 5;
    MLAS char* QIMG = lds + O_Q; MLAS char* KIMG = lds + O_K; MLAS char* CIMG = lds + O_C; MLAS char* KWTR = lds + O_KW; MLAS char* VTR = lds + O_V; MLAS char* SC = lds + O_SC;
    MLAS float* arr = (MLAS float*)(lds + O_ARR); MLAS float* npart = (MLAS float*)(lds + O_NP); MLAS float* nvec = (MLAS float*)(lds + O_N);
    const int srow = tid >> 4, cg = tid & 15;
    const int vrow = tid >> 3, vcol = (tid & 7) * 8;
    const size_t tok0 = (size_t)b * 2048;
    const unsigned short* xq = QKC + tok0 * 1024 + h * 128 + cg * 8;
    const unsigned short* xk = xq + 512;
    const unsigned short* xv = PROJ + tok0 * PITCH + 1024 + h * 256 + s4 * 64 + vcol;
    const float* gs = GS + tok0 * 16 + h * 4;
    const int dkb = wid >> 1, dvb = wid & 1;
    const int tb0 = (wid & 3) >> 1, jb = wid & 1;
    f32x16 cst = f32x16{};
    float m_prev = 0.f;
    for (int i = tid; i < (64 * PQ) / 16; i += 512) ((MLAS u32x4*)CIMG)[i] = (u32x4){0u, 0u, 0u, 0u};
    if (tid < 128) nvec[tid] = 0.f;
    Pre P;
#define ML_LOAD(t0_) do { P.q[0] = *reinterpret_cast<const bf16x8*>(xq + (size_t)((t0_) + srow) * 1024); P.q[1] = *reinterpret_cast<const bf16x8*>(xq + (size_t)((t0_) + srow + 32) * 1024); \
        P.k[0] = *reinterpret_cast<const bf16x8*>(xk + (size_t)((t0_) + srow) * 1024); P.k[1] = *reinterpret_cast<const bf16x8*>(xk + (size_t)((t0_) + srow + 32) * 1024); \
        P.v = *reinterpret_cast<const bf16x8*>(xv + (size_t)((t0_) + vrow) * PITCH); P.g = *reinterpret_cast<const f32x4*>(gs + (size_t)((t0_) + lane) * 16); } while (0)
    ML_LOAD(0);
    u32x2 dst_w[4] = {}; float dst_ss = 0.f;
    const int trb_kw = (int)(uintptr_t)KWTR + v_rd_base(lane), trb_v = (int)(uintptr_t)VTR + v_rd_base(lane);
    __syncthreads();
    for (int c = 0; c < NC; ++c) {
        const int t0 = c * L;
        const float bsum = P.g[0], e = P.g[1], pm = P.g[2];
        asm volatile("" :: "v"(P.g[3]));
        const float b_last = __int_as_float(__builtin_amdgcn_readlane(__float_as_int(bsum), 63)), m_loc = b_last + __int_as_float(__builtin_amdgcn_readlane(__float_as_int(pm), 63));
        const float m_new = fmaxf(b_last + m_prev, m_loc), decay = __expf(b_last + m_prev - m_new);
        const float wp = __expf(b_last + e - m_new);
        const float m_inter = bsum + m_prev, m_j = fmaxf(m_inter, bsum + pm);
        if (wid == 0) { arr[A_E + lane] = e; arr[A_BM + lane] = bsum - m_j; arr[A_INTER + lane] = __expf(m_inter - m_j); arr[A_EMJ + lane] = __expf(-m_j); arr[A_WP + lane] = wp; }
        m_prev = m_new;
#pragma unroll
        for (int i = 0; i < 2; ++i) { const int row = srow + 32 * i; const float wrow = __shfl(wp, row);
            *reinterpret_cast<MLAS bf16x8*>(QIMG + row * PQ + cg * 16) = P.q[i];
            *reinterpret_cast<MLAS bf16x8*>(KIMG + row * PQ + cg * 16) = P.k[i];
            const u32x4 kw = __builtin_bit_cast(u32x4, P.k[i]); u32x4 ow;
#pragma unroll
            for (int q = 0; q < 4; ++q) ow[q] = cvtpk(bf2f_lo(kw[q]) * wrow, bf2f_hi(kw[q]) * wrow);
            *reinterpret_cast<MLAS u32x4*>(KWTR + v_st(row, cg * 8)) = ow; }
        *reinterpret_cast<MLAS bf16x8*>(VTR + v_st(vrow, vcol)) = P.v;
        __syncthreads();
#define ML_STORE_OUT(tt) do { if (wid >= 4) { const int j_ = 32 * jb + r32; unsigned short* hp_ = HT + (tok0 + (tt) + j_) * 1024 + h * 256 + s4 * 64 + 32 * tb0 + 4 * hi; \
            _Pragma("unroll") for (int q4 = 0; q4 < 4; ++q4) *reinterpret_cast<u32x2*>(hp_ + 8 * q4) = dst_w[q4]; \
            if (hi == 0) SSQ[(tok0 + (tt) + j_) * 32 + h * 8 + s4 * 2 + tb0] = dst_ss; } } while (0)
        if (c > 0) ML_STORE_OUT(t0 - L);
        { const int tn = (c + 1 < NC) ? t0 + L : t0; ML_LOAD(tn); }
        f32x16 acc_qc = f32x16{};
        if (wid < 4) {
            f32x16 g = f32x16{};
            if (!(tb0 == 1 && jb == 0)) {
                const MLAS char* ka = KIMG + (32 * tb0 + r32) * PQ + hi * 16; const MLAS char* qa = QIMG + (32 * jb + r32) * PQ + hi * 16;
bf16x8 fa[8], fb[8];
#pragma unroll
                for (int kk = 0; kk < 8; ++kk) { fa[kk] = *reinterpret_cast<const MLAS bf16x8*>(ka + kk * 32); fb[kk] = *reinterpret_cast<const MLAS bf16x8*>(qa + kk * 32); }
                ML_SBAR();
#pragma unroll
                for (int kk = 0; kk < 8; ++kk) g = __builtin_amdgcn_mfma_f32_32x32x16_bf16(fa[kk], fb[kk], g, 0, 0, 0);
            }
            const int j = 32 * jb + r32; const float bm = arr[A_BM + j]; float rsum = 0.f;
#pragma unroll
            for (int q4 = 0; q4 < 4; ++q4) { const f32x4 ev = *reinterpret_cast<const MLAS f32x4*>(arr + A_E + 32 * tb0 + 8 * q4 + 4 * hi);
                float sc4[4];
#pragma unroll
                for (int i = 0; i < 4; ++i) { const int s = 32 * tb0 + 8 * q4 + 4 * hi + i; const float v = (s <= j) ? g[4 * q4 + i] * __expf(bm + ev[i]) : 0.f; sc4[i] = v; rsum += v; }
                const u32x2 w = {cvtpk(sc4[0], sc4[1]), cvtpk(sc4[2], sc4[3])};
                *reinterpret_cast<MLAS u32x2*>(SC + j * PS + (32 * tb0 + 8 * q4 + 4 * hi) * 2) = w; }
            rsum += __shfl_xor(rsum, 32);
            if (hi == 0) arr[(tb0 ? A_RS1 : A_RS0) + j] = rsum;
        } else {
            const MLAS char* ca = CIMG + (32 * tb0 + r32) * PQ + hi * 16; const MLAS char* qa = QIMG + (32 * jb + r32) * PQ + hi * 16;
bf16x8 fa[8], fb[8];
#pragma unroll
            for (int kk = 0; kk < 8; ++kk) { fa[kk] = *reinterpret_cast<const MLAS bf16x8*>(ca + kk * 32); fb[kk] = *reinterpret_cast<const MLAS bf16x8*>(qa + kk * 32); }
            ML_SBAR();
#pragma unroll
            for (int kk = 0; kk < 8; ++kk) acc_qc = __builtin_amdgcn_mfma_f32_32x32x16_bf16(fa[kk], fb[kk], acc_qc, 0, 0, 0);
        }
        {
            const int j = tid >> 3, part = tid & 7;
            const u32x4 q0 = *reinterpret_cast<const MLAS u32x4*>(QIMG + j * PQ + part * 32), q1 = *reinterpret_cast<const MLAS u32x4*>(QIMG + j * PQ + part * 32 + 16);
            float s = 0.f;
#pragma unroll
            for (int q = 0; q < 4; ++q) { const f32x4 n4 = *reinterpret_cast<const MLAS f32x4*>(nvec + part * 16 + 4 * q);
                const unsigned w0 = q < 2 ? q0[2 * q] : q1[2 * q - 4], w1 = q < 2 ? q0[2 * q + 1] : q1[2 * q - 3];
                s += bf2f_lo(w0) * n4[0] + bf2f_hi(w0) * n4[1] + bf2f_lo(w1) * n4[2] + bf2f_hi(w1) * n4[3]; }
            s += __shfl_xor(s, 1); s += __shfl_xor(s, 2); s += __shfl_xor(s, 4);
            if (part == 0) arr[A_QN + j] = s;
            float n0 = 0.f, n1 = 0.f;
#pragma unroll
            for (int i = 0; i < 8; ++i) { const int srow = 8 * wid + i; const unsigned kw = *reinterpret_cast<const MLAS unsigned*>(KIMG + srow * PQ + lane * 4); const float w = arr[A_WP + srow];
                n0 += w * bf2f_lo(kw); n1 += w * bf2f_hi(kw); }
            npart[wid * 128 + 2 * lane] = n0; npart[wid * 128 + 2 * lane + 1] = n1;
        }
        __syncthreads();
        if (wid >= 4) {
            f32x16 acc_n = f32x16{};
            const MLAS char* sa = SC + (32 * jb + r32) * PS + hi * 16;
            {   s16x4 l0, l1, l2, l3, h0, h1, h2, h3;
                if (tb0 == 0) { ML_TRRD(l0, trb_v, 0); ML_TRRD(h0, trb_v, 2048); ML_TRRD(l1, trb_v, 4096); ML_TRRD(h1, trb_v, 6144); ML_TRRD(l2, trb_v, 8192); ML_TRRD(h2, trb_v, 10240); ML_TRRD(l3, trb_v, 12288); ML_TRRD(h3, trb_v, 14336); }
                else { ML_TRRD(l0, trb_v, 512); ML_TRRD(h0, trb_v, 512 + 2048); ML_TRRD(l1, trb_v, 512 + 4096); ML_TRRD(h1, trb_v, 512 + 6144); ML_TRRD(l2, trb_v, 512 + 8192); ML_TRRD(h2, trb_v, 512 + 10240); ML_TRRD(l3, trb_v, 512 + 12288); ML_TRRD(h3, trb_v, 512 + 14336); }
                const bf16x8 s0 = *reinterpret_cast<const MLAS bf16x8*>(sa), s1 = *reinterpret_cast<const MLAS bf16x8*>(sa + 32), s2 = *reinterpret_cast<const MLAS bf16x8*>(sa + 64), s3 = *reinterpret_cast<const MLAS bf16x8*>(sa + 96);
                asm volatile("s_waitcnt lgkmcnt(0)" ::: "memory"); ML_SBAR();
                acc_n = __builtin_amdgcn_mfma_f32_32x32x16_bf16(ML_FR(l0, h0), s0, acc_n, 0, 0, 0);
                acc_n = __builtin_amdgcn_mfma_f32_32x32x16_bf16(ML_FR(l1, h1), s1, acc_n, 0, 0, 0);
                acc_n = __builtin_amdgcn_mfma_f32_32x32x16_bf16(ML_FR(l2, h2), s2, acc_n, 0, 0, 0);
                acc_n = __builtin_amdgcn_mfma_f32_32x32x16_bf16(ML_FR(l3, h3), s3, acc_n, 0, 0, 0); }
            const int j = 32 * jb + r32; const float inter = arr[A_INTER + j];
            const float den = arr[A_RS0 + j] + arr[A_RS1 + j] + inter * arr[A_QN + j];
            const float rden = 1.f / fmaxf(fabsf(den), arr[A_EMJ + j]);
            float ss = 0.f;
#pragma unroll
            for (int q4 = 0; q4 < 4; ++q4) { float hv[4];
#pragma unroll
                for (int i = 0; i < 4; ++i) { hv[i] = (acc_n[4 * q4 + i] + inter * acc_qc[4 * q4 + i]) * rden; ss += hv[i] * hv[i]; }
                dst_w[q4] = (u32x2){cvtpk(hv[0], hv[1]), cvtpk(hv[2], hv[3])}; }
            ss += __shfl_xor(ss, 32);
            dst_ss = ss;
        }
        {
            s16x4 al[4], ah[4], bl[4], bh[4];
#define ML_LD4(d0k, d0v) do { ML_TRRD(al[0], trb_kw, (d0k) * 512); ML_TRRD(ah[0], trb_kw, (d0k) * 512 + 2048); ML_TRRD(al[1], trb_kw, (d0k) * 512 + 4096); ML_TRRD(ah[1], trb_kw, (d0k) * 512 + 6144); \
            ML_TRRD(al[2], trb_kw, (d0k) * 512 + 8192); ML_TRRD(ah[2], trb_kw, (d0k) * 512 + 10240); ML_TRRD(al[3], trb_kw, (d0k) * 512 + 12288); ML_TRRD(ah[3], trb_kw, (d0k) * 512 + 14336); \
            ML_TRRD(bl[0], trb_v, (d0v) * 512); ML_TRRD(bh[0], trb_v, (d0v) * 512 + 2048); ML_TRRD(bl[1], trb_v, (d0v) * 512 + 4096); ML_TRRD(bh[1], trb_v, (d0v) * 512 + 6144); \
            ML_TRRD(bl[2], trb_v, (d0v) * 512 + 8192); ML_TRRD(bh[2], trb_v, (d0v) * 512 + 10240); ML_TRRD(bl[3], trb_v, (d0v) * 512 + 12288); ML_TRRD(bh[3], trb_v, (d0v) * 512 + 14336); } while (0)
            switch (wid) { case 0: ML_LD4(0, 0); break; case 1: ML_LD4(0, 1); break; case 2: ML_LD4(1, 0); break; case 3: ML_LD4(1, 1); break;
                           case 4: ML_LD4(2, 0); break; case 5: ML_LD4(2, 1); break; case 6: ML_LD4(3, 0); break; default: ML_LD4(3, 1); break; }
#undef ML_LD4
#pragma unroll
            for (int r = 0; r < 16; ++r) cst[r] *= decay;
            asm volatile("s_waitcnt lgkmcnt(0)" ::: "memory"); ML_SBAR();
#pragma unroll
            for (int ks = 0; ks < 4; ++ks) cst = __builtin_amdgcn_mfma_f32_32x32x16_bf16(ML_FR(al[ks], ah[ks]), ML_FR(bl[ks], bh[ks]), cst, 0, 0, 0);
            const int dv = 32 * dvb + r32;
#pragma unroll
            for (int q4 = 0; q4 < 4; ++q4) { const u32x2 w = {cvtpk(cst[4 * q4], cst[4 * q4 + 1]), cvtpk(cst[4 * q4 + 2], cst[4 * q4 + 3])};
                *reinterpret_cast<MLAS u32x2*>(CIMG + dv * PQ + (32 * dkb + 8 * q4 + 4 * hi) * 2) = w; }
        }
        if (tid < 128) { float s = nvec[tid] * decay;
#pragma unroll
            for (int w = 0; w < 8; ++w) s += npart[w * 128 + tid];
            nvec[tid] = s; }
        __syncthreads();
    }
    ML_STORE_OUT((NC - 1) * L);
#undef ML_STORE_OUT
#undef ML_LOAD
}
}
static_assert(ml::LDS_BYTES <= 131072, "mLSTM LDS inside the ring region");
constexpr size_t MiB = 1u << 20;
constexpr size_t WS_CTL = 0, CTL_ZERO_BYTES = 1 * MiB;
constexpr size_t WS_WQKV = 2 * MiB, WS_WAO = 8 * MiB, WS_WML = 10 * MiB  , WS_WMO = 17 * MiB, WS_W1 = 19 * MiB  , WS_W2 = 35 * MiB  ;
constexpr size_t WS_GATES = 51 * MiB;
constexpr size_t WS_SSQ = 52 * MiB;
constexpr size_t WS_GS = 56 * MiB;
constexpr size_t WS_SSQH = 58 * MiB;
constexpr size_t WS_XN = 64 * MiB;
constexpr size_t WS_U = 128 * MiB;
constexpr size_t WS_HT = 320 * MiB;
constexpr size_t WS_AO = 384 * MiB;
constexpr size_t WS_STASH = 448 * MiB;
constexpr size_t WS_END = 480 * MiB;
constexpr int CW_TMO = 0, CW_CODE = 1;
constexpr int CW_BAR = 4096;
constexpr int RING_OFF = 0, RING_BYTES = 131072;
constexpr int LDSCTL_OFF = RING_BYTES, MISC_OFF = LDSCTL_OFF + 320;
constexpr int EPIRED_OFF = LDSCTL_OFF + 1024;
constexpr int RSTD_OFF = EPIRED_OFF + 4096;
constexpr int LDS_BYTES = 147456;
static_assert(RSTD_OFF + 8192 <= LDS_BYTES, "LDS map");
static_assert(MISC_OFF + 128 <= LDS_BYTES, "LDS map");

#define GAS __attribute__((address_space(1)))
#define LAS __attribute__((address_space(3)))
typedef unsigned short bf16;
typedef unsigned v4u __attribute__((ext_vector_type(4)));
typedef float f32x4 __attribute__((ext_vector_type(4)));
typedef short bf16x8 __attribute__((ext_vector_type(8)));
typedef GAS unsigned gu32;
typedef GAS unsigned long long gu64;
#define RLX_AGENT __ATOMIC_RELAXED, __HIP_MEMORY_SCOPE_AGENT
#define LDS_WAIT() asm volatile("s_waitcnt lgkmcnt(0)" ::: "memory")
#define VM_WAIT() asm volatile("s_waitcnt vmcnt(0)" ::: "memory")
__device__ __forceinline__ unsigned long long rt() { return __builtin_amdgcn_s_memrealtime(); }
__device__ __forceinline__ unsigned f2bf(float f) { unsigned u = __builtin_bit_cast(unsigned, f); return (u + 0x7fffu + ((u >> 16) & 1u)) >> 16; }
__device__ __forceinline__ unsigned pk2(float lo, float hi) { return f2bf(lo) | (f2bf(hi) << 16); }

#define XB_TMO      128
#define XB_XCNT(j)  (256  + 64 * (j))
#define XB_XSUB(j)  (1280 + 64 * (j))
#define XB_XGEN(j)  (2304 + 64 * (j))
#define XB_TOP      3328
#define XB_TOPGEN   3392
#define XCD_BAR_WORDS 3456
#define XB_SPIN_CAP (1u << 23)

__device__ __forceinline__ unsigned xb_ld(unsigned* p)              { return __hip_atomic_load(p, __ATOMIC_RELAXED, __HIP_MEMORY_SCOPE_AGENT); }
__device__ __forceinline__ unsigned xb_add(unsigned* p, unsigned v) { return __hip_atomic_fetch_add(p, v, __ATOMIC_RELAXED, __HIP_MEMORY_SCOPE_AGENT); }
__device__ __forceinline__ unsigned xb_xcc_id() { return (unsigned)__builtin_amdgcn_s_getreg((3 << 11) | 20) & 0xFu; }
#define XB_SPIN(cond, bar) do { unsigned _sp = 0; while (cond) { __builtin_amdgcn_s_sleep(1); \
    if ((++_sp & 255u) == 0u) { if (xb_ld(&(bar)[XB_TMO])) break; if (_sp > XB_SPIN_CAP) { atomicAdd(&(bar)[XB_TMO], 1u); break; } } } } while (0)

struct XcdBarrier {
    unsigned* bar; unsigned x;
    volatile LAS unsigned* st;
};

__device__ __forceinline__ XcdBarrier xcd_barrier_post(unsigned* bar, volatile LAS unsigned* st) {
    XcdBarrier b; b.bar = bar; b.x = xb_xcc_id(); b.st = st;
    if (threadIdx.x == 0) (void)xb_add(&bar[XB_XCNT(b.x)], 1u);
    return b;
}
__device__ __forceinline__ void xcd_barrier_complete(unsigned* bar, unsigned x, unsigned& nloc, unsigned& nx) {
    const unsigned G = gridDim.x * gridDim.y * gridDim.z;
    unsigned sum, cnt, mine, sp = 0u;
    for (;;) {
        sum = 0u; cnt = 0u; mine = 0u;
#pragma unroll
        for (unsigned j = 0; j < 16; ++j) { const unsigned c = xb_ld(&bar[XB_XCNT(j)]); sum += c; cnt += (c > 0u) ? 1u : 0u; mine = (j == x) ? c : mine; }
        if (sum == G) break;
        __builtin_amdgcn_s_sleep(1);
        if ((++sp & 255u) == 0u) { if (xb_ld(&bar[XB_TMO])) break; if (sp > XB_SPIN_CAP) { atomicAdd(&bar[XB_TMO], 1u); break; } }
    }
    nloc = mine > 0u ? mine : 1u; nx = cnt > 0u ? cnt : 1u;
}

__device__ __forceinline__ void xcd_barrier(const XcdBarrier& b) {
    asm volatile("s_waitcnt vmcnt(0)" ::: "memory");
    __syncthreads();
    if (threadIdx.x == 0) {
        unsigned* bar = b.bar;
        __builtin_amdgcn_s_waitcnt(0);
        unsigned nloc = b.st[0], nx = b.st[1];
        if (nloc == 0u) { xcd_barrier_complete(bar, b.x, nloc, nx); b.st[0] = nloc; b.st[1] = nx; }
        const unsigned old = xb_add(&bar[XB_XSUB(b.x)], 1u);
        const unsigned gen = old / nloc;
        if (old + 1u == (gen + 1u) * nloc) {
            __builtin_amdgcn_fence(__ATOMIC_RELEASE, "agent");
            asm volatile("s_waitcnt vmcnt(0)" ::: "memory");
            const unsigned og = xb_add(&bar[XB_TOP], 1u);
            const unsigned tg = og / nx;
            if (og + 1u == (tg + 1u) * nx) xb_add(&bar[XB_TOPGEN], 1u);
            else XB_SPIN(xb_ld(&bar[XB_TOPGEN]) == tg, bar);
            __builtin_amdgcn_fence(__ATOMIC_ACQUIRE, "agent");
            xb_add(&bar[XB_XGEN(b.x)], 1u);
            asm volatile("s_waitcnt vmcnt(0)" ::: "memory");
        } else {
            XB_SPIN(xb_ld(&bar[XB_XGEN(b.x)]) == gen, bar);
            __builtin_amdgcn_fence(__ATOMIC_ACQUIRE, "agent");
            asm volatile("s_waitcnt vmcnt(0)" ::: "memory");
        }
    }
    __syncthreads();
}

struct Frame {
    LAS unsigned char* lds;
    volatile LAS unsigned* MISC;
    gu32* ctl;
    int tid, lane, wave;
    int vcu, G;
};
__device__ __forceinline__ float wave_sum(float v) {
#pragma unroll
    for (int o = 1; o < 64; o <<= 1) v += __shfl_xor(v, o);
    return v;
}
__device__ __forceinline__ void p0_transpose_item(const float* W, int K, int ldw, int nblk, bf16* WT, const float* gk, int gmask, float gs, LAS float* scr, int item, int lane) {
    const int kb = item / nblk, nb = item % nblk, k0 = 64 * kb, n0 = 64 * nb;
    f32x4 v[16];
#pragma unroll
    for (int i = 0; i < 16; ++i) v[i] = *(const GAS f32x4*)(W + (size_t)(k0 + 4 * i + (lane >> 4)) * ldw + n0 + (lane & 15) * 4);
#pragma unroll
    for (int i = 0; i < 16; ++i) { const int kk = 4 * i + (lane >> 4); const float g = gk ? gk[(k0 + kk) & gmask] * gs : gs; LAS float* d = scr + kk * 64; const int nn = (lane & 15) * 4 + kk;
        d[nn & 63] = v[i].x * g; d[(nn + 1) & 63] = v[i].y * g; d[(nn + 2) & 63] = v[i].z * g; d[(nn + 3) & 63] = v[i].w * g; }
    LDS_WAIT(); asm volatile("" ::: "memory");
    const int c = lane & 7;
#pragma unroll
    for (int j = 0; j < 8; ++j) { const int n = (lane >> 3) + 8 * j; const LAS float* s = scr + (8 * c) * 64; const int nn = n + 8 * c;
        v4u o; o.x = pk2(s[0 * 64 + (nn & 63)], s[1 * 64 + ((nn + 1) & 63)]); o.y = pk2(s[2 * 64 + ((nn + 2) & 63)], s[3 * 64 + ((nn + 3) & 63)]);
        o.z = pk2(s[4 * 64 + ((nn + 4) & 63)], s[5 * 64 + ((nn + 5) & 63)]); o.w = pk2(s[6 * 64 + ((nn + 6) & 63)], s[7 * 64 + ((nn + 7) & 63)]);
        *(GAS v4u*)(WT + (size_t)(n0 + n) * K + k0 + 8 * c) = o; }
    LDS_WAIT(); asm volatile("" ::: "memory");
}
__device__ __forceinline__ void rms_row_load(const float* xrow, int lane, f32x4 (&v)[4]) {
    const GAS f32x4* xr = (const GAS f32x4*)xrow + lane; float s2 = 0.f;
#pragma unroll
    for (int j = 0; j < 4; ++j) { v[j] = xr[64 * j]; s2 += (v[j].x * v[j].x + v[j].y * v[j].y) + (v[j].z * v[j].z + v[j].w * v[j].w); }
    const float rstd = 1.f / sqrtf(wave_sum(s2) * (1.f / D) + EPS);
#pragma unroll
    for (int j = 0; j < 4; ++j) v[j] = v[j] * rstd;
}
__device__ __forceinline__ void row_store_bf16(bf16* orow, int lane, const f32x4 (&v)[4]) {
    GAS unsigned long long* o8 = (GAS unsigned long long*)orow + lane;
#pragma unroll
    for (int j = 0; j < 4; ++j) o8[64 * j] = (unsigned long long)pk2(v[j].x, v[j].y) | ((unsigned long long)pk2(v[j].z, v[j].w) << 32);
}
__device__ __forceinline__ float log_sigmoid(float x) { return fminf(x, 0.f) - log1pf(expf(-fabsf(x))); }

struct Args { const float* in[22]; float* out; unsigned char* ws; int ph_lo, ph_hi, li, pad; };

__device__ __forceinline__ void p0_prologue(Frame& F, const Args& a) {
    unsigned char* ws = a.ws;
    LAS float* scr = (LAS float*)(F.lds + RING_OFF + F.wave * 16384);
    const int gw = F.vcu * NWAVES + F.wave, NGW = F.G * NWAVES;
    constexpr int I_QKV = (D / 64) * (NQKV / 64), I_O = (D / 64) * (D / 64), I_ML = (D / 64) * (NPROJ / 64), I_1 = (D / 64) * (FF / 64), I_2 = (FF / 64) * (D / 64);
    constexpr int NITEMS = I_QKV + I_O + I_ML + I_O + 2 * I_1 + 2 * I_2;
    for (int it = gw; it < NITEMS; it += NGW) {
        int r = it;
        if (r < I_QKV) { p0_transpose_item(a.in[3], D, NQKV, NQKV / 64, (bf16*)(ws + WS_WQKV), a.in[2], 0xffff, 1.f, scr, r, F.lane); continue; } r -= I_QKV;
        if (r < I_O) { p0_transpose_item(a.in[9], D, D, D / 64, (bf16*)(ws + WS_WAO), a.in[8], 127, 1.f - LAMBDA_INIT0, scr, r, F.lane); continue; } r -= I_O;
        if (r < I_ML) { p0_transpose_item(a.in[11], D, MLW, NPROJ / 64, (bf16*)(ws + WS_WML), a.in[10], 0xffff, 1.f, scr, r, F.lane); continue; } r -= I_ML;
        if (r < I_O) { p0_transpose_item(a.in[17], D, D, D / 64, (bf16*)(ws + WS_WMO), a.in[16], 0xffff, 1.f, scr, r, F.lane); continue; } r -= I_O;
        if (r < 2 * I_1) { const int l = r / I_1; p0_transpose_item(a.in[19] + (size_t)l * D * FF, D, FF, FF / 64, (bf16*)(ws + WS_W1) + (size_t)l * D * FF, a.in[18] + l * D, 0xffff, 1.f, scr, r % I_1, F.lane); continue; } r -= 2 * I_1;
        { const int l = r / I_2; p0_transpose_item(a.in[20] + (size_t)l * D * FF, FF, D, D / 64, (bf16*)(ws + WS_W2) + (size_t)l * D * FF, nullptr, 0, 1.f, scr, r % I_2, F.lane); }
    }
    { bf16* WT = (bf16*)(ws + WS_WML) + (size_t)NPROJ * D; const int gt = (F.vcu * NWAVES + F.wave) * 64 + F.lane, NGT = F.G * NWAVES * 64;
      for (int i = gt; i < 256 * D / 2; i += NGT) { const int j = (2 * i) / D, k = (2 * i) % D;
          const unsigned w = j < 8 ? pk2(a.in[10][k] * a.in[11][(size_t)k * MLW + NPROJ + j], a.in[10][k + 1] * a.in[11][(size_t)(k + 1) * MLW + NPROJ + j]) : 0u;
          ((GAS unsigned*)WT)[i] = w; } }
    bf16* XN = (bf16*)(ws + WS_XN); float* SSQH = (float*)(ws + WS_SSQH);
    for (int m = gw; m < M; m += NGW) { f32x4 v[4]; const GAS f32x4* xr = (const GAS f32x4*)(a.in[0] + (size_t)m * D) + F.lane; float s2 = 0.f;
#pragma unroll
        for (int j = 0; j < 4; ++j) { v[j] = xr[64 * j]; s2 += (v[j].x * v[j].x + v[j].y * v[j].y) + (v[j].z * v[j].z + v[j].w * v[j].w); }
        s2 = wave_sum(s2); row_store_bf16(XN + (size_t)m * D, F.lane, v);
        if (F.lane < 4) SSQH[(size_t)m * 4 + F.lane] = F.lane == 0 ? s2 : 0.f; }
}
__device__ __forceinline__ void final_norm_phase(Frame& F, const bf16* XN, const float* SSQH, const float* g, float* out) {
    const int gw = F.vcu * NWAVES + F.wave, NGW = F.G * NWAVES;
    for (int m = gw; m < M; m += NGW) {
        const float rstd = pg8::row_rstd(SSQH, m);
        const v4u h0 = *(const GAS v4u*)(XN + (size_t)m * D + F.lane * 16), h1 = *(const GAS v4u*)(XN + (size_t)m * D + F.lane * 16 + 8);
        GAS f32x4* o = (GAS f32x4*)(out + (size_t)m * D + F.lane * 16); const GAS f32x4* gg = (const GAS f32x4*)(g + F.lane * 16);
#pragma unroll
        for (int q = 0; q < 2; ++q) { const f32x4 a = gg[q];
            o[q] = (f32x4){__uint_as_float(h0[2 * q] << 16) * rstd * a.x, __uint_as_float(h0[2 * q] & 0xffff0000u) * rstd * a.y, __uint_as_float(h0[2 * q + 1] << 16) * rstd * a.z, __uint_as_float(h0[2 * q + 1] & 0xffff0000u) * rstd * a.w}; }
#pragma unroll
        for (int q = 0; q < 2; ++q) { const f32x4 a = gg[2 + q];
            o[2 + q] = (f32x4){__uint_as_float(h1[2 * q] << 16) * rstd * a.x, __uint_as_float(h1[2 * q] & 0xffff0000u) * rstd * a.y, __uint_as_float(h1[2 * q + 1] << 16) * rstd * a.z, __uint_as_float(h1[2 * q + 1] & 0xffff0000u) * rstd * a.w}; }
    }
}

__device__ __forceinline__ float bf2f(bf16 v) { return __uint_as_float((unsigned)v << 16); }
__device__ __forceinline__ int t5_bucket(int d) {
    if (d < 16) return d;
    const float v = logf((float)d / 16.f) / logf(8.f) * 16.f; int b = 16 + (int)v; return b > 31 ? 31 : b;
}
__device__ __forceinline__ void naive_attn_phase(Frame& F, const bf16* __restrict__ QKV, const float* __restrict__ rel_bias, const float* __restrict__ lq1, const float* __restrict__ lk1,
                                                  const float* __restrict__ lq2, const float* __restrict__ lk2, bf16* AO) {
    LAS float* lut = (LAS float*)(F.lds + RING_OFF);
    const int tid = F.tid, half = tid & 1;
    float s1 = 0.f, s2 = 0.f;
    for (int i = 0; i < 64; ++i) { s1 += lq1[i] * lk1[i]; s2 += lq2[i] * lk2[i]; }
    const float lam = expf(s1) - expf(s2) + LAMBDA_INIT0;
    for (int u = F.vcu; u < BATCH * NH_A * (SEQ / 256); u += F.G) {
        const int qb = u % (SEQ / 256), h = (u / (SEQ / 256)) % NH_A, b = u / (SEQ / 256) / NH_A, q0 = qb * 256, q = q0 + (tid >> 1);
        __syncthreads();
        if (tid < 128) lut[tid] = rel_bias[t5_bucket(tid) * NH_A + h] * LOG2E;
        __syncthreads();
        const size_t tok = (size_t)b * SEQ + q;
        float res[64];
        for (int m = 0; m < 2; ++m) {
            float qv[64];
            const bf16* qp = QKV + tok * NQKV + h * 128 + m * 64;
#pragma unroll
            for (int d = 0; d < 64; ++d) qv[d] = bf2f(qp[d]);
            float o[64];
#pragma unroll
            for (int d = 0; d < 64; ++d) o[d] = 0.f;
            float mrun = -1e30f, l = 0.f;
            const int kend = q0 + 256;
            for (int k = 0; k < kend; ++k) {
                const bf16* kr = QKV + ((size_t)b * SEQ + k) * NQKV + D + h * 128 + m * 64;
                const bf16* vr = QKV + ((size_t)b * SEQ + k) * NQKV + 2 * D + h * 128 + half * 64;
                float s = 0.f;
#pragma unroll
                for (int d = 0; d < 64; ++d) s += qv[d] * bf2f(kr[d]);
                const int dist = q - k;
                if (dist >= 0) {
                    s += lut[dist < 127 ? dist : 127];
                    if (s > mrun) { const float al = exp2f(mrun - s); l *= al;
#pragma unroll
                        for (int d = 0; d < 64; ++d) o[d] *= al;
                        mrun = s; }
                    const float p = exp2f(s - mrun); l += p;
#pragma unroll
                    for (int d = 0; d < 64; ++d) o[d] += p * bf2f(vr[d]);
                }
            }
            const float il = 1.f / l;
            if (m == 0) {
#pragma unroll
                for (int d = 0; d < 64; ++d) res[d] = o[d] * il;
            } else {
                float ss = 0.f;
#pragma unroll
                for (int d = 0; d < 64; ++d) { res[d] = res[d] - lam * (o[d] * il); ss += res[d] * res[d]; }
                ss += __shfl_xor(ss, 1);
                const float rstd = 1.f / sqrtf(ss * (1.f / 128.f) + EPS);
                bf16* op = AO + tok * D + h * 128 + half * 64;
#pragma unroll
                for (int d = 0; d < 64; d += 2) *(unsigned*)(op + d) = pk2(res[d] * rstd, res[d + 1] * rstd);
            }
        }
    }
    __syncthreads();
}
__device__ __forceinline__ void naive_mlstm_phase(Frame& F, const bf16* __restrict__ PROJ, const float* __restrict__ GATES, const float* __restrict__ conv_w, const float* __restrict__ conv_b, bf16* AO) {
    LAS float* q_s = (LAS float*)(F.lds + RING_OFF); LAS float* k_s = q_s + 128; LAS float* v_s = q_s + 256; LAS float* red = q_s + 512;
    const int tid = F.tid, dv = tid >> 1, half = tid & 1, lane = F.lane, wave = F.wave;
    for (int u = (int)blockIdx.x; u < BATCH * NH_M; u += F.G) {
        const int h = u & 3, b = u >> 2;
        float C[64], n[64];
#pragma unroll
        for (int j = 0; j < 64; ++j) { C[j] = 0.f; n[j] = 0.f; }
        float mst = 0.f;
        const int col = (tid < 128) ? (h * 128 + tid) : (512 + h * 128 + ((tid - 128) & 127));
        float cw0 = 0.f, cw1 = 0.f, cw2 = 0.f, cw3 = 0.f, cb = 0.f;
        if (tid < 256) { cw0 = conv_w[0 * D + col]; cw1 = conv_w[1 * D + col]; cw2 = conv_w[2 * D + col]; cw3 = conv_w[3 * D + col]; cb = conv_b[col]; }
        __syncthreads();
        for (int t = 0; t < SEQ; ++t) {
            const size_t tok = (size_t)b * SEQ + t;
            if (tid < 256) {
                float x3 = bf2f(PROJ[tok * NPROJ + col]);
                float x2 = t >= 1 ? bf2f(PROJ[(tok - 1) * NPROJ + col]) : 0.f;
                float x1 = t >= 2 ? bf2f(PROJ[(tok - 2) * NPROJ + col]) : 0.f;
                float x0 = t >= 3 ? bf2f(PROJ[(tok - 3) * NPROJ + col]) : 0.f;
                float y = cw0 * x0 + cw1 * x1 + cw2 * x2 + cw3 * x3 + cb;
                y = y / (1.f + expf(-y));
                if (tid < 128) q_s[tid] = y * MQSCALE; else k_s[tid - 128] = y;
            } else {
                v_s[tid - 256] = bf2f(PROJ[tok * NPROJ + 1024 + h * 256 + (tid - 256)]);
            }
            const float ig = GATES[tok * 8 + h], lf = GATES[tok * 8 + 4 + h];
            __syncthreads();
            const float mnew = fmaxf(lf + mst, ig), fd = expf(lf + mst - mnew), gi = expf(ig - mnew);
            mst = mnew;
            const float gv = gi * v_s[dv];
            float num = 0.f, den = 0.f;
#pragma unroll
            for (int j = 0; j < 64; ++j) { const float kk = k_s[half * 64 + j], qq = q_s[half * 64 + j];
                C[j] = fd * C[j] + gv * kk; n[j] = fd * n[j] + gi * kk; num += C[j] * qq; den += n[j] * qq; }
            num += __shfl_xor(num, 1); den += __shfl_xor(den, 1);
            const float hv = num / fmaxf(fabsf(den), expf(-mnew));
            float ss = half == 0 ? hv * hv : 0.f;
            ss = wave_sum(ss);
            if (lane == 0) red[wave] = ss;
            __syncthreads();
            float tot = 0.f;
#pragma unroll
            for (int w = 0; w < 8; ++w) tot += red[w];
            const float rstd = 1.f / sqrtf(tot * (1.f / 256.f) + EPS);
            if (half == 0) { const float op = bf2f(PROJ[tok * NPROJ + 2048 + h * 256 + dv]); const float sg = 1.f / (1.f + expf(-op));
                AO[tok * D + h * 256 + dv] = (bf16)f2bf(sg * hv * rstd); }
            __syncthreads();
        }
    }
}

__device__ __forceinline__ void attn_phase(Frame& F, const bf16* __restrict__ QKV, bf16* AO, float* stash, const float* __restrict__ rel_bias, const float* __restrict__ lq1, const float* __restrict__ lk1,
                                           const float* __restrict__ lq2, const float* __restrict__ lk2) {
    using da2::f32x16; using da2::f32x4;
    LAS char* lds = (LAS char*)(F.lds + RING_OFF);
    LAS float* tbl = (LAS float*)(lds + da2::OFF_LUT);
    const int tid = F.tid, lane = F.lane, wid = F.wave, r32 = lane & 31, hi = lane >> 5;
    float s1 = 0.f, s2 = 0.f;
    for (int i = 0; i < 64; ++i) { s1 += lq1[i] * lk1[i]; s2 += lq2[i] * lk2[i]; }
    const float lam = expf(s1) - expf(s2) + LAMBDA_INIT0;
    const __amdgpu_buffer_rsrc_t strs = __builtin_amdgcn_make_buffer_rsrc(stash + ((size_t)blockIdx.x * NWAVES + wid) * 4096, 0, 16384, 0x00020000);
    const int stvo = lane * 16;
    LAS char* stg = lds + wid * da2::STG_WAVE;
    for (int L = F.vcu; L < BATCH * NH_A * 4; L += F.G) {
        const int bh = L >> 2, x = L & 3, b = bh >> 3, h = bh & 7;
        __syncthreads();
        const float c31 = rel_bias[31 * NH_A + h] * LOG2E;
        for (int i = tid; i < 4 * da2::TBL_N; i += NWAVES * 64) { const int c = i >> 9, y = i & 511, d = da2::TBL_X0 - (y + c);
            tbl[i] = d < 0 ? -__builtin_inff() : (d > 127 ? 0.f : rel_bias[t5_bucket(d) * NH_A + h] * LOG2E - c31); }
        __syncthreads();
        for (int s = 0; s < 4; ++s) {
            const int qb = (s >> 1) ? 7 - x : x, m = s & 1, P0 = qb * 256;
            const bf16* Qp = QKV + ((size_t)b * SEQ + P0) * NQKV + h * 128 + m * 64;
            const bf16* Kp = QKV + (size_t)b * SEQ * NQKV + D + h * 128 + m * 64;
            const bf16* Vp = QKV + (size_t)b * SEQ * NQKV + 2 * D + h * 128;
            f32x16 o[4];
            da2::attn_block(Qp, Kp, Vp, P0, lds, c31, o);
            if (m == 0) {
#pragma unroll
                for (int i = 0; i < 16; ++i) { const f32x4 v = {o[i >> 2][(i & 3) * 4 + 0], o[i >> 2][(i & 3) * 4 + 1], o[i >> 2][(i & 3) * 4 + 2], o[i >> 2][(i & 3) * 4 + 3]};
                    __builtin_amdgcn_raw_buffer_store_b128(__builtin_bit_cast(v4u, v), strs, stvo, i * 1024, 0); }
            } else {
#pragma unroll
                for (int i = 0; i < 16; ++i) { const f32x4 sti = __builtin_bit_cast(f32x4, __builtin_amdgcn_raw_buffer_load_b128(strs, stvo, i * 1024, 0));
#pragma unroll
                    for (int e = 0; e < 4; ++e) { const int dq = i >> 2, r = (i & 3) * 4 + e; const float v = sti[e] - lam * o[dq][r];
                        *(LAS unsigned short*)(stg + da2::crow(r, hi) * da2::STG_PITCH + (dq * 32 + r32) * 2) = (unsigned short)f2bf(v); } }
                asm volatile("s_waitcnt lgkmcnt(0)" ::: "memory");
                const int row = lane >> 1, half = lane & 1;
                v4u w[8]; float ss = 0.f;
#pragma unroll
                for (int i = 0; i < 8; ++i) { w[i] = *(const LAS v4u*)(stg + row * da2::STG_PITCH + half * 128 + i * 16);
#pragma unroll
                    for (int q = 0; q < 4; ++q) { const float a0 = __uint_as_float(w[i][q] << 16), a1 = __uint_as_float(w[i][q] & 0xffff0000u); ss += a0 * a0 + a1 * a1; } }
                ss += __shfl_xor(ss, 1);
                const float rstd = __builtin_amdgcn_rsqf(ss * (1.f / 128.f) + EPS);
                bf16* Ow = AO + ((size_t)b * SEQ + P0 + wid * 32 + row) * D + h * 128 + half * 64;
#pragma unroll
                for (int i = 0; i < 8; ++i) { v4u ov;
#pragma unroll
                    for (int q = 0; q < 4; ++q) ov[q] = pk2(__uint_as_float(w[i][q] << 16) * rstd, __uint_as_float(w[i][q] & 0xffff0000u) * rstd);
                    *(GAS v4u*)(Ow + i * 8) = ov; }
                asm volatile("s_waitcnt lgkmcnt(0)\n\ts_barrier" ::: "memory");
            }
        }
    }
    __syncthreads();
}
__device__ __forceinline__ void convscan_phase(Frame& F, const bf16* __restrict__ PROJ, const float* __restrict__ GATES, const float* __restrict__ conv_w, const float* __restrict__ conv_b, bf16* QKC, float* GS) {
    {   const int pc = F.tid & 127, col = pc * 8;
        float cw[4][8], cbias[8];
#pragma unroll
        for (int i = 0; i < 8; ++i) { cbias[i] = conv_b[col + i];
#pragma unroll
            for (int t = 0; t < 4; ++t) cw[t][i] = conv_w[t * 1024 + col + i]; }
        const float osc = col < 512 ? MQSCALE : 1.f;
        for (int seg = F.vcu * 4 + (F.tid >> 7); seg < M / 32; seg += F.G * 4) {
            const int tokb = seg * 32;
#pragma unroll 1
            for (int run = 0; run < 4; ++run) {
                const int t8 = tokb + run * 8; const bool first = (t8 & (SEQ - 1)) == 0;
                const bf16* p = PROJ + (size_t)t8 * NPROJ + col;
                v4u r[11];
#pragma unroll
                for (int i = 0; i < 3; ++i) r[i] = first ? (v4u){0u, 0u, 0u, 0u} : *(const GAS v4u*)(p + ((ptrdiff_t)i - 3) * NPROJ);
#pragma unroll
                for (int i = 3; i < 11; ++i) r[i] = *(const GAS v4u*)(p + (size_t)(i - 3) * NPROJ);
#pragma unroll
                for (int t = 0; t < 8; ++t) {
                    unsigned o[4];
#pragma unroll
                    for (int q = 0; q < 4; ++q) {
                        float s0 = cbias[2 * q], s1 = cbias[2 * q + 1];
#pragma unroll
                        for (int tap = 0; tap < 4; ++tap) { const unsigned w = r[t + tap][q]; s0 += cw[tap][2 * q] * __uint_as_float(w << 16); s1 += cw[tap][2 * q + 1] * __uint_as_float(w & 0xffff0000u); }
                        s0 = s0 / (1.f + __expf(-s0)) * osc; s1 = s1 / (1.f + __expf(-s1)) * osc; o[q] = pk2(s0, s1); }
                    *(GAS v4u*)(QKC + (size_t)(t8 + t) * D + col) = (v4u){o[0], o[1], o[2], o[3]};
                }
            }
        }
    }
    {   const int gw = F.vcu * NWAVES + F.wave, NGW = F.G * NWAVES, lane = F.lane;
        for (int task = gw; task < BATCH * NH_M * (SEQ / 64); task += NGW) {
            const int c = task % (SEQ / 64), h = (task / (SEQ / 64)) % NH_M, b = task / (SEQ / 64) / NH_M;
            const size_t tok = (size_t)b * SEQ + c * 64 + lane;
            const float ig = GATES[tok * 8 + h], lf = GATES[tok * 8 + 4 + h];
            float bsum = lf;
#pragma unroll
            for (int off = 1; off < 64; off <<= 1) { const float t = __shfl_up(bsum, off); if (lane >= off) bsum += t; }
            const float e = ig - bsum; float pm = e;
#pragma unroll
            for (int off = 1; off < 64; off <<= 1) { const float t = __shfl_up(pm, off); if (lane >= off) pm = fmaxf(pm, t); }
            *(GAS f32x4*)(GS + tok * 16 + h * 4) = (f32x4){bsum, e, pm, 0.f};
        }
    }
}
__device__ __forceinline__ void mlstm_phase(Frame& F, const bf16* __restrict__ PROJ, const bf16* __restrict__ QKC, const float* __restrict__ GS, bf16* HT, float* SSQ) {
    for (int u = F.vcu; u < BATCH * NH_M * 4; u += F.G) {
        __syncthreads();
        ml::mlstm_unit(u >> 4, (u >> 2) & 3, u & 3, PROJ, QKC, GS, HT, SSQ, (LAS char*)(F.lds + RING_OFF));
    }
    __syncthreads();
}
__device__ __forceinline__ void gatenorm_phase(Frame& F, const bf16* __restrict__ PROJ, const bf16* __restrict__ HT, const float* __restrict__ SSQ, bf16* AO) {
    const int gw = F.vcu * NWAVES + F.wave, NGW = F.G * NWAVES, lane = F.lane;
    for (int m = gw; m < M; m += NGW) {
        const int hd = lane >> 4;
        const f32x4 s0 = *(const GAS f32x4*)(SSQ + (size_t)m * 32 + hd * 8), s1 = *(const GAS f32x4*)(SSQ + (size_t)m * 32 + hd * 8 + 4);
        const float tot = ((s0.x + s0.y) + (s0.z + s0.w)) + ((s1.x + s1.y) + (s1.z + s1.w));
        const float rstd = 1.f / sqrtf(tot * (1.f / 256.f) + EPS);
        const v4u h0 = *(const GAS v4u*)(HT + (size_t)m * D + lane * 16), h1 = *(const GAS v4u*)(HT + (size_t)m * D + lane * 16 + 8);
        const v4u o0 = *(const GAS v4u*)(PROJ + (size_t)m * NPROJ + 2048 + lane * 16), o1 = *(const GAS v4u*)(PROJ + (size_t)m * NPROJ + 2048 + lane * 16 + 8);
        v4u r0, r1;
#pragma unroll
        for (int q = 0; q < 4; ++q) {
            { const float ha = __uint_as_float(h0[q] << 16) * rstd, hb = __uint_as_float(h0[q] & 0xffff0000u) * rstd, oa = __uint_as_float(o0[q] << 16), ob = __uint_as_float(o0[q] & 0xffff0000u);
              r0[q] = pk2(ha / (1.f + __expf(-oa)), hb / (1.f + __expf(-ob))); }
            { const float ha = __uint_as_float(h1[q] << 16) * rstd, hb = __uint_as_float(h1[q] & 0xffff0000u) * rstd, oa = __uint_as_float(o1[q] << 16), ob = __uint_as_float(o1[q] & 0xffff0000u);
              r1[q] = pk2(ha / (1.f + __expf(-oa)), hb / (1.f + __expf(-ob))); }
        }
        *(GAS v4u*)(AO + (size_t)m * D + lane * 16) = r0; *(GAS v4u*)(AO + (size_t)m * D + lane * 16 + 8) = r1;
    }
}

template <class Epi>
__device__ __forceinline__ void run_gemm(Frame& F, const bf16* A, const bf16* Bt, int N, int K, const Epi& E, const float* ssq = nullptr) {
    pg8::Gemm g{A, Bt, M, N, K}; pg8::StaticOrder S; S.init(M, N, F.G, (int)blockIdx.x);
    if (ssq) pg8::fill_rstd_table(S, ssq, (LAS float*)(F.lds + RSTD_OFF));
    pg8::gemm_phase<Epi, pg8::StaticOrder, PG8_ALIGN, PG8_SP2>(F.lds + RING_OFF, g, S, E);
}
__global__ void __launch_bounds__(NWAVES * 64, 2) fwd(Args args) {
    extern __shared__ __attribute__((aligned(16))) unsigned char lds[];
    Frame F;
    F.lds = (LAS unsigned char*)lds;
    F.MISC = (volatile LAS unsigned*)(F.lds + MISC_OFF);
    F.tid = threadIdx.x; F.lane = F.tid & 63; F.wave = __builtin_amdgcn_readfirstlane(F.tid >> 6);
    F.G = gridDim.x; { const int bx = blockIdx.x; F.vcu = (F.G % 8 == 0) ? (bx % 8) * (F.G / 8) + bx / 8 : bx; }
    unsigned char* ws = args.ws;
    F.ctl = (gu32*)(ws + WS_CTL);
    for (int u = F.tid; u < (LDS_BYTES - LDSCTL_OFF) / 4; u += NWAVES * 64) ((LAS unsigned*)(F.lds + LDSCTL_OFF))[u] = 0u;
    __syncthreads();
    const int lo = args.ph_lo, hi = args.ph_hi;
    const bool use_bar = (hi - lo) > 1;
    XcdBarrier bar; bar.bar = (unsigned*)(F.ctl + CW_BAR) + args.li * XCD_BAR_WORDS; bar.x = 0; bar.st = nullptr;
    if (use_bar) bar = xcd_barrier_post((unsigned*)(F.ctl + CW_BAR) + args.li * XCD_BAR_WORDS, F.MISC + 8);
#define IN(k) (lo <= (k) && (k) < hi)
#define SEAM(k) do { if (hi > lo + 1) xcd_barrier(bar); } while (0)
#define REP(k) for (int rep_ = 0; rep_ < ((DUP_PHASE == (k)) ? 2 : 1); ++rep_)
#define DUPBAR(k) do { if (DUP_PHASE == (k) && rep_ == 0) xcd_barrier(bar); } while (0)
    bf16* const XN = (bf16*)(ws + WS_XN); bf16* const AO = (bf16*)(ws + WS_AO); bf16* const QKV = (bf16*)(ws + WS_U); bf16* const U = (bf16*)(ws + WS_U); float* const SSQH = (float*)(ws + WS_SSQH);
    float* const H = args.out;
    using pg8::EpiBf16; using pg8::EpiResNorm; (void)H; const LAS float* const RT = (const LAS float*)(F.lds + RSTD_OFF);

    if (IN(0)) { REP(0) { p0_prologue(F, args); DUPBAR(0); } SEAM(0); }
    if (IN(1)) { EpiBf16<0> E{QKV, NQKV, D, QSCALE, RT, -1, nullptr, nullptr, nullptr}; if (DUP_PHASE == 1) { run_gemm(F, XN, (const bf16*)(ws + WS_WQKV), NQKV, D, E, SSQH); xcd_barrier(bar); } run_gemm(F, XN, (const bf16*)(ws + WS_WQKV), NQKV, D, E, SSQH); SEAM(1); }
    if (IN(2)) { REP(2) { attn_phase(F, QKV, AO, (float*)(ws + WS_STASH), args.in[1], args.in[4], args.in[5], args.in[6], args.in[7]); DUPBAR(2); } SEAM(2); }
    if (IN(3)) { EpiResNorm<true> E{args.in[0], nullptr, XN, SSQH, D, (LAS float*)(F.lds + EPIRED_OFF)}; if (DUP_PHASE == 3) { run_gemm(F, AO, (const bf16*)(ws + WS_WAO), D, D, E); xcd_barrier(bar); } run_gemm(F, AO, (const bf16*)(ws + WS_WAO), D, D, E); SEAM(4); }
    if (IN(5)) { EpiBf16<2> E{U, FF, 0, 1.f, RT, -1, nullptr, nullptr, nullptr}; if (DUP_PHASE == 5) { run_gemm(F, XN, (const bf16*)(ws + WS_W1), FF, D, E, SSQH); xcd_barrier(bar); } run_gemm(F, XN, (const bf16*)(ws + WS_W1), FF, D, E, SSQH); SEAM(5); }
    if (IN(6)) { EpiResNorm<false> E{nullptr, XN, XN, SSQH, D, (LAS float*)(F.lds + EPIRED_OFF)}; run_gemm(F, U, (const bf16*)(ws + WS_W2), D, FF, E); SEAM(7); }
    if (IN(8)) { EpiBf16<0> E{QKV, NPROJ, 0, 1.f, RT, NPROJ / 256, (float*)(ws + WS_GATES), args.in[12], args.in[13]}; if (DUP_PHASE == 8) { run_gemm(F, XN, (const bf16*)(ws + WS_WML), NPROJ + 256, D, E, SSQH); xcd_barrier(bar); } run_gemm(F, XN, (const bf16*)(ws + WS_WML), NPROJ + 256, D, E, SSQH); SEAM(8); }
    if (IN(9)) { REP(16) { convscan_phase(F, QKV, (const float*)(ws + WS_GATES), args.in[14], args.in[15], AO, (float*)(ws + WS_GS)); xcd_barrier(bar); }
        REP(9) { mlstm_phase(F, QKV, AO, (const float*)(ws + WS_GS), (bf16*)(ws + WS_HT), (float*)(ws + WS_SSQ)); DUPBAR(9); } SEAM(9); }
    if (IN(10)) { REP(10) { gatenorm_phase(F, QKV, (const bf16*)(ws + WS_HT), (const float*)(ws + WS_SSQ), AO); DUPBAR(10); } SEAM(10); }
    if (IN(11)) { EpiResNorm<false> E{nullptr, XN, XN, SSQH, D, (LAS float*)(F.lds + EPIRED_OFF)}; run_gemm(F, AO, (const bf16*)(ws + WS_WMO), D, D, E); SEAM(12); }
    if (IN(13)) { EpiBf16<2> E{U, FF, 0, 1.f, RT, -1, nullptr, nullptr, nullptr}; if (DUP_PHASE == 13) { run_gemm(F, XN, (const bf16*)(ws + WS_W1) + (size_t)D * FF, FF, D, E, SSQH); xcd_barrier(bar); } run_gemm(F, XN, (const bf16*)(ws + WS_W1) + (size_t)D * FF, FF, D, E, SSQH); SEAM(13); }
    if (IN(14)) { EpiResNorm<false> E{nullptr, XN, XN, SSQH, D, (LAS float*)(F.lds + EPIRED_OFF)}; run_gemm(F, U, (const bf16*)(ws + WS_W2) + (size_t)D * FF, D, FF, E); SEAM(14); }
    if (IN(15)) { final_norm_phase(F, XN, SSQH, args.in[21], args.out); }
#undef IN
#undef SEAM
}

extern "C" void kernel_launch(void* const* d_in, const int* in_sizes, int n_in, void* d_out, int out_size, void* d_ws, size_t ws_size, hipStream_t stream) {
    static int grid = 0;
    if (grid == 0) {
        if (n_in != 22 || in_sizes[0] != M * D || out_size != M * D || ws_size < WS_END) { fprintf(stderr, "kernel_launch: unexpected shapes (n_in %d, in0 %d, out %d, ws %zu); nothing launched\n", n_in, n_in > 0 ? in_sizes[0] : -1, out_size, ws_size); grid = -1; return; }
        int dev = 0, cus = 0, per_cu = 0;
        if (hipGetDevice(&dev) != hipSuccess || hipDeviceGetAttribute(&cus, hipDeviceAttributeMultiprocessorCount, dev) != hipSuccess) { grid = -1; return; }
        if (hipFuncSetAttribute((const void*)fwd, hipFuncAttributeMaxDynamicSharedMemorySize, LDS_BYTES) != hipSuccess) { fprintf(stderr, "kernel_launch: hipFuncSetAttribute failed\n"); grid = -1; return; }
        if (hipOccupancyMaxActiveBlocksPerMultiprocessor(&per_cu, (const void*)fwd, NWAVES * 64, LDS_BYTES) != hipSuccess || per_cu < 1) fprintf(stderr, "kernel_launch: occupancy query says %d\n", per_cu);
        (void)hipGetLastError();
        grid = cus;
    }
    if (grid < 0) return;
    (void)hipMemsetAsync((char*)d_ws + WS_CTL, 0, CTL_ZERO_BYTES, stream);
    Args a{};
    for (int i = 0; i < 22; ++i) a.in[i] = (const float*)d_in[i];
    a.out = (float*)d_out; a.ws = (unsigned char*)d_ws;
    int li = 0;
    auto run = [&](int lo, int hi) { a.ph_lo = lo; a.ph_hi = hi; a.li = li++; hipLaunchKernelGGL(fwd, dim3(grid), dim3(NWAVES * 64), LDS_BYTES, stream, a); };
    run(0, NPHASE);
}
```

```cpp
#include <hip/hip_runtime.h>
#include <cstdio>
#include <cstdint>
namespace pg8 {
#define PG8_LAS __attribute__((address_space(3)))
typedef unsigned short bf16_t;
typedef short bf16x8 __attribute__((ext_vector_type(8)));
typedef float f32x4 __attribute__((ext_vector_type(4)));
typedef unsigned u32x4 __attribute__((ext_vector_type(4)));
constexpr int BM = 256, BK = 64, HALF = 128, HTB = HALF * BK * 2  , STAGE_BYTES = 8 * HTB, NXCD = 8, WGM = 8;

__host__ __device__ __forceinline__ int lds_byte(int r, int c) { const int st = (r >> 4) * 2 + (c >> 5), rr = r & 15, cc = c & 31, ob = rr * 64 + cc * 2; return st * 1024 + (ob ^ (((ob >> 9) & 1) << 5)); }
__host__ __device__ __forceinline__ void stage_rc(int b, int& R, int& C) { const int st = b / 1024, sb = b % 1024, swz = sb ^ (((sb >> 9) & 1) << 5); R = (st >> 1) * 16 + swz / 64; C = (st & 1) * 32 + (swz % 64) / 2; }
__host__ __device__ __forceinline__ int perm32(int rho) { const int n = rho >> 4, i = rho & 15; return 8 * (i >> 2) + 4 * n + (i & 3); }

struct Unit { int pm, pn; };
struct Gemm { const bf16_t* A; const bf16_t* Bt; int M, N, K; };

struct StaticOrder {
    int nM, nN, nwg, G, c;
    __host__ __device__ void init(int M, int N, int G_, int c_) { nM = M / BM; nN = N / BM; nwg = nM * nN; G = G_; c = c_; }
    __host__ __device__ bool next(int i, Unit& u) const {
        const long L = (long)i * G + c; if (L >= nwg) return false;
        int wgid = (int)L; { const int q = nwg / NXCD, r = nwg % NXCD, xcd = wgid % NXCD, off = wgid / NXCD; wgid = (xcd < r ? xcd * (q + 1) : r * (q + 1) + (xcd - r) * q) + off; }
        const int nig = WGM * nN, gid = wgid / nig, fm = gid * WGM, gsz = (nM - fm) < WGM ? (nM - fm) : WGM;
        u.pm = fm + ((wgid % nig) % gsz); u.pn = (wgid % nig) / gsz; return true;
    }
    __device__ __forceinline__ void a_ready(const Unit&) const {}
    __device__ __forceinline__ void done(const Unit&) const {}
};

__device__ __forceinline__ unsigned cvt_pk_bf16(float lo, float hi) { unsigned r; asm volatile("v_cvt_pk_bf16_f32 %0, %1, %2" : "=v"(r) : "v"(lo), "v"(hi)); return r; }
__device__ __forceinline__ float row_rstd(const float* ssq, int row) {
    const f32x4 a = *(const f32x4*)(ssq + (size_t)row * 4);
    return __builtin_amdgcn_rsqf(((a[0] + a[1]) + (a[2] + a[3])) * (1.0f / 1024.0f) + 1e-6f);
}
__device__ __forceinline__ float log_sigmoid_f(float x) { return fminf(x, 0.f) - log1pf(expf(-fabsf(x))); }
template <int ACT> struct EpiBf16 {
    static constexpr bool PERM = true, AFTER_DRAIN = false;
    bf16_t* O; int ldc; int scale_cols; float scale0; const PG8_LAS float* rstd_tbl  ; int gate_tile; float* gates; const float* b_i; const float* b_f;
    __device__ __forceinline__ void operator()(const f32x4 (&acc)[2][2][4][2], const Unit& u, int wr, int wc, int fr, int fq, int ui) const {
        const int row0 = u.pm * BM + wr * 64 + fr; const int colt = u.pn * BM;
        const float sc = (colt < scale_cols) ? scale0 : 1.f;
        const int col0 = colt + wc * 32 + 8 * fq;
        float rs[2][4];
#pragma unroll
        for (int ai = 0; ai < 2; ++ai)
#pragma unroll
            for (int m = 0; m < 4; ++m) rs[ai][m] = rstd_tbl ? rstd_tbl[ui * BM + ai * HALF + wr * 64 + m * 16 + fr] * sc : sc;
        if (u.pn == gate_tile) {
            if (wc == 0 && fq == 0) { const f32x4 bi = *(const f32x4*)b_i, bf = *(const f32x4*)b_f;
#pragma unroll
                for (int ai = 0; ai < 2; ++ai)
#pragma unroll
                    for (int m = 0; m < 4; ++m) { const int row = row0 + ai * HALF + m * 16; const f32x4 gi = acc[ai][0][m][0] * rs[ai][m] + bi; f32x4 gf = acc[ai][0][m][1] * rs[ai][m] + bf;
#pragma unroll
                        for (int e = 0; e < 4; ++e) gf[e] = log_sigmoid_f(gf[e]);
                        *(f32x4*)(gates + (size_t)row * 8) = gi; *(f32x4*)(gates + (size_t)row * 8 + 4) = gf; } }
            return;
        }
#pragma unroll
        for (int ai = 0; ai < 2; ++ai)
#pragma unroll
            for (int m = 0; m < 4; ++m) { bf16_t* rowp = O + (size_t)(row0 + ai * HALF + m * 16) * ldc + col0; const float r = rs[ai][m];
#pragma unroll
                for (int bj = 0; bj < 2; ++bj) { f32x4 v0 = acc[ai][bj][m][0] * r, v1 = acc[ai][bj][m][1] * r;
                    if (ACT == 2) {
#pragma unroll
                        for (int e = 0; e < 4; ++e) { const float a = fmaxf(v0[e], 0.f), b = fmaxf(v1[e], 0.f); v0[e] = a * a; v1[e] = b * b; } }
                    u32x4 w; w.x = cvt_pk_bf16(v0[0], v0[1]); w.y = cvt_pk_bf16(v0[2], v0[3]); w.z = cvt_pk_bf16(v1[0], v1[1]); w.w = cvt_pk_bf16(v1[2], v1[3]);
                    *(u32x4*)(rowp + bj * HALF) = w; } }
    }
};
template <class Sched>
__device__ __forceinline__ void fill_rstd_table(const Sched& S, const float* ssq, PG8_LAS float* tbl) {
    Unit u;
    for (int i = 0; i < 8 && S.next(i, u); ++i)
        for (int r = threadIdx.x; r < BM; r += 512) tbl[i * BM + r] = row_rstd(ssq, u.pm * BM + r);
    asm volatile("s_waitcnt lgkmcnt(0)" ::: "memory");
}
template <bool BASE_F32> struct EpiResNorm {
    static constexpr bool PERM = true, AFTER_DRAIN = false;
    const float* basef; const bf16_t* baseh; bf16_t* xn; float* ssq; int ldc; PG8_LAS float* red;
    __device__ __forceinline__ void operator()(const f32x4 (&acc)[2][2][4][2], const Unit& u, int wr, int wc, int fr, int fq, int) const {
        const int row0 = u.pm * BM + wr * 64 + fr; const int col0 = u.pn * BM + wc * 32 + 8 * fq;
#pragma unroll
        for (int ai = 0; ai < 2; ++ai)
#pragma unroll
            for (int m = 0; m < 4; ++m) { const int row = row0 + ai * HALF + m * 16; const size_t off = (size_t)row * ldc + col0; float s = 0.f;
#pragma unroll
                for (int bj = 0; bj < 2; ++bj) { f32x4 v0, v1;
                    if (BASE_F32) { v0 = *(const f32x4*)(basef + off + bj * HALF); v1 = *(const f32x4*)(basef + off + bj * HALF + 4); }
                    else { const u32x4 h = *(const u32x4*)(baseh + off + bj * HALF);
                        v0 = (f32x4){__uint_as_float(h.x << 16), __uint_as_float(h.x & 0xffff0000u), __uint_as_float(h.y << 16), __uint_as_float(h.y & 0xffff0000u)};
                        v1 = (f32x4){__uint_as_float(h.z << 16), __uint_as_float(h.z & 0xffff0000u), __uint_as_float(h.w << 16), __uint_as_float(h.w & 0xffff0000u)}; }
                    v0 = v0 + acc[ai][bj][m][0]; v1 = v1 + acc[ai][bj][m][1];
                    s += ((v0[0] * v0[0] + v0[1] * v0[1]) + (v0[2] * v0[2] + v0[3] * v0[3])) + ((v1[0] * v1[0] + v1[1] * v1[1]) + (v1[2] * v1[2] + v1[3] * v1[3]));
                    u32x4 w; w.x = cvt_pk_bf16(v0[0], v0[1]); w.y = cvt_pk_bf16(v0[2], v0[3]); w.z = cvt_pk_bf16(v1[0], v1[1]); w.w = cvt_pk_bf16(v1[2], v1[3]);
                    *(u32x4*)(xn + off + bj * HALF) = w; }
                s += __shfl_xor(s, 16); s += __shfl_xor(s, 32);
                if (fq == 0) red[(ai * HALF + wr * 64 + m * 16 + fr) * 4 + wc] = s; }
        asm volatile("s_waitcnt lgkmcnt(0)" ::: "memory"); __builtin_amdgcn_s_barrier(); asm volatile("" ::: "memory");
        const int t = threadIdx.x;
        if (t < BM) { const f32x4 p = *(const PG8_LAS f32x4*)(red + t * 4); ssq[(size_t)(u.pm * BM + t) * 4 + u.pn] = (p[0] + p[1]) + (p[2] + p[3]); }
    }
};

template <class Epi, class Sched, bool ALIGN_EPI = false, bool SP2 = false>
__device__ __forceinline__ void gemm_phase(PG8_LAS unsigned char* lds, const Gemm g, const Sched& S, const Epi& E) {
    const int tid = threadIdx.x, wid = __builtin_amdgcn_readfirstlane(tid >> 6), lane = tid & 63, wr = wid >> 2, wc = wid & 3, fr = lane & 15, fq = lane >> 4;
    const int K = g.K, nt = K / BK;
    unsigned voffA[2], voffB[2];
#pragma unroll
    for (int i = 0; i < 2; ++i) { int R, C; stage_rc(tid * 16 + i * 8192, R, C); const int Rb = Epi::PERM ? ((R & ~31) + perm32(R & 31)) : R;
        voffA[i] = (unsigned)(R * K + C) * 2u; voffB[i] = (unsigned)(Rb * K + C) * 2u; }
    const size_t kstep = (size_t)(BK * 2);
    const size_t hstep = (size_t)HALF * K * 2;
    const size_t tstep = 2 * hstep;
    const unsigned ldsw = (unsigned)wid * 1024u;
    const int aoff = lds_byte(wr * 64 + fr, fq * 8), boff = lds_byte(wc * 32 + fr, fq * 8);
#define PG8_SA(b, h) (((b) * 2 + (h)) * HTB)
#define PG8_SB(b, h) ((4 + (b) * 2 + (h)) * HTB)
#define PG8_STAGE(bufoff, gbase, voff) do { _Pragma("unroll") for (int _i = 0; _i < 2; ++_i) \
        __builtin_amdgcn_global_load_lds((const unsigned*)((const char*)(gbase) + (voff)[_i]), (PG8_LAS unsigned*)(lds + (bufoff) + ldsw + _i * 8192), 16, 0, 0); } while (0)
#define PG8_LDA(dst, b, h) do { _Pragma("unroll") for (int m = 0; m < 4; ++m) _Pragma("unroll") for (int k = 0; k < 2; ++k) dst[m][k] = *(const PG8_LAS bf16x8*)(lds + PG8_SA(b, h) + aoff + m * 2048 + k * 1024); } while (0)
#define PG8_LDB(dst, b, h) do { _Pragma("unroll") for (int n = 0; n < 2; ++n) _Pragma("unroll") for (int k = 0; k < 2; ++k) dst[n][k] = *(const PG8_LAS bf16x8*)(lds + PG8_SB(b, h) + boff + n * 2048 + k * 1024); } while (0)
#define PG8_MMA(ai, bj, At, Bt) do { __builtin_amdgcn_s_setprio(1); _Pragma("unroll") for (int m = 0; m < 4; ++m) _Pragma("unroll") for (int n = 0; n < 2; ++n) _Pragma("unroll") for (int k = 0; k < 2; ++k) \
        acc[ai][bj][m][n] = __builtin_amdgcn_mfma_f32_16x16x32_bf16(Bt[n][k], At[m][k], acc[ai][bj][m][n], 0, 0, 0); __builtin_amdgcn_s_setprio(0); } while (0)
#define PG8_WAIT_V(n) asm volatile("s_waitcnt vmcnt(" #n ")" ::: "memory")
#define PG8_WAIT_L(n) asm volatile("s_waitcnt lgkmcnt(" #n ")" ::: "memory")
#define PG8_BAR __builtin_amdgcn_s_barrier()
#define PG8_SCHED __builtin_amdgcn_sched_barrier(0)
    Unit cur, nxt; int ui = 0;
    if (!S.next(0, cur)) return;
    f32x4 acc[2][2][4][2];
#pragma unroll
    for (int a = 0; a < 2; ++a)
#pragma unroll
        for (int b = 0; b < 2; ++b)
#pragma unroll
            for (int m = 0; m < 4; ++m)
#pragma unroll
                for (int n = 0; n < 2; ++n) acc[a][b][m][n] = (f32x4){0.f, 0.f, 0.f, 0.f};
    bf16x8 At[4][2], B0[2][2], B1[2][2];
    const char* cA = (const char*)g.A + (size_t)cur.pm * tstep; const char* cB = (const char*)g.Bt + (size_t)cur.pn * tstep;
    S.a_ready(cur);
    if constexpr (SP2) {
        PG8_STAGE(PG8_SB(0, 0), cB, voffB); PG8_STAGE(PG8_SB(0, 1), cB + hstep, voffB); PG8_STAGE(PG8_SA(0, 0), cA, voffA); PG8_STAGE(PG8_SA(0, 1), cA + hstep, voffA);
        if (wr == 1) PG8_BAR;
        PG8_WAIT_V(2); PG8_BAR;
        PG8_STAGE(PG8_SB(1, 0), cB + kstep, voffB); PG8_STAGE(PG8_SA(1, 0), cA + kstep, voffA); PG8_STAGE(PG8_SB(1, 1), cB + hstep + kstep, voffB);
        PG8_WAIT_V(6); PG8_BAR;
    } else {
        PG8_STAGE(PG8_SB(0, 0), cB, voffB); PG8_STAGE(PG8_SA(0, 0), cA, voffA); PG8_STAGE(PG8_SB(0, 1), cB + hstep, voffB); PG8_STAGE(PG8_SA(0, 1), cA + hstep, voffA);
        if (wr == 1) PG8_BAR;
        PG8_WAIT_V(4); PG8_BAR;
        PG8_STAGE(PG8_SB(1, 0), cB + kstep, voffB); PG8_STAGE(PG8_SA(1, 0), cA + kstep, voffA); PG8_STAGE(PG8_SB(1, 1), cB + hstep + kstep, voffB);
        PG8_WAIT_V(6); PG8_BAR;
    }
    for (;;) {
        const bool has_next = S.next(ui + 1, nxt);
        const char* nA = has_next ? (const char*)g.A + (size_t)nxt.pm * tstep : cA; const char* nB = has_next ? (const char*)g.Bt + (size_t)nxt.pn * tstep : cB;
        for (int t = 0; t < nt; t += 2) {
            const bool last = (t == nt - 2);
            const char* a1 = cA + (size_t)(t + 1) * kstep;
            const char* a2 = last ? nA : cA + (size_t)(t + 2) * kstep; const char* b2 = last ? nB : cB + (size_t)(t + 2) * kstep;
            const char* a3 = a2 + kstep; const char* b3 = b2 + kstep;
            if (last && has_next) S.a_ready(nxt);
            if constexpr (SP2) {
            PG8_LDB(B0, 0, 0); PG8_LDB(B1, 0, 1); PG8_SCHED; PG8_LDA(At, 0, 0); PG8_STAGE(PG8_SA(1, 1), a1 + hstep, voffA);
            PG8_WAIT_V(8); PG8_WAIT_L(0); PG8_BAR; PG8_MMA(0, 0, At, B0); PG8_MMA(0, 1, At, B1); PG8_BAR; PG8_SCHED;
            PG8_LDA(At, 0, 1); PG8_STAGE(PG8_SB(0, 0), b2, voffB); PG8_STAGE(PG8_SB(0, 1), b2 + hstep, voffB); PG8_STAGE(PG8_SA(0, 0), a2, voffA);
            PG8_WAIT_V(8); PG8_WAIT_L(0); PG8_BAR; PG8_MMA(1, 0, At, B0); PG8_MMA(1, 1, At, B1); PG8_BAR; PG8_SCHED;
            PG8_LDB(B0, 1, 0); PG8_LDB(B1, 1, 1); PG8_SCHED; PG8_LDA(At, 1, 0); PG8_STAGE(PG8_SA(0, 1), a2 + hstep, voffA);
            PG8_WAIT_V(8); PG8_WAIT_L(0); PG8_BAR; PG8_MMA(0, 0, At, B0); PG8_MMA(0, 1, At, B1); PG8_BAR; PG8_SCHED;
            PG8_LDA(At, 1, 1); PG8_STAGE(PG8_SB(1, 0), b3, voffB); PG8_STAGE(PG8_SB(1, 1), b3 + hstep, voffB); PG8_STAGE(PG8_SA(1, 0), a3, voffA);
            PG8_WAIT_V(8); PG8_WAIT_L(0); PG8_BAR; PG8_MMA(1, 0, At, B0); PG8_MMA(1, 1, At, B1); PG8_BAR; PG8_SCHED;
            } else {
            PG8_LDB(B0, 0, 0); PG8_SCHED; PG8_LDA(At, 0, 0); PG8_STAGE(PG8_SA(1, 1), a1 + hstep, voffA);
            PG8_WAIT_L(8); PG8_BAR; PG8_WAIT_L(0); PG8_MMA(0, 0, At, B0); PG8_BAR; PG8_SCHED;
            PG8_LDB(B1, 0, 1); PG8_STAGE(PG8_SB(0, 0), b2, voffB);
            PG8_BAR; PG8_WAIT_L(0); PG8_MMA(0, 1, At, B1); PG8_BAR;
            PG8_LDA(At, 0, 1); PG8_STAGE(PG8_SA(0, 0), a2, voffA);
            PG8_BAR; PG8_WAIT_L(0); PG8_MMA(1, 0, At, B0); PG8_BAR; PG8_SCHED;
            PG8_STAGE(PG8_SB(0, 1), b2 + hstep, voffB);
            PG8_WAIT_V(6); PG8_BAR; PG8_MMA(1, 1, At, B1); PG8_BAR;
            PG8_LDB(B0, 1, 0); PG8_SCHED; PG8_LDA(At, 1, 0); PG8_STAGE(PG8_SA(0, 1), a2 + hstep, voffA);
            PG8_WAIT_L(8); PG8_BAR; PG8_WAIT_L(0); PG8_MMA(0, 0, At, B0); PG8_BAR; PG8_SCHED;
            PG8_LDB(B1, 1, 1); PG8_STAGE(PG8_SB(1, 0), b3, voffB);
            PG8_BAR; PG8_WAIT_L(0); PG8_MMA(0, 1, At, B1); PG8_BAR;
            PG8_LDA(At, 1, 1); PG8_STAGE(PG8_SA(1, 0), a3, voffA);
            PG8_BAR; PG8_WAIT_L(0); PG8_MMA(1, 0, At, B0); PG8_BAR; PG8_SCHED;
            PG8_STAGE(PG8_SB(1, 1), b3 + hstep, voffB);
            PG8_WAIT_V(6); PG8_BAR; PG8_MMA(1, 1, At, B1); PG8_BAR;
            }
        }
        if constexpr (ALIGN_EPI) { if (wr == 0) PG8_BAR; }
        if constexpr (!Epi::AFTER_DRAIN) { E(acc, cur, wr, wc, fr, fq, ui); S.done(cur); }
        if (!has_next) break;
#pragma unroll
        for (int a = 0; a < 2; ++a)
#pragma unroll
            for (int b = 0; b < 2; ++b)
#pragma unroll
                for (int m = 0; m < 4; ++m)
#pragma unroll
                    for (int n = 0; n < 2; ++n) acc[a][b][m][n] = (f32x4){0.f, 0.f, 0.f, 0.f};
        cur = nxt; cA = nA; cB = nB; ++ui;
        if constexpr (ALIGN_EPI) { if (wr == 1) PG8_BAR; }
    }
    PG8_WAIT_V(0);
    if constexpr (!ALIGN_EPI) { if (wr == 0) PG8_BAR; }
    PG8_BAR;
    if constexpr (Epi::AFTER_DRAIN) { E.fused(acc, cur, wr, wc, fr, fq, lds, wid, lane); S.done(cur); }
#undef PG8_SA
#undef PG8_SB
#undef PG8_STAGE
#undef PG8_LDA
#undef PG8_LDB
#undef PG8_MMA
#undef PG8_WAIT_V
#undef PG8_WAIT_L
#undef PG8_BAR
#undef PG8_SCHED
}
}

#ifndef PG8_SP2
#define PG8_SP2 true
#endif
#ifndef PG8_ALIGN
#define PG8_ALIGN true
#endif
namespace da {
typedef short bf16x8 __attribute__((ext_vector_type(8)));
typedef short s16x4 __attribute__((ext_vector_type(4)));
typedef float f32x16 __attribute__((ext_vector_type(16)));
typedef float f32x4 __attribute__((ext_vector_type(4)));
typedef unsigned u32x4 __attribute__((ext_vector_type(4)));
#define DLAS __attribute__((address_space(3)))
constexpr int NW = 8, QBLK = 32, KVBLK = 64, QB = NW * QBLK, PITCH = 3072;
constexpr int SHM_V = KVBLK * 128 * 2, SHM_K = KVBLK * 64 * 2;
constexpr int OFF_V = 0, OFF_K = 2 * SHM_V, OFF_WS = OFF_K + 2 * SHM_K, OFF_LUT = OFF_WS + NW * 64 * 4, LDS_BYTES = OFF_LUT + 512;
constexpr float THR = 8.f;
#define DA_KSWZ(row, c) ((row) * 128 + ((((c) ^ (((row) >> 1) & 7))) << 4))
#define DA_SBAR() __builtin_amdgcn_sched_barrier(0)
__device__ __forceinline__ int v_st(int k, int c) { const int kk = (k & ~0xC) | ((k & 4) << 1) | ((k & 8) >> 1); return ((kk >> 3) * 4 + (c >> 5)) * 512 + ((kk & 7) * 32 + (c & 31)) * 2; }
__device__ __forceinline__ int v_rd_base(int lane) { return ((lane & 3) << 3) | (((lane >> 2) & 3) << 6) | (((lane >> 4) & 1) << 5) | (((lane >> 5) & 1) << 8); }
constexpr int v_rd_off(int d0, int ks, int half) { return d0 * 512 + ks * 4096 + half * 2048; }
__device__ __forceinline__ int crow(int r, int hi) { return (r & 3) + 8 * (r >> 2) + 4 * hi; }
__device__ __forceinline__ unsigned cvtpk(float lo, float hi) { unsigned r; asm volatile("v_cvt_pk_bf16_f32 %0, %1, %2" : "=v"(r) : "v"(lo), "v"(hi)); return r; }
__device__ __forceinline__ void mask_tile(f32x16& p0, f32x16& p1, int dq) {
    const float NEG = -__builtin_inff();
#pragma unroll
    for (int r = 0; r < 16; ++r) { const int c = (r & 3) + 8 * (r >> 2); if (dq - c < 0) p0[r] = NEG; if (dq - c - 32 < 0) p1[r] = NEG; }
}
__device__ __forceinline__ void bias_tile(f32x16& p0, f32x16& p1, int dq, const DLAS float* lut) {
#pragma unroll
    for (int g = 0; g < 4; ++g) {
#pragma unroll
        for (int rr = 0; rr < 4; ++rr) { const int r = g * 4 + rr; const int c = (r & 3) + 8 * (r >> 2);
            int i0 = dq - c; i0 = i0 < 0 ? 0 : (i0 > 127 ? 127 : i0); int i1 = dq - c - 32; i1 = i1 < 0 ? 0 : (i1 > 127 ? 127 : i1);
            p0[r] += lut[i0]; p1[r] += lut[i1]; }
        DA_SBAR();
    }
}
__device__ __forceinline__ void partialSM(f32x16& p0, f32x16& p1, float& m_reg, float& alpha, float cb) {
    float pmax = p0[0];
#pragma unroll
    for (int r = 1; r < 16; ++r) pmax = fmaxf(pmax, p0[r]);
#pragma unroll
    for (int r = 0; r < 16; ++r) pmax = fmaxf(pmax, p1[r]);
    { auto rr = __builtin_amdgcn_permlane32_swap(__float_as_uint(pmax), __float_as_uint(pmax), false, false);
      pmax = fmaxf(__uint_as_float(rr[0]), __uint_as_float(rr[1])); }
    pmax += cb;
    float mn;
    if (__builtin_expect(__all(pmax - m_reg <= THR), 1)) { mn = m_reg; alpha = 1.f; }
    else { mn = fmaxf(m_reg, pmax); alpha = __builtin_amdgcn_exp2f(m_reg - mn); m_reg = mn; }
    const float off = cb - mn;
#pragma unroll
    for (int r = 0; r < 16; ++r) p0[r] += off;
#pragma unroll
    for (int r = 0; r < 16; ++r) p1[r] += off;
#pragma unroll
    for (int r = 0; r < 16; ++r) p0[r] = __builtin_amdgcn_exp2f(p0[r]);
}
__device__ __forceinline__ void finishSM(f32x16& p0, f32x16& p1, float alpha, float& l_reg, bf16x8& pa0, bf16x8& pa1, bf16x8& pa2, bf16x8& pa3) {
#pragma unroll
    for (int r = 0; r < 16; ++r) p1[r] = __builtin_amdgcn_exp2f(p1[r]);
    float ps = 0;
#pragma unroll
    for (int r = 0; r < 16; ++r) ps += p0[r];
#pragma unroll
    for (int r = 0; r < 16; ++r) ps += p1[r];
    { auto rr = __builtin_amdgcn_permlane32_swap(__float_as_uint(ps), __float_as_uint(ps), false, false);
      ps = __uint_as_float(rr[0]) + __uint_as_float(rr[1]); }
    l_reg = l_reg * alpha + ps;
#define DA_PK4(P, B_, OUT) do { unsigned a0 = cvtpk(P[B_+0], P[B_+1]), a1 = cvtpk(P[B_+2], P[B_+3]);                          \
        unsigned b0 = cvtpk(P[B_+4], P[B_+5]), b1 = cvtpk(P[B_+6], P[B_+7]);                                             \
        auto r0 = __builtin_amdgcn_permlane32_swap(a0, b0, false, false); auto r1 = __builtin_amdgcn_permlane32_swap(a1, b1, false, false); \
        u32x4 w = {r0[0], r1[0], r0[1], r1[1]}; OUT = *reinterpret_cast<bf16x8*>(&w); } while (0)
    DA_PK4(p0, 0, pa0); DA_PK4(p0, 8, pa1); DA_PK4(p1, 0, pa2); DA_PK4(p1, 8, pa3);
#undef DA_PK4
}
template <int KB>
__device__ __forceinline__ void qkt(f32x16& p0, f32x16& p1, const DLAS char* K_lds, int r32, int hi, const bf16x8* qr) {
    p0 = f32x16{}; p1 = f32x16{};
#pragma unroll
    for (int d0 = 0; d0 < 4; ++d0) { const DLAS char* a = K_lds + KB * SHM_K + DA_KSWZ(r32, d0 * 2 + hi);
        const bf16x8 b0 = *reinterpret_cast<const DLAS bf16x8*>(a);
        const bf16x8 b1 = *reinterpret_cast<const DLAS bf16x8*>(a + 32 * 128);
        p0 = __builtin_amdgcn_mfma_f32_32x32x16_bf16(b0, qr[d0], p0, 0, 0, 0);
        p1 = __builtin_amdgcn_mfma_f32_32x32x16_bf16(b1, qr[d0], p1, 0, 0, 0); }
}
template <int VB>
__device__ __forceinline__ void pv_tile(f32x16* o, int vb0, bf16x8 pa0, bf16x8 pa1, bf16x8 pa2, bf16x8 pa3) {
#define DA_TRRD(dst, off) asm volatile("ds_read_b64_tr_b16 %0, %1 offset:%2" : "=&v"(dst) : "v"(vb0), "i"(off) : "memory")
#define DA_PV_D0(d0) do { s16x4 l0, l1, l2, l3, h0, h1, h2, h3; constexpr int b_ = VB * SHM_V + v_rd_off(d0, 0, 0); \
        DA_TRRD(l0, b_); DA_TRRD(h0, b_ + 2048); DA_TRRD(l1, b_ + 4096); DA_TRRD(h1, b_ + 6144); DA_TRRD(l2, b_ + 8192); DA_TRRD(h2, b_ + 10240); DA_TRRD(l3, b_ + 12288); DA_TRRD(h3, b_ + 14336); \
        asm volatile("s_waitcnt lgkmcnt(0)" ::: "memory"); DA_SBAR();   \
        o[d0] = __builtin_amdgcn_mfma_f32_32x32x16_bf16(pa0, (bf16x8){l0[0], l0[1], l0[2], l0[3], h0[0], h0[1], h0[2], h0[3]}, o[d0], 0, 0, 0);   \
        o[d0] = __builtin_amdgcn_mfma_f32_32x32x16_bf16(pa1, (bf16x8){l1[0], l1[1], l1[2], l1[3], h1[0], h1[1], h1[2], h1[3]}, o[d0], 0, 0, 0);   \
        o[d0] = __builtin_amdgcn_mfma_f32_32x32x16_bf16(pa2, (bf16x8){l2[0], l2[1], l2[2], l2[3], h2[0], h2[1], h2[2], h2[3]}, o[d0], 0, 0, 0);   \
        o[d0] = __builtin_amdgcn_mfma_f32_32x32x16_bf16(pa3, (bf16x8){l3[0], l3[1], l3[2], l3[3], h3[0], h3[1], h3[2], h3[3]}, o[d0], 0, 0, 0); } while (0)
    DA_PV_D0(0); DA_PV_D0(1); DA_PV_D0(2); DA_PV_D0(3);
#undef DA_PV_D0
#undef DA_TRRD
}
template <bool ORDER_B>
__device__ __forceinline__ void attn_block(const unsigned short* __restrict__ Qp, const unsigned short* __restrict__ Kp, const unsigned short* __restrict__ Vp, int P0, DLAS char* lds, float c31, f32x16 (&o)[4]) {
    const int tid = threadIdx.x, wid = __builtin_amdgcn_readfirstlane(tid >> 6), lane = tid & 63, r32 = lane & 31, hi = lane >> 5;
    const int NT = (P0 + QB) / KVBLK;
    const int qlo = P0 + wid * QBLK, qm = qlo + r32 - 4 * hi;
    DLAS char* V_lds = lds + OFF_V; DLAS char* K_lds = lds + OFF_K;
    DLAS float* wsf = (DLAS float*)(lds + OFF_WS) + wid * 64; DLAS float* li_l = wsf; DLAS float* al_l = wsf + 32;
    const DLAS float* lut = (const DLAS float*)(lds + OFF_LUT);
    float m_reg = -1e30f, l_reg = 0.f;
#pragma unroll
    for (int d = 0; d < 4; ++d) o[d] = f32x16{};
    const int sr = tid >> 4, sc = (tid & 15) * 8, vst0 = v_st(sr, sc), vst1 = v_st(32 + sr, sc);
    const int kr = tid >> 3, kc = tid & 7, kws = DA_KSWZ(kr, kc);
    const int vb0 = (int)(uintptr_t)V_lds + v_rd_base(lane);
    bf16x8 qr[4];
#pragma unroll
    for (int d0 = 0; d0 < 4; ++d0) qr[d0] = *reinterpret_cast<const bf16x8*>(Qp + (size_t)(wid * QBLK + r32) * PITCH + d0 * 16 + hi * 8);
    bf16x8 st_v0, st_v1, st_k0;
#define DA_VMW() asm volatile("s_waitcnt vmcnt(0)" ::: "memory")
#define DA_SLOAD(k0) do { st_v0 = *reinterpret_cast<const bf16x8*>(Vp + (size_t)((k0) + sr) * PITCH + sc); st_v1 = *reinterpret_cast<const bf16x8*>(Vp + (size_t)((k0) + 32 + sr) * PITCH + sc); \
                          st_k0 = *reinterpret_cast<const bf16x8*>(Kp + (size_t)((k0) + kr) * PITCH + kc * 8); } while (0)
#define DA_SWRITE(bf) do { *reinterpret_cast<DLAS bf16x8*>(V_lds + (bf) * SHM_V + vst0) = st_v0; *reinterpret_cast<DLAS bf16x8*>(V_lds + (bf) * SHM_V + vst1) = st_v1; \
                           *reinterpret_cast<DLAS bf16x8*>(K_lds + (bf) * SHM_K + kws) = st_k0; } while (0)
#define DA_RESC(a) do { if (__any((a) < 1.f)) { if (hi == 0) al_l[r32] = (a); asm volatile("s_waitcnt lgkmcnt(0)" ::: "memory");              \
                        _Pragma("unroll") for (int d_ = 0; d_ < 4; ++d_) _Pragma("unroll") for (int r = 0; r < 16; ++r) o[d_][r] *= al_l[crow(r, hi)]; } } while (0)
#define DA_BIASMASK(P0_, P1_, t, cbv) do { const int kb_ = (t) * KVBLK; if (kb_ + KVBLK - 1 + 128 > qlo) { bias_tile(P0_, P1_, qm - kb_, lut); cbv = 0.f; if (kb_ + KVBLK - 1 > qlo) mask_tile(P0_, P1_, qm - kb_); } else cbv = c31; } while (0)
    f32x16 pA0, pA1, pB0, pB1; float alA, alB, cbA, cbB; bf16x8 pa0, pa1, pa2, pa3;
    DA_SLOAD(0); DA_VMW(); DA_SWRITE(0); DA_SBAR();
    DA_SLOAD(KVBLK);
    __syncthreads();
    DA_SBAR(); qkt<0>(pA0, pA1, K_lds, r32, hi, qr);
    DA_BIASMASK(pA0, pA1, 0, cbA); partialSM(pA0, pA1, m_reg, alA, cbA);
    DA_VMW(); DA_SWRITE(1);
    __syncthreads();
#define DA_HALF_STEP(PX0, PX1, alX, cbX, PY0, PY1, alY, t, KB, VB, SB) do {                                                      \
        DA_SBAR(); DA_SLOAD(((t) + 1) * KVBLK); DA_SBAR();              \
        if constexpr (!ORDER_B) {                                                                                               \
            qkt<KB>(PX0, PX1, K_lds, r32, hi, qr);                                                                     \
            finishSM(PY0, PY1, alY, l_reg, pa0, pa1, pa2, pa3); DA_SBAR();                                                       \
            pv_tile<VB>(o, vb0, pa0, pa1, pa2, pa3); DA_BIASMASK(PX0, PX1, (t), cbX); partialSM(PX0, PX1, m_reg, alX, cbX);      \
        } else {                                                                                                                \
            finishSM(PY0, PY1, alY, l_reg, pa0, pa1, pa2, pa3); DA_SBAR();                                            \
            pv_tile<VB>(o, vb0, pa0, pa1, pa2, pa3); DA_SBAR();                                                                   \
            qkt<KB>(PX0, PX1, K_lds, r32, hi, qr); DA_BIASMASK(PX0, PX1, (t), cbX); partialSM(PX0, PX1, m_reg, alX, cbX);        \
        }                                                                                                                       \
        __syncthreads();                                                                                                      \
        DA_VMW(); DA_SWRITE(SB);                                                                          \
        DA_RESC(alX); __syncthreads(); } while (0)
    for (int t = 1; t + 1 < NT; t += 2) {
        DA_HALF_STEP(pB0, pB1, alB, cbB, pA0, pA1, alA, t, 1, 0, 0);
        DA_HALF_STEP(pA0, pA1, alA, cbA, pB0, pB1, alB, t + 1, 0, 1, 1);
    }
    DA_SBAR(); qkt<1>(pB0, pB1, K_lds, r32, hi, qr); DA_SBAR();
    finishSM(pA0, pA1, alA, l_reg, pa0, pa1, pa2, pa3); DA_SBAR();
    pv_tile<0>(o, vb0, pa0, pa1, pa2, pa3);
    DA_BIASMASK(pB0, pB1, NT - 1, cbB); partialSM(pB0, pB1, m_reg, alB, cbB); DA_RESC(alB);
    finishSM(pB0, pB1, alB, l_reg, pa0, pa1, pa2, pa3); DA_SBAR(); pv_tile<1>(o, vb0, pa0, pa1, pa2, pa3);
    if (hi == 0) li_l[r32] = l_reg; asm volatile("s_waitcnt lgkmcnt(0)" ::: "memory");
#pragma unroll
    for (int r = 0; r < 16; ++r) { const float rl = __builtin_amdgcn_rcpf(li_l[crow(r, hi)]);
#pragma unroll
        for (int d0 = 0; d0 < 4; ++d0) o[d0][r] *= rl; }
    __syncthreads();
#undef DA_VMW
#undef DA_SLOAD
#undef DA_SWRITE
#undef DA_RESC
#undef DA_BIASMASK
#undef DA_HALF_STEP
}
}
static_assert(da::LDS_BYTES <= 131072, "attention LDS inside the ring region");
namespace da2 {
typedef short bf16x8 __attribute__((ext_vector_type(8)));
typedef short s16x4 __attribute__((ext_vector_type(4)));
typedef float f32x16 __attribute__((ext_vector_type(16)));
typedef float f32x4 __attribute__((ext_vector_type(4)));
typedef unsigned u32x4 __attribute__((ext_vector_type(4)));
#define D2LAS __attribute__((address_space(3)))
constexpr int NW = 8, QBLK = 32, KVBLK = 64, QB = NW * QBLK, PITCH = 3072;
constexpr int KSLOT = 8192, VSLOT = 16384, NKS = 3, NVS = 4;
constexpr int OFF_K = 0, OFF_V = NKS * KSLOT, OFF_WS = OFF_V + NVS * VSLOT, OFF_LUT = OFF_WS + NW * 64 * 4, LDS_BYTES = OFF_LUT + 4 * 2048;
constexpr int STG_PITCH = 272, STG_WAVE = 32 * STG_PITCH;
constexpr float THR = 8.f;
#define D2_SBAR() __builtin_amdgcn_sched_barrier(0)
__device__ __forceinline__ int crow(int r, int hi) { return (r & 3) + 8 * (r >> 2) + 4 * hi; }
typedef float f32x2_t __attribute__((ext_vector_type(2))); typedef __bf16 bf16x2_t __attribute__((ext_vector_type(2)));
__device__ __forceinline__ unsigned cvtpk(float lo, float hi) { f32x2_t v = {lo, hi}; bf16x2_t b = __builtin_convertvector(v, bf16x2_t); return __builtin_bit_cast(unsigned, b); }
__device__ __forceinline__ void glds16(const void* gsrc, unsigned lds_dst) { unsigned keep;
    asm volatile("s_mov_b32 %0, m0\n\ts_mov_b32 m0, %2\n\ts_nop 0\n\tglobal_load_lds_dwordx4 %1, off\n\ts_mov_b32 m0, %0" : "=&s"(keep) : "v"(gsrc), "s"(lds_dst) : "memory"); }
#define D2_WAIT_BAR(N) asm volatile("s_waitcnt vmcnt(" #N ") lgkmcnt(0)\n\ts_barrier" ::: "memory")
constexpr int TBL_X0 = 224, TBL_N = 512, TBL_COPY_BYTES = TBL_N * 4;
__device__ __forceinline__ void bias_mask_tile(f32x16& p0, f32x16& p1, int dq, const D2LAS char* tbl_lane  ) {
    const D2LAS char* a = tbl_lane - 4 * dq;
#pragma unroll
    for (int g = 0; g < 4; ++g) { const f32x4 t0 = *reinterpret_cast<const D2LAS f32x4*>(a + 32 * g), t1 = *reinterpret_cast<const D2LAS f32x4*>(a + 32 * g + 128);
#pragma unroll
        for (int i = 0; i < 4; ++i) { p0[4 * g + i] += t0[i]; p1[4 * g + i] += t1[i]; } }
}
__device__ __forceinline__ float rowmax(const f32x16& p0, const f32x16& p1) {
    float a = fmaxf(fmaxf(p0[0], p0[1]), p1[0]), b = fmaxf(fmaxf(p0[2], p0[3]), p1[1]); a = fmaxf(fmaxf(a, p1[2]), p1[3]);
#pragma unroll
    for (int r = 4; r < 16; r += 4) { a = fmaxf(fmaxf(a, p0[r]), p0[r + 1]); b = fmaxf(fmaxf(b, p0[r + 2]), p0[r + 3]); a = fmaxf(fmaxf(a, p1[r]), p1[r + 1]); b = fmaxf(fmaxf(b, p1[r + 2]), p1[r + 3]); }
    float m = fmaxf(a, b);
    auto rr = __builtin_amdgcn_permlane32_swap(__float_as_uint(m), __float_as_uint(m), false, false);
    return fmaxf(__uint_as_float(rr[0]), __uint_as_float(rr[1]));
}
__device__ __forceinline__ void qkt(f32x16& p0, f32x16& p1, const D2LAS char* Kslot, int r32, int hi, const bf16x8* qr, const f32x16& cinit) {
    const int sw = (r32 >> 1) & 7;
#pragma unroll
    for (int d0 = 0; d0 < 4; ++d0) { const D2LAS char* a = Kslot + r32 * 128 + (((d0 * 2 + hi) ^ sw) << 4);
        const bf16x8 b0 = *reinterpret_cast<const D2LAS bf16x8*>(a), b1 = *reinterpret_cast<const D2LAS bf16x8*>(a + 32 * 128);
        if (d0 == 0) { p0 = __builtin_amdgcn_mfma_f32_32x32x16_bf16(b0, qr[0], cinit, 0, 0, 0); p1 = __builtin_amdgcn_mfma_f32_32x32x16_bf16(b1, qr[0], cinit, 0, 0, 0); }
        else { p0 = __builtin_amdgcn_mfma_f32_32x32x16_bf16(b0, qr[d0], p0, 0, 0, 0); p1 = __builtin_amdgcn_mfma_f32_32x32x16_bf16(b1, qr[d0], p1, 0, 0, 0); } }
}
__device__ __forceinline__ void pv_tile(f32x16* o, int vb, bf16x8 pa0, bf16x8 pa1, bf16x8 pa2, bf16x8 pa3) {
#define D2_TRRD(dst, off) asm volatile("ds_read_b64_tr_b16 %0, %1 offset:%2" : "=&v"(dst) : "v"(vb), "i"(off) : "memory")
#define D2_PV(dq) do { s16x4 l0, l1, l2, l3, h0, h1, h2, h3; constexpr int b_ = (dq) * 4096; \
        D2_TRRD(l0, b_); D2_TRRD(h0, b_ + 512); D2_TRRD(l1, b_ + 1024); D2_TRRD(h1, b_ + 1536); D2_TRRD(l2, b_ + 2048); D2_TRRD(h2, b_ + 2560); D2_TRRD(l3, b_ + 3072); D2_TRRD(h3, b_ + 3584); \
        asm volatile("s_waitcnt lgkmcnt(0)" ::: "memory"); D2_SBAR();   \
        o[dq] = __builtin_amdgcn_mfma_f32_32x32x16_bf16(pa0, (bf16x8){l0[0], l0[1], l0[2], l0[3], h0[0], h0[1], h0[2], h0[3]}, o[dq], 0, 0, 0);   \
        o[dq] = __builtin_amdgcn_mfma_f32_32x32x16_bf16(pa1, (bf16x8){l1[0], l1[1], l1[2], l1[3], h1[0], h1[1], h1[2], h1[3]}, o[dq], 0, 0, 0);   \
        o[dq] = __builtin_amdgcn_mfma_f32_32x32x16_bf16(pa2, (bf16x8){l2[0], l2[1], l2[2], l2[3], h2[0], h2[1], h2[2], h2[3]}, o[dq], 0, 0, 0);   \
        o[dq] = __builtin_amdgcn_mfma_f32_32x32x16_bf16(pa3, (bf16x8){l3[0], l3[1], l3[2], l3[3], h3[0], h3[1], h3[2], h3[3]}, o[dq], 0, 0, 0); } while (0)
    D2_PV(0); D2_PV(1); D2_PV(2); D2_PV(3);
#undef D2_PV
#undef D2_TRRD
}
__device__ __forceinline__ void attn_block(const unsigned short* __restrict__ Qp, const unsigned short* __restrict__ Kp, const unsigned short* __restrict__ Vp, int P0, D2LAS char* lds, float c31, f32x16 (&o)[4]) {
    const int tid = threadIdx.x, wid = __builtin_amdgcn_readfirstlane(tid >> 6), lane = tid & 63, r32 = lane & 31, hi = lane >> 5;
    const int NT = (P0 + QB) / KVBLK;
    const int qlo = P0 + wid * QBLK, qm = qlo + r32 - 4 * hi;
    const unsigned lds0 = (unsigned)(uintptr_t)lds;
    D2LAS float* wsf = (D2LAS float*)(lds + OFF_WS) + wid * 64;
    const D2LAS char* tbl_lane = lds + OFF_LUT + ((-r32) & 3) * TBL_COPY_BYTES + 4 * (TBL_X0 - ((-r32) & 3));
    const int krow = wid * 8 + (lane >> 3);
    const unsigned short* ksrc = Kp + (size_t)krow * PITCH + (((lane & 7) ^ ((krow >> 1) & 7)) * 8);
    const unsigned short* vsrc = Vp + (size_t)(16 * (wid & 3) + (lane >> 2)) * PITCH + (wid >> 2) * 32 + (lane & 3) * 8;
    const unsigned kdst = lds0 + OFF_K + wid * 1024, vdst = lds0 + OFF_V + wid * 1024;
    int ks_i = 0, vs_i = 0;
    int jt = 0;
#define D2_DMA() do { glds16(ksrc + (size_t)jt * (KVBLK * PITCH), (unsigned)__builtin_amdgcn_readfirstlane(kdst + ks_i * KSLOT)); \
        glds16(vsrc + (size_t)jt * (KVBLK * PITCH), (unsigned)__builtin_amdgcn_readfirstlane(vdst + vs_i * VSLOT)); \
        glds16(vsrc + (size_t)jt * (KVBLK * PITCH) + 64, (unsigned)__builtin_amdgcn_readfirstlane(vdst + vs_i * VSLOT + 8192)); \
        ++jt; ks_i = ks_i == NKS - 1 ? 0 : ks_i + 1; vs_i = vs_i == NVS - 1 ? 0 : vs_i + 1; } while (0)
    bf16x8 qr[4];
#pragma unroll
    for (int d0 = 0; d0 < 4; ++d0) qr[d0] = *reinterpret_cast<const bf16x8*>(Qp + (size_t)(wid * QBLK + r32) * PITCH + d0 * 16 + hi * 8);
    D2_DMA(); D2_DMA(); D2_DMA();
    const D2LAS char* Kl = lds + OFF_K;
    const int vb0 = (int)(lds0 + OFF_V) + ((lane >> 4) & 1) * 32 + (lane & 3) * 8 + (4 * hi + ((lane & 15) >> 2)) * 64;
    float M = 0.f, l_reg = 0.f;
#pragma unroll
    for (int d = 0; d < 4; ++d) o[d] = f32x16{};
    f32x16 negb;
#pragma unroll
    for (int r = 0; r < 16; ++r) negb[r] = c31;
    f32x16 pA0, pA1, pB0, pB1; bf16x8 pa0, pa1, pa2, pa3;
    int kc = 0, vp = 0;
#define D2_BIASMASK(P0_, P1_, t) do { const int kb_ = (t) * KVBLK; if (kb_ + KVBLK - 1 + 128 > qlo) bias_mask_tile(P0_, P1_, qm - kb_, tbl_lane); } while (0)
#define D2_DECIDE(PX0, PX1, first) do { const float rm = rowmax(PX0, PX1); resc = false; \
        if ((first) || __builtin_expect(__any(rm > THR), 0)) { const float dl = (first) ? rm : fmaxf(rm, 0.f); M += dl; \
            _Pragma("unroll") for (int r = 0; r < 16; ++r) { PX0[r] -= dl; PX1[r] -= dl; } \
            _Pragma("unroll") for (int r = 0; r < 16; ++r) negb[r] = c31 - M; \
            const float f = __builtin_amdgcn_exp2f(-dl); l_reg *= f; if (hi == 0) wsf[r32] = f; resc = !(first); } \
        _Pragma("unroll") for (int r = 0; r < 16; ++r) { PX0[r] = __builtin_amdgcn_exp2f(PX0[r]); PX1[r] = __builtin_amdgcn_exp2f(PX1[r]); } } while (0)
#define D2_RESC() do { if (resc) { asm volatile("s_waitcnt lgkmcnt(0)" ::: "memory"); \
        _Pragma("unroll") for (int d_ = 0; d_ < 4; ++d_) _Pragma("unroll") for (int r = 0; r < 16; ++r) o[d_][r] *= wsf[crow(r, hi)]; } } while (0)
#define D2_FINISH(PY0, PY1) do { float s_ = 0.f; _Pragma("unroll") for (int r = 0; r < 16; ++r) s_ += PY0[r] + PY1[r]; l_reg += s_; \
        { u32x4 w_ = {cvtpk(PY0[0], PY0[1]), cvtpk(PY0[2], PY0[3]), cvtpk(PY0[4], PY0[5]), cvtpk(PY0[6], PY0[7])}; pa0 = __builtin_bit_cast(bf16x8, w_); } \
        { u32x4 w_ = {cvtpk(PY0[8], PY0[9]), cvtpk(PY0[10], PY0[11]), cvtpk(PY0[12], PY0[13]), cvtpk(PY0[14], PY0[15])}; pa1 = __builtin_bit_cast(bf16x8, w_); } \
        { u32x4 w_ = {cvtpk(PY1[0], PY1[1]), cvtpk(PY1[2], PY1[3]), cvtpk(PY1[4], PY1[5]), cvtpk(PY1[6], PY1[7])}; pa2 = __builtin_bit_cast(bf16x8, w_); } \
        { u32x4 w_ = {cvtpk(PY1[8], PY1[9]), cvtpk(PY1[10], PY1[11]), cvtpk(PY1[12], PY1[13]), cvtpk(PY1[14], PY1[15])}; pa3 = __builtin_bit_cast(bf16x8, w_); } } while (0)
#define D2_ENDW(t) do { if ((t) + 2 < NT) { D2_WAIT_BAR(5); } else if ((t) + 1 < NT) { D2_WAIT_BAR(2); } else { D2_WAIT_BAR(0); } } while (0)
    bool resc = false;
    D2_WAIT_BAR(8);
    qkt(pA0, pA1, Kl, r32, hi, qr, negb); D2_BIASMASK(pA0, pA1, 0); D2_DECIDE(pA0, pA1, true);
    D2_WAIT_BAR(5);
    kc = 1; vp = 0;
#define D2_HALF_STEP(PX0, PX1, PY0, PY1, t) do { \
        if ((t) + 2 < NT) D2_DMA(); \
        qkt(PX0, PX1, Kl + kc * KSLOT, r32, hi, qr, negb); \
        D2_FINISH(PY0, PY1); D2_SBAR(); \
        pv_tile(o, vb0 + vp * VSLOT, pa0, pa1, pa2, pa3); \
        D2_BIASMASK(PX0, PX1, (t)); D2_DECIDE(PX0, PX1, false); D2_RESC(); \
        D2_ENDW(t); kc = kc == NKS - 1 ? 0 : kc + 1; vp = vp == NVS - 1 ? 0 : vp + 1; } while (0)
    for (int t = 1; t + 1 < NT; t += 2) {
        D2_HALF_STEP(pB0, pB1, pA0, pA1, t);
        D2_HALF_STEP(pA0, pA1, pB0, pB1, t + 1);
    }
    D2_HALF_STEP(pB0, pB1, pA0, pA1, NT - 1);
    D2_FINISH(pB0, pB1); D2_SBAR(); pv_tile(o, vb0 + vp * VSLOT, pa0, pa1, pa2, pa3);
    { auto rr = __builtin_amdgcn_permlane32_swap(__float_as_uint(l_reg), __float_as_uint(l_reg), false, false); l_reg = __uint_as_float(rr[0]) + __uint_as_float(rr[1]); }
    if (hi == 0) wsf[32 + r32] = l_reg; asm volatile("s_waitcnt lgkmcnt(0)" ::: "memory");
#pragma unroll
    for (int r = 0; r < 16; ++r) { const float rl = __builtin_amdgcn_rcpf(wsf[32 + crow(r, hi)]);
#pragma unroll
        for (int d0 = 0; d0 < 4; ++d0) o[d0][r] *= rl; }
    asm volatile("s_waitcnt lgkmcnt(0)\n\ts_barrier" ::: "memory");
#undef D2_DMA
#undef D2_BIASMASK
#undef D2_DECIDE
#undef D2_RESC
#undef D2_FINISH
#undef D2_ENDW
#undef D2_HALF_STEP
}
}
static_assert(da2::LDS_BYTES <= 131072, "attention v2 LDS inside the ring region");
constexpr int NWAVES = 8;
#ifndef MK_N_LAUNCHES
#define MK_N_LAUNCHES 1
#endif
constexpr int BATCH = 16, SEQ = 2048, D = 1024, FF = 4096, M = BATCH * SEQ;
constexpr int NQKV = 3072;
constexpr int MLW = 3080, NPROJ = 3072;
constexpr int NH_A = 8, NH_M = 4;
constexpr float EPS = 1e-6f, LOG2E = 1.4426950408889634f;
constexpr float QSCALE = 0.125f * LOG2E;
constexpr float LAMBDA_INIT0 = 0.2f;
constexpr float MQSCALE = 0.08838834764831845f;
constexpr int NPHASE = 16;
constexpr int DUP_PHASE = -1;

namespace ml {
typedef short bf16x8 __attribute__((ext_vector_type(8)));
typedef short s16x4 __attribute__((ext_vector_type(4)));
typedef float f32x16 __attribute__((ext_vector_type(16)));
typedef float f32x4 __attribute__((ext_vector_type(4)));
typedef unsigned u32x4 __attribute__((ext_vector_type(4)));
typedef unsigned u32x2 __attribute__((ext_vector_type(2)));
#define MLAS __attribute__((address_space(3)))
constexpr int L = 64, NC = 2048 / L, PITCH = 3072;
constexpr int PQ = 272, PS = 144;
constexpr int O_Q = 0, O_K = O_Q + 64 * PQ, O_C = O_K + 64 * PQ, O_KW = O_C + 64 * PQ, O_V = O_KW + 16384, O_SC = O_V + 16384, O_ARR = O_SC + 64 * PS, O_NP = O_ARR + 9 * 256, O_N = O_NP + 4096, O_OUT = O_N + 512, O_OSS = O_OUT + 8192, LDS_BYTES = O_OSS + 512;
enum { A_E = 0, A_BM = 64, A_INTER = 128, A_EMJ = 192, A_WP = 256, A_RS0 = 320, A_RS1 = 384, A_QN = 448, A_SCAL = 512 };
__device__ __forceinline__ float bf2f_lo(unsigned w) { return __uint_as_float(w << 16); }
__device__ __forceinline__ float bf2f_hi(unsigned w) { return __uint_as_float(w & 0xffff0000u); }
typedef float f32x2_t __attribute__((ext_vector_type(2))); typedef __bf16 bf16x2_t __attribute__((ext_vector_type(2)));
__device__ __forceinline__ unsigned cvtpk(float lo, float hi) { f32x2_t v = {lo, hi}; bf16x2_t b = __builtin_convertvector(v, bf16x2_t); return __builtin_bit_cast(unsigned, b); }
__device__ __forceinline__ int crow(int r, int hi) { return (r & 3) + 8 * (r >> 2) + 4 * hi; }
__device__ __forceinline__ int v_st(int k, int c) { const int kk = (k & ~0xC) | ((k & 4) << 1) | ((k & 8) >> 1); return ((kk >> 3) * 4 + (c >> 5)) * 512 + ((kk & 7) * 32 + (c & 31)) * 2; }
__device__ __forceinline__ int v_rd_base(int lane) { return ((lane & 3) << 3) | (((lane >> 2) & 3) << 6) | (((lane >> 4) & 1) << 5) | (((lane >> 5) & 1) << 8); }
#define ML_TRRD(dst, base, off) asm volatile("ds_read_b64_tr_b16 %0, %1 offset:%2" : "=&v"(dst) : "v"(base), "i"(off) : "memory")
#define ML_SBAR() __builtin_amdgcn_sched_barrier(0)
#define ML_FR(lo, hi_) (bf16x8){lo[0], lo[1], lo[2], lo[3], hi_[0], hi_[1], hi_[2], hi_[3]}
struct Pre { bf16x8 q[2], k[2], v; f32x4 g; };

__device__ __forceinline__ void mlstm_unit(int b, int h, int s4, const unsigned short* __restrict__ PROJ, const unsigned short* __restrict__ QKC, const float* __restrict__ GS,
                                           unsigned short* HT, float* SSQ, MLAS char* lds) {
    const int tid = threadIdx.x, wid = __builtin_amdgcn_readfirstlane(tid >> 6), lane = tid & 63, r32 = lane & 31, hi = lane >> 5;
    MLAS char* QIMG = lds + O_Q; MLAS char* KIMG = lds + O_K; MLAS char* CIMG = lds + O_C; MLAS char* KWTR = lds + O_KW; MLAS char* VTR = lds + O_V; MLAS char* SC = lds + O_SC;
    MLAS float* arr = (MLAS float*)(lds + O_ARR); MLAS float* npart = (MLAS float*)(lds + O_NP); MLAS float* nvec = (MLAS float*)(lds + O_N);
    MLAS char* OUT = lds + O_OUT; MLAS float* OSS = (MLAS float*)(lds + O_OSS);
    const int srow = tid >> 4, cg = tid & 15;
    const int vrow = tid >> 3, vcol = (tid & 7) * 8;
    const size_t tok0 = (size_t)b * 2048;
    const unsigned short* xq = QKC + tok0 * 1024 + h * 128 + cg * 8;
    const unsigned short* xk = xq + 512;
    const unsigned short* xv = PROJ + tok0 * PITCH + 1024 + h * 256 + s4 * 64 + vcol;
    const float* gs = GS + tok0 * 16 + h * 4;
    const int dkb = wid >> 1, dvb = wid & 1;
    const int tb0 = (wid & 3) >> 1, jb = wid & 1;
    f32x16 cst = f32x16{};
    float m_prev = 0.f;
    for (int i = tid; i < (64 * PQ) / 16; i += 512) ((MLAS u32x4*)CIMG)[i] = (u32x4){0u, 0u, 0u, 0u};
    if (tid < 128) nvec[tid] = 0.f;
    Pre P;
#define ML_LOAD(t0_) do { P.q[0] = *reinterpret_cast<const bf16x8*>(xq + (size_t)((t0_) + srow) * 1024); P.q[1] = *reinterpret_cast<const bf16x8*>(xq + (size_t)((t0_) + srow + 32) * 1024); \
        P.k[0] = *reinterpret_cast<const bf16x8*>(xk + (size_t)((t0_) + srow) * 1024); P.k[1] = *reinterpret_cast<const bf16x8*>(xk + (size_t)((t0_) + srow + 32) * 1024); \
        P.v = *reinterpret_cast<const bf16x8*>(xv + (size_t)((t0_) + vrow) * PITCH); P.g = *reinterpret_cast<const f32x4*>(gs + (size_t)((t0_) + lane) * 16); } while (0)
    ML_LOAD(0);
    const int trb_kw = (int)(uintptr_t)KWTR + v_rd_base(lane), trb_v = (int)(uintptr_t)VTR + v_rd_base(lane);
    __syncthreads();
    for (int c = 0; c < NC; ++c) {
        const int t0 = c * L;
        const float bsum = P.g[0], e = P.g[1], pm = P.g[2];
        asm volatile("" :: "v"(P.g[3]));
        const float b_last = __int_as_float(__builtin_amdgcn_readlane(__float_as_int(bsum), 63)), m_loc = b_last + __int_as_float(__builtin_amdgcn_readlane(__float_as_int(pm), 63));
        const float m_new = fmaxf(b_last + m_prev, m_loc), decay = __expf(b_last + m_prev - m_new);
        const float wp = __expf(b_last + e - m_new);
        const float m_inter = bsum + m_prev, m_j = fmaxf(m_inter, bsum + pm);
        if (wid == 0) { arr[A_E + lane] = e; arr[A_BM + lane] = bsum - m_j; arr[A_INTER + lane] = __expf(m_inter - m_j); arr[A_EMJ + lane] = __expf(-m_j); arr[A_WP + lane] = wp; }
        m_prev = m_new;
#pragma unroll
        for (int i = 0; i < 2; ++i) { const int row = srow + 32 * i; const float wrow = __shfl(wp, row);
            *reinterpret_cast<MLAS bf16x8*>(QIMG + row * PQ + cg * 16) = P.q[i];
            *reinterpret_cast<MLAS bf16x8*>(KIMG + row * PQ + cg * 16) = P.k[i];
            const u32x4 kw = __builtin_bit_cast(u32x4, P.k[i]); u32x4 ow;
#pragma unroll
            for (int q = 0; q < 4; ++q) ow[q] = cvtpk(bf2f_lo(kw[q]) * wrow, bf2f_hi(kw[q]) * wrow);
            *reinterpret_cast<MLAS u32x4*>(KWTR + v_st(row, cg * 8)) = ow; }
        *reinterpret_cast<MLAS bf16x8*>(VTR + v_st(vrow, vcol)) = P.v;
        __syncthreads();
#define ML_STORE_OUT(tt) do { { const int row_ = tid >> 3, ch_ = tid & 7; const u32x4 v_ = *reinterpret_cast<const MLAS u32x4*>(OUT + row_ * 128 + ch_ * 16); \
            *reinterpret_cast<u32x4*>(HT + (tok0 + (tt) + row_) * 1024 + h * 256 + s4 * 64 + ch_ * 8) = v_; } \
            if (tid < 128) SSQ[((size_t)((b * 4 + h) * 8 + s4 * 2 + (tid >> 6))) * 2048 + (tt) + (tid & 63)] = OSS[tid]; } while (0)
        if (c > 0) ML_STORE_OUT(t0 - L);
        { const int tn = (c + 1 < NC) ? t0 + L : t0; ML_LOAD(tn); }
        f32x16 acc_qc = f32x16{};
        if (wid < 4) {
            f32x16 g = f32x16{};
            if (!(tb0 == 1 && jb == 0)) {
                const MLAS char* ka = KIMG + (32 * tb0 + r32) * PQ + hi * 16; const MLAS char* qa = QIMG + (32 * jb + r32) * PQ + hi * 16;
bf16x8 fa[8], fb[8];
#pragma unroll
                for (int kk = 0; kk < 8; ++kk) { fa[kk] = *reinterpret_cast<const MLAS bf16x8*>(ka + kk * 32); fb[kk] = *reinterpret_cast<const MLAS bf16x8*>(qa + kk * 32); }
                ML_SBAR();
#pragma unroll
                for (int kk = 0; kk < 8; ++kk) g = __builtin_amdgcn_mfma_f32_32x32x16_bf16(fa[kk], fb[kk], g, 0, 0, 0);
            }
            const int j = 32 * jb + r32; const float bm = arr[A_BM + j]; float rsum = 0.f;
#pragma unroll
            for (int q4 = 0; q4 < 4; ++q4) { const f32x4 ev = *reinterpret_cast<const MLAS f32x4*>(arr + A_E + 32 * tb0 + 8 * q4 + 4 * hi);
                float sc4[4];
#pragma unroll
                for (int i = 0; i < 4; ++i) { const int s = 32 * tb0 + 8 * q4 + 4 * hi + i; const float v = (s <= j) ? g[4 * q4 + i] * __expf(bm + ev[i]) : 0.f; sc4[i] = v; rsum += v; }
                const u32x2 w = {cvtpk(sc4[0], sc4[1]), cvtpk(sc4[2], sc4[3])};
                *reinterpret_cast<MLAS u32x2*>(SC + j * PS + (32 * tb0 + 8 * q4 + 4 * hi) * 2) = w; }
            rsum += __shfl_xor(rsum, 32);
            if (hi == 0) arr[(tb0 ? A_RS1 : A_RS0) + j] = rsum;
        } else {
            const MLAS char* ca = CIMG + (32 * tb0 + r32) * PQ + hi * 16; const MLAS char* qa = QIMG + (32 * jb + r32) * PQ + hi * 16;
bf16x8 fa[8], fb[8];
#pragma unroll
            for (int kk = 0; kk < 8; ++kk) { fa[kk] = *reinterpret_cast<const MLAS bf16x8*>(ca + kk * 32); fb[kk] = *reinterpret_cast<const MLAS bf16x8*>(qa + kk * 32); }
            ML_SBAR();
#pragma unroll
            for (int kk = 0; kk < 8; ++kk) acc_qc = __builtin_amdgcn_mfma_f32_32x32x16_bf16(fa[kk], fb[kk], acc_qc, 0, 0, 0);
        }
        {
            const int j = tid >> 3, part = tid & 7;
            const u32x4 q0 = *reinterpret_cast<const MLAS u32x4*>(QIMG + j * PQ + part * 32), q1 = *reinterpret_cast<const MLAS u32x4*>(QIMG + j * PQ + part * 32 + 16);
            float s = 0.f;
#pragma unroll
            for (int q = 0; q < 4; ++q) { const f32x4 n4 = *reinterpret_cast<const MLAS f32x4*>(nvec + part * 16 + 4 * q);
                const unsigned w0 = q < 2 ? q0[2 * q] : q1[2 * q - 4], w1 = q < 2 ? q0[2 * q + 1] : q1[2 * q - 3];
                s += bf2f_lo(w0) * n4[0] + bf2f_hi(w0) * n4[1] + bf2f_lo(w1) * n4[2] + bf2f_hi(w1) * n4[3]; }
            s += __shfl_xor(s, 1); s += __shfl_xor(s, 2); s += __shfl_xor(s, 4);
            if (part == 0) arr[A_QN + j] = s;
            float n0 = 0.f, n1 = 0.f;
#pragma unroll
            for (int i = 0; i < 8; ++i) { const int srow = 8 * wid + i; const unsigned kw = *reinterpret_cast<const MLAS unsigned*>(KIMG + srow * PQ + lane * 4); const float w = arr[A_WP + srow];
                n0 += w * bf2f_lo(kw); n1 += w * bf2f_hi(kw); }
            npart[wid * 128 + 2 * lane] = n0; npart[wid * 128 + 2 * lane + 1] = n1;
        }
        __syncthreads();
        if (wid >= 4) {
            f32x16 acc_n = f32x16{};
            const MLAS char* sa = SC + (32 * jb + r32) * PS + hi * 16;
            {   s16x4 l0, l1, l2, l3, h0, h1, h2, h3;
                if (tb0 == 0) { ML_TRRD(l0, trb_v, 0); ML_TRRD(h0, trb_v, 2048); ML_TRRD(l1, trb_v, 4096); ML_TRRD(h1, trb_v, 6144); ML_TRRD(l2, trb_v, 8192); ML_TRRD(h2, trb_v, 10240); ML_TRRD(l3, trb_v, 12288); ML_TRRD(h3, trb_v, 14336); }
                else { ML_TRRD(l0, trb_v, 512); ML_TRRD(h0, trb_v, 512 + 2048); ML_TRRD(l1, trb_v, 512 + 4096); ML_TRRD(h1, trb_v, 512 + 6144); ML_TRRD(l2, trb_v, 512 + 8192); ML_TRRD(h2, trb_v, 512 + 10240); ML_TRRD(l3, trb_v, 512 + 12288); ML_TRRD(h3, trb_v, 512 + 14336); }
                const bf16x8 s0 = *reinterpret_cast<const MLAS bf16x8*>(sa), s1 = *reinterpret_cast<const MLAS bf16x8*>(sa + 32), s2 = *reinterpret_cast<const MLAS bf16x8*>(sa + 64), s3 = *reinterpret_cast<const MLAS bf16x8*>(sa + 96);
                asm volatile("s_waitcnt lgkmcnt(0)" ::: "memory"); ML_SBAR();
                acc_n = __builtin_amdgcn_mfma_f32_32x32x16_bf16(ML_FR(l0, h0), s0, acc_n, 0, 0, 0);
                acc_n = __builtin_amdgcn_mfma_f32_32x32x16_bf16(ML_FR(l1, h1), s1, acc_n, 0, 0, 0);
                acc_n = __builtin_amdgcn_mfma_f32_32x32x16_bf16(ML_FR(l2, h2), s2, acc_n, 0, 0, 0);
                acc_n = __builtin_amdgcn_mfma_f32_32x32x16_bf16(ML_FR(l3, h3), s3, acc_n, 0, 0, 0); }
            const int j = 32 * jb + r32; const float inter = arr[A_INTER + j];
            const float den = arr[A_RS0 + j] + arr[A_RS1 + j] + inter * arr[A_QN + j];
            const float rden = 1.f / fmaxf(fabsf(den), arr[A_EMJ + j]);
            float ss = 0.f;
#pragma unroll
            for (int q4 = 0; q4 < 4; ++q4) { float hv[4];
#pragma unroll
                for (int i = 0; i < 4; ++i) { hv[i] = (acc_n[4 * q4 + i] + inter * acc_qc[4 * q4 + i]) * rden; ss += hv[i] * hv[i]; }
                *reinterpret_cast<MLAS u32x2*>(OUT + j * 128 + (32 * tb0 + 8 * q4 + 4 * hi) * 2) = (u32x2){cvtpk(hv[0], hv[1]), cvtpk(hv[2], hv[3])}; }
            ss += __shfl_xor(ss, 32);
            if (hi == 0) OSS[tb0 * 64 + j] = ss;
        }
        {
            s16x4 al[4], ah[4], bl[4], bh[4];
#define ML_LD4(d0k, d0v) do { ML_TRRD(al[0], trb_kw, (d0k) * 512); ML_TRRD(ah[0], trb_kw, (d0k) * 512 + 2048); ML_TRRD(al[1], trb_kw, (d0k) * 512 + 4096); ML_TRRD(ah[1], trb_kw, (d0k) * 512 + 6144); \
            ML_TRRD(al[2], trb_kw, (d0k) * 512 + 8192); ML_TRRD(ah[2], trb_kw, (d0k) * 512 + 10240); ML_TRRD(al[3], trb_kw, (d0k) * 512 + 12288); ML_TRRD(ah[3], trb_kw, (d0k) * 512 + 14336); \
            ML_TRRD(bl[0], trb_v, (d0v) * 512); ML_TRRD(bh[0], trb_v, (d0v) * 512 + 2048); ML_TRRD(bl[1], trb_v, (d0v) * 512 + 4096); ML_TRRD(bh[1], trb_v, (d0v) * 512 + 6144); \
            ML_TRRD(bl[2], trb_v, (d0v) * 512 + 8192); ML_TRRD(bh[2], trb_v, (d0v) * 512 + 10240); ML_TRRD(bl[3], trb_v, (d0v) * 512 + 12288); ML_TRRD(bh[3], trb_v, (d0v) * 512 + 14336); } while (0)
            switch (wid) { case 0: ML_LD4(0, 0); break; case 1: ML_LD4(0, 1); break; case 2: ML_LD4(1, 0); break; case 3: ML_LD4(1, 1); break;
                           case 4: ML_LD4(2, 0); break; case 5: ML_LD4(2, 1); break; case 6: ML_LD4(3, 0); break; default: ML_LD4(3, 1); break; }
#undef ML_LD4
#pragma unroll
            for (int r = 0; r < 16; ++r) cst[r] *= decay;
            asm volatile("s_waitcnt lgkmcnt(0)" ::: "memory"); ML_SBAR();
#pragma unroll
            for (int ks = 0; ks < 4; ++ks) cst = __builtin_amdgcn_mfma_f32_32x32x16_bf16(ML_FR(al[ks], ah[ks]), ML_FR(bl[ks], bh[ks]), cst, 0, 0, 0);
            const int dv = 32 * dvb + r32;
#pragma unroll
            for (int q4 = 0; q4 < 4; ++q4) { const u32x2 w = {cvtpk(cst[4 * q4], cst[4 * q4 + 1]), cvtpk(cst[4 * q4 + 2], cst[4 * q4 + 3])};
                *reinterpret_cast<MLAS u32x2*>(CIMG + dv * PQ + (32 * dkb + 8 * q4 + 4 * hi) * 2) = w; }
        }
        if (tid < 128) { float s = nvec[tid] * decay;
#pragma unroll
            for (int w = 0; w < 8; ++w) s += npart[w * 128 + tid];
            nvec[tid] = s; }
        __syncthreads();
    }
    ML_STORE_OUT((NC - 1) * L);
#undef ML_STORE_OUT
#undef ML_LOAD
}
}
static_assert(ml::LDS_BYTES <= 131072, "mLSTM LDS inside the ring region");
constexpr size_t MiB = 1u << 20;
constexpr size_t WS_CTL = 0, CTL_ZERO_BYTES = 1 * MiB;
constexpr size_t WS_WQKV = 2 * MiB, WS_WAO = 8 * MiB, WS_WML = 10 * MiB  , WS_WMO = 17 * MiB, WS_W1 = 19 * MiB  , WS_W2 = 35 * MiB  ;
constexpr size_t WS_GATES = 51 * MiB;
constexpr size_t WS_SSQ = 52 * MiB;
constexpr size_t WS_GS = 56 * MiB;
constexpr size_t WS_SSQH = 58 * MiB;
constexpr size_t WS_XN = 64 * MiB;
constexpr size_t WS_U = 128 * MiB;
constexpr size_t WS_HT = 320 * MiB;
constexpr size_t WS_AO = 384 * MiB;
constexpr size_t WS_STASH = 448 * MiB;
constexpr size_t WS_END = 480 * MiB;
constexpr int CW_TMO = 0, CW_CODE = 1;
constexpr int CW_BAR = 4096;
constexpr int RING_OFF = 0, RING_BYTES = 131072;
constexpr int LDSCTL_OFF = RING_BYTES, MISC_OFF = LDSCTL_OFF + 320;
constexpr int EPIRED_OFF = LDSCTL_OFF + 1024;
constexpr int RSTD_OFF = EPIRED_OFF + 4096;
constexpr int LDS_BYTES = 147456;
static_assert(RSTD_OFF + 8192 <= LDS_BYTES, "LDS map");
static_assert(MISC_OFF + 128 <= LDS_BYTES, "LDS map");

#define GAS __attribute__((address_space(1)))
#define LAS __attribute__((address_space(3)))
typedef unsigned short bf16;
typedef unsigned v4u __attribute__((ext_vector_type(4)));
typedef float f32x4 __attribute__((ext_vector_type(4)));
typedef short bf16x8 __attribute__((ext_vector_type(8)));
typedef GAS unsigned gu32;
typedef GAS unsigned long long gu64;
#define RLX_AGENT __ATOMIC_RELAXED, __HIP_MEMORY_SCOPE_AGENT
#define LDS_WAIT() asm volatile("s_waitcnt lgkmcnt(0)" ::: "memory")
#define VM_WAIT() asm volatile("s_waitcnt vmcnt(0)" ::: "memory")
__device__ __forceinline__ unsigned long long rt() { return __builtin_amdgcn_s_memrealtime(); }
__device__ __forceinline__ unsigned f2bf(float f) { unsigned u = __builtin_bit_cast(unsigned, f); return (u + 0x7fffu + ((u >> 16) & 1u)) >> 16; }
__device__ __forceinline__ unsigned pk2(float lo, float hi) { return f2bf(lo) | (f2bf(hi) << 16); }

#define XB_TMO      128
#define XB_XCNT(j)  (256  + 64 * (j))
#define XB_XSUB(j)  (1280 + 64 * (j))
#define XB_XGEN(j)  (2304 + 64 * (j))
#define XB_TOP      3328
#define XB_TOPGEN   3392
#define XCD_BAR_WORDS 3456
#define XB_SPIN_CAP (1u << 23)

__device__ __forceinline__ unsigned xb_ld(unsigned* p)              { return __hip_atomic_load(p, __ATOMIC_RELAXED, __HIP_MEMORY_SCOPE_AGENT); }
__device__ __forceinline__ unsigned xb_add(unsigned* p, unsigned v) { return __hip_atomic_fetch_add(p, v, __ATOMIC_RELAXED, __HIP_MEMORY_SCOPE_AGENT); }
__device__ __forceinline__ unsigned xb_xcc_id() { return (unsigned)__builtin_amdgcn_s_getreg((3 << 11) | 20) & 0xFu; }
#define XB_SPIN(cond, bar) do { unsigned _sp = 0; while (cond) { __builtin_amdgcn_s_sleep(1); \
    if ((++_sp & 255u) == 0u) { if (xb_ld(&(bar)[XB_TMO])) break; if (_sp > XB_SPIN_CAP) { atomicAdd(&(bar)[XB_TMO], 1u); break; } } } } while (0)

struct XcdBarrier {
    unsigned* bar; unsigned x;
    volatile LAS unsigned* st;
};

__device__ __forceinline__ XcdBarrier xcd_barrier_post(unsigned* bar, volatile LAS unsigned* st) {
    XcdBarrier b; b.bar = bar; b.x = xb_xcc_id(); b.st = st;
    if (threadIdx.x == 0) (void)xb_add(&bar[XB_XCNT(b.x)], 1u);
    return b;
}
__device__ __forceinline__ void xcd_barrier_complete(unsigned* bar, unsigned x, unsigned& nloc, unsigned& nx) {
    const unsigned G = gridDim.x * gridDim.y * gridDim.z;
    unsigned sum, cnt, mine, sp = 0u;
    for (;;) {
        sum = 0u; cnt = 0u; mine = 0u;
#pragma unroll
        for (unsigned j = 0; j < 16; ++j) { const unsigned c = xb_ld(&bar[XB_XCNT(j)]); sum += c; cnt += (c > 0u) ? 1u : 0u; mine = (j == x) ? c : mine; }
        if (sum == G) break;
        __builtin_amdgcn_s_sleep(1);
        if ((++sp & 255u) == 0u) { if (xb_ld(&bar[XB_TMO])) break; if (sp > XB_SPIN_CAP) { atomicAdd(&bar[XB_TMO], 1u); break; } }
    }
    nloc = mine > 0u ? mine : 1u; nx = cnt > 0u ? cnt : 1u;
}

__device__ __forceinline__ void xcd_barrier(const XcdBarrier& b) {
    asm volatile("s_waitcnt vmcnt(0)" ::: "memory");
    __syncthreads();
    if (threadIdx.x == 0) {
        unsigned* bar = b.bar;
        __builtin_amdgcn_s_waitcnt(0);
        unsigned nloc = b.st[0], nx = b.st[1];
        if (nloc == 0u) { xcd_barrier_complete(bar, b.x, nloc, nx); b.st[0] = nloc; b.st[1] = nx; }
        const unsigned old = xb_add(&bar[XB_XSUB(b.x)], 1u);
        const unsigned gen = old / nloc;
        if (old + 1u == (gen + 1u) * nloc) {
            __builtin_amdgcn_fence(__ATOMIC_RELEASE, "agent");
            asm volatile("s_waitcnt vmcnt(0)" ::: "memory");
            const unsigned og = xb_add(&bar[XB_TOP], 1u);
            const unsigned tg = og / nx;
            if (og + 1u == (tg + 1u) * nx) xb_add(&bar[XB_TOPGEN], 1u);
            else XB_SPIN(xb_ld(&bar[XB_TOPGEN]) == tg, bar);
            __builtin_amdgcn_fence(__ATOMIC_ACQUIRE, "agent");
            xb_add(&bar[XB_XGEN(b.x)], 1u);
            asm volatile("s_waitcnt vmcnt(0)" ::: "memory");
        } else {
            XB_SPIN(xb_ld(&bar[XB_XGEN(b.x)]) == gen, bar);
            __builtin_amdgcn_fence(__ATOMIC_ACQUIRE, "agent");
            asm volatile("s_waitcnt vmcnt(0)" ::: "memory");
        }
    }
    __syncthreads();
}

struct Frame {
    LAS unsigned char* lds;
    volatile LAS unsigned* MISC;
    gu32* ctl;
    int tid, lane, wave;
    int vcu, G;
};
__device__ __forceinline__ float wave_sum(float v) {
#pragma unroll
    for (int o = 1; o < 64; o <<= 1) v += __shfl_xor(v, o);
    return v;
}
__device__ __forceinline__ void p0_transpose_item(const float* W, int K, int ldw, int nblk, bf16* WT, const float* gk, int gmask, float gs, LAS float* scr, int item, int lane) {
    const int kb = item / nblk, nb = item % nblk, k0 = 64 * kb, n0 = 64 * nb;
    f32x4 v[16];
#pragma unroll
    for (int i = 0; i < 16; ++i) v[i] = *(const GAS f32x4*)(W + (size_t)(k0 + 4 * i + (lane >> 4)) * ldw + n0 + (lane & 15) * 4);
#pragma unroll
    for (int i = 0; i < 16; ++i) { const int kk = 4 * i + (lane >> 4); const float g = gk ? gk[(k0 + kk) & gmask] * gs : gs; LAS float* d = scr + kk * 64; const int nn = (lane & 15) * 4 + kk;
        d[nn & 63] = v[i].x * g; d[(nn + 1) & 63] = v[i].y * g; d[(nn + 2) & 63] = v[i].z * g; d[(nn + 3) & 63] = v[i].w * g; }
    LDS_WAIT(); asm volatile("" ::: "memory");
    const int c = lane & 7;
#pragma unroll
    for (int j = 0; j < 8; ++j) { const int n = (lane >> 3) + 8 * j; const LAS float* s = scr + (8 * c) * 64; const int nn = n + 8 * c;
        v4u o; o.x = pk2(s[0 * 64 + (nn & 63)], s[1 * 64 + ((nn + 1) & 63)]); o.y = pk2(s[2 * 64 + ((nn + 2) & 63)], s[3 * 64 + ((nn + 3) & 63)]);
        o.z = pk2(s[4 * 64 + ((nn + 4) & 63)], s[5 * 64 + ((nn + 5) & 63)]); o.w = pk2(s[6 * 64 + ((nn + 6) & 63)], s[7 * 64 + ((nn + 7) & 63)]);
        *(GAS v4u*)(WT + (size_t)(n0 + n) * K + k0 + 8 * c) = o; }
    LDS_WAIT(); asm volatile("" ::: "memory");
}
__device__ __forceinline__ void rms_row_load(const float* xrow, int lane, f32x4 (&v)[4]) {
    const GAS f32x4* xr = (const GAS f32x4*)xrow + lane; float s2 = 0.f;
#pragma unroll
    for (int j = 0; j < 4; ++j) { v[j] = xr[64 * j]; s2 += (v[j].x * v[j].x + v[j].y * v[j].y) + (v[j].z * v[j].z + v[j].w * v[j].w); }
    const float rstd = 1.f / sqrtf(wave_sum(s2) * (1.f / D) + EPS);
#pragma unroll
    for (int j = 0; j < 4; ++j) v[j] = v[j] * rstd;
}
__device__ __forceinline__ void row_store_bf16(bf16* orow, int lane, const f32x4 (&v)[4]) {
    GAS unsigned long long* o8 = (GAS unsigned long long*)orow + lane;
#pragma unroll
    for (int j = 0; j < 4; ++j) o8[64 * j] = (unsigned long long)pk2(v[j].x, v[j].y) | ((unsigned long long)pk2(v[j].z, v[j].w) << 32);
}
__device__ __forceinline__ float log_sigmoid(float x) { return fminf(x, 0.f) - log1pf(expf(-fabsf(x))); }

struct Args { const float* in[22]; float* out; unsigned char* ws; int ph_lo, ph_hi, li, pad; };

__device__ __forceinline__ void p0_prologue(Frame& F, const Args& a) {
    unsigned char* ws = a.ws;
    LAS float* scr = (LAS float*)(F.lds + RING_OFF + F.wave * 16384);
    const int gw = F.vcu * NWAVES + F.wave, NGW = F.G * NWAVES;
    constexpr int I_QKV = (D / 64) * (NQKV / 64), I_O = (D / 64) * (D / 64), I_ML = (D / 64) * (NPROJ / 64), I_1 = (D / 64) * (FF / 64), I_2 = (FF / 64) * (D / 64);
    constexpr int NITEMS = I_QKV + I_O + I_ML + I_O + 2 * I_1 + 2 * I_2;
    for (int it = gw; it < NITEMS; it += NGW) {
        int r = it;
        if (r < I_QKV) { p0_transpose_item(a.in[3], D, NQKV, NQKV / 64, (bf16*)(ws + WS_WQKV), a.in[2], 0xffff, 1.f, scr, r, F.lane); continue; } r -= I_QKV;
        if (r < I_O) { p0_transpose_item(a.in[9], D, D, D / 64, (bf16*)(ws + WS_WAO), a.in[8], 127, 1.f - LAMBDA_INIT0, scr, r, F.lane); continue; } r -= I_O;
        if (r < I_ML) { p0_transpose_item(a.in[11], D, MLW, NPROJ / 64, (bf16*)(ws + WS_WML), a.in[10], 0xffff, 1.f, scr, r, F.lane); continue; } r -= I_ML;
        if (r < I_O) { p0_transpose_item(a.in[17], D, D, D / 64, (bf16*)(ws + WS_WMO), a.in[16], 0xffff, 1.f, scr, r, F.lane); continue; } r -= I_O;
        if (r < 2 * I_1) { const int l = r / I_1; p0_transpose_item(a.in[19] + (size_t)l * D * FF, D, FF, FF / 64, (bf16*)(ws + WS_W1) + (size_t)l * D * FF, a.in[18] + l * D, 0xffff, 1.f, scr, r % I_1, F.lane); continue; } r -= 2 * I_1;
        { const int l = r / I_2; p0_transpose_item(a.in[20] + (size_t)l * D * FF, FF, D, D / 64, (bf16*)(ws + WS_W2) + (size_t)l * D * FF, nullptr, 0, 1.f, scr, r % I_2, F.lane); }
    }
    { bf16* WT = (bf16*)(ws + WS_WML) + (size_t)NPROJ * D; const int gt = (F.vcu * NWAVES + F.wave) * 64 + F.lane, NGT = F.G * NWAVES * 64;
      for (int i = gt; i < 256 * D / 2; i += NGT) { const int j = (2 * i) / D, k = (2 * i) % D;
          const unsigned w = j < 8 ? pk2(a.in[10][k] * a.in[11][(size_t)k * MLW + NPROJ + j], a.in[10][k + 1] * a.in[11][(size_t)(k + 1) * MLW + NPROJ + j]) : 0u;
          ((GAS unsigned*)WT)[i] = w; } }
    bf16* XN = (bf16*)(ws + WS_XN); float* SSQH = (float*)(ws + WS_SSQH);
    for (int m = gw; m < M; m += NGW) { f32x4 v[4]; const GAS f32x4* xr = (const GAS f32x4*)(a.in[0] + (size_t)m * D) + F.lane; float s2 = 0.f;
#pragma unroll
        for (int j = 0; j < 4; ++j) { v[j] = xr[64 * j]; s2 += (v[j].x * v[j].x + v[j].y * v[j].y) + (v[j].z * v[j].z + v[j].w * v[j].w); }
        s2 = wave_sum(s2); row_store_bf16(XN + (size_t)m * D, F.lane, v);
        if (F.lane < 4) SSQH[(size_t)m * 4 + F.lane] = F.lane == 0 ? s2 : 0.f; }
}
__device__ __forceinline__ void final_norm_phase(Frame& F, const bf16* XN, const float* SSQH, const float* g, float* out) {
    const int gw = F.vcu * NWAVES + F.wave, NGW = F.G * NWAVES;
    for (int m = gw; m < M; m += NGW) {
        const float rstd = pg8::row_rstd(SSQH, m);
        const v4u h0 = *(const GAS v4u*)(XN + (size_t)m * D + F.lane * 16), h1 = *(const GAS v4u*)(XN + (size_t)m * D + F.lane * 16 + 8);
        GAS f32x4* o = (GAS f32x4*)(out + (size_t)m * D + F.lane * 16); const GAS f32x4* gg = (const GAS f32x4*)(g + F.lane * 16);
#pragma unroll
        for (int q = 0; q < 2; ++q) { const f32x4 a = gg[q];
            o[q] = (f32x4){__uint_as_float(h0[2 * q] << 16) * rstd * a.x, __uint_as_float(h0[2 * q] & 0xffff0000u) * rstd * a.y, __uint_as_float(h0[2 * q + 1] << 16) * rstd * a.z, __uint_as_float(h0[2 * q + 1] & 0xffff0000u) * rstd * a.w}; }
#pragma unroll
        for (int q = 0; q < 2; ++q) { const f32x4 a = gg[2 + q];
            o[2 + q] = (f32x4){__uint_as_float(h1[2 * q] << 16) * rstd * a.x, __uint_as_float(h1[2 * q] & 0xffff0000u) * rstd * a.y, __uint_as_float(h1[2 * q + 1] << 16) * rstd * a.z, __uint_as_float(h1[2 * q + 1] & 0xffff0000u) * rstd * a.w}; }
    }
}

__device__ __forceinline__ float bf2f(bf16 v) { return __uint_as_float((unsigned)v << 16); }
__device__ __forceinline__ int t5_bucket(int d) {
    if (d < 16) return d;
    const float v = logf((float)d / 16.f) / logf(8.f) * 16.f; int b = 16 + (int)v; return b > 31 ? 31 : b;
}
__device__ __forceinline__ void naive_attn_phase(Frame& F, const bf16* __restrict__ QKV, const float* __restrict__ rel_bias, const float* __restrict__ lq1, const float* __restrict__ lk1,
                                                  const float* __restrict__ lq2, const float* __restrict__ lk2, bf16* AO) {
    LAS float* lut = (LAS float*)(F.lds + RING_OFF);
    const int tid = F.tid, half = tid & 1;
    float s1 = 0.f, s2 = 0.f;
    for (int i = 0; i < 64; ++i) { s1 += lq1[i] * lk1[i]; s2 += lq2[i] * lk2[i]; }
    const float lam = expf(s1) - expf(s2) + LAMBDA_INIT0;
    for (int u = F.vcu; u < BATCH * NH_A * (SEQ / 256); u += F.G) {
        const int qb = u % (SEQ / 256), h = (u / (SEQ / 256)) % NH_A, b = u / (SEQ / 256) / NH_A, q0 = qb * 256, q = q0 + (tid >> 1);
        __syncthreads();
        if (tid < 128) lut[tid] = rel_bias[t5_bucket(tid) * NH_A + h] * LOG2E;
        __syncthreads();
        const size_t tok = (size_t)b * SEQ + q;
        float res[64];
        for (int m = 0; m < 2; ++m) {
            float qv[64];
            const bf16* qp = QKV + tok * NQKV + h * 128 + m * 64;
#pragma unroll
            for (int d = 0; d < 64; ++d) qv[d] = bf2f(qp[d]);
            float o[64];
#pragma unroll
            for (int d = 0; d < 64; ++d) o[d] = 0.f;
            float mrun = -1e30f, l = 0.f;
            const int kend = q0 + 256;
            for (int k = 0; k < kend; ++k) {
                const bf16* kr = QKV + ((size_t)b * SEQ + k) * NQKV + D + h * 128 + m * 64;
                const bf16* vr = QKV + ((size_t)b * SEQ + k) * NQKV + 2 * D + h * 128 + half * 64;
                float s = 0.f;
#pragma unroll
                for (int d = 0; d < 64; ++d) s += qv[d] * bf2f(kr[d]);
                const int dist = q - k;
                if (dist >= 0) {
                    s += lut[dist < 127 ? dist : 127];
                    if (s > mrun) { const float al = exp2f(mrun - s); l *= al;
#pragma unroll
                        for (int d = 0; d < 64; ++d) o[d] *= al;
                        mrun = s; }
                    const float p = exp2f(s - mrun); l += p;
#pragma unroll
                    for (int d = 0; d < 64; ++d) o[d] += p * bf2f(vr[d]);
                }
            }
            const float il = 1.f / l;
            if (m == 0) {
#pragma unroll
                for (int d = 0; d < 64; ++d) res[d] = o[d] * il;
            } else {
                float ss = 0.f;
#pragma unroll
                for (int d = 0; d < 64; ++d) { res[d] = res[d] - lam * (o[d] * il); ss += res[d] * res[d]; }
                ss += __shfl_xor(ss, 1);
                const float rstd = 1.f / sqrtf(ss * (1.f / 128.f) + EPS);
                bf16* op = AO + tok * D + h * 128 + half * 64;
#pragma unroll
                for (int d = 0; d < 64; d += 2) *(unsigned*)(op + d) = pk2(res[d] * rstd, res[d + 1] * rstd);
            }
        }
    }
    __syncthreads();
}
__device__ __forceinline__ void naive_mlstm_phase(Frame& F, const bf16* __restrict__ PROJ, const float* __restrict__ GATES, const float* __restrict__ conv_w, const float* __restrict__ conv_b, bf16* AO) {
    LAS float* q_s = (LAS float*)(F.lds + RING_OFF); LAS float* k_s = q_s + 128; LAS float* v_s = q_s + 256; LAS float* red = q_s + 512;
    const int tid = F.tid, dv = tid >> 1, half = tid & 1, lane = F.lane, wave = F.wave;
    for (int u = (int)blockIdx.x; u < BATCH * NH_M; u += F.G) {
        const int h = u & 3, b = u >> 2;
        float C[64], n[64];
#pragma unroll
        for (int j = 0; j < 64; ++j) { C[j] = 0.f; n[j] = 0.f; }
        float mst = 0.f;
        const int col = (tid < 128) ? (h * 128 + tid) : (512 + h * 128 + ((tid - 128) & 127));
        float cw0 = 0.f, cw1 = 0.f, cw2 = 0.f, cw3 = 0.f, cb = 0.f;
        if (tid < 256) { cw0 = conv_w[0 * D + col]; cw1 = conv_w[1 * D + col]; cw2 = conv_w[2 * D + col]; cw3 = conv_w[3 * D + col]; cb = conv_b[col]; }
        __syncthreads();
        for (int t = 0; t < SEQ; ++t) {
            const size_t tok = (size_t)b * SEQ + t;
            if (tid < 256) {
                float x3 = bf2f(PROJ[tok * NPROJ + col]);
                float x2 = t >= 1 ? bf2f(PROJ[(tok - 1) * NPROJ + col]) : 0.f;
                float x1 = t >= 2 ? bf2f(PROJ[(tok - 2) * NPROJ + col]) : 0.f;
                float x0 = t >= 3 ? bf2f(PROJ[(tok - 3) * NPROJ + col]) : 0.f;
                float y = cw0 * x0 + cw1 * x1 + cw2 * x2 + cw3 * x3 + cb;
                y = y / (1.f + expf(-y));
                if (tid < 128) q_s[tid] = y * MQSCALE; else k_s[tid - 128] = y;
            } else {
                v_s[tid - 256] = bf2f(PROJ[tok * NPROJ + 1024 + h * 256 + (tid - 256)]);
            }
            const float ig = GATES[tok * 8 + h], lf = GATES[tok * 8 + 4 + h];
            __syncthreads();
            const float mnew = fmaxf(lf + mst, ig), fd = expf(lf + mst - mnew), gi = expf(ig - mnew);
            mst = mnew;
            const float gv = gi * v_s[dv];
            float num = 0.f, den = 0.f;
#pragma unroll
            for (int j = 0; j < 64; ++j) { const float kk = k_s[half * 64 + j], qq = q_s[half * 64 + j];
                C[j] = fd * C[j] + gv * kk; n[j] = fd * n[j] + gi * kk; num += C[j] * qq; den += n[j] * qq; }
            num += __shfl_xor(num, 1); den += __shfl_xor(den, 1);
            const float hv = num / fmaxf(fabsf(den), expf(-mnew));
            float ss = half == 0 ? hv * hv : 0.f;
            ss = wave_sum(ss);
            if (lane == 0) red[wave] = ss;
            __syncthreads();
            float tot = 0.f;
#pragma unroll
            for (int w = 0; w < 8; ++w) tot += red[w];
            const float rstd = 1.f / sqrtf(tot * (1.f / 256.f) + EPS);
            if (half == 0) { const float op = bf2f(PROJ[tok * NPROJ + 2048 + h * 256 + dv]); const float sg = 1.f / (1.f + expf(-op));
                AO[tok * D + h * 256 + dv] = (bf16)f2bf(sg * hv * rstd); }
            __syncthreads();
        }
    }
}

__device__ __forceinline__ void attn_phase(Frame& F, const bf16* __restrict__ QKV, bf16* AO, float* stash, const float* __restrict__ rel_bias, const float* __restrict__ lq1, const float* __restrict__ lk1,
                                           const float* __restrict__ lq2, const float* __restrict__ lk2) {
    using da2::f32x16; using da2::f32x4;
    LAS char* lds = (LAS char*)(F.lds + RING_OFF);
    LAS float* tbl = (LAS float*)(lds + da2::OFF_LUT);
    const int tid = F.tid, lane = F.lane, wid = F.wave, r32 = lane & 31, hi = lane >> 5;
    float s1 = 0.f, s2 = 0.f;
    for (int i = 0; i < 64; ++i) { s1 += lq1[i] * lk1[i]; s2 += lq2[i] * lk2[i]; }
    const float lam = expf(s1) - expf(s2) + LAMBDA_INIT0;
    const __amdgpu_buffer_rsrc_t strs = __builtin_amdgcn_make_buffer_rsrc(stash + ((size_t)blockIdx.x * NWAVES + wid) * 4096, 0, 16384, 0x00020000);
    const int stvo = lane * 16;
    LAS char* stg = lds + wid * da2::STG_WAVE;
    for (int L = F.vcu; L < BATCH * NH_A * 4; L += F.G) {
        const int bh = L >> 2, x = L & 3, b = bh >> 3, h = bh & 7;
        __syncthreads();
        const float c31 = rel_bias[31 * NH_A + h] * LOG2E;
        for (int i = tid; i < 4 * da2::TBL_N; i += NWAVES * 64) { const int c = i >> 9, y = i & 511, d = da2::TBL_X0 - (y + c);
            tbl[i] = d < 0 ? -__builtin_inff() : (d > 127 ? 0.f : rel_bias[t5_bucket(d) * NH_A + h] * LOG2E - c31); }
        __syncthreads();
        for (int s = 0; s < 4; ++s) {
            const int qb = (s >> 1) ? 7 - x : x, m = s & 1, P0 = qb * 256;
            const bf16* Qp = QKV + ((size_t)b * SEQ + P0) * NQKV + h * 128 + m * 64;
            const bf16* Kp = QKV + (size_t)b * SEQ * NQKV + D + h * 128 + m * 64;
            const bf16* Vp = QKV + (size_t)b * SEQ * NQKV + 2 * D + h * 128;
            f32x16 o[4];
            da2::attn_block(Qp, Kp, Vp, P0, lds, c31, o);
            if (m == 0) {
#pragma unroll
                for (int i = 0; i < 16; ++i) { const f32x4 v = {o[i >> 2][(i & 3) * 4 + 0], o[i >> 2][(i & 3) * 4 + 1], o[i >> 2][(i & 3) * 4 + 2], o[i >> 2][(i & 3) * 4 + 3]};
                    __builtin_amdgcn_raw_buffer_store_b128(__builtin_bit_cast(v4u, v), strs, stvo, i * 1024, 0); }
            } else {
#pragma unroll
                for (int i = 0; i < 16; ++i) { const f32x4 sti = __builtin_bit_cast(f32x4, __builtin_amdgcn_raw_buffer_load_b128(strs, stvo, i * 1024, 0));
#pragma unroll
                    for (int e = 0; e < 4; ++e) { const int dq = i >> 2, r = (i & 3) * 4 + e; const float v = sti[e] - lam * o[dq][r];
                        *(LAS unsigned short*)(stg + da2::crow(r, hi) * da2::STG_PITCH + (dq * 32 + r32) * 2) = (unsigned short)f2bf(v); } }
                asm volatile("s_waitcnt lgkmcnt(0)" ::: "memory");
                const int row = lane >> 1, half = lane & 1;
                v4u w[8]; float ss = 0.f;
#pragma unroll
                for (int i = 0; i < 8; ++i) { w[i] = *(const LAS v4u*)(stg + row * da2::STG_PITCH + half * 128 + i * 16);
#pragma unroll
                    for (int q = 0; q < 4; ++q) { const float a0 = __uint_as_float(w[i][q] << 16), a1 = __uint_as_float(w[i][q] & 0xffff0000u); ss += a0 * a0 + a1 * a1; } }
                ss += __shfl_xor(ss, 1);
                const float rstd = __builtin_amdgcn_rsqf(ss * (1.f / 128.f) + EPS);
                bf16* Ow = AO + ((size_t)b * SEQ + P0 + wid * 32 + row) * D + h * 128 + half * 64;
#pragma unroll
                for (int i = 0; i < 8; ++i) { v4u ov;
#pragma unroll
                    for (int q = 0; q < 4; ++q) ov[q] = pk2(__uint_as_float(w[i][q] << 16) * rstd, __uint_as_float(w[i][q] & 0xffff0000u) * rstd);
                    *(GAS v4u*)(Ow + i * 8) = ov; }
                asm volatile("s_waitcnt lgkmcnt(0)\n\ts_barrier" ::: "memory");
            }
        }
    }
    __syncthreads();
}
__device__ __forceinline__ void convscan_phase(Frame& F, const bf16* __restrict__ PROJ, const float* __restrict__ GATES, const float* __restrict__ conv_w, const float* __restrict__ conv_b, bf16* QKC, float* GS) {
    {   const int pc = F.tid & 127, col = pc * 8;
        float cw[4][8], cbias[8];
#pragma unroll
        for (int i = 0; i < 8; ++i) { cbias[i] = conv_b[col + i];
#pragma unroll
            for (int t = 0; t < 4; ++t) cw[t][i] = conv_w[t * 1024 + col + i]; }
        const float osc = col < 512 ? MQSCALE : 1.f;
        for (int seg = F.vcu * 4 + (F.tid >> 7); seg < M / 32; seg += F.G * 4) {
            const int tokb = seg * 32;
#pragma unroll 1
            for (int run = 0; run < 4; ++run) {
                const int t8 = tokb + run * 8; const bool first = (t8 & (SEQ - 1)) == 0;
                const bf16* p = PROJ + (size_t)t8 * NPROJ + col;
                v4u r[11];
#pragma unroll
                for (int i = 0; i < 3; ++i) r[i] = first ? (v4u){0u, 0u, 0u, 0u} : *(const GAS v4u*)(p + ((ptrdiff_t)i - 3) * NPROJ);
#pragma unroll
                for (int i = 3; i < 11; ++i) r[i] = *(const GAS v4u*)(p + (size_t)(i - 3) * NPROJ);
#pragma unroll
                for (int t = 0; t < 8; ++t) {
                    unsigned o[4];
#pragma unroll
                    for (int q = 0; q < 4; ++q) {
                        float s0 = cbias[2 * q], s1 = cbias[2 * q + 1];
#pragma unroll
                        for (int tap = 0; tap < 4; ++tap) { const unsigned w = r[t + tap][q]; s0 += cw[tap][2 * q] * __uint_as_float(w << 16); s1 += cw[tap][2 * q + 1] * __uint_as_float(w & 0xffff0000u); }
                        s0 = s0 / (1.f + __expf(-s0)) * osc; s1 = s1 / (1.f + __expf(-s1)) * osc; o[q] = pk2(s0, s1); }
                    *(GAS v4u*)(QKC + (size_t)(t8 + t) * D + col) = (v4u){o[0], o[1], o[2], o[3]};
                }
            }
        }
    }
    {   const int gw = F.vcu * NWAVES + F.wave, NGW = F.G * NWAVES, lane = F.lane;
        for (int task = gw; task < BATCH * NH_M * (SEQ / 64); task += NGW) {
            const int c = task % (SEQ / 64), h = (task / (SEQ / 64)) % NH_M, b = task / (SEQ / 64) / NH_M;
            const size_t tok = (size_t)b * SEQ + c * 64 + lane;
            const float ig = GATES[tok * 8 + h], lf = GATES[tok * 8 + 4 + h];
            float bsum = lf;
#pragma unroll
            for (int off = 1; off < 64; off <<= 1) { const float t = __shfl_up(bsum, off); if (lane >= off) bsum += t; }
            const float e = ig - bsum; float pm = e;
#pragma unroll
            for (int off = 1; off < 64; off <<= 1) { const float t = __shfl_up(pm, off); if (lane >= off) pm = fmaxf(pm, t); }
            *(GAS f32x4*)(GS + tok * 16 + h * 4) = (f32x4){bsum, e, pm, 0.f};
        }
    }
}
__device__ __forceinline__ void mlstm_phase(Frame& F, const bf16* __restrict__ PROJ, const bf16* __restrict__ QKC, const float* __restrict__ GS, bf16* HT, float* SSQ) {
    for (int u = F.vcu; u < BATCH * NH_M * 4; u += F.G) {
        __syncthreads();
        ml::mlstm_unit(u >> 4, (u >> 2) & 3, u & 3, PROJ, QKC, GS, HT, SSQ, (LAS char*)(F.lds + RING_OFF));
    }
    __syncthreads();
}
__device__ __forceinline__ void gatenorm_phase(Frame& F, const bf16* __restrict__ PROJ, const bf16* __restrict__ HT, const float* __restrict__ SSQ, bf16* AO) {
    const int gw = F.vcu * NWAVES + F.wave, NGW = F.G * NWAVES, lane = F.lane;
    for (int m = gw; m < M; m += NGW) {
        const int hd = lane >> 4;
        const float* sp = SSQ + ((size_t)((m >> 11) * 4 + hd) * 8) * 2048 + (m & 2047); float tot = 0.f;
#pragma unroll
        for (int p = 0; p < 8; ++p) tot += sp[(size_t)p * 2048];
        const float rstd = 1.f / sqrtf(tot * (1.f / 256.f) + EPS);
        const v4u h0 = *(const GAS v4u*)(HT + (size_t)m * D + lane * 16), h1 = *(const GAS v4u*)(HT + (size_t)m * D + lane * 16 + 8);
        const v4u o0 = *(const GAS v4u*)(PROJ + (size_t)m * NPROJ + 2048 + lane * 16), o1 = *(const GAS v4u*)(PROJ + (size_t)m * NPROJ + 2048 + lane * 16 + 8);
        v4u r0, r1;
#pragma unroll
        for (int q = 0; q < 4; ++q) {
            { const float ha = __uint_as_float(h0[q] << 16) * rstd, hb = __uint_as_float(h0[q] & 0xffff0000u) * rstd, oa = __uint_as_float(o0[q] << 16), ob = __uint_as_float(o0[q] & 0xffff0000u);
              r0[q] = pk2(ha / (1.f + __expf(-oa)), hb / (1.f + __expf(-ob))); }
            { const float ha = __uint_as_float(h1[q] << 16) * rstd, hb = __uint_as_float(h1[q] & 0xffff0000u) * rstd, oa = __uint_as_float(o1[q] << 16), ob = __uint_as_float(o1[q] & 0xffff0000u);
              r1[q] = pk2(ha / (1.f + __expf(-oa)), hb / (1.f + __expf(-ob))); }
        }
        *(GAS v4u*)(AO + (size_t)m * D + lane * 16) = r0; *(GAS v4u*)(AO + (size_t)m * D + lane * 16 + 8) = r1;
    }
}

template <class Epi>
__device__ __forceinline__ void run_gemm(Frame& F, const bf16* A, const bf16* Bt, int N, int K, const Epi& E, const float* ssq = nullptr) {
    pg8::Gemm g{A, Bt, M, N, K}; pg8::StaticOrder S; S.init(M, N, F.G, (int)blockIdx.x);
    if (ssq) pg8::fill_rstd_table(S, ssq, (LAS float*)(F.lds + RSTD_OFF));
    pg8::gemm_phase<Epi, pg8::StaticOrder, PG8_ALIGN, PG8_SP2>(F.lds + RING_OFF, g, S, E);
}
__global__ void __launch_bounds__(NWAVES * 64, 2) fwd(Args args) {
    extern __shared__ __attribute__((aligned(16))) unsigned char lds[];
    Frame F;
    F.lds = (LAS unsigned char*)lds;
    F.MISC = (volatile LAS unsigned*)(F.lds + MISC_OFF);
    F.tid = threadIdx.x; F.lane = F.tid & 63; F.wave = __builtin_amdgcn_readfirstlane(F.tid >> 6);
    F.G = gridDim.x; { const int bx = blockIdx.x; F.vcu = (F.G % 8 == 0) ? (bx % 8) * (F.G / 8) + bx / 8 : bx; }
    unsigned char* ws = args.ws;
    F.ctl = (gu32*)(ws + WS_CTL);
    for (int u = F.tid; u < (LDS_BYTES - LDSCTL_OFF) / 4; u += NWAVES * 64) ((LAS unsigned*)(F.lds + LDSCTL_OFF))[u] = 0u;
    __syncthreads();
    const int lo = args.ph_lo, hi = args.ph_hi;
    const bool use_bar = (hi - lo) > 1;
    XcdBarrier bar; bar.bar = (unsigned*)(F.ctl + CW_BAR) + args.li * XCD_BAR_WORDS; bar.x = 0; bar.st = nullptr;
    if (use_bar) bar = xcd_barrier_post((unsigned*)(F.ctl + CW_BAR) + args.li * XCD_BAR_WORDS, F.MISC + 8);
#define IN(k) (lo <= (k) && (k) < hi)
#define SEAM(k) do { if (hi > lo + 1) xcd_barrier(bar); } while (0)
#define REP(k) for (int rep_ = 0; rep_ < ((DUP_PHASE == (k)) ? 2 : 1); ++rep_)
#define DUPBAR(k) do { if (DUP_PHASE == (k) && rep_ == 0) xcd_barrier(bar); } while (0)
    bf16* const XN = (bf16*)(ws + WS_XN); bf16* const AO = (bf16*)(ws + WS_AO); bf16* const QKV = (bf16*)(ws + WS_U); bf16* const U = (bf16*)(ws + WS_U); float* const SSQH = (float*)(ws + WS_SSQH);
    float* const H = args.out;
    using pg8::EpiBf16; using pg8::EpiResNorm; (void)H; const LAS float* const RT = (const LAS float*)(F.lds + RSTD_OFF);

    if (IN(0)) { REP(0) { p0_prologue(F, args); DUPBAR(0); } SEAM(0); }
    if (IN(1)) { EpiBf16<0> E{QKV, NQKV, D, QSCALE, RT, -1, nullptr, nullptr, nullptr}; if (DUP_PHASE == 1) { run_gemm(F, XN, (const bf16*)(ws + WS_WQKV), NQKV, D, E, SSQH); xcd_barrier(bar); } run_gemm(F, XN, (const bf16*)(ws + WS_WQKV), NQKV, D, E, SSQH); SEAM(1); }
    if (IN(2)) { REP(2) { attn_phase(F, QKV, AO, (float*)(ws + WS_STASH), args.in[1], args.in[4], args.in[5], args.in[6], args.in[7]); DUPBAR(2); } SEAM(2); }
    if (IN(3)) { EpiResNorm<true> E{args.in[0], nullptr, XN, SSQH, D, (LAS float*)(F.lds + EPIRED_OFF)}; if (DUP_PHASE == 3) { run_gemm(F, AO, (const bf16*)(ws + WS_WAO), D, D, E); xcd_barrier(bar); } run_gemm(F, AO, (const bf16*)(ws + WS_WAO), D, D, E); SEAM(4); }
    if (IN(5)) { EpiBf16<2> E{U, FF, 0, 1.f, RT, -1, nullptr, nullptr, nullptr}; if (DUP_PHASE == 5) { run_gemm(F, XN, (const bf16*)(ws + WS_W1), FF, D, E, SSQH); xcd_barrier(bar); } run_gemm(F, XN, (const bf16*)(ws + WS_W1), FF, D, E, SSQH); SEAM(5); }
    if (IN(6)) { EpiResNorm<false> E{nullptr, XN, XN, SSQH, D, (LAS float*)(F.lds + EPIRED_OFF)}; run_gemm(F, U, (const bf16*)(ws + WS_W2), D, FF, E); SEAM(7); }
    if (IN(8)) { EpiBf16<0> E{QKV, NPROJ, 0, 1.f, RT, NPROJ / 256, (float*)(ws + WS_GATES), args.in[12], args.in[13]}; if (DUP_PHASE == 8) { run_gemm(F, XN, (const bf16*)(ws + WS_WML), NPROJ + 256, D, E, SSQH); xcd_barrier(bar); } run_gemm(F, XN, (const bf16*)(ws + WS_WML), NPROJ + 256, D, E, SSQH); SEAM(8); }
    if (IN(9)) { REP(16) { convscan_phase(F, QKV, (const float*)(ws + WS_GATES), args.in[14], args.in[15], AO, (float*)(ws + WS_GS)); xcd_barrier(bar); }
        REP(9) { mlstm_phase(F, QKV, AO, (const float*)(ws + WS_GS), (bf16*)(ws + WS_HT), (float*)(ws + WS_SSQ)); DUPBAR(9); } SEAM(9); }
    if (IN(10)) { REP(10) { gatenorm_phase(F, QKV, (const bf16*)(ws + WS_HT), (const float*)(ws + WS_SSQ), AO); DUPBAR(10); } SEAM(10); }
    if (IN(11)) { EpiResNorm<false> E{nullptr, XN, XN, SSQH, D, (LAS float*)(F.lds + EPIRED_OFF)}; run_gemm(F, AO, (const bf16*)(ws + WS_WMO), D, D, E); SEAM(12); }
    if (IN(13)) { EpiBf16<2> E{U, FF, 0, 1.f, RT, -1, nullptr, nullptr, nullptr}; if (DUP_PHASE == 13) { run_gemm(F, XN, (const bf16*)(ws + WS_W1) + (size_t)D * FF, FF, D, E, SSQH); xcd_barrier(bar); } run_gemm(F, XN, (const bf16*)(ws + WS_W1) + (size_t)D * FF, FF, D, E, SSQH); SEAM(13); }
    if (IN(14)) { EpiResNorm<false> E{nullptr, XN, XN, SSQH, D, (LAS float*)(F.lds + EPIRED_OFF)}; run_gemm(F, U, (const bf16*)(ws + WS_W2) + (size_t)D * FF, D, FF, E); SEAM(14); }
    if (IN(15)) { final_norm_phase(F, XN, SSQH, args.in[21], args.out); }
#undef IN
#undef SEAM
}

extern "C" void kernel_launch(void* const* d_in, const int* in_sizes, int n_in, void* d_out, int out_size, void* d_ws, size_t ws_size, hipStream_t stream) {
    static int grid = 0;
    if (grid == 0) {
        if (n_in != 22 || in_sizes[0] != M * D || out_size != M * D || ws_size < WS_END) { fprintf(stderr, "kernel_launch: unexpected shapes (n_in %d, in0 %d, out %d, ws %zu); nothing launched\n", n_in, n_in > 0 ? in_sizes[0] : -1, out_size, ws_size); grid = -1; return; }
        int dev = 0, cus = 0, per_cu = 0;
        if (hipGetDevice(&dev) != hipSuccess || hipDeviceGetAttribute(&cus, hipDeviceAttributeMultiprocessorCount, dev) != hipSuccess) { grid = -1; return; }
        if (hipFuncSetAttribute((const void*)fwd, hipFuncAttributeMaxDynamicSharedMemorySize, LDS_BYTES) != hipSuccess) { fprintf(stderr, "kernel_launch: hipFuncSetAttribute failed\n"); grid = -1; return; }
        if (hipOccupancyMaxActiveBlocksPerMultiprocessor(&per_cu, (const void*)fwd, NWAVES * 64, LDS_BYTES) != hipSuccess || per_cu < 1) fprintf(stderr, "kernel_launch: occupancy query says %d\n", per_cu);
        (void)hipGetLastError();
        grid = cus;
    }
    if (grid < 0) return;
    (void)hipMemsetAsync((char*)d_ws + WS_CTL, 0, CTL_ZERO_BYTES, stream);
    Args a{};
    for (int i = 0; i < 22; ++i) a.in[i] = (const float*)d_in[i];
    a.out = (float*)d_out; a.ws = (unsigned char*)d_ws;
    int li = 0;
    auto run = [&](int lo, int hi) { a.ph_lo = lo; a.ph_hi = hi; a.li = li++; hipLaunchKernelGGL(fwd, dim3(grid), dim3(NWAVES * 64), LDS_BYTES, stream, a); };
    run(0, NPHASE);
}
```

```cpp
#include <hip/hip_runtime.h>
#include <cstdio>
#include <cstdint>
namespace pg8 {
#define PG8_LAS __attribute__((address_space(3)))
typedef unsigned short bf16_t;
typedef short bf16x8 __attribute__((ext_vector_type(8)));
typedef float f32x4 __attribute__((ext_vector_type(4)));
typedef unsigned u32x4 __attribute__((ext_vector_type(4)));
constexpr int BM = 256, BK = 64, HALF = 128, HTB = HALF * BK * 2  , STAGE_BYTES = 8 * HTB, NXCD = 8, WGM = 8;

__host__ __device__ __forceinline__ int lds_byte(int r, int c) { const int st = (r >> 4) * 2 + (c >> 5), rr = r & 15, cc = c & 31, ob = rr * 64 + cc * 2; return st * 1024 + (ob ^ (((ob >> 9) & 1) << 5)); }
__host__ __device__ __forceinline__ void stage_rc(int b, int& R, int& C) { const int st = b / 1024, sb = b % 1024, swz = sb ^ (((sb >> 9) & 1) << 5); R = (st >> 1) * 16 + swz / 64; C = (st & 1) * 32 + (swz % 64) / 2; }
__host__ __device__ __forceinline__ int perm32(int rho) { const int n = rho >> 4, i = rho & 15; return 8 * (i >> 2) + 4 * n + (i & 3); }

struct Unit { int pm, pn; };
struct Gemm { const bf16_t* A; const bf16_t* Bt; int M, N, K; };

struct StaticOrder {
    int nM, nN, nwg, G, c;
    __host__ __device__ void init(int M, int N, int G_, int c_) { nM = M / BM; nN = N / BM; nwg = nM * nN; G = G_; c = c_; }
    __host__ __device__ bool next(int i, Unit& u) const {
        const long L = (long)i * G + c; if (L >= nwg) return false;
        int wgid = (int)L; { const int q = nwg / NXCD, r = nwg % NXCD, xcd = wgid % NXCD, off = wgid / NXCD; wgid = (xcd < r ? xcd * (q + 1) : r * (q + 1) + (xcd - r) * q) + off; }
        const int nig = WGM * nN, gid = wgid / nig, fm = gid * WGM, gsz = (nM - fm) < WGM ? (nM - fm) : WGM;
        u.pm = fm + ((wgid % nig) % gsz); u.pn = (wgid % nig) / gsz; return true;
    }
    __device__ __forceinline__ void a_ready(const Unit&) const {}
    __device__ __forceinline__ void done(const Unit&) const {}
};

__device__ __forceinline__ unsigned cvt_pk_bf16(float lo, float hi) { unsigned r; asm volatile("v_cvt_pk_bf16_f32 %0, %1, %2" : "=v"(r) : "v"(lo), "v"(hi)); return r; }
__device__ __forceinline__ float row_rstd(const float* ssq, int row) {
    const f32x4 a = *(const f32x4*)(ssq + (size_t)row * 4);
    return __builtin_amdgcn_rsqf(((a[0] + a[1]) + (a[2] + a[3])) * (1.0f / 1024.0f) + 1e-6f);
}
__device__ __forceinline__ float log_sigmoid_f(float x) { return fminf(x, 0.f) - log1pf(expf(-fabsf(x))); }
template <int ACT> struct EpiBf16 {
    static constexpr bool PERM = true, AFTER_DRAIN = false, KSEG = false;
    bf16_t* O; int ldc; int scale_cols; float scale0; const PG8_LAS float* rstd_tbl  ; int gate_tile; float* gates; const float* b_i; const float* b_f;
    __device__ __forceinline__ void operator()(const f32x4 (&acc)[2][2][4][2], const Unit& u, int wr, int wc, int fr, int fq, int ui) const {
        const int row0 = u.pm * BM + wr * 64 + fr; const int colt = u.pn * BM;
        const float sc = (colt < scale_cols) ? scale0 : 1.f;
        const int col0 = colt + wc * 32 + 8 * fq;
        float rs[2][4];
#pragma unroll
        for (int ai = 0; ai < 2; ++ai)
#pragma unroll
            for (int m = 0; m < 4; ++m) rs[ai][m] = rstd_tbl ? rstd_tbl[ui * BM + ai * HALF + wr * 64 + m * 16 + fr] * sc : sc;
        if (u.pn == gate_tile) {
            if (wc == 0 && fq == 0) { const f32x4 bi = *(const f32x4*)b_i, bf = *(const f32x4*)b_f;
#pragma unroll
                for (int ai = 0; ai < 2; ++ai)
#pragma unroll
                    for (int m = 0; m < 4; ++m) { const int row = row0 + ai * HALF + m * 16; const f32x4 gi = acc[ai][0][m][0] * rs[ai][m] + bi; f32x4 gf = acc[ai][0][m][1] * rs[ai][m] + bf;
#pragma unroll
                        for (int e = 0; e < 4; ++e) gf[e] = log_sigmoid_f(gf[e]);
                        *(f32x4*)(gates + (size_t)row * 8) = gi; *(f32x4*)(gates + (size_t)row * 8 + 4) = gf; } }
            return;
        }
#pragma unroll
        for (int ai = 0; ai < 2; ++ai)
#pragma unroll
            for (int m = 0; m < 4; ++m) { bf16_t* rowp = O + (size_t)(row0 + ai * HALF + m * 16) * ldc + col0; const float r = rs[ai][m];
#pragma unroll
                for (int bj = 0; bj < 2; ++bj) { f32x4 v0 = acc[ai][bj][m][0] * r, v1 = acc[ai][bj][m][1] * r;
                    if (ACT == 2) {
#pragma unroll
                        for (int e = 0; e < 4; ++e) { const float a = fmaxf(v0[e], 0.f), b = fmaxf(v1[e], 0.f); v0[e] = a * a; v1[e] = b * b; } }
                    u32x4 w; w.x = cvt_pk_bf16(v0[0], v0[1]); w.y = cvt_pk_bf16(v0[2], v0[3]); w.z = cvt_pk_bf16(v1[0], v1[1]); w.w = cvt_pk_bf16(v1[2], v1[3]);
                    *(u32x4*)(rowp + bj * HALF) = w; } }
    }
};
template <class Sched>
__device__ __forceinline__ void fill_rstd_table(const Sched& S, const float* ssq, PG8_LAS float* tbl) {
    Unit u;
    for (int i = 0; i < 8 && S.next(i, u); ++i)
        for (int r = threadIdx.x; r < BM; r += 512) tbl[i * BM + r] = row_rstd(ssq, u.pm * BM + r);
    asm volatile("s_waitcnt lgkmcnt(0)" ::: "memory");
}
template <bool BASE_F32, bool KSEG_ = false> struct EpiResNorm {
    static constexpr bool PERM = true, AFTER_DRAIN = false, KSEG = KSEG_;
    const float* basef; const bf16_t* baseh; bf16_t* xn; float* ssq; int ldc; PG8_LAS float* red; const PG8_LAS float* hn;
    __device__ __forceinline__ void kseg(f32x4 (&acc)[2][2][4][2], int seg  , int wr, int fr, int ui) const {
#pragma unroll
        for (int ai = 0; ai < 2; ++ai)
#pragma unroll
            for (int m = 0; m < 4; ++m) { const float f = hn[(ui * BM + ai * HALF + wr * 64 + m * 16 + fr) * 4 + seg];
#pragma unroll
                for (int bj = 0; bj < 2; ++bj)
#pragma unroll
                    for (int n = 0; n < 2; ++n) acc[ai][bj][m][n] = acc[ai][bj][m][n] * f; }
    }
    __device__ __forceinline__ void operator()(const f32x4 (&acc)[2][2][4][2], const Unit& u, int wr, int wc, int fr, int fq, int ui) const {
        const int row0 = u.pm * BM + wr * 64 + fr; const int col0 = u.pn * BM + wc * 32 + 8 * fq;
#pragma unroll
        for (int ai = 0; ai < 2; ++ai)
#pragma unroll
            for (int m = 0; m < 4; ++m) { const int row = row0 + ai * HALF + m * 16; const size_t off = (size_t)row * ldc + col0; float s = 0.f;
                const float f3 = KSEG ? hn[(ui * BM + ai * HALF + wr * 64 + m * 16 + fr) * 4 + 3] : 1.f;
#pragma unroll
                for (int bj = 0; bj < 2; ++bj) { f32x4 v0, v1;
                    if (BASE_F32) { v0 = *(const f32x4*)(basef + off + bj * HALF); v1 = *(const f32x4*)(basef + off + bj * HALF + 4); }
                    else { const u32x4 h = *(const u32x4*)(baseh + off + bj * HALF);
                        v0 = (f32x4){__uint_as_float(h.x << 16), __uint_as_float(h.x & 0xffff0000u), __uint_as_float(h.y << 16), __uint_as_float(h.y & 0xffff0000u)};
                        v1 = (f32x4){__uint_as_float(h.z << 16), __uint_as_float(h.z & 0xffff0000u), __uint_as_float(h.w << 16), __uint_as_float(h.w & 0xffff0000u)}; }
                    v0 = v0 + acc[ai][bj][m][0] * f3; v1 = v1 + acc[ai][bj][m][1] * f3;
                    s += ((v0[0] * v0[0] + v0[1] * v0[1]) + (v0[2] * v0[2] + v0[3] * v0[3])) + ((v1[0] * v1[0] + v1[1] * v1[1]) + (v1[2] * v1[2] + v1[3] * v1[3]));
                    u32x4 w; w.x = cvt_pk_bf16(v0[0], v0[1]); w.y = cvt_pk_bf16(v0[2], v0[3]); w.z = cvt_pk_bf16(v1[0], v1[1]); w.w = cvt_pk_bf16(v1[2], v1[3]);
                    *(u32x4*)(xn + off + bj * HALF) = w; }
                s += __shfl_xor(s, 16); s += __shfl_xor(s, 32);
                if (fq == 0) red[(ai * HALF + wr * 64 + m * 16 + fr) * 4 + wc] = s; }
        asm volatile("s_waitcnt lgkmcnt(0)" ::: "memory"); __builtin_amdgcn_s_barrier(); asm volatile("" ::: "memory");
        const int t = threadIdx.x;
        if (t < BM) { const f32x4 p = *(const PG8_LAS f32x4*)(red + t * 4); ssq[(size_t)(u.pm * BM + t) * 4 + u.pn] = (p[0] + p[1]) + (p[2] + p[3]); }
    }
};
template <class Sched>
__device__ __forceinline__ void fill_headnorm_table(const Sched& S, const float* SSQ, PG8_LAS float* hn) {
    Unit u;
    for (int i = 0; i < 2 && S.next(i, u); ++i)
        for (int r = threadIdx.x; r < BM; r += 512) { const int row = u.pm * BM + r, bb = row >> 11, tok = row & 2047; float rs[4];
#pragma unroll
            for (int h = 0; h < 4; ++h) { const float* sp = SSQ + ((size_t)(bb * 4 + h) * 8) * 2048 + tok; float tot = 0.f;
#pragma unroll
                for (int p = 0; p < 8; ++p) tot += sp[(size_t)p * 2048];
                rs[h] = __builtin_amdgcn_rsqf(tot * (1.0f / 256.0f) + 1e-6f); }
            *(PG8_LAS f32x4*)(hn + (i * BM + r) * 4) = (f32x4){rs[0] / rs[1], rs[1] / rs[2], rs[2] / rs[3], rs[3]}; }
    asm volatile("s_waitcnt lgkmcnt(0)" ::: "memory");
}

template <class Epi, class Sched, bool ALIGN_EPI = false, bool SP2 = false>
__device__ __forceinline__ void gemm_phase(PG8_LAS unsigned char* lds, const Gemm g, const Sched& S, const Epi& E) {
    const int tid = threadIdx.x, wid = __builtin_amdgcn_readfirstlane(tid >> 6), lane = tid & 63, wr = wid >> 2, wc = wid & 3, fr = lane & 15, fq = lane >> 4;
    const int K = g.K, nt = K / BK;
    unsigned voffA[2], voffB[2];
#pragma unroll
    for (int i = 0; i < 2; ++i) { int R, C; stage_rc(tid * 16 + i * 8192, R, C); const int Rb = Epi::PERM ? ((R & ~31) + perm32(R & 31)) : R;
        voffA[i] = (unsigned)(R * K + C) * 2u; voffB[i] = (unsigned)(Rb * K + C) * 2u; }
    const size_t kstep = (size_t)(BK * 2);
    const size_t hstep = (size_t)HALF * K * 2;
    const size_t tstep = 2 * hstep;
    const unsigned ldsw = (unsigned)wid * 1024u;
    const int aoff = lds_byte(wr * 64 + fr, fq * 8), boff = lds_byte(wc * 32 + fr, fq * 8);
#define PG8_SA(b, h) (((b) * 2 + (h)) * HTB)
#define PG8_SB(b, h) ((4 + (b) * 2 + (h)) * HTB)
#define PG8_STAGE(bufoff, gbase, voff) do { _Pragma("unroll") for (int _i = 0; _i < 2; ++_i) \
        __builtin_amdgcn_global_load_lds((const unsigned*)((const char*)(gbase) + (voff)[_i]), (PG8_LAS unsigned*)(lds + (bufoff) + ldsw + _i * 8192), 16, 0, 0); } while (0)
#define PG8_LDA(dst, b, h) do { _Pragma("unroll") for (int m = 0; m < 4; ++m) _Pragma("unroll") for (int k = 0; k < 2; ++k) dst[m][k] = *(const PG8_LAS bf16x8*)(lds + PG8_SA(b, h) + aoff + m * 2048 + k * 1024); } while (0)
#define PG8_LDB(dst, b, h) do { _Pragma("unroll") for (int n = 0; n < 2; ++n) _Pragma("unroll") for (int k = 0; k < 2; ++k) dst[n][k] = *(const PG8_LAS bf16x8*)(lds + PG8_SB(b, h) + boff + n * 2048 + k * 1024); } while (0)
#define PG8_MMA(ai, bj, At, Bt) do { __builtin_amdgcn_s_setprio(1); _Pragma("unroll") for (int m = 0; m < 4; ++m) _Pragma("unroll") for (int n = 0; n < 2; ++n) _Pragma("unroll") for (int k = 0; k < 2; ++k) \
        acc[ai][bj][m][n] = __builtin_amdgcn_mfma_f32_16x16x32_bf16(Bt[n][k], At[m][k], acc[ai][bj][m][n], 0, 0, 0); __builtin_amdgcn_s_setprio(0); } while (0)
#define PG8_WAIT_V(n) asm volatile("s_waitcnt vmcnt(" #n ")" ::: "memory")
#define PG8_WAIT_L(n) asm volatile("s_waitcnt lgkmcnt(" #n ")" ::: "memory")
#define PG8_BAR __builtin_amdgcn_s_barrier()
#define PG8_SCHED __builtin_amdgcn_sched_barrier(0)
    Unit cur, nxt; int ui = 0;
    if (!S.next(0, cur)) return;
    f32x4 acc[2][2][4][2];
#pragma unroll
    for (int a = 0; a < 2; ++a)
#pragma unroll
        for (int b = 0; b < 2; ++b)
#pragma unroll
            for (int m = 0; m < 4; ++m)
#pragma unroll
                for (int n = 0; n < 2; ++n) acc[a][b][m][n] = (f32x4){0.f, 0.f, 0.f, 0.f};
    bf16x8 At[4][2], B0[2][2], B1[2][2];
    const char* cA = (const char*)g.A + (size_t)cur.pm * tstep; const char* cB = (const char*)g.Bt + (size_t)cur.pn * tstep;
    S.a_ready(cur);
    if constexpr (SP2) {
        PG8_STAGE(PG8_SB(0, 0), cB, voffB); PG8_STAGE(PG8_SB(0, 1), cB + hstep, voffB); PG8_STAGE(PG8_SA(0, 0), cA, voffA); PG8_STAGE(PG8_SA(0, 1), cA + hstep, voffA);
        if (wr == 1) PG8_BAR;
        PG8_WAIT_V(2); PG8_BAR;
        PG8_STAGE(PG8_SB(1, 0), cB + kstep, voffB); PG8_STAGE(PG8_SA(1, 0), cA + kstep, voffA); PG8_STAGE(PG8_SB(1, 1), cB + hstep + kstep, voffB);
        PG8_WAIT_V(6); PG8_BAR;
    } else {
        PG8_STAGE(PG8_SB(0, 0), cB, voffB); PG8_STAGE(PG8_SA(0, 0), cA, voffA); PG8_STAGE(PG8_SB(0, 1), cB + hstep, voffB); PG8_STAGE(PG8_SA(0, 1), cA + hstep, voffA);
        if (wr == 1) PG8_BAR;
        PG8_WAIT_V(4); PG8_BAR;
        PG8_STAGE(PG8_SB(1, 0), cB + kstep, voffB); PG8_STAGE(PG8_SA(1, 0), cA + kstep, voffA); PG8_STAGE(PG8_SB(1, 1), cB + hstep + kstep, voffB);
        PG8_WAIT_V(6); PG8_BAR;
    }
    for (;;) {
        const bool has_next = S.next(ui + 1, nxt);
        const char* nA = has_next ? (const char*)g.A + (size_t)nxt.pm * tstep : cA; const char* nB = has_next ? (const char*)g.Bt + (size_t)nxt.pn * tstep : cB;
        for (int t = 0; t < nt; t += 2) {
            if constexpr (Epi::KSEG) { if (t == 4 || t == 8 || t == 12) E.kseg(acc, (t >> 2) - 1, wr, fr, ui); }
            const bool last = (t == nt - 2);
            const char* a1 = cA + (size_t)(t + 1) * kstep;
            const char* a2 = last ? nA : cA + (size_t)(t + 2) * kstep; const char* b2 = last ? nB : cB + (size_t)(t + 2) * kstep;
            const char* a3 = a2 + kstep; const char* b3 = b2 + kstep;
            if (last && has_next) S.a_ready(nxt);
            if constexpr (SP2) {
            PG8_LDB(B0, 0, 0); PG8_LDB(B1, 0, 1); PG8_SCHED; PG8_LDA(At, 0, 0); PG8_STAGE(PG8_SA(1, 1), a1 + hstep, voffA);
            PG8_WAIT_V(8); PG8_WAIT_L(0); PG8_BAR; PG8_MMA(0, 0, At, B0); PG8_MMA(0, 1, At, B1); PG8_BAR; PG8_SCHED;
            PG8_LDA(At, 0, 1); PG8_STAGE(PG8_SB(0, 0), b2, voffB); PG8_STAGE(PG8_SB(0, 1), b2 + hstep, voffB); PG8_STAGE(PG8_SA(0, 0), a2, voffA);
            PG8_WAIT_V(8); PG8_WAIT_L(0); PG8_BAR; PG8_MMA(1, 0, At, B0); PG8_MMA(1, 1, At, B1); PG8_BAR; PG8_SCHED;
            PG8_LDB(B0, 1, 0); PG8_LDB(B1, 1, 1); PG8_SCHED; PG8_LDA(At, 1, 0); PG8_STAGE(PG8_SA(0, 1), a2 + hstep, voffA);
            PG8_WAIT_V(8); PG8_WAIT_L(0); PG8_BAR; PG8_MMA(0, 0, At, B0); PG8_MMA(0, 1, At, B1); PG8_BAR; PG8_SCHED;
            PG8_LDA(At, 1, 1); PG8_STAGE(PG8_SB(1, 0), b3, voffB); PG8_STAGE(PG8_SB(1, 1), b3 + hstep, voffB); PG8_STAGE(PG8_SA(1, 0), a3, voffA);
            PG8_WAIT_V(8); PG8_WAIT_L(0); PG8_BAR; PG8_MMA(1, 0, At, B0); PG8_MMA(1, 1, At, B1); PG8_BAR; PG8_SCHED;
            } else {
            PG8_LDB(B0, 0, 0); PG8_SCHED; PG8_LDA(At, 0, 0); PG8_STAGE(PG8_SA(1, 1), a1 + hstep, voffA);
            PG8_WAIT_L(8); PG8_BAR; PG8_WAIT_L(0); PG8_MMA(0, 0, At, B0); PG8_BAR; PG8_SCHED;
            PG8_LDB(B1, 0, 1); PG8_STAGE(PG8_SB(0, 0), b2, voffB);
            PG8_BAR; PG8_WAIT_L(0); PG8_MMA(0, 1, At, B1); PG8_BAR;
            PG8_LDA(At, 0, 1); PG8_STAGE(PG8_SA(0, 0), a2, voffA);
            PG8_BAR; PG8_WAIT_L(0); PG8_MMA(1, 0, At, B0); PG8_BAR; PG8_SCHED;
            PG8_STAGE(PG8_SB(0, 1), b2 + hstep, voffB);
            PG8_WAIT_V(6); PG8_BAR; PG8_MMA(1, 1, At, B1); PG8_BAR;
            PG8_LDB(B0, 1, 0); PG8_SCHED; PG8_LDA(At, 1, 0); PG8_STAGE(PG8_SA(0, 1), a2 + hstep, voffA);
            PG8_WAIT_L(8); PG8_BAR; PG8_WAIT_L(0); PG8_MMA(0, 0, At, B0); PG8_BAR; PG8_SCHED;
            PG8_LDB(B1, 1, 1); PG8_STAGE(PG8_SB(1, 0), b3, voffB);
            PG8_BAR; PG8_WAIT_L(0); PG8_MMA(0, 1, At, B1); PG8_BAR;
            PG8_LDA(At, 1, 1); PG8_STAGE(PG8_SA(1, 0), a3, voffA);
            PG8_BAR; PG8_WAIT_L(0); PG8_MMA(1, 0, At, B0); PG8_BAR; PG8_SCHED;
            PG8_STAGE(PG8_SB(1, 1), b3 + hstep, voffB);
            PG8_WAIT_V(6); PG8_BAR; PG8_MMA(1, 1, At, B1); PG8_BAR;
            }
        }
        if constexpr (ALIGN_EPI) { if (wr == 0) PG8_BAR; }
        if constexpr (!Epi::AFTER_DRAIN) { E(acc, cur, wr, wc, fr, fq, ui); S.done(cur); }
        if (!has_next) break;
#pragma unroll
        for (int a = 0; a < 2; ++a)
#pragma unroll
            for (int b = 0; b < 2; ++b)
#pragma unroll
                for (int m = 0; m < 4; ++m)
#pragma unroll
                    for (int n = 0; n < 2; ++n) acc[a][b][m][n] = (f32x4){0.f, 0.f, 0.f, 0.f};
        cur = nxt; cA = nA; cB = nB; ++ui;
        if constexpr (ALIGN_EPI) { if (wr == 1) PG8_BAR; }
    }
    PG8_WAIT_V(0);
    if constexpr (!ALIGN_EPI) { if (wr == 0) PG8_BAR; }
    PG8_BAR;
    if constexpr (Epi::AFTER_DRAIN) { E.fused(acc, cur, wr, wc, fr, fq, lds, wid, lane); S.done(cur); }
#undef PG8_SA
#undef PG8_SB
#undef PG8_STAGE
#undef PG8_LDA
#undef PG8_LDB
#undef PG8_MMA
#undef PG8_WAIT_V
#undef PG8_WAIT_L
#undef PG8_BAR
#undef PG8_SCHED
}
}

#ifndef PG8_SP2
#define PG8_SP2 true
#endif
#ifndef PG8_ALIGN
#define PG8_ALIGN true
#endif
namespace da {
typedef short bf16x8 __attribute__((ext_vector_type(8)));
typedef short s16x4 __attribute__((ext_vector_type(4)));
typedef float f32x16 __attribute__((ext_vector_type(16)));
typedef float f32x4 __attribute__((ext_vector_type(4)));
typedef unsigned u32x4 __attribute__((ext_vector_type(4)));
#define DLAS __attribute__((address_space(3)))
constexpr int NW = 8, QBLK = 32, KVBLK = 64, QB = NW * QBLK, PITCH = 3072;
constexpr int SHM_V = KVBLK * 128 * 2, SHM_K = KVBLK * 64 * 2;
constexpr int OFF_V = 0, OFF_K = 2 * SHM_V, OFF_WS = OFF_K + 2 * SHM_K, OFF_LUT = OFF_WS + NW * 64 * 4, LDS_BYTES = OFF_LUT + 512;
constexpr float THR = 8.f;
#define DA_KSWZ(row, c) ((row) * 128 + ((((c) ^ (((row) >> 1) & 7))) << 4))
#define DA_SBAR() __builtin_amdgcn_sched_barrier(0)
__device__ __forceinline__ int v_st(int k, int c) { const int kk = (k & ~0xC) | ((k & 4) << 1) | ((k & 8) >> 1); return ((kk >> 3) * 4 + (c >> 5)) * 512 + ((kk & 7) * 32 + (c & 31)) * 2; }
__device__ __forceinline__ int v_rd_base(int lane) { return ((lane & 3) << 3) | (((lane >> 2) & 3) << 6) | (((lane >> 4) & 1) << 5) | (((lane >> 5) & 1) << 8); }
constexpr int v_rd_off(int d0, int ks, int half) { return d0 * 512 + ks * 4096 + half * 2048; }
__device__ __forceinline__ int crow(int r, int hi) { return (r & 3) + 8 * (r >> 2) + 4 * hi; }
__device__ __forceinline__ unsigned cvtpk(float lo, float hi) { unsigned r; asm volatile("v_cvt_pk_bf16_f32 %0, %1, %2" : "=v"(r) : "v"(lo), "v"(hi)); return r; }
__device__ __forceinline__ void mask_tile(f32x16& p0, f32x16& p1, int dq) {
    const float NEG = -__builtin_inff();
#pragma unroll
    for (int r = 0; r < 16; ++r) { const int c = (r & 3) + 8 * (r >> 2); if (dq - c < 0) p0[r] = NEG; if (dq - c - 32 < 0) p1[r] = NEG; }
}
__device__ __forceinline__ void bias_tile(f32x16& p0, f32x16& p1, int dq, const DLAS float* lut) {
#pragma unroll
    for (int g = 0; g < 4; ++g) {
#pragma unroll
        for (int rr = 0; rr < 4; ++rr) { const int r = g * 4 + rr; const int c = (r & 3) + 8 * (r >> 2);
            int i0 = dq - c; i0 = i0 < 0 ? 0 : (i0 > 127 ? 127 : i0); int i1 = dq - c - 32; i1 = i1 < 0 ? 0 : (i1 > 127 ? 127 : i1);
            p0[r] += lut[i0]; p1[r] += lut[i1]; }
        DA_SBAR();
    }
}
__device__ __forceinline__ void partialSM(f32x16& p0, f32x16& p1, float& m_reg, float& alpha, float cb) {
    float pmax = p0[0];
#pragma unroll
    for (int r = 1; r < 16; ++r) pmax = fmaxf(pmax, p0[r]);
#pragma unroll
    for (int r = 0; r < 16; ++r) pmax = fmaxf(pmax, p1[r]);
    { auto rr = __builtin_amdgcn_permlane32_swap(__float_as_uint(pmax), __float_as_uint(pmax), false, false);
      pmax = fmaxf(__uint_as_float(rr[0]), __uint_as_float(rr[1])); }
    pmax += cb;
    float mn;
    if (__builtin_expect(__all(pmax - m_reg <= THR), 1)) { mn = m_reg; alpha = 1.f; }
    else { mn = fmaxf(m_reg, pmax); alpha = __builtin_amdgcn_exp2f(m_reg - mn); m_reg = mn; }
    const float off = cb - mn;
#pragma unroll
    for (int r = 0; r < 16; ++r) p0[r] += off;
#pragma unroll
    for (int r = 0; r < 16; ++r) p1[r] += off;
#pragma unroll
    for (int r = 0; r < 16; ++r) p0[r] = __builtin_amdgcn_exp2f(p0[r]);
}
__device__ __forceinline__ void finishSM(f32x16& p0, f32x16& p1, float alpha, float& l_reg, bf16x8& pa0, bf16x8& pa1, bf16x8& pa2, bf16x8& pa3) {
#pragma unroll
    for (int r = 0; r < 16; ++r) p1[r] = __builtin_amdgcn_exp2f(p1[r]);
    float ps = 0;
#pragma unroll
    for (int r = 0; r < 16; ++r) ps += p0[r];
#pragma unroll
    for (int r = 0; r < 16; ++r) ps += p1[r];
    { auto rr = __builtin_amdgcn_permlane32_swap(__float_as_uint(ps), __float_as_uint(ps), false, false);
      ps = __uint_as_float(rr[0]) + __uint_as_float(rr[1]); }
    l_reg = l_reg * alpha + ps;
#define DA_PK4(P, B_, OUT) do { unsigned a0 = cvtpk(P[B_+0], P[B_+1]), a1 = cvtpk(P[B_+2], P[B_+3]);                          \
        unsigned b0 = cvtpk(P[B_+4], P[B_+5]), b1 = cvtpk(P[B_+6], P[B_+7]);                                             \
        auto r0 = __builtin_amdgcn_permlane32_swap(a0, b0, false, false); auto r1 = __builtin_amdgcn_permlane32_swap(a1, b1, false, false); \
        u32x4 w = {r0[0], r1[0], r0[1], r1[1]}; OUT = *reinterpret_cast<bf16x8*>(&w); } while (0)
    DA_PK4(p0, 0, pa0); DA_PK4(p0, 8, pa1); DA_PK4(p1, 0, pa2); DA_PK4(p1, 8, pa3);
#undef DA_PK4
}
template <int KB>
__device__ __forceinline__ void qkt(f32x16& p0, f32x16& p1, const DLAS char* K_lds, int r32, int hi, const bf16x8* qr) {
    p0 = f32x16{}; p1 = f32x16{};
#pragma unroll
    for (int d0 = 0; d0 < 4; ++d0) { const DLAS char* a = K_lds + KB * SHM_K + DA_KSWZ(r32, d0 * 2 + hi);
        const bf16x8 b0 = *reinterpret_cast<const DLAS bf16x8*>(a);
        const bf16x8 b1 = *reinterpret_cast<const DLAS bf16x8*>(a + 32 * 128);
        p0 = __builtin_amdgcn_mfma_f32_32x32x16_bf16(b0, qr[d0], p0, 0, 0, 0);
        p1 = __builtin_amdgcn_mfma_f32_32x32x16_bf16(b1, qr[d0], p1, 0, 0, 0); }
}
template <int VB>
__device__ __forceinline__ void pv_tile(f32x16* o, int vb0, bf16x8 pa0, bf16x8 pa1, bf16x8 pa2, bf16x8 pa3) {
#define DA_TRRD(dst, off) asm volatile("ds_read_b64_tr_b16 %0, %1 offset:%2" : "=&v"(dst) : "v"(vb0), "i"(off) : "memory")
#define DA_PV_D0(d0) do { s16x4 l0, l1, l2, l3, h0, h1, h2, h3; constexpr int b_ = VB * SHM_V + v_rd_off(d0, 0, 0); \
        DA_TRRD(l0, b_); DA_TRRD(h0, b_ + 2048); DA_TRRD(l1, b_ + 4096); DA_TRRD(h1, b_ + 6144); DA_TRRD(l2, b_ + 8192); DA_TRRD(h2, b_ + 10240); DA_TRRD(l3, b_ + 12288); DA_TRRD(h3, b_ + 14336); \
        asm volatile("s_waitcnt lgkmcnt(0)" ::: "memory"); DA_SBAR();   \
        o[d0] = __builtin_amdgcn_mfma_f32_32x32x16_bf16(pa0, (bf16x8){l0[0], l0[1], l0[2], l0[3], h0[0], h0[1], h0[2], h0[3]}, o[d0], 0, 0, 0);   \
        o[d0] = __builtin_amdgcn_mfma_f32_32x32x16_bf16(pa1, (bf16x8){l1[0], l1[1], l1[2], l1[3], h1[0], h1[1], h1[2], h1[3]}, o[d0], 0, 0, 0);   \
        o[d0] = __builtin_amdgcn_mfma_f32_32x32x16_bf16(pa2, (bf16x8){l2[0], l2[1], l2[2], l2[3], h2[0], h2[1], h2[2], h2[3]}, o[d0], 0, 0, 0);   \
        o[d0] = __builtin_amdgcn_mfma_f32_32x32x16_bf16(pa3, (bf16x8){l3[0], l3[1], l3[2], l3[3], h3[0], h3[1], h3[2], h3[3]}, o[d0], 0, 0, 0); } while (0)
    DA_PV_D0(0); DA_PV_D0(1); DA_PV_D0(2); DA_PV_D0(3);
#undef DA_PV_D0
#undef DA_TRRD
}
template <bool ORDER_B>
__device__ __forceinline__ void attn_block(const unsigned short* __restrict__ Qp, const unsigned short* __restrict__ Kp, const unsigned short* __restrict__ Vp, int P0, DLAS char* lds, float c31, f32x16 (&o)[4]) {
    const int tid = threadIdx.x, wid = __builtin_amdgcn_readfirstlane(tid >> 6), lane = tid & 63, r32 = lane & 31, hi = lane >> 5;
    const int NT = (P0 + QB) / KVBLK;
    const int qlo = P0 + wid * QBLK, qm = qlo + r32 - 4 * hi;
    DLAS char* V_lds = lds + OFF_V; DLAS char* K_lds = lds + OFF_K;
    DLAS float* wsf = (DLAS float*)(lds + OFF_WS) + wid * 64; DLAS float* li_l = wsf; DLAS float* al_l = wsf + 32;
    const DLAS float* lut = (const DLAS float*)(lds + OFF_LUT);
    float m_reg = -1e30f, l_reg = 0.f;
#pragma unroll
    for (int d = 0; d < 4; ++d) o[d] = f32x16{};
    const int sr = tid >> 4, sc = (tid & 15) * 8, vst0 = v_st(sr, sc), vst1 = v_st(32 + sr, sc);
    const int kr = tid >> 3, kc = tid & 7, kws = DA_KSWZ(kr, kc);
    const int vb0 = (int)(uintptr_t)V_lds + v_rd_base(lane);
    bf16x8 qr[4];
#pragma unroll
    for (int d0 = 0; d0 < 4; ++d0) qr[d0] = *reinterpret_cast<const bf16x8*>(Qp + (size_t)(wid * QBLK + r32) * PITCH + d0 * 16 + hi * 8);
    bf16x8 st_v0, st_v1, st_k0;
#define DA_VMW() asm volatile("s_waitcnt vmcnt(0)" ::: "memory")
#define DA_SLOAD(k0) do { st_v0 = *reinterpret_cast<const bf16x8*>(Vp + (size_t)((k0) + sr) * PITCH + sc); st_v1 = *reinterpret_cast<const bf16x8*>(Vp + (size_t)((k0) + 32 + sr) * PITCH + sc); \
                          st_k0 = *reinterpret_cast<const bf16x8*>(Kp + (size_t)((k0) + kr) * PITCH + kc * 8); } while (0)
#define DA_SWRITE(bf) do { *reinterpret_cast<DLAS bf16x8*>(V_lds + (bf) * SHM_V + vst0) = st_v0; *reinterpret_cast<DLAS bf16x8*>(V_lds + (bf) * SHM_V + vst1) = st_v1; \
                           *reinterpret_cast<DLAS bf16x8*>(K_lds + (bf) * SHM_K + kws) = st_k0; } while (0)
#define DA_RESC(a) do { if (__any((a) < 1.f)) { if (hi == 0) al_l[r32] = (a); asm volatile("s_waitcnt lgkmcnt(0)" ::: "memory");              \
                        _Pragma("unroll") for (int d_ = 0; d_ < 4; ++d_) _Pragma("unroll") for (int r = 0; r < 16; ++r) o[d_][r] *= al_l[crow(r, hi)]; } } while (0)
#define DA_BIASMASK(P0_, P1_, t, cbv) do { const int kb_ = (t) * KVBLK; if (kb_ + KVBLK - 1 + 128 > qlo) { bias_tile(P0_, P1_, qm - kb_, lut); cbv = 0.f; if (kb_ + KVBLK - 1 > qlo) mask_tile(P0_, P1_, qm - kb_); } else cbv = c31; } while (0)
    f32x16 pA0, pA1, pB0, pB1; float alA, alB, cbA, cbB; bf16x8 pa0, pa1, pa2, pa3;
    DA_SLOAD(0); DA_VMW(); DA_SWRITE(0); DA_SBAR();
    DA_SLOAD(KVBLK);
    __syncthreads();
    DA_SBAR(); qkt<0>(pA0, pA1, K_lds, r32, hi, qr);
    DA_BIASMASK(pA0, pA1, 0, cbA); partialSM(pA0, pA1, m_reg, alA, cbA);
    DA_VMW(); DA_SWRITE(1);
    __syncthreads();
#define DA_HALF_STEP(PX0, PX1, alX, cbX, PY0, PY1, alY, t, KB, VB, SB) do {                                                      \
        DA_SBAR(); DA_SLOAD(((t) + 1) * KVBLK); DA_SBAR();              \
        if constexpr (!ORDER_B) {                                                                                               \
            qkt<KB>(PX0, PX1, K_lds, r32, hi, qr);                                                                     \
            finishSM(PY0, PY1, alY, l_reg, pa0, pa1, pa2, pa3); DA_SBAR();                                                       \
            pv_tile<VB>(o, vb0, pa0, pa1, pa2, pa3); DA_BIASMASK(PX0, PX1, (t), cbX); partialSM(PX0, PX1, m_reg, alX, cbX);      \
        } else {                                                                                                                \
            finishSM(PY0, PY1, alY, l_reg, pa0, pa1, pa2, pa3); DA_SBAR();                                            \
            pv_tile<VB>(o, vb0, pa0, pa1, pa2, pa3); DA_SBAR();                                                                   \
            qkt<KB>(PX0, PX1, K_lds, r32, hi, qr); DA_BIASMASK(PX0, PX1, (t), cbX); partialSM(PX0, PX1, m_reg, alX, cbX);        \
        }                                                                                                                       \
        __syncthreads();                                                                                                      \
        DA_VMW(); DA_SWRITE(SB);                                                                          \
        DA_RESC(alX); __syncthreads(); } while (0)
    for (int t = 1; t + 1 < NT; t += 2) {
        DA_HALF_STEP(pB0, pB1, alB, cbB, pA0, pA1, alA, t, 1, 0, 0);
        DA_HALF_STEP(pA0, pA1, alA, cbA, pB0, pB1, alB, t + 1, 0, 1, 1);
    }
    DA_SBAR(); qkt<1>(pB0, pB1, K_lds, r32, hi, qr); DA_SBAR();
    finishSM(pA0, pA1, alA, l_reg, pa0, pa1, pa2, pa3); DA_SBAR();
    pv_tile<0>(o, vb0, pa0, pa1, pa2, pa3);
    DA_BIASMASK(pB0, pB1, NT - 1, cbB); partialSM(pB0, pB1, m_reg, alB, cbB); DA_RESC(alB);
    finishSM(pB0, pB1, alB, l_reg, pa0, pa1, pa2, pa3); DA_SBAR(); pv_tile<1>(o, vb0, pa0, pa1, pa2, pa3);
    if (hi == 0) li_l[r32] = l_reg; asm volatile("s_waitcnt lgkmcnt(0)" ::: "memory");
#pragma unroll
    for (int r = 0; r < 16; ++r) { const float rl = __builtin_amdgcn_rcpf(li_l[crow(r, hi)]);
#pragma unroll
        for (int d0 = 0; d0 < 4; ++d0) o[d0][r] *= rl; }
    __syncthreads();
#undef DA_VMW
#undef DA_SLOAD
#undef DA_SWRITE
#undef DA_RESC
#undef DA_BIASMASK
#undef DA_HALF_STEP
}
}
static_assert(da::LDS_BYTES <= 131072, "attention LDS inside the ring region");
namespace da2 {
typedef short bf16x8 __attribute__((ext_vector_type(8)));
typedef short s16x4 __attribute__((ext_vector_type(4)));
typedef float f32x16 __attribute__((ext_vector_type(16)));
typedef float f32x4 __attribute__((ext_vector_type(4)));
typedef unsigned u32x4 __attribute__((ext_vector_type(4)));
#define D2LAS __attribute__((address_space(3)))
constexpr int NW = 8, QBLK = 32, KVBLK = 64, QB = NW * QBLK, PITCH = 3072;
constexpr int KSLOT = 8192, VSLOT = 16384, NKS = 3, NVS = 4;
constexpr int OFF_K = 0, OFF_V = NKS * KSLOT, OFF_WS = OFF_V + NVS * VSLOT, OFF_LUT = OFF_WS + NW * 64 * 4, LDS_BYTES = OFF_LUT + 4 * 2048;
constexpr int STG_PITCH = 272, STG_WAVE = 32 * STG_PITCH;
constexpr float THR = 8.f;
#define D2_SBAR() __builtin_amdgcn_sched_barrier(0)
__device__ __forceinline__ int crow(int r, int hi) { return (r & 3) + 8 * (r >> 2) + 4 * hi; }
typedef float f32x2_t __attribute__((ext_vector_type(2))); typedef __bf16 bf16x2_t __attribute__((ext_vector_type(2)));
__device__ __forceinline__ unsigned cvtpk(float lo, float hi) { f32x2_t v = {lo, hi}; bf16x2_t b = __builtin_convertvector(v, bf16x2_t); return __builtin_bit_cast(unsigned, b); }
__device__ __forceinline__ void glds16(const void* gsrc, unsigned lds_dst) { unsigned keep;
    asm volatile("s_mov_b32 %0, m0\n\ts_mov_b32 m0, %2\n\ts_nop 0\n\tglobal_load_lds_dwordx4 %1, off\n\ts_mov_b32 m0, %0" : "=&s"(keep) : "v"(gsrc), "s"(lds_dst) : "memory"); }
#define D2_WAIT_BAR(N) asm volatile("s_waitcnt vmcnt(" #N ") lgkmcnt(0)\n\ts_barrier" ::: "memory")
constexpr int TBL_X0 = 224, TBL_N = 512, TBL_COPY_BYTES = TBL_N * 4;
__device__ __forceinline__ void bias_mask_tile(f32x16& p0, f32x16& p1, int dq, const D2LAS char* tbl_lane  ) {
    const D2LAS char* a = tbl_lane - 4 * dq;
#pragma unroll
    for (int g = 0; g < 4; ++g) { const f32x4 t0 = *reinterpret_cast<const D2LAS f32x4*>(a + 32 * g), t1 = *reinterpret_cast<const D2LAS f32x4*>(a + 32 * g + 128);
#pragma unroll
        for (int i = 0; i < 4; ++i) { p0[4 * g + i] += t0[i]; p1[4 * g + i] += t1[i]; } }
}
__device__ __forceinline__ float rowmax(const f32x16& p0, const f32x16& p1) {
    float a = fmaxf(fmaxf(p0[0], p0[1]), p1[0]), b = fmaxf(fmaxf(p0[2], p0[3]), p1[1]); a = fmaxf(fmaxf(a, p1[2]), p1[3]);
#pragma unroll
    for (int r = 4; r < 16; r += 4) { a = fmaxf(fmaxf(a, p0[r]), p0[r + 1]); b = fmaxf(fmaxf(b, p0[r + 2]), p0[r + 3]); a = fmaxf(fmaxf(a, p1[r]), p1[r + 1]); b = fmaxf(fmaxf(b, p1[r + 2]), p1[r + 3]); }
    float m = fmaxf(a, b);
    auto rr = __builtin_amdgcn_permlane32_swap(__float_as_uint(m), __float_as_uint(m), false, false);
    return fmaxf(__uint_as_float(rr[0]), __uint_as_float(rr[1]));
}
__device__ __forceinline__ void qkt(f32x16& p0, f32x16& p1, const D2LAS char* Kslot, int r32, int hi, const bf16x8* qr, const f32x16& cinit) {
    const int sw = (r32 >> 1) & 7;
#pragma unroll
    for (int d0 = 0; d0 < 4; ++d0) { const D2LAS char* a = Kslot + r32 * 128 + (((d0 * 2 + hi) ^ sw) << 4);
        const bf16x8 b0 = *reinterpret_cast<const D2LAS bf16x8*>(a), b1 = *reinterpret_cast<const D2LAS bf16x8*>(a + 32 * 128);
        if (d0 == 0) { p0 = __builtin_amdgcn_mfma_f32_32x32x16_bf16(b0, qr[0], cinit, 0, 0, 0); p1 = __builtin_amdgcn_mfma_f32_32x32x16_bf16(b1, qr[0], cinit, 0, 0, 0); }
        else { p0 = __builtin_amdgcn_mfma_f32_32x32x16_bf16(b0, qr[d0], p0, 0, 0, 0); p1 = __builtin_amdgcn_mfma_f32_32x32x16_bf16(b1, qr[d0], p1, 0, 0, 0); } }
}
__device__ __forceinline__ void pv_tile(f32x16* o, int vb, bf16x8 pa0, bf16x8 pa1, bf16x8 pa2, bf16x8 pa3) {
#define D2_TRRD(dst, off) asm volatile("ds_read_b64_tr_b16 %0, %1 offset:%2" : "=&v"(dst) : "v"(vb), "i"(off) : "memory")
#define D2_PV(dq) do { s16x4 l0, l1, l2, l3, h0, h1, h2, h3; constexpr int b_ = (dq) * 4096; \
        D2_TRRD(l0, b_); D2_TRRD(h0, b_ + 512); D2_TRRD(l1, b_ + 1024); D2_TRRD(h1, b_ + 1536); D2_TRRD(l2, b_ + 2048); D2_TRRD(h2, b_ + 2560); D2_TRRD(l3, b_ + 3072); D2_TRRD(h3, b_ + 3584); \
        asm volatile("s_waitcnt lgkmcnt(0)" ::: "memory"); D2_SBAR();   \
        o[dq] = __builtin_amdgcn_mfma_f32_32x32x16_bf16(pa0, (bf16x8){l0[0], l0[1], l0[2], l0[3], h0[0], h0[1], h0[2], h0[3]}, o[dq], 0, 0, 0);   \
        o[dq] = __builtin_amdgcn_mfma_f32_32x32x16_bf16(pa1, (bf16x8){l1[0], l1[1], l1[2], l1[3], h1[0], h1[1], h1[2], h1[3]}, o[dq], 0, 0, 0);   \
        o[dq] = __builtin_amdgcn_mfma_f32_32x32x16_bf16(pa2, (bf16x8){l2[0], l2[1], l2[2], l2[3], h2[0], h2[1], h2[2], h2[3]}, o[dq], 0, 0, 0);   \
        o[dq] = __builtin_amdgcn_mfma_f32_32x32x16_bf16(pa3, (bf16x8){l3[0], l3[1], l3[2], l3[3], h3[0], h3[1], h3[2], h3[3]}, o[dq], 0, 0, 0); } while (0)
    D2_PV(0); D2_PV(1); D2_PV(2); D2_PV(3);
#undef D2_PV
#undef D2_TRRD
}
__device__ __forceinline__ void attn_block(const unsigned short* __restrict__ Qp, const unsigned short* __restrict__ Kp, const unsigned short* __restrict__ Vp, int P0, D2LAS char* lds, float c31, f32x16 (&o)[4]) {
    const int tid = threadIdx.x, wid = __builtin_amdgcn_readfirstlane(tid >> 6), lane = tid & 63, r32 = lane & 31, hi = lane >> 5;
    const int NT = (P0 + QB) / KVBLK;
    const int qlo = P0 + wid * QBLK, qm = qlo + r32 - 4 * hi;
    const unsigned lds0 = (unsigned)(uintptr_t)lds;
    D2LAS float* wsf = (D2LAS float*)(lds + OFF_WS) + wid * 64;
    const D2LAS char* tbl_lane = lds + OFF_LUT + ((-r32) & 3) * TBL_COPY_BYTES + 4 * (TBL_X0 - ((-r32) & 3));
    const int krow = wid * 8 + (lane >> 3);
    const unsigned short* ksrc = Kp + (size_t)krow * PITCH + (((lane & 7) ^ ((krow >> 1) & 7)) * 8);
    const unsigned short* vsrc = Vp + (size_t)(16 * (wid & 3) + (lane >> 2)) * PITCH + (wid >> 2) * 32 + (lane & 3) * 8;
    const unsigned kdst = lds0 + OFF_K + wid * 1024, vdst = lds0 + OFF_V + wid * 1024;
    int ks_i = 0, vs_i = 0;
    int jt = 0;
#define D2_DMA() do { glds16(ksrc + (size_t)jt * (KVBLK * PITCH), (unsigned)__builtin_amdgcn_readfirstlane(kdst + ks_i * KSLOT)); \
        glds16(vsrc + (size_t)jt * (KVBLK * PITCH), (unsigned)__builtin_amdgcn_readfirstlane(vdst + vs_i * VSLOT)); \
        glds16(vsrc + (size_t)jt * (KVBLK * PITCH) + 64, (unsigned)__builtin_amdgcn_readfirstlane(vdst + vs_i * VSLOT + 8192)); \
        ++jt; ks_i = ks_i == NKS - 1 ? 0 : ks_i + 1; vs_i = vs_i == NVS - 1 ? 0 : vs_i + 1; } while (0)
    bf16x8 qr[4];
#pragma unroll
    for (int d0 = 0; d0 < 4; ++d0) qr[d0] = *reinterpret_cast<const bf16x8*>(Qp + (size_t)(wid * QBLK + r32) * PITCH + d0 * 16 + hi * 8);
    D2_DMA(); D2_DMA(); D2_DMA();
    const D2LAS char* Kl = lds + OFF_K;
    const int vb0 = (int)(lds0 + OFF_V) + ((lane >> 4) & 1) * 32 + (lane & 3) * 8 + (4 * hi + ((lane & 15) >> 2)) * 64;
    float M = 0.f, l_reg = 0.f;
#pragma unroll
    for (int d = 0; d < 4; ++d) o[d] = f32x16{};
    f32x16 negb;
#pragma unroll
    for (int r = 0; r < 16; ++r) negb[r] = c31;
    f32x16 pA0, pA1, pB0, pB1; bf16x8 pa0, pa1, pa2, pa3;
    int kc = 0, vp = 0;
#define D2_BIASMASK(P0_, P1_, t) do { const int kb_ = (t) * KVBLK; if (kb_ + KVBLK - 1 + 128 > qlo) bias_mask_tile(P0_, P1_, qm - kb_, tbl_lane); } while (0)
#define D2_DECIDE(PX0, PX1, first) do { const float rm = rowmax(PX0, PX1); resc = false; \
        if ((first) || __builtin_expect(__any(rm > THR), 0)) { const float dl = (first) ? rm : fmaxf(rm, 0.f); M += dl; \
            _Pragma("unroll") for (int r = 0; r < 16; ++r) { PX0[r] -= dl; PX1[r] -= dl; } \
            _Pragma("unroll") for (int r = 0; r < 16; ++r) negb[r] = c31 - M; \
            const float f = __builtin_amdgcn_exp2f(-dl); l_reg *= f; if (hi == 0) wsf[r32] = f; resc = !(first); } \
        _Pragma("unroll") for (int r = 0; r < 16; ++r) { PX0[r] = __builtin_amdgcn_exp2f(PX0[r]); PX1[r] = __builtin_amdgcn_exp2f(PX1[r]); } } while (0)
#define D2_RESC() do { if (resc) { asm volatile("s_waitcnt lgkmcnt(0)" ::: "memory"); \
        _Pragma("unroll") for (int d_ = 0; d_ < 4; ++d_) _Pragma("unroll") for (int r = 0; r < 16; ++r) o[d_][r] *= wsf[crow(r, hi)]; } } while (0)
#define D2_FINISH(PY0, PY1) do { float s_ = 0.f; _Pragma("unroll") for (int r = 0; r < 16; ++r) s_ += PY0[r] + PY1[r]; l_reg += s_; \
        { u32x4 w_ = {cvtpk(PY0[0], PY0[1]), cvtpk(PY0[2], PY0[3]), cvtpk(PY0[4], PY0[5]), cvtpk(PY0[6], PY0[7])}; pa0 = __builtin_bit_cast(bf16x8, w_); } \
        { u32x4 w_ = {cvtpk(PY0[8], PY0[9]), cvtpk(PY0[10], PY0[11]), cvtpk(PY0[12], PY0[13]), cvtpk(PY0[14], PY0[15])}; pa1 = __builtin_bit_cast(bf16x8, w_); } \
        { u32x4 w_ = {cvtpk(PY1[0], PY1[1]), cvtpk(PY1[2], PY1[3]), cvtpk(PY1[4], PY1[5]), cvtpk(PY1[6], PY1[7])}; pa2 = __builtin_bit_cast(bf16x8, w_); } \
        { u32x4 w_ = {cvtpk(PY1[8], PY1[9]), cvtpk(PY1[10], PY1[11]), cvtpk(PY1[12], PY1[13]), cvtpk(PY1[14], PY1[15])}; pa3 = __builtin_bit_cast(bf16x8, w_); } } while (0)
#define D2_ENDW(t) do { if ((t) + 2 < NT) { D2_WAIT_BAR(5); } else if ((t) + 1 < NT) { D2_WAIT_BAR(2); } else { D2_WAIT_BAR(0); } } while (0)
    bool resc = false;
    D2_WAIT_BAR(8);
    qkt(pA0, pA1, Kl, r32, hi, qr, negb); D2_BIASMASK(pA0, pA1, 0); D2_DECIDE(pA0, pA1, true);
    D2_WAIT_BAR(5);
    kc = 1; vp = 0;
#define D2_HALF_STEP(PX0, PX1, PY0, PY1, t) do { \
        if ((t) + 2 < NT) D2_DMA(); \
        qkt(PX0, PX1, Kl + kc * KSLOT, r32, hi, qr, negb); \
        D2_FINISH(PY0, PY1); D2_SBAR(); \
        pv_tile(o, vb0 + vp * VSLOT, pa0, pa1, pa2, pa3); \
        D2_BIASMASK(PX0, PX1, (t)); D2_DECIDE(PX0, PX1, false); D2_RESC(); \
        D2_ENDW(t); kc = kc == NKS - 1 ? 0 : kc + 1; vp = vp == NVS - 1 ? 0 : vp + 1; } while (0)
    for (int t = 1; t + 1 < NT; t += 2) {
        D2_HALF_STEP(pB0, pB1, pA0, pA1, t);
        D2_HALF_STEP(pA0, pA1, pB0, pB1, t + 1);
    }
    D2_HALF_STEP(pB0, pB1, pA0, pA1, NT - 1);
    D2_FINISH(pB0, pB1); D2_SBAR(); pv_tile(o, vb0 + vp * VSLOT, pa0, pa1, pa2, pa3);
    { auto rr = __builtin_amdgcn_permlane32_swap(__float_as_uint(l_reg), __float_as_uint(l_reg), false, false); l_reg = __uint_as_float(rr[0]) + __uint_as_float(rr[1]); }
    if (hi == 0) wsf[32 + r32] = l_reg; asm volatile("s_waitcnt lgkmcnt(0)" ::: "memory");
#pragma unroll
    for (int r = 0; r < 16; ++r) { const float rl = __builtin_amdgcn_rcpf(wsf[32 + crow(r, hi)]);
#pragma unroll
        for (int d0 = 0; d0 < 4; ++d0) o[d0][r] *= rl; }
    asm volatile("s_waitcnt lgkmcnt(0)\n\ts_barrier" ::: "memory");
#undef D2_DMA
#undef D2_BIASMASK
#undef D2_DECIDE
#undef D2_RESC
#undef D2_FINISH
#undef D2_ENDW
#undef D2_HALF_STEP
}
}
static_assert(da2::LDS_BYTES <= 131072, "attention v2 LDS inside the ring region");
constexpr int NWAVES = 8;
#ifndef MK_N_LAUNCHES
#define MK_N_LAUNCHES 1
#endif
constexpr int BATCH = 16, SEQ = 2048, D = 1024, FF = 4096, M = BATCH * SEQ;
constexpr int NQKV = 3072;
constexpr int MLW = 3080, NPROJ = 3072;
constexpr int NH_A = 8, NH_M = 4;
constexpr float EPS = 1e-6f, LOG2E = 1.4426950408889634f;
constexpr float QSCALE = 0.125f * LOG2E;
constexpr float LAMBDA_INIT0 = 0.2f;
constexpr float MQSCALE = 0.08838834764831845f;
constexpr int NPHASE = 16;
constexpr int DUP_PHASE = -1;

namespace ml {
typedef short bf16x8 __attribute__((ext_vector_type(8)));
typedef short s16x4 __attribute__((ext_vector_type(4)));
typedef float f32x16 __attribute__((ext_vector_type(16)));
typedef float f32x4 __attribute__((ext_vector_type(4)));
typedef unsigned u32x4 __attribute__((ext_vector_type(4)));
typedef unsigned u32x2 __attribute__((ext_vector_type(2)));
#define MLAS __attribute__((address_space(3)))
constexpr int L = 64, NC = 2048 / L, PITCH = 3072;
constexpr int PQ = 272, PS = 144;
constexpr int O_Q = 0, O_K = O_Q + 64 * PQ, O_C = O_K + 64 * PQ, O_KW = O_C + 64 * PQ, O_V = O_KW + 16384, O_SC = O_V + 16384, O_ARR = O_SC + 64 * PS, O_NP = O_ARR + 9 * 256, O_N = O_NP + 4096, O_OUT = O_N + 512, O_OSS = O_OUT + 8192, O_V2 = O_OSS + 512, O_ARR2 = O_V2 + 16384, LDS_BYTES = O_ARR2 + 9 * 256;
enum { A_E = 0, A_BM = 64, A_INTER = 128, A_EMJ = 192, A_WP = 256, A_RS0 = 320, A_RS1 = 384, A_QN = 448, A_SCAL = 512 };
__device__ __forceinline__ float bf2f_lo(unsigned w) { return __uint_as_float(w << 16); }
__device__ __forceinline__ float bf2f_hi(unsigned w) { return __uint_as_float(w & 0xffff0000u); }
typedef float f32x2_t __attribute__((ext_vector_type(2))); typedef __bf16 bf16x2_t __attribute__((ext_vector_type(2)));
__device__ __forceinline__ unsigned cvtpk(float lo, float hi) { f32x2_t v = {lo, hi}; bf16x2_t b = __builtin_convertvector(v, bf16x2_t); return __builtin_bit_cast(unsigned, b); }
__device__ __forceinline__ int crow(int r, int hi) { return (r & 3) + 8 * (r >> 2) + 4 * hi; }
__device__ __forceinline__ int v_st(int k, int c) { const int kk = (k & ~0xC) | ((k & 4) << 1) | ((k & 8) >> 1); return ((kk >> 3) * 4 + (c >> 5)) * 512 + ((kk & 7) * 32 + (c & 31)) * 2; }
__device__ __forceinline__ int v_rd_base(int lane) { return ((lane & 3) << 3) | (((lane >> 2) & 3) << 6) | (((lane >> 4) & 1) << 5) | (((lane >> 5) & 1) << 8); }
#define ML_TRRD(dst, base, off) asm volatile("ds_read_b64_tr_b16 %0, %1 offset:%2" : "=&v"(dst) : "v"(base), "i"(off) : "memory")
#define ML_SBAR() __builtin_amdgcn_sched_barrier(0)
#define ML_FR(lo, hi_) (bf16x8){lo[0], lo[1], lo[2], lo[3], hi_[0], hi_[1], hi_[2], hi_[3]}
struct Pre { bf16x8 q[2], k[2], v; f32x4 g; u32x2 og[4]; };

__device__ __forceinline__ void mlstm_unit(int b, int h, int s4, const unsigned short* __restrict__ PROJ, const unsigned short* __restrict__ QKC, const float* __restrict__ GS,
                                           unsigned short* HT, float* SSQ, MLAS char* lds) {
    const int tid = threadIdx.x, wid = __builtin_amdgcn_readfirstlane(tid >> 6), lane = tid & 63, r32 = lane & 31, hi = lane >> 5;
    MLAS char* QIMG = lds + O_Q; MLAS char* KIMG = lds + O_K; MLAS char* CIMG = lds + O_C; MLAS char* KWTR = lds + O_KW; MLAS char* VTR = lds + O_V; MLAS char* SC = lds + O_SC;
    MLAS float* arr = (MLAS float*)(lds + O_ARR); MLAS float* npart = (MLAS float*)(lds + O_NP); MLAS float* nvec = (MLAS float*)(lds + O_N);
    MLAS char* OUT = lds + O_OUT; MLAS float* OSS = (MLAS float*)(lds + O_OSS);
    const int srow = tid >> 4, cg = tid & 15;
    const int vrow = tid >> 3, vcol = (tid & 7) * 8;
    const size_t tok0 = (size_t)b * 2048;
    const unsigned short* xq = QKC + tok0 * 1024 + h * 128 + cg * 8;
    const unsigned short* xk = xq + 512;
    const unsigned short* xv = PROJ + tok0 * PITCH + 1024 + h * 256 + s4 * 64 + vcol;
    const float* gs = GS + tok0 * 16 + h * 4;
    const int dkb = wid >> 1, dvb = wid & 1;
    const int tb0 = (wid & 3) >> 1, jb = wid & 1;
    const unsigned short* xo = PROJ + tok0 * PITCH + 2048 + h * 256 + s4 * 64 + 32 * tb0 + 4 * hi;
    f32x16 cst = f32x16{};
    float m_prev = 0.f;
    for (int i = tid; i < (64 * PQ) / 16; i += 512) ((MLAS u32x4*)CIMG)[i] = (u32x4){0u, 0u, 0u, 0u};
    if (tid < 128) nvec[tid] = 0.f;
    Pre P;
#define ML_LOAD(t0_) do { P.q[0] = *reinterpret_cast<const bf16x8*>(xq + (size_t)((t0_) + srow) * 1024); P.q[1] = *reinterpret_cast<const bf16x8*>(xq + (size_t)((t0_) + srow + 32) * 1024); \
        P.k[0] = *reinterpret_cast<const bf16x8*>(xk + (size_t)((t0_) + srow) * 1024); P.k[1] = *reinterpret_cast<const bf16x8*>(xk + (size_t)((t0_) + srow + 32) * 1024); \
        P.v = *reinterpret_cast<const bf16x8*>(xv + (size_t)((t0_) + vrow) * PITCH); P.g = *reinterpret_cast<const f32x4*>(gs + (size_t)((t0_) + lane) * 16); \
        if (wid >= 4) { _Pragma("unroll") for (int q4_ = 0; q4_ < 4; ++q4_) P.og[q4_] = *reinterpret_cast<const u32x2*>(xo + (size_t)((t0_) + 32 * jb + r32) * PITCH + 8 * q4_); } } while (0)
    ML_LOAD(0);
    const int trb_kw = (int)(uintptr_t)KWTR + v_rd_base(lane), trb_v = (int)(uintptr_t)VTR + v_rd_base(lane);
    __syncthreads();
    for (int c = 0; c < NC; ++c) {
        const int t0 = c * L;
        MLAS char* const VTRc = (c & 1) ? lds + O_V2 : lds + O_V; MLAS float* const arrc = (MLAS float*)((c & 1) ? lds + O_ARR2 : lds + O_ARR);
        const int trb_vc = trb_v + ((c & 1) ? (O_V2 - O_V) : 0);
        const float bsum = P.g[0], e = P.g[1], pm = P.g[2];
        asm volatile("" :: "v"(P.g[3]));
        const float b_last = __int_as_float(__builtin_amdgcn_readlane(__float_as_int(bsum), 63)), m_loc = b_last + __int_as_float(__builtin_amdgcn_readlane(__float_as_int(pm), 63));
        const float m_new = fmaxf(b_last + m_prev, m_loc), decay = __expf(b_last + m_prev - m_new);
        const float wp = __expf(b_last + e - m_new);
        const float m_inter = bsum + m_prev, m_j = fmaxf(m_inter, bsum + pm);
        if (wid == 0) { arrc[A_E + lane] = e; arrc[A_BM + lane] = bsum - m_j; arrc[A_INTER + lane] = __expf(m_inter - m_j); arrc[A_EMJ + lane] = __expf(-m_j); arrc[A_WP + lane] = wp; }
        m_prev = m_new;
#pragma unroll
        for (int i = 0; i < 2; ++i) { const int row = srow + 32 * i; const float wrow = __shfl(wp, row);
            *reinterpret_cast<MLAS bf16x8*>(QIMG + row * PQ + cg * 16) = P.q[i];
            *reinterpret_cast<MLAS bf16x8*>(KIMG + row * PQ + cg * 16) = P.k[i];
            const u32x4 kw = __builtin_bit_cast(u32x4, P.k[i]); u32x4 ow;
#pragma unroll
            for (int q = 0; q < 4; ++q) ow[q] = cvtpk(bf2f_lo(kw[q]) * wrow, bf2f_hi(kw[q]) * wrow);
            *reinterpret_cast<MLAS u32x4*>(KWTR + v_st(row, cg * 8)) = ow; }
        *reinterpret_cast<MLAS bf16x8*>(VTRc + v_st(vrow, vcol)) = P.v;
        __syncthreads();
#define ML_STORE_OUT(tt) do { { const int row_ = tid >> 3, ch_ = tid & 7; const u32x4 v_ = *reinterpret_cast<const MLAS u32x4*>(OUT + row_ * 128 + ch_ * 16); \
            *reinterpret_cast<u32x4*>(HT + (tok0 + (tt) + row_) * 1024 + h * 256 + s4 * 64 + ch_ * 8) = v_; } \
            if (tid < 128) SSQ[((size_t)((b * 4 + h) * 8 + s4 * 2 + (tid >> 6))) * 2048 + (tt) + (tid & 63)] = OSS[tid]; } while (0)
        if (c > 0) ML_STORE_OUT(t0 - L);
        u32x2 ogc[4];
#pragma unroll
        for (int q4 = 0; q4 < 4; ++q4) ogc[q4] = P.og[q4];
        { const int tn = (c + 1 < NC) ? t0 + L : t0; ML_LOAD(tn); }
        f32x16 acc_qc = f32x16{};
        if (wid < 4) {
            f32x16 g = f32x16{};
            if (!(tb0 == 1 && jb == 0)) {
                const MLAS char* ka = KIMG + (32 * tb0 + r32) * PQ + hi * 16; const MLAS char* qa = QIMG + (32 * jb + r32) * PQ + hi * 16;
bf16x8 fa[8], fb[8];
#pragma unroll
                for (int kk = 0; kk < 8; ++kk) { fa[kk] = *reinterpret_cast<const MLAS bf16x8*>(ka + kk * 32); fb[kk] = *reinterpret_cast<const MLAS bf16x8*>(qa + kk * 32); }
                ML_SBAR();
#pragma unroll
                for (int kk = 0; kk < 8; ++kk) g = __builtin_amdgcn_mfma_f32_32x32x16_bf16(fa[kk], fb[kk], g, 0, 0, 0);
            }
            const int j = 32 * jb + r32; const float bm = arrc[A_BM + j]; float rsum = 0.f;
#pragma unroll
            for (int q4 = 0; q4 < 4; ++q4) { const f32x4 ev = *reinterpret_cast<const MLAS f32x4*>(arrc + A_E + 32 * tb0 + 8 * q4 + 4 * hi);
                float sc4[4];
#pragma unroll
                for (int i = 0; i < 4; ++i) { const int s = 32 * tb0 + 8 * q4 + 4 * hi + i; const float v = (s <= j) ? g[4 * q4 + i] * __expf(bm + ev[i]) : 0.f; sc4[i] = v; rsum += v; }
                const u32x2 w = {cvtpk(sc4[0], sc4[1]), cvtpk(sc4[2], sc4[3])};
                *reinterpret_cast<MLAS u32x2*>(SC + j * PS + (32 * tb0 + 8 * q4 + 4 * hi) * 2) = w; }
            rsum += __shfl_xor(rsum, 32);
            if (hi == 0) arrc[(tb0 ? A_RS1 : A_RS0) + j] = rsum;
        } else {
            const MLAS char* ca = CIMG + (32 * tb0 + r32) * PQ + hi * 16; const MLAS char* qa = QIMG + (32 * jb + r32) * PQ + hi * 16;
bf16x8 fa[8], fb[8];
#pragma unroll
            for (int kk = 0; kk < 8; ++kk) { fa[kk] = *reinterpret_cast<const MLAS bf16x8*>(ca + kk * 32); fb[kk] = *reinterpret_cast<const MLAS bf16x8*>(qa + kk * 32); }
            ML_SBAR();
#pragma unroll
            for (int kk = 0; kk < 8; ++kk) acc_qc = __builtin_amdgcn_mfma_f32_32x32x16_bf16(fa[kk], fb[kk], acc_qc, 0, 0, 0);
        }
        {
            const int j = tid >> 3, part = tid & 7;
            const u32x4 q0 = *reinterpret_cast<const MLAS u32x4*>(QIMG + j * PQ + part * 32), q1 = *reinterpret_cast<const MLAS u32x4*>(QIMG + j * PQ + part * 32 + 16);
            float s = 0.f;
#pragma unroll
            for (int q = 0; q < 4; ++q) { const f32x4 n4 = *reinterpret_cast<const MLAS f32x4*>(nvec + part * 16 + 4 * q);
                const unsigned w0 = q < 2 ? q0[2 * q] : q1[2 * q - 4], w1 = q < 2 ? q0[2 * q + 1] : q1[2 * q - 3];
                s += bf2f_lo(w0) * n4[0] + bf2f_hi(w0) * n4[1] + bf2f_lo(w1) * n4[2] + bf2f_hi(w1) * n4[3]; }
            s += __shfl_xor(s, 1); s += __shfl_xor(s, 2); s += __shfl_xor(s, 4);
            if (part == 0) arrc[A_QN + j] = s;
            float n0 = 0.f, n1 = 0.f;
#pragma unroll
            for (int i = 0; i < 8; ++i) { const int srow = 8 * wid + i; const unsigned kw = *reinterpret_cast<const MLAS unsigned*>(KIMG + srow * PQ + lane * 4); const float w = arrc[A_WP + srow];
                n0 += w * bf2f_lo(kw); n1 += w * bf2f_hi(kw); }
            npart[wid * 128 + 2 * lane] = n0; npart[wid * 128 + 2 * lane + 1] = n1;
        }
        {
            s16x4 al[4], ah[4], bl[4], bh[4];
#define ML_LD4(d0k, d0v) do { ML_TRRD(al[0], trb_kw, (d0k) * 512); ML_TRRD(ah[0], trb_kw, (d0k) * 512 + 2048); ML_TRRD(al[1], trb_kw, (d0k) * 512 + 4096); ML_TRRD(ah[1], trb_kw, (d0k) * 512 + 6144); \
            ML_TRRD(al[2], trb_kw, (d0k) * 512 + 8192); ML_TRRD(ah[2], trb_kw, (d0k) * 512 + 10240); ML_TRRD(al[3], trb_kw, (d0k) * 512 + 12288); ML_TRRD(ah[3], trb_kw, (d0k) * 512 + 14336); \
            ML_TRRD(bl[0], trb_vc, (d0v) * 512); ML_TRRD(bh[0], trb_vc, (d0v) * 512 + 2048); ML_TRRD(bl[1], trb_vc, (d0v) * 512 + 4096); ML_TRRD(bh[1], trb_vc, (d0v) * 512 + 6144); \
            ML_TRRD(bl[2], trb_vc, (d0v) * 512 + 8192); ML_TRRD(bh[2], trb_vc, (d0v) * 512 + 10240); ML_TRRD(bl[3], trb_vc, (d0v) * 512 + 12288); ML_TRRD(bh[3], trb_vc, (d0v) * 512 + 14336); } while (0)
            switch (wid) { case 0: ML_LD4(0, 0); break; case 1: ML_LD4(0, 1); break; case 2: ML_LD4(1, 0); break; case 3: ML_LD4(1, 1); break;
                           case 4: ML_LD4(2, 0); break; case 5: ML_LD4(2, 1); break; case 6: ML_LD4(3, 0); break; default: ML_LD4(3, 1); break; }
#undef ML_LD4
#pragma unroll
            for (int r = 0; r < 16; ++r) cst[r] *= decay;
            asm volatile("s_waitcnt lgkmcnt(0)" ::: "memory"); ML_SBAR();
#pragma unroll
            for (int ks = 0; ks < 4; ++ks) cst = __builtin_amdgcn_mfma_f32_32x32x16_bf16(ML_FR(al[ks], ah[ks]), ML_FR(bl[ks], bh[ks]), cst, 0, 0, 0);
        }
        __syncthreads();
        if (wid >= 4) {
            f32x16 acc_n = f32x16{};
            const MLAS char* sa = SC + (32 * jb + r32) * PS + hi * 16;
            {   s16x4 l0, l1, l2, l3, h0, h1, h2, h3;
                if (tb0 == 0) { ML_TRRD(l0, trb_vc, 0); ML_TRRD(h0, trb_vc, 2048); ML_TRRD(l1, trb_vc, 4096); ML_TRRD(h1, trb_vc, 6144); ML_TRRD(l2, trb_vc, 8192); ML_TRRD(h2, trb_vc, 10240); ML_TRRD(l3, trb_vc, 12288); ML_TRRD(h3, trb_vc, 14336); }
                else { ML_TRRD(l0, trb_vc, 512); ML_TRRD(h0, trb_vc, 512 + 2048); ML_TRRD(l1, trb_vc, 512 + 4096); ML_TRRD(h1, trb_vc, 512 + 6144); ML_TRRD(l2, trb_vc, 512 + 8192); ML_TRRD(h2, trb_vc, 512 + 10240); ML_TRRD(l3, trb_vc, 512 + 12288); ML_TRRD(h3, trb_vc, 512 + 14336); }
                const bf16x8 s0 = *reinterpret_cast<const MLAS bf16x8*>(sa), s1 = *reinterpret_cast<const MLAS bf16x8*>(sa + 32), s2 = *reinterpret_cast<const MLAS bf16x8*>(sa + 64), s3 = *reinterpret_cast<const MLAS bf16x8*>(sa + 96);
                asm volatile("s_waitcnt lgkmcnt(0)" ::: "memory"); ML_SBAR();
                acc_n = __builtin_amdgcn_mfma_f32_32x32x16_bf16(ML_FR(l0, h0), s0, acc_n, 0, 0, 0);
                acc_n = __builtin_amdgcn_mfma_f32_32x32x16_bf16(ML_FR(l1, h1), s1, acc_n, 0, 0, 0);
                acc_n = __builtin_amdgcn_mfma_f32_32x32x16_bf16(ML_FR(l2, h2), s2, acc_n, 0, 0, 0);
                acc_n = __builtin_amdgcn_mfma_f32_32x32x16_bf16(ML_FR(l3, h3), s3, acc_n, 0, 0, 0); }
            const int j = 32 * jb + r32; const float inter = arrc[A_INTER + j];
            const float den = arrc[A_RS0 + j] + arrc[A_RS1 + j] + inter * arrc[A_QN + j];
            const float rden = 1.f / fmaxf(fabsf(den), arrc[A_EMJ + j]);
            float ss = 0.f;
#pragma unroll
            for (int q4 = 0; q4 < 4; ++q4) { float hv[4];
#pragma unroll
                for (int i = 0; i < 4; ++i) { hv[i] = (acc_n[4 * q4 + i] + inter * acc_qc[4 * q4 + i]) * rden; ss += hv[i] * hv[i]; }
                { const float o0 = bf2f_lo(ogc[q4][0]), o1 = bf2f_hi(ogc[q4][0]), o2 = bf2f_lo(ogc[q4][1]), o3 = bf2f_hi(ogc[q4][1]);
                  hv[0] = hv[0] / (1.f + __expf(-o0)); hv[1] = hv[1] / (1.f + __expf(-o1)); hv[2] = hv[2] / (1.f + __expf(-o2)); hv[3] = hv[3] / (1.f + __expf(-o3)); }
                *reinterpret_cast<MLAS u32x2*>(OUT + j * 128 + (32 * tb0 + 8 * q4 + 4 * hi) * 2) = (u32x2){cvtpk(hv[0], hv[1]), cvtpk(hv[2], hv[3])}; }
            ss += __shfl_xor(ss, 32);
            if (hi == 0) OSS[tb0 * 64 + j] = ss;
        }
        {
            const int dv = 32 * dvb + r32;
#pragma unroll
            for (int q4 = 0; q4 < 4; ++q4) { const u32x2 w = {cvtpk(cst[4 * q4], cst[4 * q4 + 1]), cvtpk(cst[4 * q4 + 2], cst[4 * q4 + 3])};
                *reinterpret_cast<MLAS u32x2*>(CIMG + dv * PQ + (32 * dkb + 8 * q4 + 4 * hi) * 2) = w; }
        }
        if (tid < 128) { float s = nvec[tid] * decay;
#pragma unroll
            for (int w = 0; w < 8; ++w) s += npart[w * 128 + tid];
            nvec[tid] = s; }
    }
    __syncthreads();
    ML_STORE_OUT((NC - 1) * L);
#undef ML_STORE_OUT
#undef ML_LOAD
}
}
static_assert(ml::LDS_BYTES <= 131072, "mLSTM LDS inside the ring region");
constexpr size_t MiB = 1u << 20;
constexpr size_t WS_CTL = 0, CTL_ZERO_BYTES = 1 * MiB;
constexpr size_t WS_WQKV = 2 * MiB, WS_WAO = 8 * MiB, WS_WML = 10 * MiB  , WS_WMO = 17 * MiB, WS_W1 = 19 * MiB  , WS_W2 = 35 * MiB  ;
constexpr size_t WS_GATES = 51 * MiB;
constexpr size_t WS_SSQ = 52 * MiB;
constexpr size_t WS_GS = 56 * MiB;
constexpr size_t WS_SSQH = 58 * MiB;
constexpr size_t WS_XN = 64 * MiB;
constexpr size_t WS_U = 128 * MiB;
constexpr size_t WS_HT = 320 * MiB;
constexpr size_t WS_AO = 384 * MiB;
constexpr size_t WS_STASH = 448 * MiB;
constexpr size_t WS_END = 480 * MiB;
constexpr int CW_TMO = 0, CW_CODE = 1;
constexpr int CW_BAR = 4096;
constexpr int RING_OFF = 0, RING_BYTES = 131072;
constexpr int LDSCTL_OFF = RING_BYTES, MISC_OFF = LDSCTL_OFF + 320;
constexpr int EPIRED_OFF = LDSCTL_OFF + 1024;
constexpr int RSTD_OFF = EPIRED_OFF + 4096;
constexpr int LDS_BYTES = 147456;
static_assert(RSTD_OFF + 8192 <= LDS_BYTES, "LDS map");
static_assert(MISC_OFF + 128 <= LDS_BYTES, "LDS map");

#define GAS __attribute__((address_space(1)))
#define LAS __attribute__((address_space(3)))
typedef unsigned short bf16;
typedef unsigned v4u __attribute__((ext_vector_type(4)));
typedef float f32x4 __attribute__((ext_vector_type(4)));
typedef short bf16x8 __attribute__((ext_vector_type(8)));
typedef GAS unsigned gu32;
typedef GAS unsigned long long gu64;
#define RLX_AGENT __ATOMIC_RELAXED, __HIP_MEMORY_SCOPE_AGENT
#define LDS_WAIT() asm volatile("s_waitcnt lgkmcnt(0)" ::: "memory")
#define VM_WAIT() asm volatile("s_waitcnt vmcnt(0)" ::: "memory")
__device__ __forceinline__ unsigned long long rt() { return __builtin_amdgcn_s_memrealtime(); }
__device__ __forceinline__ unsigned f2bf(float f) { unsigned u = __builtin_bit_cast(unsigned, f); return (u + 0x7fffu + ((u >> 16) & 1u)) >> 16; }
__device__ __forceinline__ unsigned pk2(float lo, float hi) { return f2bf(lo) | (f2bf(hi) << 16); }

#define XB_TMO      128
#define XB_XCNT(j)  (256  + 64 * (j))
#define XB_XSUB(j)  (1280 + 64 * (j))
#define XB_XGEN(j)  (2304 + 64 * (j))
#define XB_TOP      3328
#define XB_TOPGEN   3392
#define XCD_BAR_WORDS 3456
#define XB_SPIN_CAP (1u << 23)

__device__ __forceinline__ unsigned xb_ld(unsigned* p)              { return __hip_atomic_load(p, __ATOMIC_RELAXED, __HIP_MEMORY_SCOPE_AGENT); }
__device__ __forceinline__ unsigned xb_add(unsigned* p, unsigned v) { return __hip_atomic_fetch_add(p, v, __ATOMIC_RELAXED, __HIP_MEMORY_SCOPE_AGENT); }
__device__ __forceinline__ unsigned xb_xcc_id() { return (unsigned)__builtin_amdgcn_s_getreg((3 << 11) | 20) & 0xFu; }
#define XB_SPIN(cond, bar) do { unsigned _sp = 0; while (cond) { __builtin_amdgcn_s_sleep(1); \
    if ((++_sp & 255u) == 0u) { if (xb_ld(&(bar)[XB_TMO])) break; if (_sp > XB_SPIN_CAP) { atomicAdd(&(bar)[XB_TMO], 1u); break; } } } } while (0)

struct XcdBarrier {
    unsigned* bar; unsigned x;
    volatile LAS unsigned* st;
};

__device__ __forceinline__ XcdBarrier xcd_barrier_post(unsigned* bar, volatile LAS unsigned* st) {
    XcdBarrier b; b.bar = bar; b.x = xb_xcc_id(); b.st = st;
    if (threadIdx.x == 0) (void)xb_add(&bar[XB_XCNT(b.x)], 1u);
    return b;
}
__device__ __forceinline__ void xcd_barrier_complete(unsigned* bar, unsigned x, unsigned& nloc, unsigned& nx) {
    const unsigned G = gridDim.x * gridDim.y * gridDim.z;
    unsigned sum, cnt, mine, sp = 0u;
    for (;;) {
        sum = 0u; cnt = 0u; mine = 0u;
#pragma unroll
        for (unsigned j = 0; j < 16; ++j) { const unsigned c = xb_ld(&bar[XB_XCNT(j)]); sum += c; cnt += (c > 0u) ? 1u : 0u; mine = (j == x) ? c : mine; }
        if (sum == G) break;
        __builtin_amdgcn_s_sleep(1);
        if ((++sp & 255u) == 0u) { if (xb_ld(&bar[XB_TMO])) break; if (sp > XB_SPIN_CAP) { atomicAdd(&bar[XB_TMO], 1u); break; } }
    }
    nloc = mine > 0u ? mine : 1u; nx = cnt > 0u ? cnt : 1u;
}

__device__ __forceinline__ void xcd_barrier(const XcdBarrier& b) {
    asm volatile("s_waitcnt vmcnt(0)" ::: "memory");
    __syncthreads();
    if (threadIdx.x == 0) {
        unsigned* bar = b.bar;
        __builtin_amdgcn_s_waitcnt(0);
        unsigned nloc = b.st[0], nx = b.st[1];
        if (nloc == 0u) { xcd_barrier_complete(bar, b.x, nloc, nx); b.st[0] = nloc; b.st[1] = nx; }
        const unsigned old = xb_add(&bar[XB_XSUB(b.x)], 1u);
        const unsigned gen = old / nloc;
        if (old + 1u == (gen + 1u) * nloc) {
            __builtin_amdgcn_fence(__ATOMIC_RELEASE, "agent");
            asm volatile("s_waitcnt vmcnt(0)" ::: "memory");
            const unsigned og = xb_add(&bar[XB_TOP], 1u);
            const unsigned tg = og / nx;
            if (og + 1u == (tg + 1u) * nx) xb_add(&bar[XB_TOPGEN], 1u);
            else XB_SPIN(xb_ld(&bar[XB_TOPGEN]) == tg, bar);
            __builtin_amdgcn_fence(__ATOMIC_ACQUIRE, "agent");
            xb_add(&bar[XB_XGEN(b.x)], 1u);
            asm volatile("s_waitcnt vmcnt(0)" ::: "memory");
        } else {
            XB_SPIN(xb_ld(&bar[XB_XGEN(b.x)]) == gen, bar);
            __builtin_amdgcn_fence(__ATOMIC_ACQUIRE, "agent");
            asm volatile("s_waitcnt vmcnt(0)" ::: "memory");
        }
    }
    __syncthreads();
}

struct Frame {
    LAS unsigned char* lds;
    volatile LAS unsigned* MISC;
    gu32* ctl;
    int tid, lane, wave;
    int vcu, G;
};
__device__ __forceinline__ float wave_sum(float v) {
#pragma unroll
    for (int o = 1; o < 64; o <<= 1) v += __shfl_xor(v, o);
    return v;
}
__device__ __forceinline__ void p0_transpose_item(const float* W, int K, int ldw, int nblk, bf16* WT, const float* gk, int gmask, float gs, LAS float* scr, int item, int lane) {
    const int kb = item / nblk, nb = item % nblk, k0 = 64 * kb, n0 = 64 * nb;
    f32x4 v[16];
#pragma unroll
    for (int i = 0; i < 16; ++i) v[i] = *(const GAS f32x4*)(W + (size_t)(k0 + 4 * i + (lane >> 4)) * ldw + n0 + (lane & 15) * 4);
#pragma unroll
    for (int i = 0; i < 16; ++i) { const int kk = 4 * i + (lane >> 4); const float g = gk ? gk[(k0 + kk) & gmask] * gs : gs; LAS float* d = scr + kk * 64; const int nn = (lane & 15) * 4 + kk;
        d[nn & 63] = v[i].x * g; d[(nn + 1) & 63] = v[i].y * g; d[(nn + 2) & 63] = v[i].z * g; d[(nn + 3) & 63] = v[i].w * g; }
    LDS_WAIT(); asm volatile("" ::: "memory");
    const int c = lane & 7;
#pragma unroll
    for (int j = 0; j < 8; ++j) { const int n = (lane >> 3) + 8 * j; const LAS float* s = scr + (8 * c) * 64; const int nn = n + 8 * c;
        v4u o; o.x = pk2(s[0 * 64 + (nn & 63)], s[1 * 64 + ((nn + 1) & 63)]); o.y = pk2(s[2 * 64 + ((nn + 2) & 63)], s[3 * 64 + ((nn + 3) & 63)]);
        o.z = pk2(s[4 * 64 + ((nn + 4) & 63)], s[5 * 64 + ((nn + 5) & 63)]); o.w = pk2(s[6 * 64 + ((nn + 6) & 63)], s[7 * 64 + ((nn + 7) & 63)]);
        *(GAS v4u*)(WT + (size_t)(n0 + n) * K + k0 + 8 * c) = o; }
    LDS_WAIT(); asm volatile("" ::: "memory");
}
__device__ __forceinline__ void rms_row_load(const float* xrow, int lane, f32x4 (&v)[4]) {
    const GAS f32x4* xr = (const GAS f32x4*)xrow + lane; float s2 = 0.f;
#pragma unroll
    for (int j = 0; j < 4; ++j) { v[j] = xr[64 * j]; s2 += (v[j].x * v[j].x + v[j].y * v[j].y) + (v[j].z * v[j].z + v[j].w * v[j].w); }
    const float rstd = 1.f / sqrtf(wave_sum(s2) * (1.f / D) + EPS);
#pragma unroll
    for (int j = 0; j < 4; ++j) v[j] = v[j] * rstd;
}
__device__ __forceinline__ void row_store_bf16(bf16* orow, int lane, const f32x4 (&v)[4]) {
    GAS unsigned long long* o8 = (GAS unsigned long long*)orow + lane;
#pragma unroll
    for (int j = 0; j < 4; ++j) o8[64 * j] = (unsigned long long)pk2(v[j].x, v[j].y) | ((unsigned long long)pk2(v[j].z, v[j].w) << 32);
}
__device__ __forceinline__ float log_sigmoid(float x) { return fminf(x, 0.f) - log1pf(expf(-fabsf(x))); }

struct Args { const float* in[22]; float* out; unsigned char* ws; int ph_lo, ph_hi, li, pad; };

__device__ __forceinline__ void p0_prologue(Frame& F, const Args& a) {
    unsigned char* ws = a.ws;
    LAS float* scr = (LAS float*)(F.lds + RING_OFF + F.wave * 16384);
    const int gw = F.vcu * NWAVES + F.wave, NGW = F.G * NWAVES;
    constexpr int I_QKV = (D / 64) * (NQKV / 64), I_O = (D / 64) * (D / 64), I_ML = (D / 64) * (NPROJ / 64), I_1 = (D / 64) * (FF / 64), I_2 = (FF / 64) * (D / 64);
    constexpr int NITEMS = I_QKV + I_O + I_ML + I_O + 2 * I_1 + 2 * I_2;
    for (int it = gw; it < NITEMS; it += NGW) {
        int r = it;
        if (r < I_QKV) { p0_transpose_item(a.in[3], D, NQKV, NQKV / 64, (bf16*)(ws + WS_WQKV), a.in[2], 0xffff, 1.f, scr, r, F.lane); continue; } r -= I_QKV;
        if (r < I_O) { p0_transpose_item(a.in[9], D, D, D / 64, (bf16*)(ws + WS_WAO), a.in[8], 127, 1.f - LAMBDA_INIT0, scr, r, F.lane); continue; } r -= I_O;
        if (r < I_ML) { p0_transpose_item(a.in[11], D, MLW, NPROJ / 64, (bf16*)(ws + WS_WML), a.in[10], 0xffff, 1.f, scr, r, F.lane); continue; } r -= I_ML;
        if (r < I_O) { p0_transpose_item(a.in[17], D, D, D / 64, (bf16*)(ws + WS_WMO), a.in[16], 0xffff, 1.f, scr, r, F.lane); continue; } r -= I_O;
        if (r < 2 * I_1) { const int l = r / I_1; p0_transpose_item(a.in[19] + (size_t)l * D * FF, D, FF, FF / 64, (bf16*)(ws + WS_W1) + (size_t)l * D * FF, a.in[18] + l * D, 0xffff, 1.f, scr, r % I_1, F.lane); continue; } r -= 2 * I_1;
        { const int l = r / I_2; p0_transpose_item(a.in[20] + (size_t)l * D * FF, FF, D, D / 64, (bf16*)(ws + WS_W2) + (size_t)l * D * FF, nullptr, 0, 1.f, scr, r % I_2, F.lane); }
    }
    { bf16* WT = (bf16*)(ws + WS_WML) + (size_t)NPROJ * D; const int gt = (F.vcu * NWAVES + F.wave) * 64 + F.lane, NGT = F.G * NWAVES * 64;
      for (int i = gt; i < 256 * D / 2; i += NGT) { const int j = (2 * i) / D, k = (2 * i) % D;
          const unsigned w = j < 8 ? pk2(a.in[10][k] * a.in[11][(size_t)k * MLW + NPROJ + j], a.in[10][k + 1] * a.in[11][(size_t)(k + 1) * MLW + NPROJ + j]) : 0u;
          ((GAS unsigned*)WT)[i] = w; } }
    bf16* XN = (bf16*)(ws + WS_XN); float* SSQH = (float*)(ws + WS_SSQH);
    for (int m = gw; m < M; m += NGW) { f32x4 v[4]; const GAS f32x4* xr = (const GAS f32x4*)(a.in[0] + (size_t)m * D) + F.lane; float s2 = 0.f;
#pragma unroll
        for (int j = 0; j < 4; ++j) { v[j] = xr[64 * j]; s2 += (v[j].x * v[j].x + v[j].y * v[j].y) + (v[j].z * v[j].z + v[j].w * v[j].w); }
        s2 = wave_sum(s2); row_store_bf16(XN + (size_t)m * D, F.lane, v);
        if (F.lane < 4) SSQH[(size_t)m * 4 + F.lane] = F.lane == 0 ? s2 : 0.f; }
}
__device__ __forceinline__ void final_norm_phase(Frame& F, const bf16* XN, const float* SSQH, const float* g, float* out) {
    const int gw = F.vcu * NWAVES + F.wave, NGW = F.G * NWAVES;
    for (int m = gw; m < M; m += NGW) {
        const float rstd = pg8::row_rstd(SSQH, m);
        const v4u h0 = *(const GAS v4u*)(XN + (size_t)m * D + F.lane * 16), h1 = *(const GAS v4u*)(XN + (size_t)m * D + F.lane * 16 + 8);
        GAS f32x4* o = (GAS f32x4*)(out + (size_t)m * D + F.lane * 16); const GAS f32x4* gg = (const GAS f32x4*)(g + F.lane * 16);
#pragma unroll
        for (int q = 0; q < 2; ++q) { const f32x4 a = gg[q];
            o[q] = (f32x4){__uint_as_float(h0[2 * q] << 16) * rstd * a.x, __uint_as_float(h0[2 * q] & 0xffff0000u) * rstd * a.y, __uint_as_float(h0[2 * q + 1] << 16) * rstd * a.z, __uint_as_float(h0[2 * q + 1] & 0xffff0000u) * rstd * a.w}; }
#pragma unroll
        for (int q = 0; q < 2; ++q) { const f32x4 a = gg[2 + q];
            o[2 + q] = (f32x4){__uint_as_float(h1[2 * q] << 16) * rstd * a.x, __uint_as_float(h1[2 * q] & 0xffff0000u) * rstd * a.y, __uint_as_float(h1[2 * q + 1] << 16) * rstd * a.z, __uint_as_float(h1[2 * q + 1] & 0xffff0000u) * rstd * a.w}; }
    }
}

__device__ __forceinline__ float bf2f(bf16 v) { return __uint_as_float((unsigned)v << 16); }
__device__ __forceinline__ int t5_bucket(int d) {
    if (d < 16) return d;
    const float v = logf((float)d / 16.f) / logf(8.f) * 16.f; int b = 16 + (int)v; return b > 31 ? 31 : b;
}
__device__ __forceinline__ void naive_attn_phase(Frame& F, const bf16* __restrict__ QKV, const float* __restrict__ rel_bias, const float* __restrict__ lq1, const float* __restrict__ lk1,
                                                  const float* __restrict__ lq2, const float* __restrict__ lk2, bf16* AO) {
    LAS float* lut = (LAS float*)(F.lds + RING_OFF);
    const int tid = F.tid, half = tid & 1;
    float s1 = 0.f, s2 = 0.f;
    for (int i = 0; i < 64; ++i) { s1 += lq1[i] * lk1[i]; s2 += lq2[i] * lk2[i]; }
    const float lam = expf(s1) - expf(s2) + LAMBDA_INIT0;
    for (int u = F.vcu; u < BATCH * NH_A * (SEQ / 256); u += F.G) {
        const int qb = u % (SEQ / 256), h = (u / (SEQ / 256)) % NH_A, b = u / (SEQ / 256) / NH_A, q0 = qb * 256, q = q0 + (tid >> 1);
        __syncthreads();
        if (tid < 128) lut[tid] = rel_bias[t5_bucket(tid) * NH_A + h] * LOG2E;
        __syncthreads();
        const size_t tok = (size_t)b * SEQ + q;
        float res[64];
        for (int m = 0; m < 2; ++m) {
            float qv[64];
            const bf16* qp = QKV + tok * NQKV + h * 128 + m * 64;
#pragma unroll
            for (int d = 0; d < 64; ++d) qv[d] = bf2f(qp[d]);
            float o[64];
#pragma unroll
            for (int d = 0; d < 64; ++d) o[d] = 0.f;
            float mrun = -1e30f, l = 0.f;
            const int kend = q0 + 256;
            for (int k = 0; k < kend; ++k) {
                const bf16* kr = QKV + ((size_t)b * SEQ + k) * NQKV + D + h * 128 + m * 64;
                const bf16* vr = QKV + ((size_t)b * SEQ + k) * NQKV + 2 * D + h * 128 + half * 64;
                float s = 0.f;
#pragma unroll
                for (int d = 0; d < 64; ++d) s += qv[d] * bf2f(kr[d]);
                const int dist = q - k;
                if (dist >= 0) {
                    s += lut[dist < 127 ? dist : 127];
                    if (s > mrun) { const float al = exp2f(mrun - s); l *= al;
#pragma unroll
                        for (int d = 0; d < 64; ++d) o[d] *= al;
                        mrun = s; }
                    const float p = exp2f(s - mrun); l += p;
#pragma unroll
                    for (int d = 0; d < 64; ++d) o[d] += p * bf2f(vr[d]);
                }
            }
            const float il = 1.f / l;
            if (m == 0) {
#pragma unroll
                for (int d = 0; d < 64; ++d) res[d] = o[d] * il;
            } else {
                float ss = 0.f;
#pragma unroll
                for (int d = 0; d < 64; ++d) { res[d] = res[d] - lam * (o[d] * il); ss += res[d] * res[d]; }
                ss += __shfl_xor(ss, 1);
                const float rstd = 1.f / sqrtf(ss * (1.f / 128.f) + EPS);
                bf16* op = AO + tok * D + h * 128 + half * 64;
#pragma unroll
                for (int d = 0; d < 64; d += 2) *(unsigned*)(op + d) = pk2(res[d] * rstd, res[d + 1] * rstd);
            }
        }
    }
    __syncthreads();
}
__device__ __forceinline__ void naive_mlstm_phase(Frame& F, const bf16* __restrict__ PROJ, const float* __restrict__ GATES, const float* __restrict__ conv_w, const float* __restrict__ conv_b, bf16* AO) {
    LAS float* q_s = (LAS float*)(F.lds + RING_OFF); LAS float* k_s = q_s + 128; LAS float* v_s = q_s + 256; LAS float* red = q_s + 512;
    const int tid = F.tid, dv = tid >> 1, half = tid & 1, lane = F.lane, wave = F.wave;
    for (int u = (int)blockIdx.x; u < BATCH * NH_M; u += F.G) {
        const int h = u & 3, b = u >> 2;
        float C[64], n[64];
#pragma unroll
        for (int j = 0; j < 64; ++j) { C[j] = 0.f; n[j] = 0.f; }
        float mst = 0.f;
        const int col = (tid < 128) ? (h * 128 + tid) : (512 + h * 128 + ((tid - 128) & 127));
        float cw0 = 0.f, cw1 = 0.f, cw2 = 0.f, cw3 = 0.f, cb = 0.f;
        if (tid < 256) { cw0 = conv_w[0 * D + col]; cw1 = conv_w[1 * D + col]; cw2 = conv_w[2 * D + col]; cw3 = conv_w[3 * D + col]; cb = conv_b[col]; }
        __syncthreads();
        for (int t = 0; t < SEQ; ++t) {
            const size_t tok = (size_t)b * SEQ + t;
            if (tid < 256) {
                float x3 = bf2f(PROJ[tok * NPROJ + col]);
                float x2 = t >= 1 ? bf2f(PROJ[(tok - 1) * NPROJ + col]) : 0.f;
                float x1 = t >= 2 ? bf2f(PROJ[(tok - 2) * NPROJ + col]) : 0.f;
                float x0 = t >= 3 ? bf2f(PROJ[(tok - 3) * NPROJ + col]) : 0.f;
                float y = cw0 * x0 + cw1 * x1 + cw2 * x2 + cw3 * x3 + cb;
                y = y / (1.f + expf(-y));
                if (tid < 128) q_s[tid] = y * MQSCALE; else k_s[tid - 128] = y;
            } else {
                v_s[tid - 256] = bf2f(PROJ[tok * NPROJ + 1024 + h * 256 + (tid - 256)]);
            }
            const float ig = GATES[tok * 8 + h], lf = GATES[tok * 8 + 4 + h];
            __syncthreads();
            const float mnew = fmaxf(lf + mst, ig), fd = expf(lf + mst - mnew), gi = expf(ig - mnew);
            mst = mnew;
            const float gv = gi * v_s[dv];
            float num = 0.f, den = 0.f;
#pragma unroll
            for (int j = 0; j < 64; ++j) { const float kk = k_s[half * 64 + j], qq = q_s[half * 64 + j];
                C[j] = fd * C[j] + gv * kk; n[j] = fd * n[j] + gi * kk; num += C[j] * qq; den += n[j] * qq; }
            num += __shfl_xor(num, 1); den += __shfl_xor(den, 1);
            const float hv = num / fmaxf(fabsf(den), expf(-mnew));
            float ss = half == 0 ? hv * hv : 0.f;
            ss = wave_sum(ss);
            if (lane == 0) red[wave] = ss;
            __syncthreads();
            float tot = 0.f;
#pragma unroll
            for (int w = 0; w < 8; ++w) tot += red[w];
            const float rstd = 1.f / sqrtf(tot * (1.f / 256.f) + EPS);
            if (half == 0) { const float op = bf2f(PROJ[tok * NPROJ + 2048 + h * 256 + dv]); const float sg = 1.f / (1.f + expf(-op));
                AO[tok * D + h * 256 + dv] = (bf16)f2bf(sg * hv * rstd); }
            __syncthreads();
        }
    }
}

__device__ __forceinline__ void attn_phase(Frame& F, const bf16* __restrict__ QKV, bf16* AO, float* stash, const float* __restrict__ rel_bias, const float* __restrict__ lq1, const float* __restrict__ lk1,
                                           const float* __restrict__ lq2, const float* __restrict__ lk2) {
    using da2::f32x16; using da2::f32x4;
    LAS char* lds = (LAS char*)(F.lds + RING_OFF);
    LAS float* tbl = (LAS float*)(lds + da2::OFF_LUT);
    const int tid = F.tid, lane = F.lane, wid = F.wave, r32 = lane & 31, hi = lane >> 5;
    float s1 = 0.f, s2 = 0.f;
    for (int i = 0; i < 64; ++i) { s1 += lq1[i] * lk1[i]; s2 += lq2[i] * lk2[i]; }
    const float lam = expf(s1) - expf(s2) + LAMBDA_INIT0;
    const __amdgpu_buffer_rsrc_t strs = __builtin_amdgcn_make_buffer_rsrc(stash + ((size_t)blockIdx.x * NWAVES + wid) * 4096, 0, 16384, 0x00020000);
    const int stvo = lane * 16;
    LAS char* stg = lds + wid * da2::STG_WAVE;
    for (int L = F.vcu; L < BATCH * NH_A * 4; L += F.G) {
        const int bh = L >> 2, x = L & 3, b = bh >> 3, h = bh & 7;
        __syncthreads();
        const float c31 = rel_bias[31 * NH_A + h] * LOG2E;
        for (int i = tid; i < 4 * da2::TBL_N; i += NWAVES * 64) { const int c = i >> 9, y = i & 511, d = da2::TBL_X0 - (y + c);
            tbl[i] = d < 0 ? -__builtin_inff() : (d > 127 ? 0.f : rel_bias[t5_bucket(d) * NH_A + h] * LOG2E - c31); }
        __syncthreads();
        for (int s = 0; s < 4; ++s) {
            const int qb = (s >> 1) ? 7 - x : x, m = s & 1, P0 = qb * 256;
            const bf16* Qp = QKV + ((size_t)b * SEQ + P0) * NQKV + h * 128 + m * 64;
            const bf16* Kp = QKV + (size_t)b * SEQ * NQKV + D + h * 128 + m * 64;
            const bf16* Vp = QKV + (size_t)b * SEQ * NQKV + 2 * D + h * 128;
            f32x16 o[4];
            da2::attn_block(Qp, Kp, Vp, P0, lds, c31, o);
            if (m == 0) {
#pragma unroll
                for (int i = 0; i < 16; ++i) { const f32x4 v = {o[i >> 2][(i & 3) * 4 + 0], o[i >> 2][(i & 3) * 4 + 1], o[i >> 2][(i & 3) * 4 + 2], o[i >> 2][(i & 3) * 4 + 3]};
                    __builtin_amdgcn_raw_buffer_store_b128(__builtin_bit_cast(v4u, v), strs, stvo, i * 1024, 0); }
            } else {
#pragma unroll
                for (int i = 0; i < 16; ++i) { const f32x4 sti = __builtin_bit_cast(f32x4, __builtin_amdgcn_raw_buffer_load_b128(strs, stvo, i * 1024, 0));
#pragma unroll
                    for (int e = 0; e < 4; ++e) { const int dq = i >> 2, r = (i & 3) * 4 + e; const float v = sti[e] - lam * o[dq][r];
                        *(LAS unsigned short*)(stg + da2::crow(r, hi) * da2::STG_PITCH + (dq * 32 + r32) * 2) = (unsigned short)f2bf(v); } }
                asm volatile("s_waitcnt lgkmcnt(0)" ::: "memory");
                const int row = lane >> 1, half = lane & 1;
                v4u w[8]; float ss = 0.f;
#pragma unroll
                for (int i = 0; i < 8; ++i) { w[i] = *(const LAS v4u*)(stg + row * da2::STG_PITCH + half * 128 + i * 16);
#pragma unroll
                    for (int q = 0; q < 4; ++q) { const float a0 = __uint_as_float(w[i][q] << 16), a1 = __uint_as_float(w[i][q] & 0xffff0000u); ss += a0 * a0 + a1 * a1; } }
                ss += __shfl_xor(ss, 1);
                const float rstd = __builtin_amdgcn_rsqf(ss * (1.f / 128.f) + EPS);
                bf16* Ow = AO + ((size_t)b * SEQ + P0 + wid * 32 + row) * D + h * 128 + half * 64;
#pragma unroll
                for (int i = 0; i < 8; ++i) { v4u ov;
#pragma unroll
                    for (int q = 0; q < 4; ++q) ov[q] = pk2(__uint_as_float(w[i][q] << 16) * rstd, __uint_as_float(w[i][q] & 0xffff0000u) * rstd);
                    *(GAS v4u*)(Ow + i * 8) = ov; }
                asm volatile("s_waitcnt lgkmcnt(0)\n\ts_barrier" ::: "memory");
            }
        }
    }
    __syncthreads();
}
__device__ __forceinline__ void convscan_phase(Frame& F, const bf16* __restrict__ PROJ, const float* __restrict__ GATES, const float* __restrict__ conv_w, const float* __restrict__ conv_b, bf16* QKC, float* GS) {
    {   const int pc = F.tid & 127, col = pc * 8;
        float cw[4][8], cbias[8];
#pragma unroll
        for (int i = 0; i < 8; ++i) { cbias[i] = conv_b[col + i];
#pragma unroll
            for (int t = 0; t < 4; ++t) cw[t][i] = conv_w[t * 1024 + col + i]; }
        const float osc = col < 512 ? MQSCALE : 1.f;
        for (int seg = F.vcu * 4 + (F.tid >> 7); seg < M / 32; seg += F.G * 4) {
            const int tokb = seg * 32;
#pragma unroll 1
            for (int run = 0; run < 4; ++run) {
                const int t8 = tokb + run * 8; const bool first = (t8 & (SEQ - 1)) == 0;
                const bf16* p = PROJ + (size_t)t8 * NPROJ + col;
                v4u r[11];
#pragma unroll
                for (int i = 0; i < 3; ++i) r[i] = first ? (v4u){0u, 0u, 0u, 0u} : *(const GAS v4u*)(p + ((ptrdiff_t)i - 3) * NPROJ);
#pragma unroll
                for (int i = 3; i < 11; ++i) r[i] = *(const GAS v4u*)(p + (size_t)(i - 3) * NPROJ);
#pragma unroll
                for (int t = 0; t < 8; ++t) {
                    unsigned o[4];
#pragma unroll
                    for (int q = 0; q < 4; ++q) {
                        float s0 = cbias[2 * q], s1 = cbias[2 * q + 1];
#pragma unroll
                        for (int tap = 0; tap < 4; ++tap) { const unsigned w = r[t + tap][q]; s0 += cw[tap][2 * q] * __uint_as_float(w << 16); s1 += cw[tap][2 * q + 1] * __uint_as_float(w & 0xffff0000u); }
                        s0 = s0 / (1.f + __expf(-s0)) * osc; s1 = s1 / (1.f + __expf(-s1)) * osc; o[q] = pk2(s0, s1); }
                    *(GAS v4u*)(QKC + (size_t)(t8 + t) * D + col) = (v4u){o[0], o[1], o[2], o[3]};
                }
            }
        }
    }
    {   const int gw = F.vcu * NWAVES + F.wave, NGW = F.G * NWAVES, lane = F.lane;
        for (int task = gw; task < BATCH * NH_M * (SEQ / 64); task += NGW) {
            const int c = task % (SEQ / 64), h = (task / (SEQ / 64)) % NH_M, b = task / (SEQ / 64) / NH_M;
            const size_t tok = (size_t)b * SEQ + c * 64 + lane;
            const float ig = GATES[tok * 8 + h], lf = GATES[tok * 8 + 4 + h];
            float bsum = lf;
#pragma unroll
            for (int off = 1; off < 64; off <<= 1) { const float t = __shfl_up(bsum, off); if (lane >= off) bsum += t; }
            const float e = ig - bsum; float pm = e;
#pragma unroll
            for (int off = 1; off < 64; off <<= 1) { const float t = __shfl_up(pm, off); if (lane >= off) pm = fmaxf(pm, t); }
            *(GAS f32x4*)(GS + tok * 16 + h * 4) = (f32x4){bsum, e, pm, 0.f};
        }
    }
}
__device__ __forceinline__ void mlstm_phase(Frame& F, const bf16* __restrict__ PROJ, const bf16* __restrict__ QKC, const float* __restrict__ GS, bf16* HT, float* SSQ) {
    for (int u = F.vcu; u < BATCH * NH_M * 4; u += F.G) {
        __syncthreads();
        ml::mlstm_unit(u >> 4, (u >> 2) & 3, u & 3, PROJ, QKC, GS, HT, SSQ, (LAS char*)(F.lds + RING_OFF));
    }
    __syncthreads();
}
__device__ __forceinline__ void gatenorm_phase(Frame& F, const bf16* __restrict__ PROJ, const bf16* __restrict__ HT, const float* __restrict__ SSQ, bf16* AO) {
    const int gw = F.vcu * NWAVES + F.wave, NGW = F.G * NWAVES, lane = F.lane;
    for (int m = gw; m < M; m += NGW) {
        const int hd = lane >> 4;
        const float* sp = SSQ + ((size_t)((m >> 11) * 4 + hd) * 8) * 2048 + (m & 2047); float tot = 0.f;
#pragma unroll
        for (int p = 0; p < 8; ++p) tot += sp[(size_t)p * 2048];
        const float rstd = 1.f / sqrtf(tot * (1.f / 256.f) + EPS);
        const v4u h0 = *(const GAS v4u*)(HT + (size_t)m * D + lane * 16), h1 = *(const GAS v4u*)(HT + (size_t)m * D + lane * 16 + 8);
        const v4u o0 = *(const GAS v4u*)(PROJ + (size_t)m * NPROJ + 2048 + lane * 16), o1 = *(const GAS v4u*)(PROJ + (size_t)m * NPROJ + 2048 + lane * 16 + 8);
        v4u r0, r1;
#pragma unroll
        for (int q = 0; q < 4; ++q) {
            { const float ha = __uint_as_float(h0[q] << 16) * rstd, hb = __uint_as_float(h0[q] & 0xffff0000u) * rstd, oa = __uint_as_float(o0[q] << 16), ob = __uint_as_float(o0[q] & 0xffff0000u);
              r0[q] = pk2(ha / (1.f + __expf(-oa)), hb / (1.f + __expf(-ob))); }
            { const float ha = __uint_as_float(h1[q] << 16) * rstd, hb = __uint_as_float(h1[q] & 0xffff0000u) * rstd, oa = __uint_as_float(o1[q] << 16), ob = __uint_as_float(o1[q] & 0xffff0000u);
              r1[q] = pk2(ha / (1.f + __expf(-oa)), hb / (1.f + __expf(-ob))); }
        }
        *(GAS v4u*)(AO + (size_t)m * D + lane * 16) = r0; *(GAS v4u*)(AO + (size_t)m * D + lane * 16 + 8) = r1;
    }
}

template <class Epi>
__device__ __forceinline__ void run_gemm(Frame& F, const bf16* A, const bf16* Bt, int N, int K, const Epi& E, const float* ssq = nullptr) {
    pg8::Gemm g{A, Bt, M, N, K}; pg8::StaticOrder S; S.init(M, N, F.G, (int)blockIdx.x);
    if (ssq) pg8::fill_rstd_table(S, ssq, (LAS float*)(F.lds + RSTD_OFF));
    pg8::gemm_phase<Epi, pg8::StaticOrder, PG8_ALIGN, PG8_SP2>(F.lds + RING_OFF, g, S, E);
}
__global__ void __launch_bounds__(NWAVES * 64, 2) fwd(Args args) {
    extern __shared__ __attribute__((aligned(16))) unsigned char lds[];
    Frame F;
    F.lds = (LAS unsigned char*)lds;
    F.MISC = (volatile LAS unsigned*)(F.lds + MISC_OFF);
    F.tid = threadIdx.x; F.lane = F.tid & 63; F.wave = __builtin_amdgcn_readfirstlane(F.tid >> 6);
    F.G = gridDim.x; { const int bx = blockIdx.x; F.vcu = (F.G % 8 == 0) ? (bx % 8) * (F.G / 8) + bx / 8 : bx; }
    unsigned char* ws = args.ws;
    F.ctl = (gu32*)(ws + WS_CTL);
    for (int u = F.tid; u < (LDS_BYTES - LDSCTL_OFF) / 4; u += NWAVES * 64) ((LAS unsigned*)(F.lds + LDSCTL_OFF))[u] = 0u;
    __syncthreads();
    const int lo = args.ph_lo, hi = args.ph_hi;
    const bool use_bar = (hi - lo) > 1;
    XcdBarrier bar; bar.bar = (unsigned*)(F.ctl + CW_BAR) + args.li * XCD_BAR_WORDS; bar.x = 0; bar.st = nullptr;
    if (use_bar) bar = xcd_barrier_post((unsigned*)(F.ctl + CW_BAR) + args.li * XCD_BAR_WORDS, F.MISC + 8);
#define IN(k) (lo <= (k) && (k) < hi)
#define SEAM(k) do { if (hi > lo + 1) xcd_barrier(bar); } while (0)
#define REP(k) for (int rep_ = 0; rep_ < ((DUP_PHASE == (k)) ? 2 : 1); ++rep_)
#define DUPBAR(k) do { if (DUP_PHASE == (k) && rep_ == 0) xcd_barrier(bar); } while (0)
    bf16* const XN = (bf16*)(ws + WS_XN); bf16* const AO = (bf16*)(ws + WS_AO); bf16* const QKV = (bf16*)(ws + WS_U); bf16* const U = (bf16*)(ws + WS_U); float* const SSQH = (float*)(ws + WS_SSQH);
    float* const H = args.out;
    using pg8::EpiBf16; using pg8::EpiResNorm; (void)H; const LAS float* const RT = (const LAS float*)(F.lds + RSTD_OFF);

    if (IN(0)) { REP(0) { p0_prologue(F, args); DUPBAR(0); } SEAM(0); }
    if (IN(1)) { EpiBf16<0> E{QKV, NQKV, D, QSCALE, RT, -1, nullptr, nullptr, nullptr}; if (DUP_PHASE == 1) { run_gemm(F, XN, (const bf16*)(ws + WS_WQKV), NQKV, D, E, SSQH); xcd_barrier(bar); } run_gemm(F, XN, (const bf16*)(ws + WS_WQKV), NQKV, D, E, SSQH); SEAM(1); }
    if (IN(2)) { REP(2) { attn_phase(F, QKV, AO, (float*)(ws + WS_STASH), args.in[1], args.in[4], args.in[5], args.in[6], args.in[7]); DUPBAR(2); } SEAM(2); }
    if (IN(3)) { EpiResNorm<false> E{nullptr, XN, XN, SSQH, D, (LAS float*)(F.lds + EPIRED_OFF), nullptr};     if (DUP_PHASE == 3) { run_gemm(F, AO, (const bf16*)(ws + WS_WAO), D, D, E); xcd_barrier(bar); } run_gemm(F, AO, (const bf16*)(ws + WS_WAO), D, D, E); SEAM(4); }
    if (IN(5)) { EpiBf16<2> E{U, FF, 0, 1.f, RT, -1, nullptr, nullptr, nullptr}; if (DUP_PHASE == 5) { run_gemm(F, XN, (const bf16*)(ws + WS_W1), FF, D, E, SSQH); xcd_barrier(bar); } run_gemm(F, XN, (const bf16*)(ws + WS_W1), FF, D, E, SSQH); SEAM(5); }
    if (IN(6)) { EpiResNorm<false> E{nullptr, XN, XN, SSQH, D, (LAS float*)(F.lds + EPIRED_OFF), nullptr}; run_gemm(F, U, (const bf16*)(ws + WS_W2), D, FF, E); SEAM(7); }
    if (IN(8)) { EpiBf16<0> E{QKV, NPROJ, 0, 1.f, RT, NPROJ / 256, (float*)(ws + WS_GATES), args.in[12], args.in[13]}; if (DUP_PHASE == 8) { run_gemm(F, XN, (const bf16*)(ws + WS_WML), NPROJ + 256, D, E, SSQH); xcd_barrier(bar); } run_gemm(F, XN, (const bf16*)(ws + WS_WML), NPROJ + 256, D, E, SSQH); SEAM(8); }
    if (IN(9)) { REP(16) { convscan_phase(F, QKV, (const float*)(ws + WS_GATES), args.in[14], args.in[15], AO, (float*)(ws + WS_GS)); xcd_barrier(bar); }
        REP(9) { mlstm_phase(F, QKV, AO, (const float*)(ws + WS_GS), (bf16*)(ws + WS_HT), (float*)(ws + WS_SSQ)); DUPBAR(9); } SEAM(9); }
    if (IN(11)) { EpiResNorm<false, true> E{nullptr, XN, XN, SSQH, D, (LAS float*)(F.lds + EPIRED_OFF), (const LAS float*)(F.lds + RSTD_OFF)};
        { pg8::StaticOrder S; S.init(M, D, F.G, (int)blockIdx.x); pg8::fill_headnorm_table(S, (const float*)(ws + WS_SSQ), (LAS float*)(F.lds + RSTD_OFF)); }
        run_gemm(F, (const bf16*)(ws + WS_HT), (const bf16*)(ws + WS_WMO), D, D, E); SEAM(12); }
    if (IN(13)) { EpiBf16<2> E{U, FF, 0, 1.f, RT, -1, nullptr, nullptr, nullptr}; if (DUP_PHASE == 13) { run_gemm(F, XN, (const bf16*)(ws + WS_W1) + (size_t)D * FF, FF, D, E, SSQH); xcd_barrier(bar); } run_gemm(F, XN, (const bf16*)(ws + WS_W1) + (size_t)D * FF, FF, D, E, SSQH); SEAM(13); }
    if (IN(14)) { EpiResNorm<false> E{nullptr, XN, XN, SSQH, D, (LAS float*)(F.lds + EPIRED_OFF), nullptr}; run_gemm(F, U, (const bf16*)(ws + WS_W2) + (size_t)D * FF, D, FF, E); SEAM(14); }
    if (IN(15)) { final_norm_phase(F, XN, SSQH, args.in[21], args.out); }
#undef IN
#undef SEAM
}

extern "C" void kernel_launch(void* const* d_in, const int* in_sizes, int n_in, void* d_out, int out_size, void* d_ws, size_t ws_size, hipStream_t stream) {
    static int grid = 0;
    if (grid == 0) {
        if (n_in != 22 || in_sizes[0] != M * D || out_size != M * D || ws_size < WS_END) { fprintf(stderr, "kernel_launch: unexpected shapes (n_in %d, in0 %d, out %d, ws %zu); nothing launched\n", n_in, n_in > 0 ? in_sizes[0] : -1, out_size, ws_size); grid = -1; return; }
        int dev = 0, cus = 0, per_cu = 0;
        if (hipGetDevice(&dev) != hipSuccess || hipDeviceGetAttribute(&cus, hipDeviceAttributeMultiprocessorCount, dev) != hipSuccess) { grid = -1; return; }
        if (hipFuncSetAttribute((const void*)fwd, hipFuncAttributeMaxDynamicSharedMemorySize, LDS_BYTES) != hipSuccess) { fprintf(stderr, "kernel_launch: hipFuncSetAttribute failed\n"); grid = -1; return; }
        if (hipOccupancyMaxActiveBlocksPerMultiprocessor(&per_cu, (const void*)fwd, NWAVES * 64, LDS_BYTES) != hipSuccess || per_cu < 1) fprintf(stderr, "kernel_launch: occupancy query says %d\n", per_cu);
        (void)hipGetLastError();
        grid = cus;
    }
    if (grid < 0) return;
    (void)hipMemsetAsync((char*)d_ws + WS_CTL, 0, CTL_ZERO_BYTES, stream);
    Args a{};
    for (int i = 0; i < 22; ++i) a.in[i] = (const float*)d_in[i];
    a.out = (float*)d_out; a.ws = (unsigned char*)d_ws;
    int li = 0;
    auto run = [&](int lo, int hi) { a.ph_lo = lo; a.ph_hi = hi; a.li = li++; hipLaunchKernelGGL(fwd, dim3(grid), dim3(NWAVES * 64), LDS_BYTES, stream, a); };
    run(0, NPHASE);
}
```
